# Optimizing an MI355X kernel written in HIP

```python
import math
import jax, jax.numpy as jnp
from jax import lax
import numpy as np

D_MODEL = 2048
BATCH = 4
SEQ = 4096
DEPTH = 4

GRID_W = 64
CTX_LEN = 256
N_MIXERS = 3
N_MOD = 9
D_FF = 5504
FFN_RES = 0.5
NORM_EPS = 1e-6
ROPE_THETA = 10000.0
Q_BLOCK = 128
MLA_HEADS = 16
MLA_NOPE = 128
MLA_ROPE = 64
MLA_V = 128
MLA_Q_RANK = 512
MLA_KV_RANK = 512
HY_ORDER = 2
HY_EMB = 33
HY_BANDS = (HY_EMB - 1) // 2
HY_FILTER_W = 64
HY_SHORT = 3
HY_DECAY_TARGET = 1e-2
HY_DECAY_MIN = -math.log(HY_DECAY_TARGET) / 1.5
HY_DECAY_MAX = -math.log(HY_DECAY_TARGET) / 0.3
WIN_HEAD_DIM = 64
WIN_Q_HEADS = D_MODEL // WIN_HEAD_DIM
WIN_KV_HEADS = WIN_Q_HEADS // 8
WIN_GROUP = WIN_Q_HEADS // WIN_KV_HEADS
WINDOW = 128

kernel_name = "hybrid_mla_hyena_swa_diffusion_trunk"


def rmsnorm(h, gain):
    hf = h.astype(jnp.float32)
    y = hf * lax.rsqrt(jnp.mean(hf * hf, axis=-1, keepdims=True) + NORM_EPS)
    return (y * gain.astype(jnp.float32)).astype(h.dtype)


def modulate(h, gain, shift, scale):
    return rmsnorm(h, gain) * (1 + scale) + shift


def swiglu(h, w_gate, w_up, w_down):
    return (jax.nn.silu(h @ w_gate) * (h @ w_up)) @ w_down


def mod_slot(m, slot):
    return m[:, :, 3 * slot], m[:, :, 3 * slot + 1], m[:, :, 3 * slot + 2]


def macaron_ffn(h, m, slot, gain, w_gate, w_up, w_down):
    shift, scale, gate = mod_slot(m, slot)
    return h + FFN_RES * gate * swiglu(modulate(h, gain, shift, scale), w_gate, w_up, w_down)


def _rope_1d(x, pos):
    n = x.shape[-1] // 2
    inv = ROPE_THETA ** (-jnp.arange(n, dtype=jnp.float32) / n)
    ang = pos.astype(jnp.float32)[:, None] * inv[None, :]
    ang = ang.reshape(ang.shape[:1] + (1,) * (x.ndim - 3) + (n,))
    cos, sin = jnp.cos(ang), jnp.sin(ang)
    xf = x.astype(jnp.float32)
    x1, x2 = xf[..., :n], xf[..., n:]
    return jnp.concatenate([x1 * cos - x2 * sin, x2 * cos + x1 * sin], axis=-1).astype(x.dtype)


def axial_rope(x, rows, cols):
    half = x.shape[-1] // 2
    return jnp.concatenate([_rope_1d(x[..., :half], rows), _rope_1d(x[..., half:], cols)], axis=-1)


def softmax_attention(q, k, v, scale):
    s = jnp.einsum('bqhd,bkhd->bhqk', q, k, preferred_element_type=jnp.float32) * scale
    p = jax.nn.softmax(s, axis=-1).astype(v.dtype)
    return jnp.einsum('bhqk,bkhd->bqhd', p, v)


def blocked_attention(q, k, v, scale):
    b, t, h, d = q.shape
    qb = q.reshape(b, t // Q_BLOCK, Q_BLOCK, h, d).swapaxes(0, 1)
    ob = lax.map(lambda qi: softmax_attention(qi, k, v, scale), qb)
    return ob.swapaxes(0, 1).reshape(b, t, h, v.shape[-1])


def mla_q(h, w_dq, g_q, w_uq):
    b, t, _ = h.shape
    return (rmsnorm(h @ w_dq, g_q) @ w_uq).reshape(b, t, MLA_HEADS, MLA_NOPE + MLA_ROPE)


def mla_kv(h, w_dkv, g_kv, w_ukv):
    b, t, _ = h.shape
    a = h @ w_dkv
    c_kv = rmsnorm(a[..., :MLA_KV_RANK], g_kv)
    k_rope = a[..., MLA_KV_RANK:]
    kv = (c_kv @ w_ukv).reshape(b, t, MLA_HEADS, MLA_NOPE + MLA_V)
    return kv[..., :MLA_NOPE], k_rope, kv[..., MLA_NOPE:]


def _mla_keys(k_nope, k_rope):
    kr = jnp.broadcast_to(k_rope[:, :, None, :], k_nope.shape[:3] + (MLA_ROPE,))
    return jnp.concatenate([k_nope, kr], axis=-1)


def mla_mixer(hx, hc, rows, cols, w_dq, g_q, w_uq, w_dkv, g_kv, w_ukv, w_o, need_ctx):
    scale = (MLA_NOPE + MLA_ROPE) ** -0.5
    b, s, _ = hx.shape
    n_c = hc.shape[1]
    q_l = mla_q(hx, w_dq, g_q, w_uq)
    q_l = jnp.concatenate([q_l[..., :MLA_NOPE], axial_rope(q_l[..., MLA_NOPE:], rows, cols)], axis=-1)
    kn_l, kr_l, v_l = mla_kv(hx, w_dkv, g_kv, w_ukv)
    k_l = _mla_keys(kn_l, axial_rope(kr_l, rows, cols))
    kn_c, kr_c, v_c = mla_kv(hc, w_dkv, g_kv, w_ukv)
    k_c = _mla_keys(kn_c, kr_c)
    k_all = jnp.concatenate([k_c, k_l], axis=1)
    v_all = jnp.concatenate([v_c, v_l], axis=1)
    o_l = blocked_attention(q_l, k_all, v_all, scale).reshape(b, s, MLA_HEADS * MLA_V) @ w_o
    o_c = None
    if need_ctx:
        q_c = mla_q(hc, w_dq, g_q, w_uq)
        o_c = softmax_attention(q_c, k_c, v_c, scale).reshape(b, n_c, MLA_HEADS * MLA_V) @ w_o
    return o_l, o_c


def hyena_pos_features(L):
    t = jnp.linspace(0.0, 1.0, L, dtype=jnp.float32)[:, None]
    w = 2.0 * math.pi * jnp.arange(L, dtype=jnp.float32)[:, None] / L
    f = jnp.linspace(1e-4, HY_BANDS - 1, HY_BANDS, dtype=jnp.float32)[None, :]
    return jnp.concatenate([t, jnp.cos(f * w), -jnp.sin(f * w)], axis=-1), t


def hyena_filters(L, f_w1, f_b1, f_w2, f_b2, f_w3, f_b3, f_freq, f_w4, decay):
    z, t = hyena_pos_features(L)
    f32 = jnp.float32
    freq = f_freq.astype(f32)
    h = jnp.sin(freq * (z @ f_w1.astype(f32) + f_b1.astype(f32)))
    h = jnp.sin(freq * (h @ f_w2.astype(f32) + f_b2.astype(f32)))
    h = jnp.sin(freq * (h @ f_w3.astype(f32) + f_b3.astype(f32)))
    h = (h @ f_w4.astype(f32)) * jnp.exp(-t * jnp.abs(decay.astype(f32)))
    h = h.reshape(L, HY_ORDER, 2, D_MODEL)
    fwd, bwd = h[:, :, 0], h[:, :, 1]
    return jnp.concatenate([fwd, jnp.zeros_like(fwd[:1]), bwd[:0:-1]], axis=0)


def long_conv(z, filt, skip):
    L = z.shape[1]
    zf = jnp.fft.rfft(z.astype(jnp.float32), n=2 * L, axis=1)
    ff = jnp.fft.rfft(filt, axis=0)
    y = jnp.fft.irfft(zf * ff[None], n=2 * L, axis=1)[:, :L]
    return (y + z.astype(jnp.float32) * skip.astype(jnp.float32)).astype(z.dtype)


def hyena_seq(h, w_in, conv_w, conv_b, f_w1, f_b1, f_w2, f_b2, f_w3, f_b3, f_freq, f_w4, decay, skip, w_out):
    L = h.shape[1]
    u = h @ w_in
    pad = HY_SHORT // 2
    up = jnp.pad(u, ((0, 0), (pad, pad), (0, 0)))
    u = sum(up[:, j:j + L] * conv_w[j] for j in range(HY_SHORT)) + conv_b
    v, *gates = jnp.split(u, HY_ORDER + 1, axis=-1)
    filt = hyena_filters(L, f_w1, f_b1, f_w2, f_b2, f_w3, f_b3, f_freq, f_w4, decay)
    z = v
    for n in range(HY_ORDER):
        z = gates[n] * long_conv(z, filt[:, n], skip[n])
    return z @ w_out


def sink_softmax(s, sink):
    sk = sink.astype(jnp.float32)[None, :, :, None, None]
    m = jnp.maximum(jnp.max(s, axis=-1, keepdims=True), sk)
    e = jnp.exp(s - m)
    return e / (jnp.sum(e, axis=-1, keepdims=True) + jnp.exp(sk - m))


def window_mixer(hx, hc, rows, cols, w_qkv, sink, w_o, need_ctx):
    b, s, _ = hx.shape
    n_c = hc.shape[1]
    qw = WIN_Q_HEADS * WIN_HEAD_DIM
    kw = WIN_KV_HEADS * WIN_HEAD_DIM
    scale = WIN_HEAD_DIM ** -0.5
    sink_h = sink.reshape(WIN_KV_HEADS, WIN_GROUP)

    def split_q(a):
        return a.reshape(a.shape[0], a.shape[1], WIN_KV_HEADS, WIN_GROUP, WIN_HEAD_DIM)

    def split_h(a):
        return a.reshape(a.shape[0], a.shape[1], WIN_KV_HEADS, WIN_HEAD_DIM)

    qkv_l = hx @ w_qkv
    q_l = axial_rope(split_q(qkv_l[..., :qw]), rows, cols)
    k_l = axial_rope(split_h(qkv_l[..., qw:qw + kw]), rows, cols)
    v_l = split_h(qkv_l[..., qw + kw:])
    kv_c = hc @ w_qkv[:, qw:]
    k_c, v_c = split_h(kv_c[..., :kw]), split_h(kv_c[..., kw:])

    span = Q_BLOCK + 2 * WINDOW
    padw = ((0, 0), (WINDOW, WINDOW), (0, 0), (0, 0))
    kp, vp = jnp.pad(k_l, padw), jnp.pad(v_l, padw)
    n_blk = s // Q_BLOCK
    qb = q_l.reshape(b, n_blk, Q_BLOCK, WIN_KV_HEADS, WIN_GROUP, WIN_HEAD_DIM).swapaxes(0, 1)

    def block(args):
        i, q_i = args
        start = i * Q_BLOCK
        k_i = lax.dynamic_slice_in_dim(kp, start, span, axis=1)
        v_i = lax.dynamic_slice_in_dim(vp, start, span, axis=1)
        q_pos = start + jnp.arange(Q_BLOCK)
        k_pos = start - WINDOW + jnp.arange(span)
        ok = (jnp.abs(q_pos[:, None] - k_pos[None, :]) <= WINDOW) & (k_pos >= 0)[None, :] & (k_pos < s)[None, :]
        s_lat = jnp.einsum('bqkgd,bskd->bkgqs', q_i, k_i, preferred_element_type=jnp.float32) * scale
        s_lat = jnp.where(ok, s_lat, -jnp.inf)
        s_ctx = jnp.einsum('bqkgd,bckd->bkgqc', q_i, k_c, preferred_element_type=jnp.float32) * scale
        p = sink_softmax(jnp.concatenate([s_ctx, s_lat], axis=-1), sink_h).astype(v_i.dtype)
        return (jnp.einsum('bkgqc,bckd->bqkgd', p[..., :n_c], v_c)
                + jnp.einsum('bkgqs,bskd->bqkgd', p[..., n_c:], v_i))

    ob = lax.map(block, (jnp.arange(n_blk), qb))
    o_l = ob.swapaxes(0, 1).reshape(b, s, qw) @ w_o
    o_c = None
    if need_ctx:
        q_c = split_q(hc @ w_qkv[:, :qw])
        s_c = jnp.einsum('bqkgd,bckd->bkgqc', q_c, k_c, preferred_element_type=jnp.float32) * scale
        p_c = sink_softmax(s_c, sink_h).astype(v_c.dtype)
        o_c = jnp.einsum('bkgqc,bckd->bqkgd', p_c, v_c).reshape(b, n_c, qw) @ w_o
    return o_l, o_c


def setup_inputs(seed: int = 0) -> dict:
    key = jax.random.key(seed)
    ks = iter(jax.random.split(key, 64))
    f32 = jnp.float32

    def nrm(shape, fan_in, gain=1.0):
        return jax.random.normal(next(ks), shape, f32) * (gain * fan_in ** -0.5)

    def near_one(shape):
        return 1.0 + 0.05 * jax.random.normal(next(ks), shape, f32)

    def small(shape):
        return 0.02 * jax.random.normal(next(ks), shape, f32)

    n_a = len(range(0, DEPTH, N_MIXERS))
    n_b = len(range(1, DEPTH, N_MIXERS))
    n_c = len(range(2, DEPTH, N_MIXERS))
    D = D_MODEL
    qw = WIN_Q_HEADS * WIN_HEAD_DIM
    kw = WIN_KV_HEADS * WIN_HEAD_DIM
    return {
        "x": jax.random.normal(next(ks), (BATCH, SEQ, D), f32),
        "c": jax.random.normal(next(ks), (BATCH, D), f32),
        "ctx": jax.random.normal(next(ks), (BATCH, CTX_LEN, D), f32),
        "c_ctx": jax.random.normal(next(ks), (D,), f32),
        "mod_w": nrm((DEPTH, D, N_MOD * D), D, 0.5),
        "mod_b": small((DEPTH, N_MOD * D)),
        "norm_g": near_one((DEPTH, 3, D)),
        "final_g": near_one((D,)),
        "ffn_wg": nrm((DEPTH, 2, D, D_FF), D),
        "ffn_wu": nrm((DEPTH, 2, D, D_FF), D),
        "ffn_wd": nrm((DEPTH, 2, D_FF, D), D_FF),
        "mla_w_dq": nrm((n_a, D, MLA_Q_RANK), D),
        "mla_g_q": near_one((n_a, MLA_Q_RANK)),
        "mla_w_uq": nrm((n_a, MLA_Q_RANK, MLA_HEADS * (MLA_NOPE + MLA_ROPE)), MLA_Q_RANK),
        "mla_w_dkv": nrm((n_a, D, MLA_KV_RANK + MLA_ROPE), D),
        "mla_g_kv": near_one((n_a, MLA_KV_RANK)),
        "mla_w_ukv": nrm((n_a, MLA_KV_RANK, MLA_HEADS * (MLA_NOPE + MLA_V)), MLA_KV_RANK),
        "mla_w_o": nrm((n_a, MLA_HEADS * MLA_V, D), MLA_HEADS * MLA_V),
        "hy_w_in": nrm((n_b, D, (HY_ORDER + 1) * D), D),
        "hy_conv_w": nrm((n_b, HY_SHORT, (HY_ORDER + 1) * D), HY_SHORT),
        "hy_conv_b": small((n_b, (HY_ORDER + 1) * D)),
        "hy_f_w1": nrm((n_b, HY_EMB, HY_FILTER_W), HY_EMB),
        "hy_f_b1": small((n_b, HY_FILTER_W)),
        "hy_f_w2": nrm((n_b, HY_FILTER_W, HY_FILTER_W), HY_FILTER_W),
        "hy_f_b2": small((n_b, HY_FILTER_W)),
        "hy_f_w3": nrm((n_b, HY_FILTER_W, HY_FILTER_W), HY_FILTER_W),
        "hy_f_b3": small((n_b, HY_FILTER_W)),
        "hy_f_freq": near_one((n_b, HY_FILTER_W)),
        "hy_f_w4": nrm((n_b, HY_FILTER_W, HY_ORDER * 2 * D), HY_FILTER_W, 0.02),
        "hy_decay": jax.random.uniform(next(ks), (n_b, HY_ORDER * 2 * D), f32, HY_DECAY_MIN, HY_DECAY_MAX),
        "hy_skip": jax.random.normal(next(ks), (n_b, HY_ORDER, D), f32),
        "hy_w_out": nrm((n_b, D, D), D),
        "win_w_qkv": nrm((n_c, D, qw + 2 * kw), D),
        "win_sink": jax.random.normal(next(ks), (n_c, WIN_Q_HEADS), f32),
        "win_w_o": nrm((n_c, qw, D), qw),
    }


def reference(x, c, ctx, c_ctx, mod_w, mod_b, norm_g, final_g, ffn_wg, ffn_wu, ffn_wd,
              mla_w_dq, mla_g_q, mla_w_uq, mla_w_dkv, mla_g_kv, mla_w_ukv, mla_w_o,
              hy_w_in, hy_conv_w, hy_conv_b, hy_f_w1, hy_f_b1, hy_f_w2, hy_f_b2, hy_f_w3, hy_f_b3,
              hy_f_freq, hy_f_w4, hy_decay, hy_skip, hy_w_out,
              win_w_qkv, win_sink, win_w_o):
    b, s, d = x.shape
    n_rows = s // GRID_W
    rows = jnp.repeat(jnp.arange(n_rows, dtype=jnp.int32), GRID_W)
    cols = jnp.arange(n_rows * GRID_W, dtype=jnp.int32) % GRID_W
    sc = jax.nn.silu(c)
    scc = jax.nn.silu(c_ctx)
    for i in range(DEPTH):
        kind, j = i % N_MIXERS, i // N_MIXERS
        need_ctx = i < DEPTH - 1
        ctx_live = need_ctx or kind != 1
        ml = (sc @ mod_w[i] + mod_b[i]).reshape(b, 1, N_MOD, d)
        x = macaron_ffn(x, ml, 0, norm_g[i, 0], ffn_wg[i, 0], ffn_wu[i, 0], ffn_wd[i, 0])
        sh, scl, gt = mod_slot(ml, 1)
        hx = modulate(x, norm_g[i, 1], sh, scl)
        hc = None
        if ctx_live:
            mc = (scc @ mod_w[i] + mod_b[i]).reshape(1, 1, N_MOD, d)
            ctx = macaron_ffn(ctx, mc, 0, norm_g[i, 0], ffn_wg[i, 0], ffn_wu[i, 0], ffn_wd[i, 0])
            shc, sclc, gtc = mod_slot(mc, 1)
            hc = modulate(ctx, norm_g[i, 1], shc, sclc)
        if kind == 0:
            o_l, o_c = mla_mixer(hx, hc, rows, cols, mla_w_dq[j], mla_g_q[j], mla_w_uq[j],
                                 mla_w_dkv[j], mla_g_kv[j], mla_w_ukv[j], mla_w_o[j], need_ctx)
        elif kind == 1:
            hp = (hy_w_in[j], hy_conv_w[j], hy_conv_b[j], hy_f_w1[j], hy_f_b1[j], hy_f_w2[j], hy_f_b2[j],
                  hy_f_w3[j], hy_f_b3[j], hy_f_freq[j], hy_f_w4[j], hy_decay[j], hy_skip[j], hy_w_out[j])
            o_l = hyena_seq(hx, *hp)
            o_c = hyena_seq(hc, *hp) if need_ctx else None
        else:
            o_l, o_c = window_mixer(hx, hc, rows, cols, win_w_qkv[j], win_sink[j], win_w_o[j], need_ctx)
        x = x + gt * o_l
        x = macaron_ffn(x, ml, 2, norm_g[i, 2], ffn_wg[i, 1], ffn_wu[i, 1], ffn_wd[i, 1])
        if need_ctx:
            ctx = ctx + gtc * o_c
            ctx = macaron_ffn(ctx, mc, 2, norm_g[i, 2], ffn_wg[i, 1], ffn_wu[i, 1], ffn_wd[i, 1])
    return rmsnorm(x, final_g)
```

```cpp
#include <hip/hip_runtime.h>
#include <cstdio>
#include <cstdint>
#include <cmath>

namespace {
typedef unsigned short u16;
constexpr int D = 2048, NB = 4, S = 4096, CTX = 256, SB = S + CTX, R = NB * SB, DFF = 5504, NMODV = 9 * D, DEPTH = 4;
constexpr int QKVA_LD = 1280;
constexpr float NORM_EPS = 1e-6f;

constexpr size_t al(size_t x) { return (x + 255) / 256 * 256; }
constexpr size_t WS_CTL = 0;
constexpr size_t WS_X = 1u << 20;
constexpr size_t WS_HB = WS_X + al((size_t)R * D * 4);
constexpr size_t WS_ACT = WS_HB + al((size_t)R * D * 2);
constexpr size_t WS_MODP = WS_ACT + al((size_t)R * DFF * 2);
constexpr size_t WS_MOD = WS_MODP + al((size_t)16 * DEPTH * 5 * NMODV * 4);
constexpr size_t WS_ROPE = WS_MOD + al((size_t)DEPTH * 5 * NMODV * 4);
constexpr size_t WS_TW = WS_ROPE + al(64 * 16 * 2 * 4);
constexpr size_t WS_FT4096 = WS_TW + al(8192 * 8);
constexpr size_t WS_FT256 = WS_FT4096 + al((size_t)8192 * 4096 * 4);
constexpr size_t WS_MIX = WS_FT256 + al((size_t)8192 * 256 * 4);
constexpr size_t WS_QKVA = WS_MIX;
constexpr size_t WS_QL = WS_QKVA + al((size_t)R * QKVA_LD * 4);
constexpr size_t WS_CKV = WS_QL + al((size_t)R * 512 * 2);
constexpr size_t WS_KR = WS_CKV + al((size_t)R * 512 * 2);
constexpr size_t WS_Q = WS_KR + al((size_t)R * 64 * 2);
constexpr size_t WS_KN = WS_Q + al((size_t)R * 3072 * 2);
constexpr size_t WS_V = WS_KN + al((size_t)R * D * 2);
constexpr size_t WS_O = WS_V + al((size_t)R * D * 2);
constexpr size_t WS_MLA_END = WS_O + al((size_t)R * D * 2);
constexpr size_t WS_UT = WS_MIX;
constexpr size_t WS_ZT = WS_UT + al((size_t)3 * D * R * 4);
constexpr size_t WS_HY_END = WS_ZT + al((size_t)D * R * 2);
constexpr size_t WS_QKV = WS_MIX;
constexpr size_t WS_WO = WS_QKV + al((size_t)R * 2560 * 2);
constexpr size_t WS_WIN_END = WS_WO + al((size_t)R * D * 2);
constexpr size_t WS_END = (WS_MLA_END > WS_HY_END ? (WS_MLA_END > WS_WIN_END ? WS_MLA_END : WS_WIN_END) : (WS_HY_END > WS_WIN_END ? WS_HY_END : WS_WIN_END));
static_assert(WS_END < 2000000000ull, "workspace map exceeds the guaranteed size");

__device__ __forceinline__ float bf2f(u16 b) { return __uint_as_float(((unsigned)b) << 16); }
__device__ __forceinline__ u16 f2bf(float f) { unsigned u = __float_as_uint(f); u += 0x7fffu + ((u >> 16) & 1u); return (u16)(u >> 16); }
__device__ __forceinline__ unsigned pk2(float lo, float hi) { return (unsigned)f2bf(lo) | ((unsigned)f2bf(hi) << 16); }
__device__ __forceinline__ float wave_sum(float v) {
#pragma unroll
    for (int o = 1; o < 64; o <<= 1) v += __shfl_xor(v, o);
    return v;
}
__device__ __forceinline__ float wave_max(float v) {
#pragma unroll
    for (int o = 1; o < 64; o <<= 1) v = fmaxf(v, __shfl_xor(v, o));
    return v;
}
__device__ __forceinline__ int modidx_of_row(int r) { const int b = r / SB, j = r - b * SB; return j < CTX ? 4 : b; }
__device__ __forceinline__ float silu_f(float x) { return x / (1.f + expf(-x)); }

struct Ptrs {
    const float* in[35];
    float* out;
    unsigned char* ws;
};
enum { I_X = 0, I_C, I_CTX, I_CCTX, I_MODW, I_MODB, I_NORMG, I_FINALG, I_WG, I_WU, I_WD, I_DQ, I_GQ, I_UQ, I_DKV, I_GKV, I_UKV, I_MWO,
       I_HWIN, I_HCW, I_HCB, I_FW1, I_FB1, I_FW2, I_FB2, I_FW3, I_FB3, I_FFREQ, I_FW4, I_DECAY, I_SKIP, I_HWOUT, I_WQKV, I_SINK, I_WWO };

__global__ __launch_bounds__(256) void k_assemble(Ptrs p) {
    float4* X = (float4*)(p.ws + WS_X);
    const size_t n = (size_t)R * D / 4;
    for (size_t i = (size_t)blockIdx.x * 256 + threadIdx.x; i < n; i += (size_t)gridDim.x * 256) {
        const int r = (int)(i / (D / 4)), c4 = (int)(i % (D / 4));
        const int b = r / SB, j = r - b * SB;
        const float4* src = j < CTX ? (const float4*)(p.in[I_CTX] + ((size_t)b * CTX + j) * D) : (const float4*)(p.in[I_X] + ((size_t)b * S + (j - CTX)) * D);
        X[i] = src[c4];
    }
}
__global__ __launch_bounds__(512) void k_modp(Ptrs p) {
    __shared__ float sc[5][D];
    for (int i = threadIdx.x; i < 5 * D; i += 512) { const int m = i / D, k = i % D; const float v = m < 4 ? p.in[I_C][m * D + k] : p.in[I_CCTX][k]; sc[m][k] = silu_f(v); }
    __syncthreads();
    const int wave = threadIdx.x >> 6, lane = threadIdx.x & 63;
    float* MODP = (float*)(p.ws + WS_MODP);
    const int nitems = DEPTH * 72 * 16;
    for (int item = blockIdx.x * 8 + wave; item < nitems; item += gridDim.x * 8) {
        const int kc = item % 16, cg = (item / 16) % 72, layer = item / (16 * 72);
        const int col = cg * 256 + lane * 4;
        const float* w = p.in[I_MODW] + (size_t)layer * D * NMODV + (size_t)(kc * 128) * NMODV + col;
        float acc[5][4];
#pragma unroll
        for (int m = 0; m < 5; ++m) { acc[m][0] = acc[m][1] = acc[m][2] = acc[m][3] = 0.f; }
#pragma unroll 4
        for (int k = 0; k < 128; ++k) {
            const float4 wv = *(const float4*)(w + (size_t)k * NMODV);
#pragma unroll
            for (int m = 0; m < 5; ++m) { const float s = sc[m][kc * 128 + k]; acc[m][0] += s * wv.x; acc[m][1] += s * wv.y; acc[m][2] += s * wv.z; acc[m][3] += s * wv.w; }
        }
#pragma unroll
        for (int m = 0; m < 5; ++m) *(float4*)(MODP + ((size_t)(kc * DEPTH + layer) * 5 + m) * NMODV + col) = make_float4(acc[m][0], acc[m][1], acc[m][2], acc[m][3]);
    }
}
__global__ __launch_bounds__(256) void k_modr(Ptrs p) {
    const float* MODP = (const float*)(p.ws + WS_MODP); float* MOD = (float*)(p.ws + WS_MOD);
    const int n = DEPTH * 5 * NMODV;
    for (int i = blockIdx.x * 256 + threadIdx.x; i < n; i += gridDim.x * 256) {
        const int col = i % NMODV, layer = i / (5 * NMODV);
        float s = p.in[I_MODB][layer * NMODV + col];
        for (int kc = 0; kc < 16; ++kc) s += MODP[(size_t)kc * n + i];
        MOD[i] = s;
    }
}
__global__ __launch_bounds__(256) void k_tables(Ptrs p) {
    float* rope = (float*)(p.ws + WS_ROPE); float* tw = (float*)(p.ws + WS_TW);
    const int i = blockIdx.x * 256 + threadIdx.x;
    if (i < 64 * 16) { const int pos = i / 16, k = i % 16; const float inv = (float)exp2(-(double)k / 16.0 * 13.287712379549449); const float ang = (float)pos * inv;
        rope[2 * i] = (float)cos((double)ang); rope[2 * i + 1] = (float)sin((double)ang); }
    if (i < 8192) { const double a = -2.0 * 3.14159265358979323846 * (double)i / 8192.0; tw[2 * i] = (float)cos(a); tw[2 * i + 1] = (float)sin(a); }
}
__global__ __launch_bounds__(512) void k_modulate(Ptrs p, int layer, int slot) {
    const float* X = (const float*)(p.ws + WS_X); u16* HB = (u16*)(p.ws + WS_HB); const float* MOD = (const float*)(p.ws + WS_MOD);
    const float* g = p.in[I_NORMG] + ((size_t)layer * 3 + slot) * D;
    const int wave = threadIdx.x >> 6, lane = threadIdx.x & 63;
    for (int r = blockIdx.x * 8 + wave; r < R; r += gridDim.x * 8) {
        const float4* xr = (const float4*)(X + (size_t)r * D);
        float4 v[8]; float ss = 0.f;
#pragma unroll
        for (int i = 0; i < 8; ++i) { v[i] = xr[lane + 64 * i]; ss += v[i].x * v[i].x + v[i].y * v[i].y + v[i].z * v[i].z + v[i].w * v[i].w; }
        const float rs = rsqrtf(wave_sum(ss) * (1.f / D) + NORM_EPS);
        const float* mb = MOD + ((size_t)(layer * 5 + modidx_of_row(r)) * 9 + 3 * slot) * D;
        uint2* o = (uint2*)(HB + (size_t)r * D);
#pragma unroll
        for (int i = 0; i < 8; ++i) { const int c4 = lane + 64 * i; const float4 gg = ((const float4*)g)[c4], sh = ((const float4*)mb)[c4], sl = ((const float4*)(mb + D))[c4];
            const float a = v[i].x * rs * gg.x * (1.f + sl.x) + sh.x, b = v[i].y * rs * gg.y * (1.f + sl.y) + sh.y, c = v[i].z * rs * gg.z * (1.f + sl.z) + sh.z, d = v[i].w * rs * gg.w * (1.f + sl.w) + sh.w;
            o[c4] = make_uint2(pk2(a, b), pk2(c, d)); }
    }
}
__global__ __launch_bounds__(512) void k_final(Ptrs p) {
    const float* X = (const float*)(p.ws + WS_X); const float* g = p.in[I_FINALG];
    const int wave = threadIdx.x >> 6, lane = threadIdx.x & 63;
    for (int q = blockIdx.x * 8 + wave; q < NB * S; q += gridDim.x * 8) {
        const int b = q / S, t = q - b * S, r = b * SB + CTX + t;
        const float4* xr = (const float4*)(X + (size_t)r * D);
        float4 v[8]; float ss = 0.f;
#pragma unroll
        for (int i = 0; i < 8; ++i) { v[i] = xr[lane + 64 * i]; ss += v[i].x * v[i].x + v[i].y * v[i].y + v[i].z * v[i].z + v[i].w * v[i].w; }
        const float rs = rsqrtf(wave_sum(ss) * (1.f / D) + NORM_EPS);
        float4* o = (float4*)(p.out + (size_t)q * D);
#pragma unroll
        for (int i = 0; i < 8; ++i) { const int c4 = lane + 64 * i; const float4 gg = ((const float4*)g)[c4]; o[c4] = make_float4(v[i].x * rs * gg.x, v[i].y * rs * gg.y, v[i].z * rs * gg.z, v[i].w * rs * gg.w); }
    }
}
__global__ __launch_bounds__(512) void k_mla_norm(Ptrs p, int jm) {
    const float* A = (const float*)(p.ws + WS_QKVA); u16* QL = (u16*)(p.ws + WS_QL); u16* CKV = (u16*)(p.ws + WS_CKV); u16* KR = (u16*)(p.ws + WS_KR);
    const float* gq = p.in[I_GQ] + jm * 512; const float* gkv = p.in[I_GKV] + jm * 512; const float* rope = (const float*)(p.ws + WS_ROPE);
    const int wave = threadIdx.x >> 6, lane = threadIdx.x & 63;
    for (int r = blockIdx.x * 8 + wave; r < R; r += gridDim.x * 8) {
        const float* a = A + (size_t)r * QKVA_LD;
        const float4 q0 = ((const float4*)a)[lane * 2], q1 = ((const float4*)a)[lane * 2 + 1];
        const float4 k0 = ((const float4*)(a + 512))[lane * 2], k1 = ((const float4*)(a + 512))[lane * 2 + 1];
        const float sq = wave_sum(q0.x * q0.x + q0.y * q0.y + q0.z * q0.z + q0.w * q0.w + q1.x * q1.x + q1.y * q1.y + q1.z * q1.z + q1.w * q1.w);
        const float sk = wave_sum(k0.x * k0.x + k0.y * k0.y + k0.z * k0.z + k0.w * k0.w + k1.x * k1.x + k1.y * k1.y + k1.z * k1.z + k1.w * k1.w);
        const float rq = rsqrtf(sq * (1.f / 512) + NORM_EPS), rk = rsqrtf(sk * (1.f / 512) + NORM_EPS);
        const float4 g0 = ((const float4*)gq)[lane * 2], g1 = ((const float4*)gq)[lane * 2 + 1], h0 = ((const float4*)gkv)[lane * 2], h1 = ((const float4*)gkv)[lane * 2 + 1];
        uint4 oq, ok;
        oq.x = pk2(q0.x * rq * g0.x, q0.y * rq * g0.y); oq.y = pk2(q0.z * rq * g0.z, q0.w * rq * g0.w); oq.z = pk2(q1.x * rq * g1.x, q1.y * rq * g1.y); oq.w = pk2(q1.z * rq * g1.z, q1.w * rq * g1.w);
        ok.x = pk2(k0.x * rk * h0.x, k0.y * rk * h0.y); ok.y = pk2(k0.z * rk * h0.z, k0.w * rk * h0.w); ok.z = pk2(k1.x * rk * h1.x, k1.y * rk * h1.y); ok.w = pk2(k1.z * rk * h1.z, k1.w * rk * h1.w);
        ((uint4*)(QL + (size_t)r * 512))[lane] = oq; ((uint4*)(CKV + (size_t)r * 512))[lane] = ok;
        if (lane < 32) {
            const int b = r / SB, j = r - b * SB; const int half = lane >> 4, i = lane & 15;
            const float x1 = a[1024 + 32 * half + i], x2 = a[1024 + 32 * half + 16 + i];
            float o1 = x1, o2 = x2;
            if (j >= CTX) { const int t = j - CTX, pos = half ? (t & 63) : (t >> 6); const float cs = rope[(pos * 16 + i) * 2], sn = rope[(pos * 16 + i) * 2 + 1]; o1 = x1 * cs - x2 * sn; o2 = x2 * cs + x1 * sn; }
            KR[(size_t)r * 64 + 32 * half + i] = f2bf(o1); KR[(size_t)r * 64 + 32 * half + 16 + i] = f2bf(o2);
        }
    }
}
__global__ __launch_bounds__(256) void k_rope(u16* buf, int ld, int nheads, int hstride, int roff, const float* rope) {
    const size_t n = (size_t)R * nheads * 32;
    for (size_t idx = (size_t)blockIdx.x * 256 + threadIdx.x; idx < n; idx += (size_t)gridDim.x * 256) {
        const int e = (int)(idx % 32), hh = (int)((idx / 32) % nheads), r = (int)(idx / (32 * (size_t)nheads));
        const int b = r / SB, j = r - b * SB; if (j < CTX) continue;
        const int t = j - CTX, half = e >> 4, i = e & 15, pos = half ? (t & 63) : (t >> 6);
        u16* x = buf + (size_t)r * ld + hh * hstride + roff + 32 * half + i;
        const float x1 = bf2f(x[0]), x2 = bf2f(x[16]), cs = rope[(pos * 16 + i) * 2], sn = rope[(pos * 16 + i) * 2 + 1];
        x[0] = f2bf(x1 * cs - x2 * sn); x[16] = f2bf(x2 * cs + x1 * sn);
    }
}
__global__ __launch_bounds__(256) void k_transpose(const u16* __restrict__ ZT, u16* __restrict__ Z) {
    __shared__ u16 tile[64][66];
    const int r0 = blockIdx.x * 64, d0 = blockIdx.y * 64, tx = threadIdx.x & 63, ty = threadIdx.x >> 6;
    for (int i = ty; i < 64; i += 4) tile[i][tx] = ZT[(size_t)(d0 + i) * R + r0 + tx];
    __syncthreads();
    for (int i = ty; i < 64; i += 4) Z[(size_t)(r0 + i) * D + d0 + tx] = tile[tx][i];
}
template <int L> __global__ __launch_bounds__(512) void k_filters(Ptrs p, float* FT) {
    __shared__ float zf[16][33]; __shared__ float ha[16][64]; __shared__ float hb[16][64]; __shared__ float h3t[64][16]; __shared__ float tp[16];
    const int tid = threadIdx.x, l0 = blockIdx.x * 16;
    for (int idx = tid; idx < 16 * 33; idx += 512) { const int pp = idx / 33, c = idx % 33, l = l0 + pp; const float t = (float)l / (float)(L - 1);
        float v;
        if (c == 0) { v = t; tp[pp] = t; }
        else { const int k = (c - 1) & 15; const float f = 1e-4f + (float)k * ((15.0f - 1e-4f) / 15.0f); const float w = 6.283185307179586f * (float)l / (float)L; const double a = (double)(f * w);
            v = c <= 16 ? (float)cos(a) : (float)(-sin(a)); }
        zf[pp][c] = v; }
    __syncthreads();
    const float* w1 = p.in[I_FW1]; const float* b1 = p.in[I_FB1]; const float* w2 = p.in[I_FW2]; const float* b2 = p.in[I_FB2]; const float* w3 = p.in[I_FW3]; const float* b3 = p.in[I_FB3]; const float* fr = p.in[I_FFREQ];
    for (int idx = tid; idx < 1024; idx += 512) { const int pp = idx >> 6, j = idx & 63; float s = b1[j]; for (int c = 0; c < 33; ++c) s += zf[pp][c] * w1[c * 64 + j]; ha[pp][j] = sinf(fr[j] * s); }
    __syncthreads();
    for (int idx = tid; idx < 1024; idx += 512) { const int pp = idx >> 6, j = idx & 63; float s = b2[j]; for (int c = 0; c < 64; ++c) s += ha[pp][c] * w2[c * 64 + j]; hb[pp][j] = sinf(fr[j] * s); }
    __syncthreads();
    for (int idx = tid; idx < 1024; idx += 512) { const int pp = idx >> 6, j = idx & 63; float s = b3[j]; for (int c = 0; c < 64; ++c) s += hb[pp][c] * w3[c * 64 + j]; h3t[j][pp] = sinf(fr[j] * s); }
    __syncthreads();
    const float* w4 = p.in[I_FW4]; const float* decay = p.in[I_DECAY];
    for (int m = 0; m < 16; ++m) {
        const int n = tid + 512 * m; float acc[16];
#pragma unroll
        for (int q = 0; q < 16; ++q) acc[q] = 0.f;
        for (int k = 0; k < 64; ++k) { const float wv = w4[(size_t)k * 8192 + n];
#pragma unroll
            for (int q = 0; q < 16; ++q) acc[q] += h3t[k][q] * wv; }
        const float dc = fabsf(decay[n]); float* o = FT + (size_t)n * L + l0;
#pragma unroll
        for (int q = 0; q < 16; ++q) o[q] = acc[q] * expf(-tp[q] * dc);
    }
}

template <class Epi, bool DUAL>
__global__ __launch_bounds__(256) void k_ngemm(const u16* __restrict__ A, int lda, const float* __restrict__ B0, const float* __restrict__ B1, int ldb, int K, Epi E) {
    __shared__ float As[16][132]; __shared__ float Bs0[16][64]; __shared__ float Bs1[DUAL ? 16 : 1][64];
    const int t = threadIdx.x, ty = t >> 4, tx = t & 15, m0 = blockIdx.y * 128, n0 = blockIdx.x * 64;
    float acc0[8][4], acc1[8][4];
#pragma unroll
    for (int i = 0; i < 8; ++i)
#pragma unroll
        for (int j = 0; j < 4; ++j) { acc0[i][j] = 0.f; acc1[i][j] = 0.f; }
    const int ar = t >> 1, ak = (t & 1) * 8, bk = t >> 4, bc = (t & 15) * 4;
    for (int k0 = 0; k0 < K; k0 += 16) {
        const uint4 av = *(const uint4*)(A + (size_t)(m0 + ar) * lda + k0 + ak);
        const float4 b0 = *(const float4*)(B0 + (size_t)(k0 + bk) * ldb + n0 + bc);
        float4 b1 = make_float4(0.f, 0.f, 0.f, 0.f); if (DUAL) b1 = *(const float4*)(B1 + (size_t)(k0 + bk) * ldb + n0 + bc);
        __syncthreads();
        As[ak + 0][ar] = __uint_as_float(av.x << 16); As[ak + 1][ar] = __uint_as_float(av.x & 0xffff0000u); As[ak + 2][ar] = __uint_as_float(av.y << 16); As[ak + 3][ar] = __uint_as_float(av.y & 0xffff0000u);
        As[ak + 4][ar] = __uint_as_float(av.z << 16); As[ak + 5][ar] = __uint_as_float(av.z & 0xffff0000u); As[ak + 6][ar] = __uint_as_float(av.w << 16); As[ak + 7][ar] = __uint_as_float(av.w & 0xffff0000u);
        *(float4*)&Bs0[bk][bc] = b0; if (DUAL) *(float4*)&Bs1[bk][bc] = b1;
        __syncthreads();
#pragma unroll
        for (int kk = 0; kk < 16; ++kk) {
            const float4 a0 = *(const float4*)&As[kk][ty * 8], a1 = *(const float4*)&As[kk][ty * 8 + 4]; const float a[8] = {a0.x, a0.y, a0.z, a0.w, a1.x, a1.y, a1.z, a1.w};
            const float4 bb = *(const float4*)&Bs0[kk][tx * 4]; const float b[4] = {bb.x, bb.y, bb.z, bb.w};
#pragma unroll
            for (int i = 0; i < 8; ++i)
#pragma unroll
                for (int j = 0; j < 4; ++j) acc0[i][j] += a[i] * b[j];
            if (DUAL) { const float4 cc = *(const float4*)&Bs1[kk][tx * 4]; const float c[4] = {cc.x, cc.y, cc.z, cc.w};
#pragma unroll
                for (int i = 0; i < 8; ++i)
#pragma unroll
                    for (int j = 0; j < 4; ++j) acc1[i][j] += a[i] * c[j]; }
        }
    }
#pragma unroll
    for (int i = 0; i < 8; ++i) E(m0 + ty * 8 + i, n0 + tx * 4, acc0[i], acc1[i]);
}
struct NE_SwiGLU { u16* act; __device__ void operator()(int row, int col, const float (&g)[4], const float (&u)[4]) const {
    uint2 o; o.x = pk2(silu_f(g[0]) * u[0], silu_f(g[1]) * u[1]); o.y = pk2(silu_f(g[2]) * u[2], silu_f(g[3]) * u[3]); *(uint2*)(act + (size_t)row * DFF + col) = o; } };
struct NE_ResGate { float* X; const float* modl; int slot; float coef;
    __device__ void operator()(int row, int col, const float (&v)[4], const float (&)[4]) const {
        const float4 g = *(const float4*)(modl + ((size_t)modidx_of_row(row) * 9 + 3 * slot + 2) * D + col); float4* x = (float4*)(X + (size_t)row * D + col); float4 o = *x;
        o.x += coef * g.x * v[0]; o.y += coef * g.y * v[1]; o.z += coef * g.z * v[2]; o.w += coef * g.w * v[3]; *x = o; } };
struct NE_F32 { float* C; int ldc, coff; __device__ void operator()(int row, int col, const float (&v)[4], const float (&)[4]) const { *(float4*)(C + (size_t)row * ldc + coff + col) = make_float4(v[0], v[1], v[2], v[3]); } };
struct NE_F32T { float* C; __device__ void operator()(int row, int col, const float (&v)[4], const float (&)[4]) const {
#pragma unroll
    for (int j = 0; j < 4; ++j) C[(size_t)(col + j) * R + row] = v[j]; } };
struct NE_Bf16 { u16* C; int ldc; __device__ void operator()(int row, int col, const float (&v)[4], const float (&)[4]) const { *(uint2*)(C + (size_t)row * ldc + col) = make_uint2(pk2(v[0], v[1]), pk2(v[2], v[3])); } };
struct NE_KV { u16* KN; u16* V; __device__ void operator()(int row, int col, const float (&v)[4], const float (&)[4]) const {
    const int h = col >> 8, c = col & 255; u16* dst = (c < 128 ? KN : V) + (size_t)row * D + h * 128 + (c & 127); *(uint2*)dst = make_uint2(pk2(v[0], v[1]), pk2(v[2], v[3])); } };

__global__ __launch_bounds__(128) void k_nattn_mla(const u16* __restrict__ Q, const u16* __restrict__ KN, const u16* __restrict__ KR, const u16* __restrict__ V, u16* __restrict__ O) {
    __shared__ float ps[2][SB]; __shared__ float qs[2][192];
    const int wave = threadIdx.x >> 6, lane = threadIdx.x & 63;
    const int item = blockIdx.x * 2 + wave; const int r = item >> 4, h = item & 15;
    const int b = r / SB, j = r - b * SB, nk = j < CTX ? CTX : SB, kb = b * SB;
    float* pp = ps[wave]; float* qq = qs[wave];
    for (int c = lane; c < 192; c += 64) qq[c] = bf2f(Q[(size_t)r * 3072 + h * 192 + c]);
    __syncthreads();
    const float scale = 0.07216878364870322f;
    float mx = -3.0e38f;
    for (int key = lane; key < nk; key += 64) {
        const uint4* kn = (const uint4*)(KN + (size_t)(kb + key) * D + h * 128); const uint4* kr = (const uint4*)(KR + (size_t)(kb + key) * 64);
        float s = 0.f;
#pragma unroll 4
        for (int c8 = 0; c8 < 24; ++c8) { const uint4 w = c8 < 16 ? kn[c8] : kr[c8 - 16]; const float* q8 = qq + c8 * 8;
            s += q8[0] * __uint_as_float(w.x << 16) + q8[1] * __uint_as_float(w.x & 0xffff0000u) + q8[2] * __uint_as_float(w.y << 16) + q8[3] * __uint_as_float(w.y & 0xffff0000u)
               + q8[4] * __uint_as_float(w.z << 16) + q8[5] * __uint_as_float(w.z & 0xffff0000u) + q8[6] * __uint_as_float(w.w << 16) + q8[7] * __uint_as_float(w.w & 0xffff0000u); }
        s *= scale; pp[key] = s; mx = fmaxf(mx, s);
    }
    mx = wave_max(mx);
    float sum = 0.f;
    for (int key = lane; key < nk; key += 64) { const float e = expf(pp[key] - mx); pp[key] = e; sum += e; }
    sum = wave_sum(sum);
    __syncthreads();
    float o0 = 0.f, o1 = 0.f;
    const u16* vb = V + (size_t)kb * D + h * 128 + lane;
    for (int key = 0; key < nk; ++key) { const float pv = pp[key]; o0 += pv * bf2f(vb[(size_t)key * D]); o1 += pv * bf2f(vb[(size_t)key * D + 64]); }
    const float inv = 1.f / sum;
    O[(size_t)r * D + h * 128 + lane] = f2bf(o0 * inv); O[(size_t)r * D + h * 128 + 64 + lane] = f2bf(o1 * inv);
}
__global__ __launch_bounds__(256) void k_nattn_win(const u16* __restrict__ QKV, const float* __restrict__ sink, u16* __restrict__ O) {
    __shared__ float ps[4][576]; __shared__ float qs[4][64];
    const int wave = threadIdx.x >> 6, lane = threadIdx.x & 63;
    const int item = blockIdx.x * 4 + wave; const int r = item >> 5, qh = item & 31, kvh = qh >> 3;
    const int b = r / SB, j = r - b * SB, kb = b * SB;
    float* pp = ps[wave]; float* qq = qs[wave];
    qq[lane] = bf2f(QKV[(size_t)r * 2560 + qh * 64 + lane]);
    __syncthreads();
    int lo = 0, nwin = 0; if (j >= CTX) { const int t = j - CTX; lo = t - 128 < 0 ? 0 : t - 128; const int hi = t + 128 > S - 1 ? S - 1 : t + 128; nwin = hi - lo + 1; }
    const int nk = CTX + nwin;
    float mx = sink[qh];
    for (int key = lane; key < nk; key += 64) {
        const int krow = kb + (key < CTX ? key : CTX + lo + (key - CTX));
        const uint4* kk = (const uint4*)(QKV + (size_t)krow * 2560 + 2048 + kvh * 64);
        float s = 0.f;
#pragma unroll
        for (int c8 = 0; c8 < 8; ++c8) { const uint4 w = kk[c8]; const float* q8 = qq + c8 * 8;
            s += q8[0] * __uint_as_float(w.x << 16) + q8[1] * __uint_as_float(w.x & 0xffff0000u) + q8[2] * __uint_as_float(w.y << 16) + q8[3] * __uint_as_float(w.y & 0xffff0000u)
               + q8[4] * __uint_as_float(w.z << 16) + q8[5] * __uint_as_float(w.z & 0xffff0000u) + q8[6] * __uint_as_float(w.w << 16) + q8[7] * __uint_as_float(w.w & 0xffff0000u); }
        s *= 0.125f; pp[key] = s; mx = fmaxf(mx, s);
    }
    mx = wave_max(mx);
    float sum = 0.f;
    for (int key = lane; key < nk; key += 64) { const float e = expf(pp[key] - mx); pp[key] = e; sum += e; }
    sum = wave_sum(sum) + expf(sink[qh] - mx);
    __syncthreads();
    float o = 0.f;
    for (int key = 0; key < nk; ++key) { const int krow = kb + (key < CTX ? key : CTX + lo + (key - CTX)); o += pp[key] * bf2f(QKV[(size_t)krow * 2560 + 2304 + kvh * 64 + lane]); }
    O[(size_t)r * D + qh * 64 + lane] = f2bf(o / sum);
}
template <int L, int NT> __global__ __launch_bounds__(NT) void k_nhyena(Ptrs p, const float* __restrict__ FT) {
    __shared__ float z[L]; __shared__ float f2[2 * L];
    constexpr int PER = L / NT;
    const float* UT = (const float*)(p.ws + WS_UT); u16* ZT = (u16*)(p.ws + WS_ZT);
    const float* cw = p.in[I_HCW]; const float* cb = p.in[I_HCB]; const float* skip = p.in[I_SKIP];
    const int b = blockIdx.x / D, d = blockIdx.x % D, rb = b * SB + (L == S ? CTX : 0), tid = threadIdx.x;
    auto sconv = [&](int ch, int t) { const float* u = UT + (size_t)ch * R + rb; const float um = t > 0 ? u[t - 1] : 0.f, u0 = u[t], up = t < L - 1 ? u[t + 1] : 0.f;
        return um * cw[ch] + u0 * cw[3 * D + ch] + up * cw[6 * D + ch] + cb[ch]; };
    float zc[PER];
#pragma unroll
    for (int i = 0; i < PER; ++i) zc[i] = sconv(d, tid + NT * i);
    for (int n = 0; n < 2; ++n) {
        __syncthreads();
#pragma unroll
        for (int i = 0; i < PER; ++i) z[tid + NT * i] = zc[i];
        const float* ff = FT + (size_t)(n * 4096 + d) * L; const float* fb = FT + (size_t)(n * 4096 + 2048 + d) * L;
        for (int idx = tid; idx < 2 * L; idx += NT) { const int lag = idx - L; f2[idx] = lag >= 0 ? ff[lag] : (lag > -L ? fb[-lag] : 0.f); }
        __syncthreads();
        float y[PER];
#pragma unroll
        for (int i = 0; i < PER; ++i) y[i] = 0.f;
        for (int s = 0; s < L; ++s) { const float zs = z[s];
#pragma unroll
            for (int i = 0; i < PER; ++i) y[i] += f2[L + tid + NT * i - s] * zs; }
        const float sk = skip[n * D + d];
#pragma unroll
        for (int i = 0; i < PER; ++i) zc[i] = sconv((n + 1) * D + d, tid + NT * i) * (y[i] + zc[i] * sk);
    }
#pragma unroll
    for (int i = 0; i < PER; ++i) ZT[(size_t)d * R + rb + tid + NT * i] = f2bf(zc[i]);
}
}

extern "C" void kernel_launch(void* const* d_in, const int* in_sizes, int n_in, void* d_out, int out_size, void* d_ws, size_t ws_size, hipStream_t stream) {
    if (n_in != 35 || ws_size < WS_END || out_size != NB * S * D) { fprintf(stderr, "kernel_launch: unexpected shapes (n_in %d, ws %zu need %zu, out %d)\n", n_in, ws_size, (size_t)WS_END, out_size); return; }
    Ptrs p{}; for (int i = 0; i < 35; ++i) p.in[i] = (const float*)d_in[i]; p.out = (float*)d_out; p.ws = (unsigned char*)d_ws;
    unsigned char* ws = p.ws;
    float* X = (float*)(ws + WS_X); u16* HB = (u16*)(ws + WS_HB); u16* ACT = (u16*)(ws + WS_ACT); const float* MOD = (const float*)(ws + WS_MOD); const float* rope = (const float*)(ws + WS_ROPE);
    k_assemble<<<2048, 256, 0, stream>>>(p);
    k_modp<<<256, 512, 0, stream>>>(p);
    k_modr<<<512, 256, 0, stream>>>(p);
    k_tables<<<32, 256, 0, stream>>>(p);
    k_filters<4096><<<4096 / 16, 512, 0, stream>>>(p, (float*)(ws + WS_FT4096));
    k_filters<256><<<256 / 16, 512, 0, stream>>>(p, (float*)(ws + WS_FT256));
    auto ffn = [&](int layer, int f) {
        const int slot = f == 0 ? 0 : 2;
        k_modulate<<<512, 512, 0, stream>>>(p, layer, slot);
        const size_t wo = (size_t)(layer * 2 + f) * D * DFF;
        k_ngemm<NE_SwiGLU, true><<<dim3(DFF / 64, R / 128), 256, 0, stream>>>(HB, D, p.in[I_WG] + wo, p.in[I_WU] + wo, DFF, D, NE_SwiGLU{ACT});
        k_ngemm<NE_ResGate, false><<<dim3(D / 64, R / 128), 256, 0, stream>>>(ACT, DFF, p.in[I_WD] + wo, nullptr, D, DFF, NE_ResGate{X, MOD + (size_t)layer * 5 * 9 * D, slot, 0.5f});
    };
    for (int layer = 0; layer < DEPTH; ++layer) {
        const int kind = layer % 3, jm = layer / 3;
        ffn(layer, 0);
        k_modulate<<<512, 512, 0, stream>>>(p, layer, 1);
        const NE_ResGate mixres{X, MOD + (size_t)layer * 5 * 9 * D, 1, 1.0f};
        if (kind == 0) {
            float* QKVA = (float*)(ws + WS_QKVA); u16* QL = (u16*)(ws + WS_QL); u16* CKV = (u16*)(ws + WS_CKV); u16* KR = (u16*)(ws + WS_KR); u16* Q = (u16*)(ws + WS_Q); u16* KN = (u16*)(ws + WS_KN); u16* V = (u16*)(ws + WS_V); u16* O = (u16*)(ws + WS_O);
            k_ngemm<NE_F32, false><<<dim3(512 / 64, R / 128), 256, 0, stream>>>(HB, D, p.in[I_DQ] + (size_t)jm * D * 512, nullptr, 512, D, NE_F32{QKVA, QKVA_LD, 0});
            k_ngemm<NE_F32, false><<<dim3(576 / 64, R / 128), 256, 0, stream>>>(HB, D, p.in[I_DKV] + (size_t)jm * D * 576, nullptr, 576, D, NE_F32{QKVA, QKVA_LD, 512});
            k_mla_norm<<<512, 512, 0, stream>>>(p, jm);
            k_ngemm<NE_Bf16, false><<<dim3(3072 / 64, R / 128), 256, 0, stream>>>(QL, 512, p.in[I_UQ] + (size_t)jm * 512 * 3072, nullptr, 3072, 512, NE_Bf16{Q, 3072});
            k_rope<<<2048, 256, 0, stream>>>(Q, 3072, 16, 192, 128, rope);
            k_ngemm<NE_KV, false><<<dim3(4096 / 64, R / 128), 256, 0, stream>>>(CKV, 512, p.in[I_UKV] + (size_t)jm * 512 * 4096, nullptr, 4096, 512, NE_KV{KN, V});
            k_nattn_mla<<<R * 16 / 2, 128, 0, stream>>>(Q, KN, KR, V, O);
            k_ngemm<NE_ResGate, false><<<dim3(D / 64, R / 128), 256, 0, stream>>>(O, D, p.in[I_MWO] + (size_t)jm * D * D, nullptr, D, D, mixres);
        } else if (kind == 1) {
            float* UT = (float*)(ws + WS_UT); u16* ZT = (u16*)(ws + WS_ZT);
            k_ngemm<NE_F32T, false><<<dim3(3 * D / 64, R / 128), 256, 0, stream>>>(HB, D, p.in[I_HWIN], nullptr, 3 * D, D, NE_F32T{UT});
            k_nhyena<4096, 512><<<NB * D, 512, 0, stream>>>(p, (const float*)(ws + WS_FT4096));
            k_nhyena<256, 256><<<NB * D, 256, 0, stream>>>(p, (const float*)(ws + WS_FT256));
            k_transpose<<<dim3(R / 64, D / 64), 256, 0, stream>>>(ZT, HB);
            k_ngemm<NE_ResGate, false><<<dim3(D / 64, R / 128), 256, 0, stream>>>(HB, D, p.in[I_HWOUT], nullptr, D, D, mixres);
        } else {
            u16* QKV = (u16*)(ws + WS_QKV); u16* O = (u16*)(ws + WS_WO);
            k_ngemm<NE_Bf16, false><<<dim3(2560 / 64, R / 128), 256, 0, stream>>>(HB, D, p.in[I_WQKV], nullptr, 2560, D, NE_Bf16{QKV, 2560});
            k_rope<<<2048, 256, 0, stream>>>(QKV, 2560, 36, 64, 0, rope);
            k_nattn_win<<<R * 32 / 4, 256, 0, stream>>>(QKV, p.in[I_SINK], O);
            k_ngemm<NE_ResGate, false><<<dim3(D / 64, R / 128), 256, 0, stream>>>(O, D, p.in[I_WWO], nullptr, D, D, mixres);
        }
        ffn(layer, 1);
    }
    k_final<<<512, 512, 0, stream>>>(p);
}
```

```cpp
#include <hip/hip_runtime.h>
#include <cstdio>
#include <cstdint>
#include <cmath>

namespace {
typedef unsigned short u16;
constexpr int D = 2048, NB = 4, S = 4096, CTX = 256, SB = S + CTX, R = NB * SB, DFF = 5504, NMODV = 9 * D, DEPTH = 4;
constexpr int QKVA_LD = 1280;
constexpr float NORM_EPS = 1e-6f;

constexpr size_t al(size_t x) { return (x + 255) / 256 * 256; }
constexpr size_t WS_CTL = 0;
constexpr size_t WS_X = 1u << 20;
constexpr size_t WS_HB = WS_X + al((size_t)R * D * 4);
constexpr size_t WS_ACT = WS_HB + al((size_t)R * D * 2);
constexpr size_t WS_MODP = WS_ACT + al((size_t)R * DFF * 2);
constexpr size_t WS_MOD = WS_MODP + al((size_t)16 * DEPTH * 5 * NMODV * 4);
constexpr size_t WS_ROPE = WS_MOD + al((size_t)DEPTH * 5 * NMODV * 4);
constexpr size_t WS_TW = WS_ROPE + al(64 * 16 * 2 * 4);
constexpr size_t WS_FT4096 = WS_TW + al(8192 * 8);
constexpr size_t WS_FT256 = WS_FT4096 + al((size_t)8192 * 4096 * 4);
constexpr size_t WS_MIX = WS_FT256 + al((size_t)8192 * 256 * 4);
constexpr size_t WS_QKVA = WS_MIX;
constexpr size_t WS_QL = WS_QKVA + al((size_t)R * QKVA_LD * 4);
constexpr size_t WS_CKV = WS_QL + al((size_t)R * 512 * 2);
constexpr size_t WS_KR = WS_CKV + al((size_t)R * 512 * 2);
constexpr size_t WS_Q = WS_KR + al((size_t)R * 64 * 2);
constexpr size_t WS_KN = WS_Q + al((size_t)R * 3072 * 2);
constexpr size_t WS_V = WS_KN + al((size_t)R * D * 2);
constexpr size_t WS_O = WS_V + al((size_t)R * D * 2);
constexpr size_t WS_MLA_END = WS_O + al((size_t)R * D * 2);
constexpr size_t WS_UT = WS_MIX;
constexpr size_t WS_ZT = WS_UT + al((size_t)3 * D * R * 4);
constexpr size_t WS_HY_END = WS_ZT + al((size_t)D * R * 2);
constexpr size_t WS_QKV = WS_MIX;
constexpr size_t WS_WO = WS_QKV + al((size_t)R * 2560 * 2);
constexpr size_t WS_WIN_END = WS_WO + al((size_t)R * D * 2);
constexpr size_t WS_END = (WS_MLA_END > WS_HY_END ? (WS_MLA_END > WS_WIN_END ? WS_MLA_END : WS_WIN_END) : (WS_HY_END > WS_WIN_END ? WS_HY_END : WS_WIN_END));
constexpr size_t SZ_WGU = (size_t)2 * DFF * D * 2, SZ_WD = (size_t)D * DFF * 2;
constexpr size_t WS_WGU = al(WS_END);
constexpr size_t WS_WD = WS_WGU + 8 * SZ_WGU;
constexpr size_t WS_WDQKV = WS_WD + 8 * SZ_WD;
constexpr size_t WS_WUQ = WS_WDQKV + 2 * (size_t)QKVA_LD * D * 2;
constexpr size_t WS_WUKV = WS_WUQ + 2 * (size_t)3072 * 512 * 2;
constexpr size_t WS_WMO = WS_WUKV + 2 * (size_t)4096 * 512 * 2;
constexpr size_t WS_WHIN = WS_WMO + 2 * (size_t)D * D * 2;
constexpr size_t WS_WHOUT = WS_WHIN + (size_t)3 * D * D * 2;
constexpr size_t WS_WWQKV = WS_WHOUT + (size_t)D * D * 2;
constexpr size_t WS_WWO = WS_WWQKV + (size_t)2560 * D * 2;
constexpr size_t WS_TOTAL = WS_WWO + (size_t)D * D * 2;
static_assert(WS_TOTAL < 2000000000ull, "workspace map exceeds the guaranteed size");

__device__ __forceinline__ float bf2f(u16 b) { return __uint_as_float(((unsigned)b) << 16); }
__device__ __forceinline__ u16 f2bf(float f) { unsigned u = __float_as_uint(f); u += 0x7fffu + ((u >> 16) & 1u); return (u16)(u >> 16); }
__device__ __forceinline__ unsigned pk2(float lo, float hi) { return (unsigned)f2bf(lo) | ((unsigned)f2bf(hi) << 16); }
__device__ __forceinline__ float wave_sum(float v) {
#pragma unroll
    for (int o = 1; o < 64; o <<= 1) v += __shfl_xor(v, o);
    return v;
}
__device__ __forceinline__ float wave_max(float v) {
#pragma unroll
    for (int o = 1; o < 64; o <<= 1) v = fmaxf(v, __shfl_xor(v, o));
    return v;
}
__device__ __forceinline__ int modidx_of_row(int r) { const int b = r / SB, j = r - b * SB; return j < CTX ? 4 : b; }
__device__ __forceinline__ float silu_f(float x) { return x / (1.f + expf(-x)); }

struct Ptrs {
    const float* in[35];
    float* out;
    unsigned char* ws;
};
enum { I_X = 0, I_C, I_CTX, I_CCTX, I_MODW, I_MODB, I_NORMG, I_FINALG, I_WG, I_WU, I_WD, I_DQ, I_GQ, I_UQ, I_DKV, I_GKV, I_UKV, I_MWO,
       I_HWIN, I_HCW, I_HCB, I_FW1, I_FB1, I_FW2, I_FB2, I_FW3, I_FB3, I_FFREQ, I_FW4, I_DECAY, I_SKIP, I_HWOUT, I_WQKV, I_SINK, I_WWO };


}

namespace pg8 {
#define PG8_LAS __attribute__((address_space(3)))
typedef unsigned short bf16_t;
typedef short bf16x8 __attribute__((ext_vector_type(8)));
typedef float f32x4 __attribute__((ext_vector_type(4)));
typedef unsigned u32x4 __attribute__((ext_vector_type(4)));
constexpr int BM = 256, BK = 64, HALF = 128, HTB = HALF * BK * 2  , STAGE_BYTES = 8 * HTB, NXCD = 8, WGM = 8;

__host__ __device__ __forceinline__ int lds_byte(int r, int c) { const int st = (r >> 4) * 2 + (c >> 5), rr = r & 15, cc = c & 31, ob = rr * 64 + cc * 2; return st * 1024 + (ob ^ (((ob >> 9) & 1) << 5)); }
__host__ __device__ __forceinline__ void stage_rc(int b, int& R, int& C) { const int st = b / 1024, sb = b % 1024, swz = sb ^ (((sb >> 9) & 1) << 5); R = (st >> 1) * 16 + swz / 64; C = (st & 1) * 32 + (swz % 64) / 2; }
__host__ __device__ __forceinline__ int perm32(int rho) { const int n = rho >> 4, i = rho & 15; return 8 * (i >> 2) + 4 * n + (i & 3); }

struct Unit { int pm, pn; };
struct Gemm { const bf16_t* A; const bf16_t* Bt; int M, N, K; };

struct StaticOrder {
    int nM, nN, nwg, G, c;
    __host__ __device__ void init(int M, int N, int G_, int c_) { nM = M / BM; nN = N / BM; nwg = nM * nN; G = G_; c = c_; }
    __host__ __device__ bool next(int i, Unit& u) const {
        const long L = (long)i * G + c; if (L >= nwg) return false;
        int wgid = (int)L; { const int q = nwg / NXCD, r = nwg % NXCD, xcd = wgid % NXCD, off = wgid / NXCD; wgid = (xcd < r ? xcd * (q + 1) : r * (q + 1) + (xcd - r) * q) + off; }
        const int nig = WGM * nN, gid = wgid / nig, fm = gid * WGM, gsz = (nM - fm) < WGM ? (nM - fm) : WGM;
        u.pm = fm + ((wgid % nig) % gsz); u.pn = (wgid % nig) / gsz; return true;
    }
    __device__ __forceinline__ void a_ready(const Unit&) const {}
    __device__ __forceinline__ void done(const Unit&) const {}
};


__device__ __forceinline__ unsigned cvt_pk_bf16(float lo, float hi) { unsigned r; asm volatile("v_cvt_pk_bf16_f32 %0, %1, %2" : "=v"(r) : "v"(lo), "v"(hi)); return r; }
typedef float f32x2 __attribute__((ext_vector_type(2)));

struct EpiF32 {
    static constexpr bool PERM = false, AFTER_DRAIN = false;
    float* C; int ldc;
    __device__ __forceinline__ void operator()(const f32x4 (&acc)[2][2][4][2], const Unit& u, int wr, int wc, int fr, int fq) const {
        const int row0 = u.pm * BM + wr * 64 + fr, col0 = u.pn * BM + wc * 32 + 4 * fq;
#pragma unroll
        for (int ai = 0; ai < 2; ++ai)
#pragma unroll
            for (int m = 0; m < 4; ++m) { float* rowp = C + (size_t)(row0 + ai * HALF + m * 16) * ldc + col0;
#pragma unroll
                for (int bj = 0; bj < 2; ++bj)
#pragma unroll
                    for (int n = 0; n < 2; ++n) *(f32x4*)(rowp + bj * HALF + n * 16) = acc[ai][bj][m][n]; }
    }
};
__device__ __forceinline__ float silu_fast(float g) { return g * __builtin_amdgcn_rcpf(1.f + __builtin_amdgcn_exp2f(-1.4426950408889634f * g)); }
struct EpiSwiGLU {
    static constexpr bool PERM = true, AFTER_DRAIN = false;
    bf16_t* act;
    __device__ __forceinline__ void operator()(const f32x4 (&acc)[2][2][4][2], const Unit& u, int wr, int wc, int fr, int fq) const {
        const int row0 = u.pm * BM + wr * 64 + fr, col0 = u.pn * HALF + wc * 32 + 8 * fq;
#pragma unroll
        for (int ai = 0; ai < 2; ++ai)
#pragma unroll
            for (int m = 0; m < 4; ++m) { const f32x4 g0 = acc[ai][0][m][0], g1 = acc[ai][0][m][1], u0 = acc[ai][1][m][0], u1 = acc[ai][1][m][1];
                u32x4 w; w.x = cvt_pk_bf16(silu_fast(g0[0]) * u0[0], silu_fast(g0[1]) * u0[1]); w.y = cvt_pk_bf16(silu_fast(g0[2]) * u0[2], silu_fast(g0[3]) * u0[3]);
                w.z = cvt_pk_bf16(silu_fast(g1[0]) * u1[0], silu_fast(g1[1]) * u1[1]); w.w = cvt_pk_bf16(silu_fast(g1[2]) * u1[2], silu_fast(g1[3]) * u1[3]);
                *(u32x4*)(act + (size_t)(row0 + ai * HALF + m * 16) * DFF + col0) = w; }
    }
};
struct EpiResGate {
    static constexpr bool PERM = false, AFTER_DRAIN = false;
    float* X; const float* modl; int slot; float coef;
    __device__ __forceinline__ void operator()(const f32x4 (&acc)[2][2][4][2], const Unit& u, int wr, int wc, int fr, int fq) const {
        const int row0 = u.pm * BM + wr * 64 + fr, col0 = u.pn * BM + wc * 32 + 4 * fq;
        const int q = u.pm % 17, midx = q == 0 ? 4 : u.pm / 17;
        const float* gp = modl + ((size_t)midx * 9 + 3 * slot + 2) * D + col0;
        f32x4 gv[2][2];
#pragma unroll
        for (int bj = 0; bj < 2; ++bj)
#pragma unroll
            for (int n = 0; n < 2; ++n) gv[bj][n] = *(const f32x4*)(gp + bj * HALF + n * 16) * coef;
#pragma unroll
        for (int ai = 0; ai < 2; ++ai)
#pragma unroll
            for (int m = 0; m < 4; ++m) { float* rowp = X + (size_t)(row0 + ai * HALF + m * 16) * D + col0;
#pragma unroll
                for (int bj = 0; bj < 2; ++bj)
#pragma unroll
                    for (int n = 0; n < 2; ++n) { f32x4* px = (f32x4*)(rowp + bj * HALF + n * 16); *px = *px + gv[bj][n] * acc[ai][bj][m][n]; } }
    }
};
struct EpiKV {
    static constexpr bool PERM = true, AFTER_DRAIN = false;
    bf16_t* KN; bf16_t* V;
    __device__ __forceinline__ void operator()(const f32x4 (&acc)[2][2][4][2], const Unit& u, int wr, int wc, int fr, int fq) const {
        const int row0 = u.pm * BM + wr * 64 + fr, col0 = u.pn * HALF + wc * 32 + 8 * fq;
#pragma unroll
        for (int ai = 0; ai < 2; ++ai)
#pragma unroll
            for (int m = 0; m < 4; ++m)
#pragma unroll
                for (int bj = 0; bj < 2; ++bj) { const f32x4 v0 = acc[ai][bj][m][0], v1 = acc[ai][bj][m][1];
                    u32x4 w; w.x = cvt_pk_bf16(v0[0], v0[1]); w.y = cvt_pk_bf16(v0[2], v0[3]); w.z = cvt_pk_bf16(v1[0], v1[1]); w.w = cvt_pk_bf16(v1[2], v1[3]);
                    *(u32x4*)((bj ? V : KN) + (size_t)(row0 + ai * HALF + m * 16) * D + col0) = w; }
    }
};
template <int MODE> struct EpiRope {
    static constexpr bool PERM = false, AFTER_DRAIN = false;
    bf16_t* C; int ldc; const float* rope;
    __device__ __forceinline__ void operator()(const f32x4 (&acc)[2][2][4][2], const Unit& u, int wr, int wc, int fr, int fq) const {
        typedef unsigned u32x2 __attribute__((ext_vector_type(2)));
        const int row0 = u.pm * BM + wr * 64 + fr, col0 = u.pn * BM + wc * 32 + 4 * fq;
        const int q = u.pm % 17; const bool isctx = q == 0; const int t0 = (q - 1) * 256 + wr * 64 + fr;
#pragma unroll
        for (int bj = 0; bj < 2; ++bj) {
            const int g32 = 8 * u.pn + 4 * bj + wc; int ty;
            if (MODE == 0) { const int gi = g32 % 6; ty = gi == 4 ? 1 : (gi == 5 ? 2 : 0); } else { ty = g32 < 72 ? 1 + (g32 & 1) : 0; }
            if (isctx) ty = 0;
#pragma unroll
            for (int ai = 0; ai < 2; ++ai)
#pragma unroll
                for (int m = 0; m < 4; ++m) { f32x4 x1 = acc[ai][bj][m][0], x2 = acc[ai][bj][m][1];
                    if (ty) { const int t = t0 + ai * HALF + m * 16, pos = ty == 1 ? (t >> 6) : (t & 63); const f32x4* rp = (const f32x4*)(rope + (size_t)(pos * 16 + 4 * fq) * 2); const f32x4 r0 = rp[0], r1 = rp[1];
                        const f32x4 cs = {r0[0], r0[2], r1[0], r1[2]}, sn = {r0[1], r0[3], r1[1], r1[3]}; const f32x4 o1 = x1 * cs - x2 * sn, o2 = x2 * cs + x1 * sn; x1 = o1; x2 = o2; }
                    bf16_t* rowp = C + (size_t)(row0 + ai * HALF + m * 16) * ldc + col0 + bj * HALF;
                    u32x2 w0, w1; w0.x = cvt_pk_bf16(x1[0], x1[1]); w0.y = cvt_pk_bf16(x1[2], x1[3]); w1.x = cvt_pk_bf16(x2[0], x2[1]); w1.y = cvt_pk_bf16(x2[2], x2[3]);
                    *(u32x2*)rowp = w0; *(u32x2*)(rowp + 16) = w1; }
        }
    }
};

template <class Epi, class Sched, bool ALIGN_EPI = false, bool SP2 = false>
__device__ __forceinline__ void gemm_phase(PG8_LAS unsigned char* lds, const Gemm g, const Sched& S, const Epi& E) {
    int tid_ = threadIdx.x; asm volatile("" : "+v"(tid_));
    const int tid = tid_, wid = __builtin_amdgcn_readfirstlane(tid >> 6), lane = tid & 63, wr = wid >> 2, wc = wid & 3, fr = lane & 15, fq = lane >> 4;
    const int K = g.K, nt = K / BK;
    unsigned voffA[2], voffB[2];
#pragma unroll
    for (int i = 0; i < 2; ++i) { int R, C; stage_rc(tid * 16 + i * 8192, R, C); const int Rb = Epi::PERM ? ((R & ~31) + perm32(R & 31)) : R;
        voffA[i] = (unsigned)(R * K + C) * 2u; voffB[i] = (unsigned)(Rb * K + C) * 2u; }
    const size_t kstep = (size_t)(BK * 2);
    const size_t hstep = (size_t)HALF * K * 2;
    const size_t tstep = 2 * hstep;
    const unsigned ldsw = (unsigned)wid * 1024u;
    const int aoff = lds_byte(wr * 64 + fr, fq * 8), boff = lds_byte(wc * 32 + fr, fq * 8);
#define PG8_SA(b, h) (((b) * 2 + (h)) * HTB)
#define PG8_SB(b, h) ((4 + (b) * 2 + (h)) * HTB)
#define PG8_STAGE(bufoff, gbase, voff) do { _Pragma("unroll") for (int _i = 0; _i < 2; ++_i) \
        __builtin_amdgcn_global_load_lds((const unsigned*)((const char*)(gbase) + (voff)[_i]), (PG8_LAS unsigned*)(lds + (bufoff) + ldsw + _i * 8192), 16, 0, 0); } while (0)
#define PG8_LDA(dst, b, h) do { _Pragma("unroll") for (int m = 0; m < 4; ++m) _Pragma("unroll") for (int k = 0; k < 2; ++k) dst[m][k] = *(const PG8_LAS bf16x8*)(lds + PG8_SA(b, h) + aoff + m * 2048 + k * 1024); } while (0)
#define PG8_LDB(dst, b, h) do { _Pragma("unroll") for (int n = 0; n < 2; ++n) _Pragma("unroll") for (int k = 0; k < 2; ++k) dst[n][k] = *(const PG8_LAS bf16x8*)(lds + PG8_SB(b, h) + boff + n * 2048 + k * 1024); } while (0)
#define PG8_MMA(ai, bj, At, Bt) do { __builtin_amdgcn_s_setprio(1); _Pragma("unroll") for (int m = 0; m < 4; ++m) _Pragma("unroll") for (int n = 0; n < 2; ++n) _Pragma("unroll") for (int k = 0; k < 2; ++k) \
        acc[ai][bj][m][n] = __builtin_amdgcn_mfma_f32_16x16x32_bf16(Bt[n][k], At[m][k], acc[ai][bj][m][n], 0, 0, 0); __builtin_amdgcn_s_setprio(0); } while (0)
#define PG8_WAIT_V(n) asm volatile("s_waitcnt vmcnt(" #n ")" ::: "memory")
#define PG8_WAIT_L(n) asm volatile("s_waitcnt lgkmcnt(" #n ")" ::: "memory")
#define PG8_BAR __builtin_amdgcn_s_barrier()
#define PG8_SCHED __builtin_amdgcn_sched_barrier(0)
    Unit cur, nxt; int ui = 0;
    if (!S.next(0, cur)) return;
    f32x4 acc[2][2][4][2];
#pragma unroll
    for (int a = 0; a < 2; ++a)
#pragma unroll
        for (int b = 0; b < 2; ++b)
#pragma unroll
            for (int m = 0; m < 4; ++m)
#pragma unroll
                for (int n = 0; n < 2; ++n) acc[a][b][m][n] = (f32x4){0.f, 0.f, 0.f, 0.f};
    bf16x8 At[4][2], B0[2][2], B1[2][2];
    const char* cA = (const char*)g.A + (size_t)cur.pm * tstep; const char* cB = (const char*)g.Bt + (size_t)cur.pn * tstep;
    S.a_ready(cur);
    if constexpr (SP2) {
        PG8_STAGE(PG8_SB(0, 0), cB, voffB); PG8_STAGE(PG8_SB(0, 1), cB + hstep, voffB); PG8_STAGE(PG8_SA(0, 0), cA, voffA); PG8_STAGE(PG8_SA(0, 1), cA + hstep, voffA);
        if (wr == 1) PG8_BAR;
        PG8_WAIT_V(2); PG8_BAR;
        PG8_STAGE(PG8_SB(1, 0), cB + kstep, voffB); PG8_STAGE(PG8_SA(1, 0), cA + kstep, voffA); PG8_STAGE(PG8_SB(1, 1), cB + hstep + kstep, voffB);
        PG8_WAIT_V(6); PG8_BAR;
    } else {
        PG8_STAGE(PG8_SB(0, 0), cB, voffB); PG8_STAGE(PG8_SA(0, 0), cA, voffA); PG8_STAGE(PG8_SB(0, 1), cB + hstep, voffB); PG8_STAGE(PG8_SA(0, 1), cA + hstep, voffA);
        if (wr == 1) PG8_BAR;
        PG8_WAIT_V(4); PG8_BAR;
        PG8_STAGE(PG8_SB(1, 0), cB + kstep, voffB); PG8_STAGE(PG8_SA(1, 0), cA + kstep, voffA); PG8_STAGE(PG8_SB(1, 1), cB + hstep + kstep, voffB);
        PG8_WAIT_V(6); PG8_BAR;
    }
    for (;;) {
        const bool has_next = S.next(ui + 1, nxt);
        const char* nA = has_next ? (const char*)g.A + (size_t)nxt.pm * tstep : cA; const char* nB = has_next ? (const char*)g.Bt + (size_t)nxt.pn * tstep : cB;
        for (int t = 0; t < nt; t += 2) {
            const bool last = (t == nt - 2);
            const char* a1 = cA + (size_t)(t + 1) * kstep;
            const char* a2 = last ? nA : cA + (size_t)(t + 2) * kstep; const char* b2 = last ? nB : cB + (size_t)(t + 2) * kstep;
            const char* a3 = a2 + kstep; const char* b3 = b2 + kstep;
            if (last && has_next) S.a_ready(nxt);
            if constexpr (SP2) {
            PG8_LDB(B0, 0, 0); PG8_LDB(B1, 0, 1); PG8_SCHED; PG8_LDA(At, 0, 0); PG8_STAGE(PG8_SA(1, 1), a1 + hstep, voffA);
            PG8_WAIT_V(8); PG8_WAIT_L(0); PG8_BAR; PG8_MMA(0, 0, At, B0); PG8_MMA(0, 1, At, B1); PG8_BAR; PG8_SCHED;
            PG8_LDA(At, 0, 1); PG8_STAGE(PG8_SB(0, 0), b2, voffB); PG8_STAGE(PG8_SB(0, 1), b2 + hstep, voffB); PG8_STAGE(PG8_SA(0, 0), a2, voffA);
            PG8_WAIT_V(8); PG8_WAIT_L(0); PG8_BAR; PG8_MMA(1, 0, At, B0); PG8_MMA(1, 1, At, B1); PG8_BAR; PG8_SCHED;
            PG8_LDB(B0, 1, 0); PG8_LDB(B1, 1, 1); PG8_SCHED; PG8_LDA(At, 1, 0); PG8_STAGE(PG8_SA(0, 1), a2 + hstep, voffA);
            PG8_WAIT_V(8); PG8_WAIT_L(0); PG8_BAR; PG8_MMA(0, 0, At, B0); PG8_MMA(0, 1, At, B1); PG8_BAR; PG8_SCHED;
            PG8_LDA(At, 1, 1); PG8_STAGE(PG8_SB(1, 0), b3, voffB); PG8_STAGE(PG8_SB(1, 1), b3 + hstep, voffB); PG8_STAGE(PG8_SA(1, 0), a3, voffA);
            PG8_WAIT_V(8); PG8_WAIT_L(0); PG8_BAR; PG8_MMA(1, 0, At, B0); PG8_MMA(1, 1, At, B1); PG8_BAR; PG8_SCHED;
            } else {
            PG8_LDB(B0, 0, 0); PG8_SCHED; PG8_LDA(At, 0, 0); PG8_STAGE(PG8_SA(1, 1), a1 + hstep, voffA);
            PG8_WAIT_L(8); PG8_BAR; PG8_WAIT_L(0); PG8_MMA(0, 0, At, B0); PG8_BAR; PG8_SCHED;
            PG8_LDB(B1, 0, 1); PG8_STAGE(PG8_SB(0, 0), b2, voffB);
            PG8_BAR; PG8_WAIT_L(0); PG8_MMA(0, 1, At, B1); PG8_BAR;
            PG8_LDA(At, 0, 1); PG8_STAGE(PG8_SA(0, 0), a2, voffA);
            PG8_BAR; PG8_WAIT_L(0); PG8_MMA(1, 0, At, B0); PG8_BAR; PG8_SCHED;
            PG8_STAGE(PG8_SB(0, 1), b2 + hstep, voffB);
            PG8_WAIT_V(6); PG8_BAR; PG8_MMA(1, 1, At, B1); PG8_BAR;
            PG8_LDB(B0, 1, 0); PG8_SCHED; PG8_LDA(At, 1, 0); PG8_STAGE(PG8_SA(0, 1), a2 + hstep, voffA);
            PG8_WAIT_L(8); PG8_BAR; PG8_WAIT_L(0); PG8_MMA(0, 0, At, B0); PG8_BAR; PG8_SCHED;
            PG8_LDB(B1, 1, 1); PG8_STAGE(PG8_SB(1, 0), b3, voffB);
            PG8_BAR; PG8_WAIT_L(0); PG8_MMA(0, 1, At, B1); PG8_BAR;
            PG8_LDA(At, 1, 1); PG8_STAGE(PG8_SA(1, 0), a3, voffA);
            PG8_BAR; PG8_WAIT_L(0); PG8_MMA(1, 0, At, B0); PG8_BAR; PG8_SCHED;
            PG8_STAGE(PG8_SB(1, 1), b3 + hstep, voffB);
            PG8_WAIT_V(6); PG8_BAR; PG8_MMA(1, 1, At, B1); PG8_BAR;
            }
        }
        if constexpr (ALIGN_EPI) { if (wr == 0) PG8_BAR; }
        if constexpr (!Epi::AFTER_DRAIN) { E(acc, cur, wr, wc, fr, fq); S.done(cur); }
        if (!has_next) break;
#pragma unroll
        for (int a = 0; a < 2; ++a)
#pragma unroll
            for (int b = 0; b < 2; ++b)
#pragma unroll
                for (int m = 0; m < 4; ++m)
#pragma unroll
                    for (int n = 0; n < 2; ++n) acc[a][b][m][n] = (f32x4){0.f, 0.f, 0.f, 0.f};
        cur = nxt; cA = nA; cB = nB; ++ui;
        if constexpr (ALIGN_EPI) { if (wr == 1) PG8_BAR; }
    }
    PG8_WAIT_V(0);
    if constexpr (!ALIGN_EPI) { if (wr == 0) PG8_BAR; }
    PG8_BAR;
    if constexpr (Epi::AFTER_DRAIN) { E.fused(acc, cur, wr, wc, fr, fq, lds, wid, lane); S.done(cur); }
#undef PG8_SA
#undef PG8_SB
#undef PG8_STAGE
#undef PG8_LDA
#undef PG8_LDB
#undef PG8_MMA
#undef PG8_WAIT_V
#undef PG8_WAIT_L
#undef PG8_BAR
#undef PG8_SCHED
}
}

namespace {

#define LAS __attribute__((address_space(3)))
__device__ __forceinline__ void conv_item(const float* __restrict__ W, int K, int N, u16* __restrict__ WT, int rowbase, float* scr, int kb, int nb, int lane) {
    const int k0 = 64 * kb, n0 = 32 * nb;
#pragma unroll 8
    for (int i = 0; i < 32; ++i) { const int kk = 2 * i + (lane >> 5); scr[kk * 33 + (lane & 31)] = W[(size_t)(k0 + kk) * N + n0 + (lane & 31)]; }
    asm volatile("s_waitcnt lgkmcnt(0)" ::: "memory");
    const int c = lane & 7;
#pragma unroll
    for (int j = 0; j < 4; ++j) { const int n = (lane >> 3) + 8 * j; const float* s = scr + (8 * c) * 33 + n;
        uint4 o; o.x = pk2(s[0 * 33], s[1 * 33]); o.y = pk2(s[2 * 33], s[3 * 33]); o.z = pk2(s[4 * 33], s[5 * 33]); o.w = pk2(s[6 * 33], s[7 * 33]);
        *(uint4*)(WT + (size_t)(rowbase + n) * K + k0 + 8 * c) = o; }
    asm volatile("s_waitcnt lgkmcnt(0)" ::: "memory");
}
__device__ __forceinline__ void conv_matrix(const float* W, int K, int N, u16* WT, int roff, int GU, float* scr, int gw, int ngw, int lane) {
    const int nnb = N / 32, nitems = (K / 64) * nnb;
    for (int it = gw; it < nitems; it += ngw) { const int kb = it / nnb, nb = it % nnb, n0 = 32 * nb;
        const int rowbase = GU == 0 ? roff + n0 : 256 * (n0 / 128) + (GU == 2 ? 128 : 0) + (n0 % 128);
        conv_item(W, K, N, WT, rowbase, scr, kb, nb, lane); }
}
struct ConvDesc { const float* W; u16* WT; int K, N, roff, GU; };
__device__ __forceinline__ void conv_all(const Ptrs& p, ConvDesc* tab, float* scr, int gw, int ngw, int lane) {
    unsigned char* ws = p.ws;
    int t = threadIdx.x; asm volatile("" : "+v"(t));
    if (t < 38) {
        ConvDesc d;
        if (t < 24) { const int lf = t / 3, w = t % 3;
            if (w == 0) d = ConvDesc{p.in[I_WG] + (size_t)lf * D * DFF, (u16*)(ws + WS_WGU + lf * SZ_WGU), D, DFF, 0, 1};
            else if (w == 1) d = ConvDesc{p.in[I_WU] + (size_t)lf * D * DFF, (u16*)(ws + WS_WGU + lf * SZ_WGU), D, DFF, 0, 2};
            else d = ConvDesc{p.in[I_WD] + (size_t)lf * DFF * D, (u16*)(ws + WS_WD + lf * SZ_WD), DFF, D, 0, 0};
        } else if (t < 34) { const int j = (t - 24) / 5, w = (t - 24) % 5; u16* wdq = (u16*)(ws + WS_WDQKV) + (size_t)j * QKVA_LD * D;
            if (w == 0) d = ConvDesc{p.in[I_DQ] + (size_t)j * D * 512, wdq, D, 512, 0, 0};
            else if (w == 1) d = ConvDesc{p.in[I_DKV] + (size_t)j * D * 576, wdq, D, 576, 512, 0};
            else if (w == 2) d = ConvDesc{p.in[I_UQ] + (size_t)j * 512 * 3072, (u16*)(ws + WS_WUQ) + (size_t)j * 3072 * 512, 512, 3072, 0, 0};
            else if (w == 3) d = ConvDesc{p.in[I_UKV] + (size_t)j * 512 * 4096, (u16*)(ws + WS_WUKV) + (size_t)j * 4096 * 512, 512, 4096, 0, 0};
            else d = ConvDesc{p.in[I_MWO] + (size_t)j * D * D, (u16*)(ws + WS_WMO) + (size_t)j * D * D, D, D, 0, 0};
        } else if (t == 34) d = ConvDesc{p.in[I_HWIN], (u16*)(ws + WS_WHIN), D, 3 * D, 0, 0};
        else if (t == 35) d = ConvDesc{p.in[I_HWOUT], (u16*)(ws + WS_WHOUT), D, D, 0, 0};
        else if (t == 36) d = ConvDesc{p.in[I_WQKV], (u16*)(ws + WS_WWQKV), D, 2560, 0, 0};
        else d = ConvDesc{p.in[I_WWO], (u16*)(ws + WS_WWO), D, D, 0, 0};
        tab[t] = d;
    }
    __syncthreads();
#pragma unroll 1
    for (int m = 0; m < 38; ++m) { const ConvDesc d = tab[m]; conv_matrix(d.W, d.K, d.N, d.WT, d.roff, d.GU, scr, gw, ngw, lane); }
    for (int j = 0; j < 2; ++j) { u16* wdq = (u16*)(ws + WS_WDQKV) + (size_t)j * QKVA_LD * D;
        for (int i = gw * 64 + lane; i < (QKVA_LD - 1088) * D / 8; i += ngw * 64) ((uint4*)(wdq + (size_t)1088 * D))[i] = make_uint4(0u, 0u, 0u, 0u); }
    __syncthreads();
}

#define XB_TMO      128
#define XB_XCNT(j)  (256  + 64 * (j))
#define XB_XSUB(j)  (1280 + 64 * (j))
#define XB_XGEN(j)  (2304 + 64 * (j))
#define XB_TOP      3328
#define XB_TOPGEN   3392
#define XCD_BAR_WORDS 3456
#define XB_SPIN_CAP (1u << 22)

__device__ __forceinline__ unsigned xb_ld(unsigned* p)              { return __hip_atomic_load(p, __ATOMIC_RELAXED, __HIP_MEMORY_SCOPE_AGENT); }
__device__ __forceinline__ unsigned xb_add(unsigned* p, unsigned v) { return __hip_atomic_fetch_add(p, v, __ATOMIC_RELAXED, __HIP_MEMORY_SCOPE_AGENT); }
__device__ __forceinline__ unsigned xb_xcc_id() { return (unsigned)__builtin_amdgcn_s_getreg((3 << 11) | 20) & 0xFu; }
#define XB_SPIN(cond, bar) do { unsigned _sp = 0; while (cond) { __builtin_amdgcn_s_sleep(1); \
    if ((++_sp & 255u) == 0u) { if (xb_ld(&(bar)[XB_TMO])) break; if (_sp > XB_SPIN_CAP) { atomicAdd(&(bar)[XB_TMO], 1u); break; } } } } while (0)

struct XcdBarrier {
    unsigned* bar; unsigned x;
    volatile LAS unsigned* st;
};

__device__ __forceinline__ XcdBarrier xcd_barrier_post(unsigned* bar, volatile LAS unsigned* st) {
    XcdBarrier b; b.bar = bar; b.x = xb_xcc_id(); b.st = st;
    if (threadIdx.x == 0) (void)xb_add(&bar[XB_XCNT(b.x)], 1u);
    return b;
}
__device__ __forceinline__ void xcd_barrier_complete(unsigned* bar, unsigned x, unsigned& nloc, unsigned& nx) {
    const unsigned G = gridDim.x * gridDim.y * gridDim.z;
    unsigned sum, cnt, mine, sp = 0u;
    for (;;) {
        sum = 0u; cnt = 0u; mine = 0u;
#pragma unroll
        for (unsigned j = 0; j < 16; ++j) { const unsigned c = xb_ld(&bar[XB_XCNT(j)]); sum += c; cnt += (c > 0u) ? 1u : 0u; mine = (j == x) ? c : mine; }
        if (sum == G) break;
        __builtin_amdgcn_s_sleep(1);
        if ((++sp & 255u) == 0u) { if (xb_ld(&bar[XB_TMO])) break; if (sp > XB_SPIN_CAP) { atomicAdd(&bar[XB_TMO], 1u); break; } }
    }
    nloc = mine > 0u ? mine : 1u; nx = cnt > 0u ? cnt : 1u;
}

__device__ __forceinline__ void xcd_barrier(const XcdBarrier& b) {
    asm volatile("s_waitcnt vmcnt(0)" ::: "memory");
    __syncthreads();
    if (threadIdx.x == 0) {
        unsigned* bar = b.bar;
        __builtin_amdgcn_s_waitcnt(0);
        unsigned nloc = b.st[0], nx = b.st[1];
        if (nloc == 0u) { xcd_barrier_complete(bar, b.x, nloc, nx); b.st[0] = nloc; b.st[1] = nx; }
        const unsigned old = xb_add(&bar[XB_XSUB(b.x)], 1u);
        const unsigned gen = old / nloc;
        if (old + 1u == (gen + 1u) * nloc) {
            __builtin_amdgcn_fence(__ATOMIC_RELEASE, "agent");
            asm volatile("s_waitcnt vmcnt(0)" ::: "memory");
            const unsigned og = xb_add(&bar[XB_TOP], 1u);
            const unsigned tg = og / nx;
            if (og + 1u == (tg + 1u) * nx) xb_add(&bar[XB_TOPGEN], 1u);
            else XB_SPIN(xb_ld(&bar[XB_TOPGEN]) == tg, bar);
            __builtin_amdgcn_fence(__ATOMIC_ACQUIRE, "agent");
            xb_add(&bar[XB_XGEN(b.x)], 1u);
            asm volatile("s_waitcnt vmcnt(0)" ::: "memory");
        } else {
            XB_SPIN(xb_ld(&bar[XB_XGEN(b.x)]) == gen, bar);
            __builtin_amdgcn_fence(__ATOMIC_ACQUIRE, "agent");
            asm volatile("s_waitcnt vmcnt(0)" ::: "memory");
        }
    }
    __syncthreads();
}


#define PH __device__ __forceinline__
#define LDSWAIT() asm volatile("s_waitcnt lgkmcnt(0)" ::: "memory")
__device__ __forceinline__ int otid() { int t = threadIdx.x; asm volatile("" : "+v"(t)); return t; }
PH void ph_assemble(const Ptrs& p, int wg, int nwg) {
    const int TID = otid();
    float4* X = (float4*)(p.ws + WS_X);
    const size_t n = (size_t)R * D / 4;
    for (size_t i = (size_t)wg * 512 + TID; i < n; i += (size_t)nwg * 512) {
        const int r = (int)(i / (D / 4)), c4 = (int)(i % (D / 4));
        const int b = r / SB, j = r - b * SB;
        const float4* src = j < CTX ? (const float4*)(p.in[I_CTX] + ((size_t)b * CTX + j) * D) : (const float4*)(p.in[I_X] + ((size_t)b * S + (j - CTX)) * D);
        X[i] = src[c4];
    }
}
PH void ph_modp(const Ptrs& p, float* sc, int wg, int nwg) {
    const int TID = otid();
    for (int i = TID; i < 5 * D; i += 512) { const int m = i / D, k = i % D; const float v = m < 4 ? p.in[I_C][m * D + k] : p.in[I_CCTX][k]; sc[i] = silu_f(v); }
    __syncthreads();
    const int wave = TID >> 6, lane = TID & 63;
    float* MODP = (float*)(p.ws + WS_MODP);
    const int nitems = DEPTH * 72 * 16;
    for (int item = wg * 8 + wave; item < nitems; item += nwg * 8) {
        const int kc = item % 16, cg = (item / 16) % 72, layer = item / (16 * 72);
        const int col = cg * 256 + lane * 4;
        const float* w = p.in[I_MODW] + (size_t)layer * D * NMODV + (size_t)(kc * 128) * NMODV + col;
        float acc[5][4];
#pragma unroll
        for (int m = 0; m < 5; ++m) { acc[m][0] = acc[m][1] = acc[m][2] = acc[m][3] = 0.f; }
#pragma unroll 4
        for (int k = 0; k < 128; ++k) {
            const float4 wv = *(const float4*)(w + (size_t)k * NMODV);
#pragma unroll
            for (int m = 0; m < 5; ++m) { const float s = sc[m * D + kc * 128 + k]; acc[m][0] += s * wv.x; acc[m][1] += s * wv.y; acc[m][2] += s * wv.z; acc[m][3] += s * wv.w; }
        }
#pragma unroll
        for (int m = 0; m < 5; ++m) *(float4*)(MODP + ((size_t)(kc * DEPTH + layer) * 5 + m) * NMODV + col) = make_float4(acc[m][0], acc[m][1], acc[m][2], acc[m][3]);
    }
    __syncthreads();
}
PH void ph_modr(const Ptrs& p, int wg, int nwg) {
    const int TID = otid();
    const float* MODP = (const float*)(p.ws + WS_MODP); float* MOD = (float*)(p.ws + WS_MOD);
    const int n = DEPTH * 5 * NMODV;
    for (int i = wg * 512 + TID; i < n; i += nwg * 512) {
        const int col = i % NMODV, layer = i / (5 * NMODV);
        float s = p.in[I_MODB][layer * NMODV + col];
        for (int kc = 0; kc < 16; ++kc) s += MODP[(size_t)kc * n + i];
        MOD[i] = s;
    }
}
PH void ph_tables(const Ptrs& p, int wg, int nwg) {
    const int TID = otid();
    float* rope = (float*)(p.ws + WS_ROPE); float* tw = (float*)(p.ws + WS_TW);
    for (int i = wg * 512 + TID; i < 8192; i += nwg * 512) {
        if (i < 64 * 16) { const int pos = i / 16, k = i % 16; const float inv = (float)exp2(-(double)k / 16.0 * 13.287712379549449); const float ang = (float)pos * inv;
            rope[2 * i] = (float)cos((double)ang); rope[2 * i + 1] = (float)sin((double)ang); }
        const double a = -2.0 * 3.14159265358979323846 * (double)i / 8192.0; tw[2 * i] = (float)cos(a); tw[2 * i + 1] = (float)sin(a);
    }
}
PH void ph_modulate(const Ptrs& p, int layer, int slot, int wg, int nwg) {
    const int TID = otid();
    const float* X = (const float*)(p.ws + WS_X); u16* HB = (u16*)(p.ws + WS_HB); const float* MOD = (const float*)(p.ws + WS_MOD);
    const float* g = p.in[I_NORMG] + ((size_t)layer * 3 + slot) * D;
    const int wave = TID >> 6, lane = TID & 63;
    for (int r = wg * 8 + wave; r < R; r += nwg * 8) {
        const float4* xr = (const float4*)(X + (size_t)r * D);
        float4 v[8]; float ss = 0.f;
#pragma unroll
        for (int i = 0; i < 8; ++i) { v[i] = xr[lane + 64 * i]; ss += v[i].x * v[i].x + v[i].y * v[i].y + v[i].z * v[i].z + v[i].w * v[i].w; }
        const float rs = rsqrtf(wave_sum(ss) * (1.f / D) + NORM_EPS);
        const float* mb = MOD + ((size_t)(layer * 5 + modidx_of_row(r)) * 9 + 3 * slot) * D;
        uint2* o = (uint2*)(HB + (size_t)r * D);
#pragma unroll
        for (int i = 0; i < 8; ++i) { const int c4 = lane + 64 * i; const float4 gg = ((const float4*)g)[c4], sh = ((const float4*)mb)[c4], sl = ((const float4*)(mb + D))[c4];
            const float a = v[i].x * rs * gg.x * (1.f + sl.x) + sh.x, b = v[i].y * rs * gg.y * (1.f + sl.y) + sh.y, c = v[i].z * rs * gg.z * (1.f + sl.z) + sh.z, d = v[i].w * rs * gg.w * (1.f + sl.w) + sh.w;
            o[c4] = make_uint2(pk2(a, b), pk2(c, d)); }
    }
}
PH void ph_final(const Ptrs& p, int wg, int nwg) {
    const int TID = otid();
    const float* X = (const float*)(p.ws + WS_X); const float* g = p.in[I_FINALG];
    const int wave = TID >> 6, lane = TID & 63;
    for (int q = wg * 8 + wave; q < NB * S; q += nwg * 8) {
        const int b = q / S, t = q - b * S, r = b * SB + CTX + t;
        const float4* xr = (const float4*)(X + (size_t)r * D);
        float4 v[8]; float ss = 0.f;
#pragma unroll
        for (int i = 0; i < 8; ++i) { v[i] = xr[lane + 64 * i]; ss += v[i].x * v[i].x + v[i].y * v[i].y + v[i].z * v[i].z + v[i].w * v[i].w; }
        const float rs = rsqrtf(wave_sum(ss) * (1.f / D) + NORM_EPS);
        float4* o = (float4*)(p.out + (size_t)q * D);
#pragma unroll
        for (int i = 0; i < 8; ++i) { const int c4 = lane + 64 * i; const float4 gg = ((const float4*)g)[c4]; o[c4] = make_float4(v[i].x * rs * gg.x, v[i].y * rs * gg.y, v[i].z * rs * gg.z, v[i].w * rs * gg.w); }
    }
}
PH void ph_mla_norm(const Ptrs& p, int jm, int wg, int nwg) {
    const int TID = otid();
    const float* A = (const float*)(p.ws + WS_QKVA); u16* QL = (u16*)(p.ws + WS_QL); u16* CKV = (u16*)(p.ws + WS_CKV); u16* KR = (u16*)(p.ws + WS_KR);
    const float* gq = p.in[I_GQ] + jm * 512; const float* gkv = p.in[I_GKV] + jm * 512; const float* rope = (const float*)(p.ws + WS_ROPE);
    const int wave = TID >> 6, lane = TID & 63;
    for (int r = wg * 8 + wave; r < R; r += nwg * 8) {
        const float* a = A + (size_t)r * QKVA_LD;
        const float4 q0 = ((const float4*)a)[lane * 2], q1 = ((const float4*)a)[lane * 2 + 1];
        const float4 k0 = ((const float4*)(a + 512))[lane * 2], k1 = ((const float4*)(a + 512))[lane * 2 + 1];
        const float sq = wave_sum(q0.x * q0.x + q0.y * q0.y + q0.z * q0.z + q0.w * q0.w + q1.x * q1.x + q1.y * q1.y + q1.z * q1.z + q1.w * q1.w);
        const float sk = wave_sum(k0.x * k0.x + k0.y * k0.y + k0.z * k0.z + k0.w * k0.w + k1.x * k1.x + k1.y * k1.y + k1.z * k1.z + k1.w * k1.w);
        const float rq = rsqrtf(sq * (1.f / 512) + NORM_EPS), rk = rsqrtf(sk * (1.f / 512) + NORM_EPS);
        const float4 g0 = ((const float4*)gq)[lane * 2], g1 = ((const float4*)gq)[lane * 2 + 1], h0 = ((const float4*)gkv)[lane * 2], h1 = ((const float4*)gkv)[lane * 2 + 1];
        uint4 oq, ok;
        oq.x = pk2(q0.x * rq * g0.x, q0.y * rq * g0.y); oq.y = pk2(q0.z * rq * g0.z, q0.w * rq * g0.w); oq.z = pk2(q1.x * rq * g1.x, q1.y * rq * g1.y); oq.w = pk2(q1.z * rq * g1.z, q1.w * rq * g1.w);
        ok.x = pk2(k0.x * rk * h0.x, k0.y * rk * h0.y); ok.y = pk2(k0.z * rk * h0.z, k0.w * rk * h0.w); ok.z = pk2(k1.x * rk * h1.x, k1.y * rk * h1.y); ok.w = pk2(k1.z * rk * h1.z, k1.w * rk * h1.w);
        ((uint4*)(QL + (size_t)r * 512))[lane] = oq; ((uint4*)(CKV + (size_t)r * 512))[lane] = ok;
        if (lane < 32) {
            const int b = r / SB, j = r - b * SB; const int half = lane >> 4, i = lane & 15;
            const float x1 = a[1024 + 32 * half + i], x2 = a[1024 + 32 * half + 16 + i];
            float o1 = x1, o2 = x2;
            if (j >= CTX) { const int t = j - CTX, pos = half ? (t & 63) : (t >> 6); const float cs = rope[(pos * 16 + i) * 2], sn = rope[(pos * 16 + i) * 2 + 1]; o1 = x1 * cs - x2 * sn; o2 = x2 * cs + x1 * sn; }
            KR[(size_t)r * 64 + 32 * half + i] = f2bf(o1); KR[(size_t)r * 64 + 32 * half + 16 + i] = f2bf(o2);
        }
    }
}
PH void ph_transpose(const u16* __restrict__ ZT, u16* __restrict__ Z, u16* tile, int wg, int nwg) {
    const int TID = otid();
    const int tx = TID & 63, ty = TID >> 6;
    for (int u = wg; u < (R / 64) * (D / 64); u += nwg) {
        const int r0 = (u % (R / 64)) * 64, d0 = (u / (R / 64)) * 64;
        for (int i = ty; i < 64; i += 8) tile[i * 66 + tx] = ZT[(size_t)(d0 + i) * R + r0 + tx];
        __syncthreads();
        for (int i = ty; i < 64; i += 8) Z[(size_t)(r0 + i) * D + d0 + tx] = tile[tx * 66 + i];
        __syncthreads();
    }
}
template <int L> PH void ph_filters(const Ptrs& p, float* FT, float* lds, int wg, int nwg) {
    const int TID = otid();
    float* zf = lds; float* ha = lds + 16 * 33; float* hb = ha + 1024; float* h3t = hb + 1024; float* tp = h3t + 1024;
    const int tid = TID;
    const float* w1 = p.in[I_FW1]; const float* b1 = p.in[I_FB1]; const float* w2 = p.in[I_FW2]; const float* b2 = p.in[I_FB2]; const float* w3 = p.in[I_FW3]; const float* b3 = p.in[I_FB3]; const float* fr = p.in[I_FFREQ];
    const float* w4 = p.in[I_FW4]; const float* decay = p.in[I_DECAY];
    for (int unit = wg; unit < L / 16; unit += nwg) {
        const int l0 = unit * 16;
        for (int idx = tid; idx < 16 * 33; idx += 512) { const int pp = idx / 33, c = idx % 33, l = l0 + pp; const float t = (float)l / (float)(L - 1);
            float v;
            if (c == 0) { v = t; tp[pp] = t; }
            else { const int k = (c - 1) & 15; const float f = 1e-4f + (float)k * ((15.0f - 1e-4f) / 15.0f); const float w = 6.283185307179586f * (float)l / (float)L; const double a = (double)(f * w);
                v = c <= 16 ? (float)cos(a) : (float)(-sin(a)); }
            zf[pp * 33 + c] = v; }
        __syncthreads();
        for (int idx = tid; idx < 1024; idx += 512) { const int pp = idx >> 6, j = idx & 63; float s = b1[j]; for (int c = 0; c < 33; ++c) s += zf[pp * 33 + c] * w1[c * 64 + j]; ha[pp * 64 + j] = sinf(fr[j] * s); }
        __syncthreads();
        for (int idx = tid; idx < 1024; idx += 512) { const int pp = idx >> 6, j = idx & 63; float s = b2[j]; for (int c = 0; c < 64; ++c) s += ha[pp * 64 + c] * w2[c * 64 + j]; hb[pp * 64 + j] = sinf(fr[j] * s); }
        __syncthreads();
        for (int idx = tid; idx < 1024; idx += 512) { const int pp = idx >> 6, j = idx & 63; float s = b3[j]; for (int c = 0; c < 64; ++c) s += hb[pp * 64 + c] * w3[c * 64 + j]; h3t[j * 16 + pp] = sinf(fr[j] * s); }
        __syncthreads();
        for (int m = 0; m < 16; ++m) {
            const int n = tid + 512 * m; float acc[16];
#pragma unroll
            for (int q = 0; q < 16; ++q) acc[q] = 0.f;
            for (int k = 0; k < 64; ++k) { const float wv = w4[(size_t)k * 8192 + n];
#pragma unroll
                for (int q = 0; q < 16; ++q) acc[q] += h3t[k * 16 + q] * wv; }
            const float dc = fabsf(decay[n]); float* o = FT + (size_t)n * L + l0;
#pragma unroll
            for (int q = 0; q < 16; ++q) o[q] = acc[q] * expf(-tp[q] * dc);
        }
        __syncthreads();
    }
}
PH void ph_nattn_mla(const u16* __restrict__ Q, const u16* __restrict__ KN, const u16* __restrict__ KR, const u16* __restrict__ V, u16* __restrict__ O, float* lds, int wg, int nwg) {
    const int TID = otid();
    const int wave = TID >> 6, lane = TID & 63;
    float* pp = lds + wave * (SB + 192); float* qq = pp + SB;
    for (int item = wg * 8 + wave; item < R * 16; item += nwg * 8) {
        const int r = item >> 4, h = item & 15;
        const int b = r / SB, j = r - b * SB, nk = j < CTX ? CTX : SB, kb = b * SB;
        for (int c = lane; c < 192; c += 64) qq[c] = bf2f(Q[(size_t)r * 3072 + h * 192 + c]);
        LDSWAIT();
        const float scale = 0.07216878364870322f;
        float mx = -3.0e38f;
        for (int key = lane; key < nk; key += 64) {
            const uint4* kn = (const uint4*)(KN + (size_t)(kb + key) * D + h * 128); const uint4* kr = (const uint4*)(KR + (size_t)(kb + key) * 64);
            float s = 0.f;
#pragma unroll 4
            for (int c8 = 0; c8 < 24; ++c8) { const uint4 w = c8 < 16 ? kn[c8] : kr[c8 - 16]; const float* q8 = qq + c8 * 8;
                s += q8[0] * __uint_as_float(w.x << 16) + q8[1] * __uint_as_float(w.x & 0xffff0000u) + q8[2] * __uint_as_float(w.y << 16) + q8[3] * __uint_as_float(w.y & 0xffff0000u)
                   + q8[4] * __uint_as_float(w.z << 16) + q8[5] * __uint_as_float(w.z & 0xffff0000u) + q8[6] * __uint_as_float(w.w << 16) + q8[7] * __uint_as_float(w.w & 0xffff0000u); }
            s *= scale; pp[key] = s; mx = fmaxf(mx, s);
        }
        mx = wave_max(mx);
        float sum = 0.f;
        for (int key = lane; key < nk; key += 64) { const float e = expf(pp[key] - mx); pp[key] = e; sum += e; }
        sum = wave_sum(sum);
        LDSWAIT();
        float o0 = 0.f, o1 = 0.f;
        const u16* vb = V + (size_t)kb * D + h * 128 + lane;
        for (int key = 0; key < nk; ++key) { const float pv = pp[key]; o0 += pv * bf2f(vb[(size_t)key * D]); o1 += pv * bf2f(vb[(size_t)key * D + 64]); }
        const float inv = 1.f / sum;
        O[(size_t)r * D + h * 128 + lane] = f2bf(o0 * inv); O[(size_t)r * D + h * 128 + 64 + lane] = f2bf(o1 * inv);
        LDSWAIT();
    }
}
PH void ph_nattn_win(const u16* __restrict__ QKV, const float* __restrict__ sink, u16* __restrict__ O, float* lds, int wg, int nwg) {
    const int TID = otid();
    const int wave = TID >> 6, lane = TID & 63;
    float* pp = lds + wave * 640; float* qq = pp + 576;
    for (int item = wg * 8 + wave; item < R * 32; item += nwg * 8) {
        const int r = item >> 5, qh = item & 31, kvh = qh >> 3;
        const int b = r / SB, j = r - b * SB, kb = b * SB;
        qq[lane] = bf2f(QKV[(size_t)r * 2560 + qh * 64 + lane]);
        LDSWAIT();
        int lo = 0, nwin = 0; if (j >= CTX) { const int t = j - CTX; lo = t - 128 < 0 ? 0 : t - 128; const int hi = t + 128 > S - 1 ? S - 1 : t + 128; nwin = hi - lo + 1; }
        const int nk = CTX + nwin;
        float mx = sink[qh];
        for (int key = lane; key < nk; key += 64) {
            const int krow = kb + (key < CTX ? key : CTX + lo + (key - CTX));
            const uint4* kk = (const uint4*)(QKV + (size_t)krow * 2560 + 2048 + kvh * 64);
            float s = 0.f;
#pragma unroll
            for (int c8 = 0; c8 < 8; ++c8) { const uint4 w = kk[c8]; const float* q8 = qq + c8 * 8;
                s += q8[0] * __uint_as_float(w.x << 16) + q8[1] * __uint_as_float(w.x & 0xffff0000u) + q8[2] * __uint_as_float(w.y << 16) + q8[3] * __uint_as_float(w.y & 0xffff0000u)
                   + q8[4] * __uint_as_float(w.z << 16) + q8[5] * __uint_as_float(w.z & 0xffff0000u) + q8[6] * __uint_as_float(w.w << 16) + q8[7] * __uint_as_float(w.w & 0xffff0000u); }
            s *= 0.125f; pp[key] = s; mx = fmaxf(mx, s);
        }
        mx = wave_max(mx);
        float sum = 0.f;
        for (int key = lane; key < nk; key += 64) { const float e = expf(pp[key] - mx); pp[key] = e; sum += e; }
        sum = wave_sum(sum) + expf(sink[qh] - mx);
        LDSWAIT();
        float o = 0.f;
        for (int key = 0; key < nk; ++key) { const int krow = kb + (key < CTX ? key : CTX + lo + (key - CTX)); o += pp[key] * bf2f(QKV[(size_t)krow * 2560 + 2304 + kvh * 64 + lane]); }
        O[(size_t)r * D + qh * 64 + lane] = f2bf(o / sum);
        LDSWAIT();
    }
}
template <int L> PH void ph_nhyena(const Ptrs& p, const float* __restrict__ FT, float* lds, int wg, int nwg) {
    const int TID = otid();
    constexpr int NTL = L < 512 ? L : 512, CPB = 512 / NTL, PER = L / NTL;
    const float* UT = (const float*)(p.ws + WS_UT); u16* ZT = (u16*)(p.ws + WS_ZT);
    const float* cw = p.in[I_HCW]; const float* cb = p.in[I_HCB]; const float* skip = p.in[I_SKIP];
    const int sub = TID / NTL, tid = TID % NTL;
    float* z = lds + sub * 3 * L; float* f2 = z + L;
    for (int unit = wg; unit < NB * D / CPB; unit += nwg) {
        const int bd = unit * CPB + sub, b = bd / D, d = bd % D, rb = b * SB + (L == S ? CTX : 0);
        auto sconv = [&](int ch, int t) { const float* u = UT + (size_t)ch * R + rb; const float um = t > 0 ? u[t - 1] : 0.f, u0 = u[t], up = t < L - 1 ? u[t + 1] : 0.f;
            return um * cw[ch] + u0 * cw[3 * D + ch] + up * cw[6 * D + ch] + cb[ch]; };
        float zc[PER];
#pragma unroll
        for (int i = 0; i < PER; ++i) zc[i] = sconv(d, tid + NTL * i);
        for (int n = 0; n < 2; ++n) {
            __syncthreads();
#pragma unroll
            for (int i = 0; i < PER; ++i) z[tid + NTL * i] = zc[i];
            const float* ff = FT + (size_t)(n * 4096 + d) * L; const float* fb = FT + (size_t)(n * 4096 + 2048 + d) * L;
            for (int idx = tid; idx < 2 * L; idx += NTL) { const int lag = idx - L; f2[idx] = lag >= 0 ? ff[lag] : (lag > -L ? fb[-lag] : 0.f); }
            __syncthreads();
            float y[PER];
#pragma unroll
            for (int i = 0; i < PER; ++i) y[i] = 0.f;
            for (int s = 0; s < L; ++s) { const float zs = z[s];
#pragma unroll
                for (int i = 0; i < PER; ++i) y[i] += f2[L + tid + NTL * i - s] * zs; }
            const float sk = skip[n * D + d];
#pragma unroll
            for (int i = 0; i < PER; ++i) zc[i] = sconv((n + 1) * D + d, tid + NTL * i) * (y[i] + zc[i] * sk);
        }
#pragma unroll
        for (int i = 0; i < PER; ++i) ZT[(size_t)d * R + rb + tid + NTL * i] = f2bf(zc[i]);
        __syncthreads();
    }
}

constexpr int LDS_BYTES = 155648;
constexpr int LDS_MISC = LDS_BYTES - 256;
constexpr int CW_BAR = 4096;
constexpr size_t CTL_ZERO_BYTES = 65536;

__global__ void __launch_bounds__(512, 2) mega_fwd(Ptrs p) {
    extern __shared__ __attribute__((aligned(16))) unsigned char lds[];
    const int tid = threadIdx.x, wg = blockIdx.x, nwg = gridDim.x;
    volatile LAS unsigned* MISC = (volatile LAS unsigned*)((LAS unsigned char*)lds + LDS_MISC);
    if (tid < 64) MISC[tid] = 0u;
    __syncthreads();
    XcdBarrier bar = xcd_barrier_post((unsigned*)(p.ws + WS_CTL) + CW_BAR, MISC + 8);
#define GRID_BAR() xcd_barrier(bar)
    PG8_LAS unsigned char* ring = (PG8_LAS unsigned char*)lds;
    unsigned char* ws = p.ws;
    float* X = (float*)(ws + WS_X); u16* HB = (u16*)(ws + WS_HB); u16* ACT = (u16*)(ws + WS_ACT); const float* MOD = (const float*)(ws + WS_MOD); const float* rope = (const float*)(ws + WS_ROPE);

#ifndef NO_PRO
    ph_assemble(p, wg, nwg);
    ph_modp(p, (float*)lds, wg, nwg);
    ph_tables(p, wg, nwg);
    ph_filters<4096>(p, (float*)(ws + WS_FT4096), (float*)lds, wg, nwg);
    ph_filters<256>(p, (float*)(ws + WS_FT256), (float*)lds, nwg - 1 - wg, nwg);
    { int t2 = threadIdx.x; asm volatile("" : "+v"(t2)); conv_all(p, (ConvDesc*)(lds + 8 * 64 * 33 * 4), (float*)lds + (t2 >> 6) * (64 * 33), wg * 8 + (t2 >> 6), nwg * 8, t2 & 63); }
#endif
    GRID_BAR();
    ph_modr(p, wg, nwg);
    GRID_BAR();

    for (int layer = 0; layer < DEPTH; ++layer) {
        const int kind = layer % 3, jm = layer / 3;
        const float* modl = MOD + (size_t)layer * 5 * 9 * D;
#pragma unroll 1
        for (int f = 0; f < 2; ++f) {
            const int slot = f == 0 ? 0 : 2, lf = layer * 2 + f;
            ph_modulate(p, layer, slot, wg, nwg);
            GRID_BAR();
            { pg8::Gemm g{HB, (const u16*)(ws + WS_WGU + lf * SZ_WGU), R, 2 * DFF, D}; pg8::StaticOrder So; So.init(g.M, g.N, nwg, wg);
              pg8::gemm_phase<pg8::EpiSwiGLU, pg8::StaticOrder, true, true>(ring, g, So, pg8::EpiSwiGLU{ACT}); }
            GRID_BAR();
            { pg8::Gemm g{ACT, (const u16*)(ws + WS_WD + lf * SZ_WD), R, D, DFF}; pg8::StaticOrder So; So.init(g.M, g.N, nwg, wg);
              pg8::gemm_phase<pg8::EpiResGate, pg8::StaticOrder, true, true>(ring, g, So, pg8::EpiResGate{X, modl, slot, 0.5f}); }
            GRID_BAR();
            if (f == 0) {
                ph_modulate(p, layer, 1, wg, nwg);
                GRID_BAR();
                const u16* Ao; const u16* Wo;
                if (kind == 0) {
                    float* QKVA = (float*)(ws + WS_QKVA); u16* QL = (u16*)(ws + WS_QL); u16* CKV = (u16*)(ws + WS_CKV); u16* KR = (u16*)(ws + WS_KR); u16* Q = (u16*)(ws + WS_Q); u16* KN = (u16*)(ws + WS_KN); u16* V = (u16*)(ws + WS_V); u16* O = (u16*)(ws + WS_O);
                    { pg8::Gemm g{HB, (const u16*)(ws + WS_WDQKV) + (size_t)jm * QKVA_LD * D, R, QKVA_LD, D}; pg8::StaticOrder So; So.init(g.M, g.N, nwg, wg);
                      pg8::gemm_phase<pg8::EpiF32, pg8::StaticOrder, true, true>(ring, g, So, pg8::EpiF32{QKVA, QKVA_LD}); }
                    GRID_BAR();
                    ph_mla_norm(p, jm, wg, nwg);
                    GRID_BAR();
                    { pg8::Gemm g{QL, (const u16*)(ws + WS_WUQ) + (size_t)jm * 3072 * 512, R, 3072, 512}; pg8::StaticOrder So; So.init(g.M, g.N, nwg, wg);
                      pg8::gemm_phase<pg8::EpiRope<0>, pg8::StaticOrder, true, true>(ring, g, So, pg8::EpiRope<0>{Q, 3072, rope}); }
                    { pg8::Gemm g{CKV, (const u16*)(ws + WS_WUKV) + (size_t)jm * 4096 * 512, R, 4096, 512}; pg8::StaticOrder So; So.init(g.M, g.N, nwg, wg);
                      pg8::gemm_phase<pg8::EpiKV, pg8::StaticOrder, true, true>(ring, g, So, pg8::EpiKV{KN, V}); }
                    GRID_BAR();
#ifndef NO_NAIVE
                    ph_nattn_mla(Q, KN, KR, V, O, (float*)lds, wg, nwg);
#endif
                    Ao = O; Wo = (const u16*)(ws + WS_WMO) + (size_t)jm * D * D;
                } else if (kind == 1) {
                    float* UT = (float*)(ws + WS_UT); u16* ZT = (u16*)(ws + WS_ZT);
                    { pg8::Gemm g{(const u16*)(ws + WS_WHIN), HB, 3 * D, R, D}; pg8::StaticOrder So; So.init(g.M, g.N, nwg, wg);
                      pg8::gemm_phase<pg8::EpiF32, pg8::StaticOrder, true, true>(ring, g, So, pg8::EpiF32{UT, R}); }
                    GRID_BAR();
#ifndef NO_NAIVE
                    ph_nhyena<4096>(p, (const float*)(ws + WS_FT4096), (float*)lds, wg, nwg);
                    ph_nhyena<256>(p, (const float*)(ws + WS_FT256), (float*)lds, wg, nwg);
#endif
                    GRID_BAR();
                    ph_transpose(ZT, HB, (u16*)lds, wg, nwg);
                    Ao = HB; Wo = (const u16*)(ws + WS_WHOUT);
                } else {
                    u16* QKV = (u16*)(ws + WS_QKV); u16* O = (u16*)(ws + WS_WO);
                    { pg8::Gemm g{HB, (const u16*)(ws + WS_WWQKV), R, 2560, D}; pg8::StaticOrder So; So.init(g.M, g.N, nwg, wg);
                      pg8::gemm_phase<pg8::EpiRope<1>, pg8::StaticOrder, true, true>(ring, g, So, pg8::EpiRope<1>{QKV, 2560, rope}); }
                    GRID_BAR();
#ifndef NO_NAIVE
                    ph_nattn_win(QKV, p.in[I_SINK], O, (float*)lds, wg, nwg);
#endif
                    Ao = O; Wo = (const u16*)(ws + WS_WWO);
                }
                GRID_BAR();
                { pg8::Gemm g{Ao, Wo, R, D, D}; pg8::StaticOrder So; So.init(g.M, g.N, nwg, wg);
                  pg8::gemm_phase<pg8::EpiResGate, pg8::StaticOrder, true, true>(ring, g, So, pg8::EpiResGate{X, modl, 1, 1.0f}); }
                GRID_BAR();
            }
        }
    }
    ph_final(p, wg, nwg);
}
}

extern "C" void kernel_launch(void* const* d_in, const int* in_sizes, int n_in, void* d_out, int out_size, void* d_ws, size_t ws_size, hipStream_t stream) {
    static int grid = 0;
    if (grid == 0) {
        if (n_in != 35 || ws_size < WS_TOTAL || out_size != NB * S * D) { fprintf(stderr, "kernel_launch: unexpected shapes (n_in %d, ws %zu need %zu, out %d)\n", n_in, ws_size, (size_t)WS_TOTAL, out_size); grid = -1; return; }
        int dev = 0, cus = 0, per_cu = 0;
        if (hipGetDevice(&dev) != hipSuccess || hipDeviceGetAttribute(&cus, hipDeviceAttributeMultiprocessorCount, dev) != hipSuccess || cus <= 0) { fprintf(stderr, "kernel_launch: device query failed\n"); grid = -1; return; }
        if (hipFuncSetAttribute((const void*)mega_fwd, hipFuncAttributeMaxDynamicSharedMemorySize, LDS_BYTES) != hipSuccess) { fprintf(stderr, "kernel_launch: hipFuncSetAttribute failed\n"); grid = -1; return; }
        if (hipOccupancyMaxActiveBlocksPerMultiprocessor(&per_cu, (const void*)mega_fwd, 512, LDS_BYTES) != hipSuccess || per_cu < 1) fprintf(stderr, "kernel_launch: note: occupancy query reports %d workgroups per CU\n", per_cu);
        (void)hipGetLastError();
        grid = cus;
    }
    if (grid < 0) return;
    if (hipMemsetAsync((char*)d_ws + WS_CTL, 0, CTL_ZERO_BYTES, stream) != hipSuccess) { fprintf(stderr, "kernel_launch: memset failed\n"); return; }
    Ptrs p{}; for (int i = 0; i < 35; ++i) p.in[i] = (const float*)d_in[i]; p.out = (float*)d_out; p.ws = (unsigned char*)d_ws;
    hipLaunchKernelGGL(mega_fwd, dim3(grid), dim3(512), LDS_BYTES, stream, p);
    const hipError_t le = hipPeekAtLastError();
    if (le != hipSuccess) fprintf(stderr, "kernel_launch: launch failed: %s\n", hipGetErrorName(le));
}
```

```cpp
#include <hip/hip_runtime.h>
#include <cstdio>
#include <cstdint>
#include <cmath>

namespace {
typedef unsigned short u16;
constexpr int D = 2048, NB = 4, S = 4096, CTX = 256, SB = S + CTX, R = NB * SB, DFF = 5504, NMODV = 9 * D, DEPTH = 4;
constexpr int QKVA_LD = 1280;
constexpr float NORM_EPS = 1e-6f;

constexpr size_t al(size_t x) { return (x + 255) / 256 * 256; }
constexpr size_t WS_CTL = 0;
constexpr size_t WS_X = 1u << 20;
constexpr size_t WS_HB = WS_X + al((size_t)R * D * 4);
constexpr size_t WS_ACT = WS_HB + al((size_t)R * D * 2);
constexpr size_t WS_MODP = WS_ACT + al((size_t)R * DFF * 2);
constexpr size_t WS_MOD = WS_MODP + al((size_t)16 * DEPTH * 5 * NMODV * 4);
constexpr size_t WS_ROPE = WS_MOD + al((size_t)DEPTH * 5 * NMODV * 4);
constexpr size_t WS_TW = WS_ROPE + al(64 * 16 * 2 * 4);
constexpr size_t WS_FT4096 = WS_TW + al(8192 * 8);
constexpr size_t WS_FT256 = WS_FT4096 + al((size_t)8192 * 4096 * 4);
constexpr size_t WS_MIX = WS_FT256 + al((size_t)8192 * 256 * 4);
constexpr size_t WS_QKVA = WS_MIX;
constexpr size_t WS_QL = WS_QKVA + al((size_t)R * QKVA_LD * 4);
constexpr size_t WS_CKV = WS_QL + al((size_t)R * 512 * 2);
constexpr size_t WS_KR = WS_CKV + al((size_t)R * 512 * 2);
constexpr size_t WS_Q = WS_KR + al((size_t)R * 64 * 2);
constexpr size_t WS_KN = WS_Q + al((size_t)R * 3072 * 2);
constexpr size_t WS_V = WS_KN + al((size_t)R * D * 2);
constexpr size_t WS_O = WS_V + al((size_t)R * D * 2);
constexpr size_t WS_MLA_END = WS_O + al((size_t)R * D * 2);
constexpr size_t WS_UT = WS_MIX;
constexpr size_t WS_ZT = WS_UT + al((size_t)3 * D * R * 4);
constexpr size_t WS_HY_END = WS_ZT + al((size_t)D * R * 2);
constexpr size_t WS_QKV = WS_MIX;
constexpr size_t WS_WO = WS_QKV + al((size_t)R * 2560 * 2);
constexpr size_t WS_WIN_END = WS_WO + al((size_t)R * D * 2);
constexpr size_t WS_END = (WS_MLA_END > WS_HY_END ? (WS_MLA_END > WS_WIN_END ? WS_MLA_END : WS_WIN_END) : (WS_HY_END > WS_WIN_END ? WS_HY_END : WS_WIN_END));
constexpr size_t SZ_WGU = (size_t)2 * DFF * D * 2, SZ_WD = (size_t)D * DFF * 2;
constexpr size_t WS_WGU = al(WS_END);
constexpr size_t WS_WD = WS_WGU + 8 * SZ_WGU;
constexpr size_t WS_WDQKV = WS_WD + 8 * SZ_WD;
constexpr size_t WS_WUQ = WS_WDQKV + 2 * (size_t)QKVA_LD * D * 2;
constexpr size_t WS_WUKV = WS_WUQ + 2 * (size_t)3072 * 512 * 2;
constexpr size_t WS_WMO = WS_WUKV + 2 * (size_t)4096 * 512 * 2;
constexpr size_t WS_WHIN = WS_WMO + 2 * (size_t)D * D * 2;
constexpr size_t WS_WHOUT = WS_WHIN + (size_t)3 * D * D * 2;
constexpr size_t WS_WWQKV = WS_WHOUT + (size_t)D * D * 2;
constexpr size_t WS_WWO = WS_WWQKV + (size_t)2560 * D * 2;
constexpr size_t WS_TOTAL = WS_WWO + (size_t)D * D * 2;
static_assert(WS_TOTAL < 2000000000ull, "workspace map exceeds the guaranteed size");

__device__ __forceinline__ float bf2f(u16 b) { return __uint_as_float(((unsigned)b) << 16); }
__device__ __forceinline__ u16 f2bf(float f) { unsigned u = __float_as_uint(f); u += 0x7fffu + ((u >> 16) & 1u); return (u16)(u >> 16); }
__device__ __forceinline__ unsigned pk2(float lo, float hi) { return (unsigned)f2bf(lo) | ((unsigned)f2bf(hi) << 16); }
template <int X> __device__ __forceinline__ float swz_xor(float v) { return __int_as_float(__builtin_amdgcn_ds_swizzle(__float_as_int(v), 0x1f | (X << 10))); }
__device__ __forceinline__ float wave_sum(float v) {
    v += swz_xor<1>(v); v += swz_xor<2>(v); v += swz_xor<4>(v); v += swz_xor<8>(v); v += swz_xor<16>(v);
    auto rr = __builtin_amdgcn_permlane32_swap(__float_as_uint(v), __float_as_uint(v), false, false); return __uint_as_float(rr[0]) + __uint_as_float(rr[1]);
}
__device__ __forceinline__ float wave_max(float v) {
    v = fmaxf(v, swz_xor<1>(v)); v = fmaxf(v, swz_xor<2>(v)); v = fmaxf(v, swz_xor<4>(v)); v = fmaxf(v, swz_xor<8>(v)); v = fmaxf(v, swz_xor<16>(v));
    auto rr = __builtin_amdgcn_permlane32_swap(__float_as_uint(v), __float_as_uint(v), false, false); return fmaxf(__uint_as_float(rr[0]), __uint_as_float(rr[1]));
}
__device__ __forceinline__ int modidx_of_row(int r) { const int b = r / SB, j = r - b * SB; return j < CTX ? 4 : b; }
__device__ __forceinline__ float silu_f(float x) { return x / (1.f + expf(-x)); }

struct Ptrs {
    const float* in[35];
    float* out;
    unsigned char* ws;
};
enum { I_X = 0, I_C, I_CTX, I_CCTX, I_MODW, I_MODB, I_NORMG, I_FINALG, I_WG, I_WU, I_WD, I_DQ, I_GQ, I_UQ, I_DKV, I_GKV, I_UKV, I_MWO,
       I_HWIN, I_HCW, I_HCB, I_FW1, I_FB1, I_FW2, I_FB2, I_FW3, I_FB3, I_FFREQ, I_FW4, I_DECAY, I_SKIP, I_HWOUT, I_WQKV, I_SINK, I_WWO };


}

namespace pg8 {
#define PG8_LAS __attribute__((address_space(3)))
typedef unsigned short bf16_t;
typedef short bf16x8 __attribute__((ext_vector_type(8)));
typedef float f32x4 __attribute__((ext_vector_type(4)));
typedef unsigned u32x4 __attribute__((ext_vector_type(4)));
constexpr int BM = 256, BK = 64, HALF = 128, HTB = HALF * BK * 2  , STAGE_BYTES = 8 * HTB, NXCD = 8, WGM = 8;

__host__ __device__ __forceinline__ int lds_byte(int r, int c) { const int st = (r >> 4) * 2 + (c >> 5), rr = r & 15, cc = c & 31, ob = rr * 64 + cc * 2; return st * 1024 + (ob ^ (((ob >> 9) & 1) << 5)); }
__host__ __device__ __forceinline__ void stage_rc(int b, int& R, int& C) { const int st = b / 1024, sb = b % 1024, swz = sb ^ (((sb >> 9) & 1) << 5); R = (st >> 1) * 16 + swz / 64; C = (st & 1) * 32 + (swz % 64) / 2; }
__host__ __device__ __forceinline__ int perm32(int rho) { const int n = rho >> 4, i = rho & 15; return 8 * (i >> 2) + 4 * n + (i & 3); }

struct Unit { int pm, pn; };
struct Gemm { const bf16_t* A; const bf16_t* Bt; int M, N, K; };

struct StaticOrder {
    int nM, nN, nwg, G, c;
    __host__ __device__ void init(int M, int N, int G_, int c_) { nM = M / BM; nN = N / BM; nwg = nM * nN; G = G_; c = c_; }
    __host__ __device__ bool next(int i, Unit& u) const {
        const long L = (long)i * G + c; if (L >= nwg) return false;
        int wgid = (int)L; { const int q = nwg / NXCD, r = nwg % NXCD, xcd = wgid % NXCD, off = wgid / NXCD; wgid = (xcd < r ? xcd * (q + 1) : r * (q + 1) + (xcd - r) * q) + off; }
        const int nig = WGM * nN, gid = wgid / nig, fm = gid * WGM, gsz = (nM - fm) < WGM ? (nM - fm) : WGM;
        u.pm = fm + ((wgid % nig) % gsz); u.pn = (wgid % nig) / gsz; return true;
    }
    __device__ __forceinline__ void a_ready(const Unit&) const {}
    __device__ __forceinline__ void done(const Unit&) const {}
};


__device__ __forceinline__ unsigned cvt_pk_bf16(float lo, float hi) { unsigned r; asm volatile("v_cvt_pk_bf16_f32 %0, %1, %2" : "=v"(r) : "v"(lo), "v"(hi)); return r; }
typedef float f32x2 __attribute__((ext_vector_type(2)));

struct EpiF32 {
    static constexpr bool PERM = false, AFTER_DRAIN = false;
    float* C; int ldc;
    __device__ __forceinline__ void operator()(const f32x4 (&acc)[2][2][4][2], const Unit& u, int wr, int wc, int fr, int fq) const {
        const int row0 = u.pm * BM + wr * 64 + fr, col0 = u.pn * BM + wc * 32 + 4 * fq;
#pragma unroll
        for (int ai = 0; ai < 2; ++ai)
#pragma unroll
            for (int m = 0; m < 4; ++m) { float* rowp = C + (size_t)(row0 + ai * HALF + m * 16) * ldc + col0;
#pragma unroll
                for (int bj = 0; bj < 2; ++bj)
#pragma unroll
                    for (int n = 0; n < 2; ++n) *(f32x4*)(rowp + bj * HALF + n * 16) = acc[ai][bj][m][n]; }
    }
};
__device__ __forceinline__ float silu_fast(float g) { return g * __builtin_amdgcn_rcpf(1.f + __builtin_amdgcn_exp2f(-1.4426950408889634f * g)); }
struct EpiSwiGLU {
    static constexpr bool PERM = true, AFTER_DRAIN = false;
    bf16_t* act;
    __device__ __forceinline__ void operator()(const f32x4 (&acc)[2][2][4][2], const Unit& u, int wr, int wc, int fr, int fq) const {
        const int row0 = u.pm * BM + wr * 64 + fr, col0 = u.pn * HALF + wc * 32 + 8 * fq;
#pragma unroll
        for (int ai = 0; ai < 2; ++ai)
#pragma unroll
            for (int m = 0; m < 4; ++m) { const f32x4 g0 = acc[ai][0][m][0], g1 = acc[ai][0][m][1], u0 = acc[ai][1][m][0], u1 = acc[ai][1][m][1];
                u32x4 w; w.x = cvt_pk_bf16(silu_fast(g0[0]) * u0[0], silu_fast(g0[1]) * u0[1]); w.y = cvt_pk_bf16(silu_fast(g0[2]) * u0[2], silu_fast(g0[3]) * u0[3]);
                w.z = cvt_pk_bf16(silu_fast(g1[0]) * u1[0], silu_fast(g1[1]) * u1[1]); w.w = cvt_pk_bf16(silu_fast(g1[2]) * u1[2], silu_fast(g1[3]) * u1[3]);
                *(u32x4*)(act + (size_t)(row0 + ai * HALF + m * 16) * DFF + col0) = w; }
    }
};
struct EpiResGate {
    static constexpr bool PERM = false, AFTER_DRAIN = false;
    float* X; const float* modl; int slot; float coef;
    __device__ __forceinline__ void operator()(const f32x4 (&acc)[2][2][4][2], const Unit& u, int wr, int wc, int fr, int fq) const {
        const int row0 = u.pm * BM + wr * 64 + fr, col0 = u.pn * BM + wc * 32 + 4 * fq;
        const int q = u.pm % 17, midx = q == 0 ? 4 : u.pm / 17;
        const float* gp = modl + ((size_t)midx * 9 + 3 * slot + 2) * D + col0;
        f32x4 gv[2][2];
#pragma unroll
        for (int bj = 0; bj < 2; ++bj)
#pragma unroll
            for (int n = 0; n < 2; ++n) gv[bj][n] = *(const f32x4*)(gp + bj * HALF + n * 16) * coef;
#pragma unroll
        for (int ai = 0; ai < 2; ++ai)
#pragma unroll
            for (int m = 0; m < 4; ++m) { float* rowp = X + (size_t)(row0 + ai * HALF + m * 16) * D + col0;
#pragma unroll
                for (int bj = 0; bj < 2; ++bj)
#pragma unroll
                    for (int n = 0; n < 2; ++n) { f32x4* px = (f32x4*)(rowp + bj * HALF + n * 16); *px = *px + gv[bj][n] * acc[ai][bj][m][n]; } }
    }
};
struct EpiKV {
    static constexpr bool PERM = true, AFTER_DRAIN = false;
    bf16_t* KN; bf16_t* V;
    __device__ __forceinline__ void operator()(const f32x4 (&acc)[2][2][4][2], const Unit& u, int wr, int wc, int fr, int fq) const {
        const int row0 = u.pm * BM + wr * 64 + fr, col0 = u.pn * HALF + wc * 32 + 8 * fq;
#pragma unroll
        for (int ai = 0; ai < 2; ++ai)
#pragma unroll
            for (int m = 0; m < 4; ++m)
#pragma unroll
                for (int bj = 0; bj < 2; ++bj) { const f32x4 v0 = acc[ai][bj][m][0], v1 = acc[ai][bj][m][1];
                    u32x4 w; w.x = cvt_pk_bf16(v0[0], v0[1]); w.y = cvt_pk_bf16(v0[2], v0[3]); w.z = cvt_pk_bf16(v1[0], v1[1]); w.w = cvt_pk_bf16(v1[2], v1[3]);
                    *(u32x4*)((bj ? V : KN) + (size_t)(row0 + ai * HALF + m * 16) * D + col0) = w; }
    }
};
template <int MODE> struct EpiRope {
    static constexpr bool PERM = false, AFTER_DRAIN = false;
    bf16_t* C; int ldc; const float* rope;
    __device__ __forceinline__ void operator()(const f32x4 (&acc)[2][2][4][2], const Unit& u, int wr, int wc, int fr, int fq) const {
        typedef unsigned u32x2 __attribute__((ext_vector_type(2)));
        const int row0 = u.pm * BM + wr * 64 + fr, col0 = u.pn * BM + wc * 32 + 4 * fq;
        const int q = u.pm % 17; const bool isctx = q == 0; const int t0 = (q - 1) * 256 + wr * 64 + fr;
#pragma unroll
        for (int bj = 0; bj < 2; ++bj) {
            const int g32 = 8 * u.pn + 4 * bj + wc; int ty;
            if (MODE == 0) { const int gi = g32 % 6; ty = gi == 4 ? 1 : (gi == 5 ? 2 : 0); } else { ty = g32 < 72 ? 1 + (g32 & 1) : 0; }
            if (isctx) ty = 0;
#pragma unroll
            for (int ai = 0; ai < 2; ++ai)
#pragma unroll
                for (int m = 0; m < 4; ++m) { f32x4 x1 = acc[ai][bj][m][0], x2 = acc[ai][bj][m][1];
                    if (ty) { const int t = t0 + ai * HALF + m * 16, pos = ty == 1 ? (t >> 6) : (t & 63); const f32x4* rp = (const f32x4*)(rope + (size_t)(pos * 16 + 4 * fq) * 2); const f32x4 r0 = rp[0], r1 = rp[1];
                        const f32x4 cs = {r0[0], r0[2], r1[0], r1[2]}, sn = {r0[1], r0[3], r1[1], r1[3]}; const f32x4 o1 = x1 * cs - x2 * sn, o2 = x2 * cs + x1 * sn; x1 = o1; x2 = o2; }
                    bf16_t* rowp = C + (size_t)(row0 + ai * HALF + m * 16) * ldc + col0 + bj * HALF;
                    u32x2 w0, w1; w0.x = cvt_pk_bf16(x1[0], x1[1]); w0.y = cvt_pk_bf16(x1[2], x1[3]); w1.x = cvt_pk_bf16(x2[0], x2[1]); w1.y = cvt_pk_bf16(x2[2], x2[3]);
                    *(u32x2*)rowp = w0; *(u32x2*)(rowp + 16) = w1; }
        }
    }
};

template <class Epi, class Sched, bool ALIGN_EPI = false, bool SP2 = false>
__device__ __forceinline__ void gemm_phase(PG8_LAS unsigned char* lds, const Gemm g, const Sched& S, const Epi& E) {
    int tid_ = threadIdx.x; asm volatile("" : "+v"(tid_));
    const int tid = tid_, wid = __builtin_amdgcn_readfirstlane(tid >> 6), lane = tid & 63, wr = wid >> 2, wc = wid & 3, fr = lane & 15, fq = lane >> 4;
    const int K = g.K, nt = K / BK;
    unsigned voffA[2], voffB[2];
#pragma unroll
    for (int i = 0; i < 2; ++i) { int R, C; stage_rc(tid * 16 + i * 8192, R, C); const int Rb = Epi::PERM ? ((R & ~31) + perm32(R & 31)) : R;
        voffA[i] = (unsigned)(R * K + C) * 2u; voffB[i] = (unsigned)(Rb * K + C) * 2u; }
    const size_t kstep = (size_t)(BK * 2);
    const size_t hstep = (size_t)HALF * K * 2;
    const size_t tstep = 2 * hstep;
    const unsigned ldsw = (unsigned)wid * 1024u;
    const int aoff = lds_byte(wr * 64 + fr, fq * 8), boff = lds_byte(wc * 32 + fr, fq * 8);
#define PG8_SA(b, h) (((b) * 2 + (h)) * HTB)
#define PG8_SB(b, h) ((4 + (b) * 2 + (h)) * HTB)
#define PG8_STAGE(bufoff, gbase, voff) do { _Pragma("unroll") for (int _i = 0; _i < 2; ++_i) \
        __builtin_amdgcn_global_load_lds((const unsigned*)((const char*)(gbase) + (voff)[_i]), (PG8_LAS unsigned*)(lds + (bufoff) + ldsw + _i * 8192), 16, 0, 0); } while (0)
#define PG8_LDA(dst, b, h) do { _Pragma("unroll") for (int m = 0; m < 4; ++m) _Pragma("unroll") for (int k = 0; k < 2; ++k) dst[m][k] = *(const PG8_LAS bf16x8*)(lds + PG8_SA(b, h) + aoff + m * 2048 + k * 1024); } while (0)
#define PG8_LDB(dst, b, h) do { _Pragma("unroll") for (int n = 0; n < 2; ++n) _Pragma("unroll") for (int k = 0; k < 2; ++k) dst[n][k] = *(const PG8_LAS bf16x8*)(lds + PG8_SB(b, h) + boff + n * 2048 + k * 1024); } while (0)
#define PG8_MMA(ai, bj, At, Bt) do { __builtin_amdgcn_s_setprio(1); _Pragma("unroll") for (int m = 0; m < 4; ++m) _Pragma("unroll") for (int n = 0; n < 2; ++n) _Pragma("unroll") for (int k = 0; k < 2; ++k) \
        acc[ai][bj][m][n] = __builtin_amdgcn_mfma_f32_16x16x32_bf16(Bt[n][k], At[m][k], acc[ai][bj][m][n], 0, 0, 0); __builtin_amdgcn_s_setprio(0); } while (0)
#define PG8_WAIT_V(n) asm volatile("s_waitcnt vmcnt(" #n ")" ::: "memory")
#define PG8_WAIT_L(n) asm volatile("s_waitcnt lgkmcnt(" #n ")" ::: "memory")
#define PG8_BAR __builtin_amdgcn_s_barrier()
#define PG8_SCHED __builtin_amdgcn_sched_barrier(0)
    Unit cur, nxt; int ui = 0;
    if (!S.next(0, cur)) return;
    f32x4 acc[2][2][4][2];
#pragma unroll
    for (int a = 0; a < 2; ++a)
#pragma unroll
        for (int b = 0; b < 2; ++b)
#pragma unroll
            for (int m = 0; m < 4; ++m)
#pragma unroll
                for (int n = 0; n < 2; ++n) acc[a][b][m][n] = (f32x4){0.f, 0.f, 0.f, 0.f};
    bf16x8 At[4][2], B0[2][2], B1[2][2];
    const char* cA = (const char*)g.A + (size_t)cur.pm * tstep; const char* cB = (const char*)g.Bt + (size_t)cur.pn * tstep;
    S.a_ready(cur);
    if constexpr (SP2) {
        PG8_STAGE(PG8_SB(0, 0), cB, voffB); PG8_STAGE(PG8_SB(0, 1), cB + hstep, voffB); PG8_STAGE(PG8_SA(0, 0), cA, voffA); PG8_STAGE(PG8_SA(0, 1), cA + hstep, voffA);
        if (wr == 1) PG8_BAR;
        PG8_WAIT_V(2); PG8_BAR;
        PG8_STAGE(PG8_SB(1, 0), cB + kstep, voffB); PG8_STAGE(PG8_SA(1, 0), cA + kstep, voffA); PG8_STAGE(PG8_SB(1, 1), cB + hstep + kstep, voffB);
        PG8_WAIT_V(6); PG8_BAR;
    } else {
        PG8_STAGE(PG8_SB(0, 0), cB, voffB); PG8_STAGE(PG8_SA(0, 0), cA, voffA); PG8_STAGE(PG8_SB(0, 1), cB + hstep, voffB); PG8_STAGE(PG8_SA(0, 1), cA + hstep, voffA);
        if (wr == 1) PG8_BAR;
        PG8_WAIT_V(4); PG8_BAR;
        PG8_STAGE(PG8_SB(1, 0), cB + kstep, voffB); PG8_STAGE(PG8_SA(1, 0), cA + kstep, voffA); PG8_STAGE(PG8_SB(1, 1), cB + hstep + kstep, voffB);
        PG8_WAIT_V(6); PG8_BAR;
    }
    for (;;) {
        const bool has_next = S.next(ui + 1, nxt);
        const char* nA = has_next ? (const char*)g.A + (size_t)nxt.pm * tstep : cA; const char* nB = has_next ? (const char*)g.Bt + (size_t)nxt.pn * tstep : cB;
        for (int t = 0; t < nt; t += 2) {
            const bool last = (t == nt - 2);
            const char* a1 = cA + (size_t)(t + 1) * kstep;
            const char* a2 = last ? nA : cA + (size_t)(t + 2) * kstep; const char* b2 = last ? nB : cB + (size_t)(t + 2) * kstep;
            const char* a3 = a2 + kstep; const char* b3 = b2 + kstep;
            if (last && has_next) S.a_ready(nxt);
            if constexpr (SP2) {
            PG8_LDB(B0, 0, 0); PG8_LDB(B1, 0, 1); PG8_SCHED; PG8_LDA(At, 0, 0); PG8_STAGE(PG8_SA(1, 1), a1 + hstep, voffA);
            PG8_WAIT_V(8); PG8_WAIT_L(0); PG8_BAR; PG8_MMA(0, 0, At, B0); PG8_MMA(0, 1, At, B1); PG8_BAR; PG8_SCHED;
            PG8_LDA(At, 0, 1); PG8_STAGE(PG8_SB(0, 0), b2, voffB); PG8_STAGE(PG8_SB(0, 1), b2 + hstep, voffB); PG8_STAGE(PG8_SA(0, 0), a2, voffA);
            PG8_WAIT_V(8); PG8_WAIT_L(0); PG8_BAR; PG8_MMA(1, 0, At, B0); PG8_MMA(1, 1, At, B1); PG8_BAR; PG8_SCHED;
            PG8_LDB(B0, 1, 0); PG8_LDB(B1, 1, 1); PG8_SCHED; PG8_LDA(At, 1, 0); PG8_STAGE(PG8_SA(0, 1), a2 + hstep, voffA);
            PG8_WAIT_V(8); PG8_WAIT_L(0); PG8_BAR; PG8_MMA(0, 0, At, B0); PG8_MMA(0, 1, At, B1); PG8_BAR; PG8_SCHED;
            PG8_LDA(At, 1, 1); PG8_STAGE(PG8_SB(1, 0), b3, voffB); PG8_STAGE(PG8_SB(1, 1), b3 + hstep, voffB); PG8_STAGE(PG8_SA(1, 0), a3, voffA);
            PG8_WAIT_V(8); PG8_WAIT_L(0); PG8_BAR; PG8_MMA(1, 0, At, B0); PG8_MMA(1, 1, At, B1); PG8_BAR; PG8_SCHED;
            } else {
            PG8_LDB(B0, 0, 0); PG8_SCHED; PG8_LDA(At, 0, 0); PG8_STAGE(PG8_SA(1, 1), a1 + hstep, voffA);
            PG8_WAIT_L(8); PG8_BAR; PG8_WAIT_L(0); PG8_MMA(0, 0, At, B0); PG8_BAR; PG8_SCHED;
            PG8_LDB(B1, 0, 1); PG8_STAGE(PG8_SB(0, 0), b2, voffB);
            PG8_BAR; PG8_WAIT_L(0); PG8_MMA(0, 1, At, B1); PG8_BAR;
            PG8_LDA(At, 0, 1); PG8_STAGE(PG8_SA(0, 0), a2, voffA);
            PG8_BAR; PG8_WAIT_L(0); PG8_MMA(1, 0, At, B0); PG8_BAR; PG8_SCHED;
            PG8_STAGE(PG8_SB(0, 1), b2 + hstep, voffB);
            PG8_WAIT_V(6); PG8_BAR; PG8_MMA(1, 1, At, B1); PG8_BAR;
            PG8_LDB(B0, 1, 0); PG8_SCHED; PG8_LDA(At, 1, 0); PG8_STAGE(PG8_SA(0, 1), a2 + hstep, voffA);
            PG8_WAIT_L(8); PG8_BAR; PG8_WAIT_L(0); PG8_MMA(0, 0, At, B0); PG8_BAR; PG8_SCHED;
            PG8_LDB(B1, 1, 1); PG8_STAGE(PG8_SB(1, 0), b3, voffB);
            PG8_BAR; PG8_WAIT_L(0); PG8_MMA(0, 1, At, B1); PG8_BAR;
            PG8_LDA(At, 1, 1); PG8_STAGE(PG8_SA(1, 0), a3, voffA);
            PG8_BAR; PG8_WAIT_L(0); PG8_MMA(1, 0, At, B0); PG8_BAR; PG8_SCHED;
            PG8_STAGE(PG8_SB(1, 1), b3 + hstep, voffB);
            PG8_WAIT_V(6); PG8_BAR; PG8_MMA(1, 1, At, B1); PG8_BAR;
            }
        }
        if constexpr (ALIGN_EPI) { if (wr == 0) PG8_BAR; }
        if constexpr (!Epi::AFTER_DRAIN) { E(acc, cur, wr, wc, fr, fq); S.done(cur); }
        if (!has_next) break;
#pragma unroll
        for (int a = 0; a < 2; ++a)
#pragma unroll
            for (int b = 0; b < 2; ++b)
#pragma unroll
                for (int m = 0; m < 4; ++m)
#pragma unroll
                    for (int n = 0; n < 2; ++n) acc[a][b][m][n] = (f32x4){0.f, 0.f, 0.f, 0.f};
        cur = nxt; cA = nA; cB = nB; ++ui;
        if constexpr (ALIGN_EPI) { if (wr == 1) PG8_BAR; }
    }
    PG8_WAIT_V(0);
    if constexpr (!ALIGN_EPI) { if (wr == 0) PG8_BAR; }
    PG8_BAR;
    if constexpr (Epi::AFTER_DRAIN) { E.fused(acc, cur, wr, wc, fr, fq, lds, wid, lane); S.done(cur); }
#undef PG8_SA
#undef PG8_SB
#undef PG8_STAGE
#undef PG8_LDA
#undef PG8_LDB
#undef PG8_MMA
#undef PG8_WAIT_V
#undef PG8_WAIT_L
#undef PG8_BAR
#undef PG8_SCHED
}
}

namespace {

#define LAS __attribute__((address_space(3)))
__device__ __forceinline__ void conv_item(const float* __restrict__ W, int K, int N, u16* __restrict__ WT, int rowbase, float* scr, int kb, int nb, int lane) {
    const int k0 = 64 * kb, n0 = 32 * nb;
#pragma unroll 8
    for (int i = 0; i < 32; ++i) { const int kk = 2 * i + (lane >> 5); scr[kk * 33 + (lane & 31)] = W[(size_t)(k0 + kk) * N + n0 + (lane & 31)]; }
    asm volatile("s_waitcnt lgkmcnt(0)" ::: "memory");
    const int c = lane & 7;
#pragma unroll
    for (int j = 0; j < 4; ++j) { const int n = (lane >> 3) + 8 * j; const float* s = scr + (8 * c) * 33 + n;
        uint4 o; o.x = pk2(s[0 * 33], s[1 * 33]); o.y = pk2(s[2 * 33], s[3 * 33]); o.z = pk2(s[4 * 33], s[5 * 33]); o.w = pk2(s[6 * 33], s[7 * 33]);
        *(uint4*)(WT + (size_t)(rowbase + n) * K + k0 + 8 * c) = o; }
    asm volatile("s_waitcnt lgkmcnt(0)" ::: "memory");
}
__device__ __forceinline__ void conv_matrix(const float* W, int K, int N, u16* WT, int roff, int GU, float* scr, int gw, int ngw, int lane) {
    const int nnb = N / 32, nitems = (K / 64) * nnb;
    for (int it = gw; it < nitems; it += ngw) { const int kb = it / nnb, nb = it % nnb, n0 = 32 * nb;
        const int rowbase = GU == 0 ? roff + n0 : 256 * (n0 / 128) + (GU == 2 ? 128 : 0) + (n0 % 128);
        conv_item(W, K, N, WT, rowbase, scr, kb, nb, lane); }
}
struct ConvDesc { const float* W; u16* WT; int K, N, roff, GU; };
__device__ __forceinline__ void conv_all(const Ptrs& p, ConvDesc* tab, float* scr, int gw, int ngw, int lane) {
    unsigned char* ws = p.ws;
    int t = threadIdx.x; asm volatile("" : "+v"(t));
    if (t < 38) {
        ConvDesc d;
        if (t < 24) { const int lf = t / 3, w = t % 3;
            if (w == 0) d = ConvDesc{p.in[I_WG] + (size_t)lf * D * DFF, (u16*)(ws + WS_WGU + lf * SZ_WGU), D, DFF, 0, 1};
            else if (w == 1) d = ConvDesc{p.in[I_WU] + (size_t)lf * D * DFF, (u16*)(ws + WS_WGU + lf * SZ_WGU), D, DFF, 0, 2};
            else d = ConvDesc{p.in[I_WD] + (size_t)lf * DFF * D, (u16*)(ws + WS_WD + lf * SZ_WD), DFF, D, 0, 0};
        } else if (t < 34) { const int j = (t - 24) / 5, w = (t - 24) % 5; u16* wdq = (u16*)(ws + WS_WDQKV) + (size_t)j * QKVA_LD * D;
            if (w == 0) d = ConvDesc{p.in[I_DQ] + (size_t)j * D * 512, wdq, D, 512, 0, 0};
            else if (w == 1) d = ConvDesc{p.in[I_DKV] + (size_t)j * D * 576, wdq, D, 576, 512, 0};
            else if (w == 2) d = ConvDesc{p.in[I_UQ] + (size_t)j * 512 * 3072, (u16*)(ws + WS_WUQ) + (size_t)j * 3072 * 512, 512, 3072, 0, 0};
            else if (w == 3) d = ConvDesc{p.in[I_UKV] + (size_t)j * 512 * 4096, (u16*)(ws + WS_WUKV) + (size_t)j * 4096 * 512, 512, 4096, 0, 0};
            else d = ConvDesc{p.in[I_MWO] + (size_t)j * D * D, (u16*)(ws + WS_WMO) + (size_t)j * D * D, D, D, 0, 0};
        } else if (t == 34) d = ConvDesc{p.in[I_HWIN], (u16*)(ws + WS_WHIN), D, 3 * D, 0, 0};
        else if (t == 35) d = ConvDesc{p.in[I_HWOUT], (u16*)(ws + WS_WHOUT), D, D, 0, 0};
        else if (t == 36) d = ConvDesc{p.in[I_WQKV], (u16*)(ws + WS_WWQKV), D, 2560, 0, 0};
        else d = ConvDesc{p.in[I_WWO], (u16*)(ws + WS_WWO), D, D, 0, 0};
        tab[t] = d;
    }
    __syncthreads();
#pragma unroll 1
    for (int m = 0; m < 38; ++m) { const ConvDesc d = tab[m]; conv_matrix(d.W, d.K, d.N, d.WT, d.roff, d.GU, scr, gw, ngw, lane); }
    for (int j = 0; j < 2; ++j) { u16* wdq = (u16*)(ws + WS_WDQKV) + (size_t)j * QKVA_LD * D;
        for (int i = gw * 64 + lane; i < (QKVA_LD - 1088) * D / 8; i += ngw * 64) ((uint4*)(wdq + (size_t)1088 * D))[i] = make_uint4(0u, 0u, 0u, 0u); }
    __syncthreads();
}

#define XB_TMO      128
#define XB_XCNT(j)  (256  + 64 * (j))
#define XB_XSUB(j)  (1280 + 64 * (j))
#define XB_XGEN(j)  (2304 + 64 * (j))
#define XB_TOP      3328
#define XB_TOPGEN   3392
#define XCD_BAR_WORDS 3456
#define XB_SPIN_CAP (1u << 22)

__device__ __forceinline__ unsigned xb_ld(unsigned* p)              { return __hip_atomic_load(p, __ATOMIC_RELAXED, __HIP_MEMORY_SCOPE_AGENT); }
__device__ __forceinline__ unsigned xb_add(unsigned* p, unsigned v) { return __hip_atomic_fetch_add(p, v, __ATOMIC_RELAXED, __HIP_MEMORY_SCOPE_AGENT); }
__device__ __forceinline__ unsigned xb_xcc_id() { return (unsigned)__builtin_amdgcn_s_getreg((3 << 11) | 20) & 0xFu; }
#define XB_SPIN(cond, bar) do { unsigned _sp = 0; while (cond) { __builtin_amdgcn_s_sleep(1); \
    if ((++_sp & 255u) == 0u) { if (xb_ld(&(bar)[XB_TMO])) break; if (_sp > XB_SPIN_CAP) { atomicAdd(&(bar)[XB_TMO], 1u); break; } } } } while (0)

struct XcdBarrier {
    unsigned* bar; unsigned x;
    volatile LAS unsigned* st;
};

__device__ __forceinline__ XcdBarrier xcd_barrier_post(unsigned* bar, volatile LAS unsigned* st) {
    XcdBarrier b; b.bar = bar; b.x = xb_xcc_id(); b.st = st;
    if (threadIdx.x == 0) (void)xb_add(&bar[XB_XCNT(b.x)], 1u);
    return b;
}
__device__ __forceinline__ void xcd_barrier_complete(unsigned* bar, unsigned x, unsigned& nloc, unsigned& nx) {
    const unsigned G = gridDim.x * gridDim.y * gridDim.z;
    unsigned sum, cnt, mine, sp = 0u;
    for (;;) {
        sum = 0u; cnt = 0u; mine = 0u;
#pragma unroll
        for (unsigned j = 0; j < 16; ++j) { const unsigned c = xb_ld(&bar[XB_XCNT(j)]); sum += c; cnt += (c > 0u) ? 1u : 0u; mine = (j == x) ? c : mine; }
        if (sum == G) break;
        __builtin_amdgcn_s_sleep(1);
        if ((++sp & 255u) == 0u) { if (xb_ld(&bar[XB_TMO])) break; if (sp > XB_SPIN_CAP) { atomicAdd(&bar[XB_TMO], 1u); break; } }
    }
    nloc = mine > 0u ? mine : 1u; nx = cnt > 0u ? cnt : 1u;
}

__device__ __forceinline__ void xcd_barrier(const XcdBarrier& b) {
    asm volatile("s_waitcnt vmcnt(0)" ::: "memory");
    __syncthreads();
    if (threadIdx.x == 0) {
        unsigned* bar = b.bar;
        unsigned xq = xb_xcc_id(); asm volatile("" : "+s"(xq));
        __builtin_amdgcn_s_waitcnt(0);
        unsigned nloc = b.st[0], nx = b.st[1];
        if (nloc == 0u) { xcd_barrier_complete(bar, xq, nloc, nx); b.st[0] = nloc; b.st[1] = nx; }
        const unsigned old = xb_add(&bar[XB_XSUB(xq)], 1u);
        const unsigned gen = old / nloc;
        if (old + 1u == (gen + 1u) * nloc) {
            __builtin_amdgcn_fence(__ATOMIC_RELEASE, "agent");
            asm volatile("s_waitcnt vmcnt(0)" ::: "memory");
            const unsigned og = xb_add(&bar[XB_TOP], 1u);
            const unsigned tg = og / nx;
            if (og + 1u == (tg + 1u) * nx) xb_add(&bar[XB_TOPGEN], 1u);
            else XB_SPIN(xb_ld(&bar[XB_TOPGEN]) == tg, bar);
            __builtin_amdgcn_fence(__ATOMIC_ACQUIRE, "agent");
            xb_add(&bar[XB_XGEN(xq)], 1u);
            asm volatile("s_waitcnt vmcnt(0)" ::: "memory");
        } else {
            XB_SPIN(xb_ld(&bar[XB_XGEN(xq)]) == gen, bar);
            __builtin_amdgcn_fence(__ATOMIC_ACQUIRE, "agent");
            asm volatile("s_waitcnt vmcnt(0)" ::: "memory");
        }
    }
    __syncthreads();
}


#define PH __device__ __forceinline__
#define LDSWAIT() asm volatile("s_waitcnt lgkmcnt(0)" ::: "memory")
__device__ __forceinline__ int otid() { int t = threadIdx.x; asm volatile("" : "+v"(t)); return t; }
PH void ph_assemble(const Ptrs& p, int wg, int nwg) {
    const int TID = otid();
    float4* X = (float4*)(p.ws + WS_X);
    const size_t n = (size_t)R * D / 4;
    for (size_t i = (size_t)wg * 512 + TID; i < n; i += (size_t)nwg * 512) {
        const int r = (int)(i / (D / 4)), c4 = (int)(i % (D / 4));
        const int b = r / SB, j = r - b * SB;
        const float4* src = j < CTX ? (const float4*)(p.in[I_CTX] + ((size_t)b * CTX + j) * D) : (const float4*)(p.in[I_X] + ((size_t)b * S + (j - CTX)) * D);
        X[i] = src[c4];
    }
}
PH void ph_modp(const Ptrs& p, float* sc, int wg, int nwg) {
    const int TID = otid();
    for (int i = TID; i < 5 * D; i += 512) { const int m = i / D, k = i % D; const float v = m < 4 ? p.in[I_C][m * D + k] : p.in[I_CCTX][k]; sc[i] = silu_f(v); }
    __syncthreads();
    const int wave = TID >> 6, lane = TID & 63;
    float* MODP = (float*)(p.ws + WS_MODP);
    const int nitems = DEPTH * 72 * 16;
    for (int item = wg * 8 + wave; item < nitems; item += nwg * 8) {
        const int kc = item % 16, cg = (item / 16) % 72, layer = item / (16 * 72);
        const int col = cg * 256 + lane * 4;
        const float* w = p.in[I_MODW] + (size_t)layer * D * NMODV + (size_t)(kc * 128) * NMODV + col;
        float acc[5][4];
#pragma unroll
        for (int m = 0; m < 5; ++m) { acc[m][0] = acc[m][1] = acc[m][2] = acc[m][3] = 0.f; }
#pragma unroll 4
        for (int k = 0; k < 128; ++k) {
            const float4 wv = *(const float4*)(w + (size_t)k * NMODV);
#pragma unroll
            for (int m = 0; m < 5; ++m) { const float s = sc[m * D + kc * 128 + k]; acc[m][0] += s * wv.x; acc[m][1] += s * wv.y; acc[m][2] += s * wv.z; acc[m][3] += s * wv.w; }
        }
#pragma unroll
        for (int m = 0; m < 5; ++m) *(float4*)(MODP + ((size_t)(kc * DEPTH + layer) * 5 + m) * NMODV + col) = make_float4(acc[m][0], acc[m][1], acc[m][2], acc[m][3]);
    }
    __syncthreads();
}
PH void ph_modr(const Ptrs& p, int wg, int nwg) {
    const int TID = otid();
    const float* MODP = (const float*)(p.ws + WS_MODP); float* MOD = (float*)(p.ws + WS_MOD);
    const int n = DEPTH * 5 * NMODV;
    for (int i = wg * 512 + TID; i < n; i += nwg * 512) {
        const int col = i % NMODV, layer = i / (5 * NMODV);
        float s = p.in[I_MODB][layer * NMODV + col];
        for (int kc = 0; kc < 16; ++kc) s += MODP[(size_t)kc * n + i];
        MOD[i] = s;
    }
}
PH void ph_tables(const Ptrs& p, int wg, int nwg) {
    const int TID = otid();
    float* rope = (float*)(p.ws + WS_ROPE); float* tw = (float*)(p.ws + WS_TW);
    for (int i = wg * 512 + TID; i < 8192; i += nwg * 512) {
        if (i < 64 * 16) { const int pos = i / 16, k = i % 16; const float inv = (float)exp2(-(double)k / 16.0 * 13.287712379549449); const float ang = (float)pos * inv;
            rope[2 * i] = (float)cos((double)ang); rope[2 * i + 1] = (float)sin((double)ang); }
        const double a = -2.0 * 3.14159265358979323846 * (double)i / 8192.0; tw[2 * i] = (float)cos(a); tw[2 * i + 1] = (float)sin(a);
    }
}
PH void ph_modulate(const Ptrs& p, int layer, int slot, int wg, int nwg) {
    const int TID = otid();
    const float* X = (const float*)(p.ws + WS_X); u16* HB = (u16*)(p.ws + WS_HB); const float* MOD = (const float*)(p.ws + WS_MOD);
    const float* g = p.in[I_NORMG] + ((size_t)layer * 3 + slot) * D;
    const int wave = TID >> 6, lane = TID & 63;
    for (int r = wg * 8 + wave; r < R; r += nwg * 8) {
        const float4* xr = (const float4*)(X + (size_t)r * D);
        float4 v[8]; float ss = 0.f;
#pragma unroll
        for (int i = 0; i < 8; ++i) { v[i] = xr[lane + 64 * i]; ss += v[i].x * v[i].x + v[i].y * v[i].y + v[i].z * v[i].z + v[i].w * v[i].w; }
        const float rs = rsqrtf(wave_sum(ss) * (1.f / D) + NORM_EPS);
        const float* mb = MOD + ((size_t)(layer * 5 + modidx_of_row(r)) * 9 + 3 * slot) * D;
        uint2* o = (uint2*)(HB + (size_t)r * D);
#pragma unroll
        for (int i = 0; i < 8; ++i) { const int c4 = lane + 64 * i; const float4 gg = ((const float4*)g)[c4], sh = ((const float4*)mb)[c4], sl = ((const float4*)(mb + D))[c4];
            const float a = v[i].x * rs * gg.x * (1.f + sl.x) + sh.x, b = v[i].y * rs * gg.y * (1.f + sl.y) + sh.y, c = v[i].z * rs * gg.z * (1.f + sl.z) + sh.z, d = v[i].w * rs * gg.w * (1.f + sl.w) + sh.w;
            o[c4] = make_uint2(pk2(a, b), pk2(c, d)); }
    }
}
PH void ph_final(const Ptrs& p, int wg, int nwg) {
    const int TID = otid();
    const float* X = (const float*)(p.ws + WS_X); const float* g = p.in[I_FINALG];
    const int wave = TID >> 6, lane = TID & 63;
    for (int q = wg * 8 + wave; q < NB * S; q += nwg * 8) {
        const int b = q / S, t = q - b * S, r = b * SB + CTX + t;
        const float4* xr = (const float4*)(X + (size_t)r * D);
        float4 v[8]; float ss = 0.f;
#pragma unroll
        for (int i = 0; i < 8; ++i) { v[i] = xr[lane + 64 * i]; ss += v[i].x * v[i].x + v[i].y * v[i].y + v[i].z * v[i].z + v[i].w * v[i].w; }
        const float rs = rsqrtf(wave_sum(ss) * (1.f / D) + NORM_EPS);
        float4* o = (float4*)(p.out + (size_t)q * D);
#pragma unroll
        for (int i = 0; i < 8; ++i) { const int c4 = lane + 64 * i; const float4 gg = ((const float4*)g)[c4]; o[c4] = make_float4(v[i].x * rs * gg.x, v[i].y * rs * gg.y, v[i].z * rs * gg.z, v[i].w * rs * gg.w); }
    }
}
PH void ph_mla_norm(const Ptrs& p, int jm, int wg, int nwg) {
    const int TID = otid();
    const float* A = (const float*)(p.ws + WS_QKVA); u16* QL = (u16*)(p.ws + WS_QL); u16* CKV = (u16*)(p.ws + WS_CKV); u16* KR = (u16*)(p.ws + WS_KR);
    const float* gq = p.in[I_GQ] + jm * 512; const float* gkv = p.in[I_GKV] + jm * 512; const float* rope = (const float*)(p.ws + WS_ROPE);
    const int wave = TID >> 6, lane = TID & 63;
    for (int r = wg * 8 + wave; r < R; r += nwg * 8) {
        const float* a = A + (size_t)r * QKVA_LD;
        const float4 q0 = ((const float4*)a)[lane * 2], q1 = ((const float4*)a)[lane * 2 + 1];
        const float4 k0 = ((const float4*)(a + 512))[lane * 2], k1 = ((const float4*)(a + 512))[lane * 2 + 1];
        const float sq = wave_sum(q0.x * q0.x + q0.y * q0.y + q0.z * q0.z + q0.w * q0.w + q1.x * q1.x + q1.y * q1.y + q1.z * q1.z + q1.w * q1.w);
        const float sk = wave_sum(k0.x * k0.x + k0.y * k0.y + k0.z * k0.z + k0.w * k0.w + k1.x * k1.x + k1.y * k1.y + k1.z * k1.z + k1.w * k1.w);
        const float rq = rsqrtf(sq * (1.f / 512) + NORM_EPS), rk = rsqrtf(sk * (1.f / 512) + NORM_EPS);
        const float4 g0 = ((const float4*)gq)[lane * 2], g1 = ((const float4*)gq)[lane * 2 + 1], h0 = ((const float4*)gkv)[lane * 2], h1 = ((const float4*)gkv)[lane * 2 + 1];
        uint4 oq, ok;
        oq.x = pk2(q0.x * rq * g0.x, q0.y * rq * g0.y); oq.y = pk2(q0.z * rq * g0.z, q0.w * rq * g0.w); oq.z = pk2(q1.x * rq * g1.x, q1.y * rq * g1.y); oq.w = pk2(q1.z * rq * g1.z, q1.w * rq * g1.w);
        ok.x = pk2(k0.x * rk * h0.x, k0.y * rk * h0.y); ok.y = pk2(k0.z * rk * h0.z, k0.w * rk * h0.w); ok.z = pk2(k1.x * rk * h1.x, k1.y * rk * h1.y); ok.w = pk2(k1.z * rk * h1.z, k1.w * rk * h1.w);
        ((uint4*)(QL + (size_t)r * 512))[lane] = oq; ((uint4*)(CKV + (size_t)r * 512))[lane] = ok;
        if (lane < 32) {
            const int b = r / SB, j = r - b * SB; const int half = lane >> 4, i = lane & 15;
            const float x1 = a[1024 + 32 * half + i], x2 = a[1024 + 32 * half + 16 + i];
            float o1 = x1, o2 = x2;
            if (j >= CTX) { const int t = j - CTX, pos = half ? (t & 63) : (t >> 6); const float cs = rope[(pos * 16 + i) * 2], sn = rope[(pos * 16 + i) * 2 + 1]; o1 = x1 * cs - x2 * sn; o2 = x2 * cs + x1 * sn; }
            KR[(size_t)r * 64 + 32 * half + i] = f2bf(o1); KR[(size_t)r * 64 + 32 * half + 16 + i] = f2bf(o2);
        }
    }
}
PH void ph_transpose(const u16* __restrict__ ZT, u16* __restrict__ Z, u16* tile, int wg, int nwg) {
    const int TID = otid();
    const int tx = TID & 63, ty = TID >> 6;
    for (int u = wg; u < (R / 64) * (D / 64); u += nwg) {
        const int r0 = (u % (R / 64)) * 64, d0 = (u / (R / 64)) * 64;
        for (int i = ty; i < 64; i += 8) tile[i * 66 + tx] = ZT[(size_t)(d0 + i) * R + r0 + tx];
        __syncthreads();
        for (int i = ty; i < 64; i += 8) Z[(size_t)(r0 + i) * D + d0 + tx] = tile[tx * 66 + i];
        __syncthreads();
    }
}
template <int L> PH void ph_filters(const Ptrs& p, float* FT, float* lds, int wg, int nwg) {
    const int TID = otid();
    float* zf = lds; float* ha = lds + 16 * 33; float* hb = ha + 1024; float* h3t = hb + 1024; float* tp = h3t + 1024;
    const int tid = TID;
    const float* w1 = p.in[I_FW1]; const float* b1 = p.in[I_FB1]; const float* w2 = p.in[I_FW2]; const float* b2 = p.in[I_FB2]; const float* w3 = p.in[I_FW3]; const float* b3 = p.in[I_FB3]; const float* fr = p.in[I_FFREQ];
    const float* w4 = p.in[I_FW4]; const float* decay = p.in[I_DECAY];
    for (int unit = wg; unit < L / 16; unit += nwg) {
        const int l0 = unit * 16;
        for (int idx = tid; idx < 16 * 33; idx += 512) { const int pp = idx / 33, c = idx % 33, l = l0 + pp; const float t = (float)l / (float)(L - 1);
            float v;
            if (c == 0) { v = t; tp[pp] = t; }
            else { const int k = (c - 1) & 15; const float f = 1e-4f + (float)k * ((15.0f - 1e-4f) / 15.0f); const float w = 6.283185307179586f * (float)l / (float)L; const double a = (double)(f * w);
                v = c <= 16 ? (float)cos(a) : (float)(-sin(a)); }
            zf[pp * 33 + c] = v; }
        __syncthreads();
        for (int idx = tid; idx < 1024; idx += 512) { const int pp = idx >> 6, j = idx & 63; float s = b1[j]; for (int c = 0; c < 33; ++c) s += zf[pp * 33 + c] * w1[c * 64 + j]; ha[pp * 64 + j] = sinf(fr[j] * s); }
        __syncthreads();
        for (int idx = tid; idx < 1024; idx += 512) { const int pp = idx >> 6, j = idx & 63; float s = b2[j]; for (int c = 0; c < 64; ++c) s += ha[pp * 64 + c] * w2[c * 64 + j]; hb[pp * 64 + j] = sinf(fr[j] * s); }
        __syncthreads();
        for (int idx = tid; idx < 1024; idx += 512) { const int pp = idx >> 6, j = idx & 63; float s = b3[j]; for (int c = 0; c < 64; ++c) s += hb[pp * 64 + c] * w3[c * 64 + j]; h3t[j * 16 + pp] = sinf(fr[j] * s); }
        __syncthreads();
        for (int m = 0; m < 16; ++m) {
            const int n = tid + 512 * m; float acc[16];
#pragma unroll
            for (int q = 0; q < 16; ++q) acc[q] = 0.f;
            for (int k = 0; k < 64; ++k) { const float wv = w4[(size_t)k * 8192 + n];
#pragma unroll
                for (int q = 0; q < 16; ++q) acc[q] += h3t[k * 16 + q] * wv; }
            const float dc = fabsf(decay[n]); float* o = FT + (size_t)n * L + l0;
#pragma unroll
            for (int q = 0; q < 16; ++q) o[q] = acc[q] * expf(-tp[q] * dc);
        }
        __syncthreads();
    }
}
PH void ph_nattn_mla(const u16* __restrict__ Q, const u16* __restrict__ KN, const u16* __restrict__ KR, const u16* __restrict__ V, u16* __restrict__ O, float* lds, int wg, int nwg) {
    const int TID = otid();
    const int wave = TID >> 6, lane = TID & 63;
    float* pp = lds + wave * (SB + 192); float* qq = pp + SB;
    for (int item = wg * 8 + wave; item < R * 16; item += nwg * 8) {
        const int r = item >> 4, h = item & 15;
        const int b = r / SB, j = r - b * SB, nk = j < CTX ? CTX : SB, kb = b * SB;
        for (int c = lane; c < 192; c += 64) qq[c] = bf2f(Q[(size_t)r * 3072 + h * 192 + c]);
        LDSWAIT();
        const float scale = 0.07216878364870322f;
        float mx = -3.0e38f;
        for (int key = lane; key < nk; key += 64) {
            const uint4* kn = (const uint4*)(KN + (size_t)(kb + key) * D + h * 128); const uint4* kr = (const uint4*)(KR + (size_t)(kb + key) * 64);
            float s = 0.f;
#pragma unroll 4
            for (int c8 = 0; c8 < 24; ++c8) { const uint4 w = c8 < 16 ? kn[c8] : kr[c8 - 16]; const float* q8 = qq + c8 * 8;
                s += q8[0] * __uint_as_float(w.x << 16) + q8[1] * __uint_as_float(w.x & 0xffff0000u) + q8[2] * __uint_as_float(w.y << 16) + q8[3] * __uint_as_float(w.y & 0xffff0000u)
                   + q8[4] * __uint_as_float(w.z << 16) + q8[5] * __uint_as_float(w.z & 0xffff0000u) + q8[6] * __uint_as_float(w.w << 16) + q8[7] * __uint_as_float(w.w & 0xffff0000u); }
            s *= scale; pp[key] = s; mx = fmaxf(mx, s);
        }
        mx = wave_max(mx);
        float sum = 0.f;
        for (int key = lane; key < nk; key += 64) { const float e = expf(pp[key] - mx); pp[key] = e; sum += e; }
        sum = wave_sum(sum);
        LDSWAIT();
        float o0 = 0.f, o1 = 0.f;
        const u16* vb = V + (size_t)kb * D + h * 128 + lane;
        for (int key = 0; key < nk; ++key) { const float pv = pp[key]; o0 += pv * bf2f(vb[(size_t)key * D]); o1 += pv * bf2f(vb[(size_t)key * D + 64]); }
        const float inv = 1.f / sum;
        O[(size_t)r * D + h * 128 + lane] = f2bf(o0 * inv); O[(size_t)r * D + h * 128 + 64 + lane] = f2bf(o1 * inv);
        LDSWAIT();
    }
}
PH void ph_nattn_win(const u16* __restrict__ QKV, const float* __restrict__ sink, u16* __restrict__ O, float* lds, int wg, int nwg) {
    const int TID = otid();
    const int wave = TID >> 6, lane = TID & 63;
    float* pp = lds + wave * 640; float* qq = pp + 576;
    for (int item = wg * 8 + wave; item < R * 32; item += nwg * 8) {
        const int r = item >> 5, qh = item & 31, kvh = qh >> 3;
        const int b = r / SB, j = r - b * SB, kb = b * SB;
        qq[lane] = bf2f(QKV[(size_t)r * 2560 + qh * 64 + lane]);
        LDSWAIT();
        int lo = 0, nwin = 0; if (j >= CTX) { const int t = j - CTX; lo = t - 128 < 0 ? 0 : t - 128; const int hi = t + 128 > S - 1 ? S - 1 : t + 128; nwin = hi - lo + 1; }
        const int nk = CTX + nwin;
        float mx = sink[qh];
        for (int key = lane; key < nk; key += 64) {
            const int krow = kb + (key < CTX ? key : CTX + lo + (key - CTX));
            const uint4* kk = (const uint4*)(QKV + (size_t)krow * 2560 + 2048 + kvh * 64);
            float s = 0.f;
#pragma unroll
            for (int c8 = 0; c8 < 8; ++c8) { const uint4 w = kk[c8]; const float* q8 = qq + c8 * 8;
                s += q8[0] * __uint_as_float(w.x << 16) + q8[1] * __uint_as_float(w.x & 0xffff0000u) + q8[2] * __uint_as_float(w.y << 16) + q8[3] * __uint_as_float(w.y & 0xffff0000u)
                   + q8[4] * __uint_as_float(w.z << 16) + q8[5] * __uint_as_float(w.z & 0xffff0000u) + q8[6] * __uint_as_float(w.w << 16) + q8[7] * __uint_as_float(w.w & 0xffff0000u); }
            s *= 0.125f; pp[key] = s; mx = fmaxf(mx, s);
        }
        mx = wave_max(mx);
        float sum = 0.f;
        for (int key = lane; key < nk; key += 64) { const float e = expf(pp[key] - mx); pp[key] = e; sum += e; }
        sum = wave_sum(sum) + expf(sink[qh] - mx);
        LDSWAIT();
        float o = 0.f;
        for (int key = 0; key < nk; ++key) { const int krow = kb + (key < CTX ? key : CTX + lo + (key - CTX)); o += pp[key] * bf2f(QKV[(size_t)krow * 2560 + 2304 + kvh * 64 + lane]); }
        O[(size_t)r * D + qh * 64 + lane] = f2bf(o / sum);
        LDSWAIT();
    }
}
template <int L> PH void ph_nhyena(const Ptrs& p, const float* __restrict__ FT, float* lds, int wg, int nwg) {
    const int TID = otid();
    constexpr int NTL = L < 512 ? L : 512, CPB = 512 / NTL, PER = L / NTL;
    const float* UT = (const float*)(p.ws + WS_UT); u16* ZT = (u16*)(p.ws + WS_ZT);
    const float* cw = p.in[I_HCW]; const float* cb = p.in[I_HCB]; const float* skip = p.in[I_SKIP];
    const int sub = TID / NTL, tid = TID % NTL;
    float* z = lds + sub * 3 * L; float* f2 = z + L;
    for (int unit = wg; unit < NB * D / CPB; unit += nwg) {
        const int bd = unit * CPB + sub, b = bd / D, d = bd % D, rb = b * SB + (L == S ? CTX : 0);
        auto sconv = [&](int ch, int t) { const float* u = UT + (size_t)ch * R + rb; const float um = t > 0 ? u[t - 1] : 0.f, u0 = u[t], up = t < L - 1 ? u[t + 1] : 0.f;
            return um * cw[ch] + u0 * cw[3 * D + ch] + up * cw[6 * D + ch] + cb[ch]; };
        float zc[PER];
#pragma unroll
        for (int i = 0; i < PER; ++i) zc[i] = sconv(d, tid + NTL * i);
        for (int n = 0; n < 2; ++n) {
            __syncthreads();
#pragma unroll
            for (int i = 0; i < PER; ++i) z[tid + NTL * i] = zc[i];
            const float* ff = FT + (size_t)(n * 4096 + d) * L; const float* fb = FT + (size_t)(n * 4096 + 2048 + d) * L;
            for (int idx = tid; idx < 2 * L; idx += NTL) { const int lag = idx - L; f2[idx] = lag >= 0 ? ff[lag] : (lag > -L ? fb[-lag] : 0.f); }
            __syncthreads();
            float y[PER];
#pragma unroll
            for (int i = 0; i < PER; ++i) y[i] = 0.f;
            for (int s = 0; s < L; ++s) { const float zs = z[s];
#pragma unroll
                for (int i = 0; i < PER; ++i) y[i] += f2[L + tid + NTL * i - s] * zs; }
            const float sk = skip[n * D + d];
#pragma unroll
            for (int i = 0; i < PER; ++i) zc[i] = sconv((n + 1) * D + d, tid + NTL * i) * (y[i] + zc[i] * sk);
        }
#pragma unroll
        for (int i = 0; i < PER; ++i) ZT[(size_t)d * R + rb + tid + NTL * i] = f2bf(zc[i]);
        __syncthreads();
    }
}

namespace att {
typedef short bf16x8 __attribute__((ext_vector_type(8)));
typedef short s16x4 __attribute__((ext_vector_type(4)));
typedef float f32x16 __attribute__((ext_vector_type(16)));
typedef unsigned u32x4 __attribute__((ext_vector_type(4)));
#define ALDS __attribute__((address_space(3)))
#define ASBAR() __builtin_amdgcn_sched_barrier(0)
__device__ __forceinline__ int crow(int r, int hi) { return (r & 3) + 8 * (r >> 2) + 4 * hi; }
__device__ __forceinline__ unsigned cvtpk(float lo, float hi) { unsigned r; asm volatile("v_cvt_pk_bf16_f32 %0, %1, %2" : "=v"(r) : "v"(lo), "v"(hi)); return r; }
template <int STRIDE> __device__ __forceinline__ int kswz(int row, int colB) { return row * STRIDE + (colB ^ (((row >> 1) & 7) << 4)); }
template <int DV> __device__ __forceinline__ int v_st(int k, int c) { const int kk = (k & ~0xC) | ((k & 4) << 1) | ((k & 8) >> 1); return ((kk >> 3) * (DV / 32) + (c >> 5)) * 512 + ((kk & 7) * 32 + (c & 31)) * 2; }
__device__ __forceinline__ int v_rd_base(int lane) { return ((lane & 3) << 3) | (((lane >> 2) & 3) << 6) | (((lane >> 4) & 1) << 5) | (((lane >> 5) & 1) << 8); }
template <int DV> constexpr int v_rd_off(int d0, int ks, int half) { return d0 * 512 + ks * (2 * (DV / 32) * 512) + half * ((DV / 32) * 512); }
template <int OFF> __device__ __forceinline__ s16x4 tr_read(int vb) { s16x4 r; asm volatile("ds_read_b64_tr_b16 %0, %1 offset:%2" : "=&v"(r) : "v"(vb), "i"(OFF) : "memory"); return r; }
__device__ __forceinline__ void partialSM(f32x16& p0, f32x16& p1, float& m_reg, float& mn, float& alpha, const float C, const float THRR) {
    float pmax = p0[0];
#pragma unroll
    for (int r = 1; r < 16; ++r) pmax = fmaxf(pmax, p0[r]);
#pragma unroll
    for (int r = 0; r < 16; ++r) pmax = fmaxf(pmax, p1[r]);
    { auto rr = __builtin_amdgcn_permlane32_swap(__float_as_uint(pmax), __float_as_uint(pmax), false, false); pmax = fmaxf(__uint_as_float(rr[0]), __uint_as_float(rr[1])); }
    if (__builtin_expect(__all(pmax - m_reg <= THRR), 1)) { mn = m_reg; alpha = 1.f; }
    else { mn = fmaxf(m_reg, pmax); alpha = __builtin_amdgcn_exp2f((m_reg - mn) * C); m_reg = mn; }
    const float mnC = -mn * C;
#pragma unroll
    for (int r = 0; r < 16; ++r) p0[r] = fmaf(p0[r], C, mnC);
#pragma unroll
    for (int r = 0; r < 16; ++r) p1[r] = fmaf(p1[r], C, mnC);
#pragma unroll
    for (int r = 0; r < 16; ++r) p0[r] = __builtin_amdgcn_exp2f(p0[r]);
}
__device__ __forceinline__ void finishSM(f32x16& p0, f32x16& p1, float alpha, float& l_reg, bf16x8& pa0, bf16x8& pa1, bf16x8& pa2, bf16x8& pa3) {
#pragma unroll
    for (int r = 0; r < 16; ++r) p1[r] = __builtin_amdgcn_exp2f(p1[r]);
    float ps = 0;
#pragma unroll
    for (int r = 0; r < 16; ++r) ps += p0[r];
#pragma unroll
    for (int r = 0; r < 16; ++r) ps += p1[r];
    { auto rr = __builtin_amdgcn_permlane32_swap(__float_as_uint(ps), __float_as_uint(ps), false, false); ps = __uint_as_float(rr[0]) + __uint_as_float(rr[1]); }
    l_reg = l_reg * alpha + ps;
#define ATT_PK4(P, BASE, OUT) do { unsigned a0 = cvtpk(P[BASE + 0], P[BASE + 1]), a1 = cvtpk(P[BASE + 2], P[BASE + 3]);   \
    unsigned b0 = cvtpk(P[BASE + 4], P[BASE + 5]), b1 = cvtpk(P[BASE + 6], P[BASE + 7]);                              \
    auto r0 = __builtin_amdgcn_permlane32_swap(a0, b0, false, false); auto r1 = __builtin_amdgcn_permlane32_swap(a1, b1, false, false); \
    u32x4 w = {r0[0], r1[0], r0[1], r1[1]}; OUT = *reinterpret_cast<bf16x8*>(&w); } while (0)
    ATT_PK4(p0, 0, pa0); ATT_PK4(p0, 8, pa1); ATT_PK4(p1, 0, pa2); ATT_PK4(p1, 8, pa3);
#undef ATT_PK4
}
template <int DQK, int KST> __device__ __forceinline__ void qkt(f32x16& p0, f32x16& p1, const ALDS char* Ks, const bf16x8* qr, int r32, int hi) {
    p0 = f32x16{}; p1 = f32x16{};
#pragma unroll
    for (int d0 = 0; d0 < DQK / 16; ++d0) { const int cb = (d0 * 16 + hi * 8) * 2;
        const bf16x8 b0 = *reinterpret_cast<const ALDS bf16x8*>(Ks + kswz<KST>(r32, cb));
        const bf16x8 b1 = *reinterpret_cast<const ALDS bf16x8*>(Ks + kswz<KST>(32 + r32, cb));
        p0 = __builtin_amdgcn_mfma_f32_32x32x16_bf16(b0, qr[d0], p0, 0, 0, 0);
        p1 = __builtin_amdgcn_mfma_f32_32x32x16_bf16(b1, qr[d0], p1, 0, 0, 0); }
}
template <int D0, int DV> __device__ __forceinline__ void pv_one(f32x16& od, int vb, bf16x8 pa0, bf16x8 pa1, bf16x8 pa2, bf16x8 pa3) {
    const s16x4 l0 = tr_read<v_rd_off<DV>(D0, 0, 0)>(vb), h0 = tr_read<v_rd_off<DV>(D0, 0, 1)>(vb), l1 = tr_read<v_rd_off<DV>(D0, 1, 0)>(vb), h1 = tr_read<v_rd_off<DV>(D0, 1, 1)>(vb);
    const s16x4 l2 = tr_read<v_rd_off<DV>(D0, 2, 0)>(vb), h2 = tr_read<v_rd_off<DV>(D0, 2, 1)>(vb), l3 = tr_read<v_rd_off<DV>(D0, 3, 0)>(vb), h3 = tr_read<v_rd_off<DV>(D0, 3, 1)>(vb);
    asm volatile("s_waitcnt lgkmcnt(0)" ::: "memory"); ASBAR();
#define ATT_PK(L, H) (bf16x8){L[0], L[1], L[2], L[3], H[0], H[1], H[2], H[3]}
    od = __builtin_amdgcn_mfma_f32_32x32x16_bf16(pa0, ATT_PK(l0, h0), od, 0, 0, 0);
    od = __builtin_amdgcn_mfma_f32_32x32x16_bf16(pa1, ATT_PK(l1, h1), od, 0, 0, 0);
    od = __builtin_amdgcn_mfma_f32_32x32x16_bf16(pa2, ATT_PK(l2, h2), od, 0, 0, 0);
    od = __builtin_amdgcn_mfma_f32_32x32x16_bf16(pa3, ATT_PK(l3, h3), od, 0, 0, 0);
#undef ATT_PK
}

constexpr int MLA_LDS_BYTES = 2 * 16384 + 2 * 24576 + 2048;
__device__ __forceinline__ void mla_unit(const u16* __restrict__ Qb, const u16* __restrict__ KNh, const u16* __restrict__ KRb, const u16* __restrict__ Vh, u16* __restrict__ Ob, int nkeys, ALDS char* lds, int tid) {
    constexpr int SHV = 16384, SHK = 24576;
    constexpr float SCALE = 0.07216878364870322f, C = SCALE * 1.4426950408889634f, THRR = 8.f / SCALE;
    const int wid = tid >> 6, lane = tid & 63, r32 = lane & 31, hi = lane >> 5;
    ALDS char* V_lds = lds; ALDS char* K_lds = lds + 2 * SHV;
    ALDS float* wsc = (ALDS float*)(lds + 2 * SHV + 2 * SHK) + wid * 64; ALDS float* li_l = wsc; ALDS float* al_l = wsc + 32;
    float m_reg = -1e30f, l_reg = 0.f; f32x16 o[4] = {}; bf16x8 qr[12];
    const u16* Qw = Qb + (unsigned)((wid * 32 + r32) * 3072 + hi * 8);
#pragma unroll
    for (int d0 = 0; d0 < 12; ++d0) qr[d0] = *reinterpret_cast<const bf16x8*>(Qw + d0 * 16);
    const int sr = tid >> 4, sc = (tid & 15) * 8, krr = tid >> 3, krc = (tid & 7) * 8;
    const int vst0 = v_st<128>(sr, sc), vst1 = v_st<128>(32 + sr, sc);
    const int kst0 = kswz<384>(sr, sc * 2), kst1 = kswz<384>(32 + sr, sc * 2), kst2 = kswz<384>(krr, (128 + krc) * 2);
    const int vb0 = (int)(unsigned)(uintptr_t)V_lds + v_rd_base(lane);
    bf16x8 vs0, vs1, ks0, ks1, kr0;
const unsigned goff = (unsigned)(sr * 2048 + sc), kroff = (unsigned)(krr * 64 + krc);
#define MLA_SLOAD(k0) do { const u16* vp = Vh + (size_t)(k0) * 2048; const u16* kp = KNh + (size_t)(k0) * 2048; \
    vs0 = *reinterpret_cast<const bf16x8*>(vp + goff); vs1 = *reinterpret_cast<const bf16x8*>(vp + 32 * 2048 + goff); \
    ks0 = *reinterpret_cast<const bf16x8*>(kp + goff); ks1 = *reinterpret_cast<const bf16x8*>(kp + 32 * 2048 + goff); \
    kr0 = *reinterpret_cast<const bf16x8*>(KRb + (size_t)(k0) * 64 + kroff); } while (0)
#define MLA_SWRITE(b) do { *reinterpret_cast<ALDS bf16x8*>(V_lds + (b) * SHV + vst0) = vs0; *reinterpret_cast<ALDS bf16x8*>(V_lds + (b) * SHV + vst1) = vs1; \
    *reinterpret_cast<ALDS bf16x8*>(K_lds + (b) * SHK + kst0) = ks0; *reinterpret_cast<ALDS bf16x8*>(K_lds + (b) * SHK + kst1) = ks1; *reinterpret_cast<ALDS bf16x8*>(K_lds + (b) * SHK + kst2) = kr0; } while (0)
    const int NT = nkeys / 64;
    MLA_SLOAD(0); MLA_SWRITE(0); __syncthreads();
    for (int j = 0; j < NT; ++j) {
        const int b = j & 1;
        if (j + 1 < NT) MLA_SLOAD((j + 1) * 64);
        f32x16 p0, p1; float mn, alpha; bf16x8 pa0, pa1, pa2, pa3;
        qkt<192, 384>(p0, p1, K_lds + b * SHK, qr, r32, hi);
        partialSM(p0, p1, m_reg, mn, alpha, C, THRR);
        if (__any(alpha < 1.f)) { if (hi == 0) al_l[r32] = alpha; asm volatile("s_waitcnt lgkmcnt(0)" ::: "memory");
#pragma unroll
            for (int d = 0; d < 4; ++d)
#pragma unroll
                for (int r = 0; r < 16; ++r) o[d][r] *= al_l[crow(r, hi)]; }
        finishSM(p0, p1, alpha, l_reg, pa0, pa1, pa2, pa3); ASBAR();
        const int vb = vb0 + b * SHV;
        pv_one<0, 128>(o[0], vb, pa0, pa1, pa2, pa3); pv_one<1, 128>(o[1], vb, pa0, pa1, pa2, pa3); pv_one<2, 128>(o[2], vb, pa0, pa1, pa2, pa3); pv_one<3, 128>(o[3], vb, pa0, pa1, pa2, pa3);
        if (j + 1 < NT) MLA_SWRITE(b ^ 1);
        __syncthreads();
    }
#undef MLA_SLOAD
#undef MLA_SWRITE
    if (hi == 0) li_l[r32] = l_reg;
    asm volatile("s_waitcnt lgkmcnt(0)" ::: "memory");
    ALDS char* ost = lds + wid * 8704;
#pragma unroll
    for (int r = 0; r < 16; ++r) { const int orow = crow(r, hi); const float rl = __builtin_amdgcn_rcpf(li_l[orow]);
#pragma unroll
        for (int d0 = 0; d0 < 4; ++d0) *reinterpret_cast<ALDS u16*>(ost + orow * 272 + (d0 * 32 + r32) * 2) = f2bf(o[d0][r] * rl); }
    asm volatile("s_waitcnt lgkmcnt(0)" ::: "memory");
#pragma unroll
    for (int i = 0; i < 8; ++i) { const int row = i * 4 + (lane >> 4), ch = lane & 15; const u32x4 v = *reinterpret_cast<const ALDS u32x4*>(ost + row * 272 + ch * 16);
        *reinterpret_cast<u32x4*>(Ob + (unsigned)((wid * 32 + row) * 2048 + ch * 8)) = v; }
    __syncthreads();
}
}
PH void ph_attn_mla(const u16* __restrict__ Q, const u16* __restrict__ KN, const u16* __restrict__ KR, const u16* __restrict__ V, u16* __restrict__ O, unsigned char* lds, int wg, int nwg) {
    const int TID = otid();
    const int vcu = (nwg % 8 == 0) ? (wg % 8) * (nwg / 8) + wg / 8 : wg;
    for (int u = vcu; u < NB * 16 * 17; u += nwg) {
        int bh, qb; if (u < NB * 16 * 16) { bh = u >> 4; qb = 1 + (u & 15); } else { bh = u - NB * 16 * 16; qb = 0; }
        const int b = bh >> 4, h = bh & 15; const size_t kb = (size_t)b * SB, q0 = kb + (size_t)qb * 256;
        att::mla_unit(Q + q0 * 3072 + h * 192, KN + kb * D + h * 128, KR + kb * 64, V + kb * D + h * 128, O + q0 * D + h * 128, qb == 0 ? CTX : SB, (ALDS char*)lds, TID);
    }
}

constexpr int LDS_BYTES = 155648;
constexpr int LDS_MISC = LDS_BYTES - 256;
constexpr int CW_BAR = 4096;
constexpr size_t CTL_ZERO_BYTES = 65536;

__global__ void __launch_bounds__(512, 2) mega_fwd(Ptrs p) {
    extern __shared__ __attribute__((aligned(16))) unsigned char lds[];
    const int tid = threadIdx.x, wg = blockIdx.x, nwg = gridDim.x;
    volatile LAS unsigned* MISC = (volatile LAS unsigned*)((LAS unsigned char*)lds + LDS_MISC);
    if (tid < 64) MISC[tid] = 0u;
    __syncthreads();
    XcdBarrier bar = xcd_barrier_post((unsigned*)(p.ws + WS_CTL) + CW_BAR, MISC + 8);
#define GRID_BAR() xcd_barrier(bar)
    PG8_LAS unsigned char* ring = (PG8_LAS unsigned char*)lds;
    unsigned char* ws = p.ws;
    float* X = (float*)(ws + WS_X); u16* HB = (u16*)(ws + WS_HB); u16* ACT = (u16*)(ws + WS_ACT); const float* MOD = (const float*)(ws + WS_MOD); const float* rope = (const float*)(ws + WS_ROPE);

#ifndef NO_PRO
    ph_assemble(p, wg, nwg);
    ph_modp(p, (float*)lds, wg, nwg);
    ph_tables(p, wg, nwg);
    ph_filters<4096>(p, (float*)(ws + WS_FT4096), (float*)lds, wg, nwg);
    ph_filters<256>(p, (float*)(ws + WS_FT256), (float*)lds, nwg - 1 - wg, nwg);
    { int t2 = threadIdx.x; asm volatile("" : "+v"(t2)); conv_all(p, (ConvDesc*)(lds + 8 * 64 * 33 * 4), (float*)lds + (t2 >> 6) * (64 * 33), wg * 8 + (t2 >> 6), nwg * 8, t2 & 63); }
#endif
    GRID_BAR();
    ph_modr(p, wg, nwg);
    GRID_BAR();

    for (int layer = 0; layer < DEPTH; ++layer) {
        const int kind = layer % 3, jm = layer / 3;
        const float* modl = MOD + (size_t)layer * 5 * 9 * D;
#pragma unroll 1
        for (int f = 0; f < 2; ++f) {
            const int slot = f == 0 ? 0 : 2, lf = layer * 2 + f;
            ph_modulate(p, layer, slot, wg, nwg);
            GRID_BAR();
            { pg8::Gemm g{HB, (const u16*)(ws + WS_WGU + lf * SZ_WGU), R, 2 * DFF, D}; pg8::StaticOrder So; So.init(g.M, g.N, nwg, wg);
              pg8::gemm_phase<pg8::EpiSwiGLU, pg8::StaticOrder, true, true>(ring, g, So, pg8::EpiSwiGLU{ACT}); }
            GRID_BAR();
            { pg8::Gemm g{ACT, (const u16*)(ws + WS_WD + lf * SZ_WD), R, D, DFF}; pg8::StaticOrder So; So.init(g.M, g.N, nwg, wg);
              pg8::gemm_phase<pg8::EpiResGate, pg8::StaticOrder, true, true>(ring, g, So, pg8::EpiResGate{X, modl, slot, 0.5f}); }
            GRID_BAR();
            if (f == 0) {
                ph_modulate(p, layer, 1, wg, nwg);
                GRID_BAR();
                const u16* Ao; const u16* Wo;
                if (kind == 0) {
                    float* QKVA = (float*)(ws + WS_QKVA); u16* QL = (u16*)(ws + WS_QL); u16* CKV = (u16*)(ws + WS_CKV); u16* KR = (u16*)(ws + WS_KR); u16* Q = (u16*)(ws + WS_Q); u16* KN = (u16*)(ws + WS_KN); u16* V = (u16*)(ws + WS_V); u16* O = (u16*)(ws + WS_O);
                    { pg8::Gemm g{HB, (const u16*)(ws + WS_WDQKV) + (size_t)jm * QKVA_LD * D, R, QKVA_LD, D}; pg8::StaticOrder So; So.init(g.M, g.N, nwg, wg);
                      pg8::gemm_phase<pg8::EpiF32, pg8::StaticOrder, true, true>(ring, g, So, pg8::EpiF32{QKVA, QKVA_LD}); }
                    GRID_BAR();
                    ph_mla_norm(p, jm, wg, nwg);
                    GRID_BAR();
                    { pg8::Gemm g{QL, (const u16*)(ws + WS_WUQ) + (size_t)jm * 3072 * 512, R, 3072, 512}; pg8::StaticOrder So; So.init(g.M, g.N, nwg, wg);
                      pg8::gemm_phase<pg8::EpiRope<0>, pg8::StaticOrder, true, true>(ring, g, So, pg8::EpiRope<0>{Q, 3072, rope}); }
                    { pg8::Gemm g{CKV, (const u16*)(ws + WS_WUKV) + (size_t)jm * 4096 * 512, R, 4096, 512}; pg8::StaticOrder So; So.init(g.M, g.N, nwg, wg);
                      pg8::gemm_phase<pg8::EpiKV, pg8::StaticOrder, true, true>(ring, g, So, pg8::EpiKV{KN, V}); }
                    GRID_BAR();
#ifndef NO_NAIVE
                    ph_attn_mla(Q, KN, KR, V, O, lds, wg, nwg);
#endif
                    Ao = O; Wo = (const u16*)(ws + WS_WMO) + (size_t)jm * D * D;
                } else if (kind == 1) {
                    float* UT = (float*)(ws + WS_UT); u16* ZT = (u16*)(ws + WS_ZT);
                    { pg8::Gemm g{(const u16*)(ws + WS_WHIN), HB, 3 * D, R, D}; pg8::StaticOrder So; So.init(g.M, g.N, nwg, wg);
                      pg8::gemm_phase<pg8::EpiF32, pg8::StaticOrder, true, true>(ring, g, So, pg8::EpiF32{UT, R}); }
                    GRID_BAR();
#ifndef NO_NAIVE
                    ph_nhyena<4096>(p, (const float*)(ws + WS_FT4096), (float*)lds, wg, nwg);
                    ph_nhyena<256>(p, (const float*)(ws + WS_FT256), (float*)lds, wg, nwg);
#endif
                    GRID_BAR();
                    ph_transpose(ZT, HB, (u16*)lds, wg, nwg);
                    Ao = HB; Wo = (const u16*)(ws + WS_WHOUT);
                } else {
                    u16* QKV = (u16*)(ws + WS_QKV); u16* O = (u16*)(ws + WS_WO);
                    { pg8::Gemm g{HB, (const u16*)(ws + WS_WWQKV), R, 2560, D}; pg8::StaticOrder So; So.init(g.M, g.N, nwg, wg);
                      pg8::gemm_phase<pg8::EpiRope<1>, pg8::StaticOrder, true, true>(ring, g, So, pg8::EpiRope<1>{QKV, 2560, rope}); }
                    GRID_BAR();
#ifndef NO_NAIVE
                    ph_nattn_win(QKV, p.in[I_SINK], O, (float*)lds, wg, nwg);
#endif
                    Ao = O; Wo = (const u16*)(ws + WS_WWO);
                }
                GRID_BAR();
                { pg8::Gemm g{Ao, Wo, R, D, D}; pg8::StaticOrder So; So.init(g.M, g.N, nwg, wg);
                  pg8::gemm_phase<pg8::EpiResGate, pg8::StaticOrder, true, true>(ring, g, So, pg8::EpiResGate{X, modl, 1, 1.0f}); }
                GRID_BAR();
            }
        }
    }
    ph_final(p, wg, nwg);
}
}

extern "C" void kernel_launch(void* const* d_in, const int* in_sizes, int n_in, void* d_out, int out_size, void* d_ws, size_t ws_size, hipStream_t stream) {
    static int grid = 0;
    if (grid == 0) {
        if (n_in != 35 || ws_size < WS_TOTAL || out_size != NB * S * D) { fprintf(stderr, "kernel_launch: unexpected shapes (n_in %d, ws %zu need %zu, out %d)\n", n_in, ws_size, (size_t)WS_TOTAL, out_size); grid = -1; return; }
        int dev = 0, cus = 0, per_cu = 0;
        if (hipGetDevice(&dev) != hipSuccess || hipDeviceGetAttribute(&cus, hipDeviceAttributeMultiprocessorCount, dev) != hipSuccess || cus <= 0) { fprintf(stderr, "kernel_launch: device query failed\n"); grid = -1; return; }
        if (hipFuncSetAttribute((const void*)mega_fwd, hipFuncAttributeMaxDynamicSharedMemorySize, LDS_BYTES) != hipSuccess) { fprintf(stderr, "kernel_launch: hipFuncSetAttribute failed\n"); grid = -1; return; }
        if (hipOccupancyMaxActiveBlocksPerMultiprocessor(&per_cu, (const void*)mega_fwd, 512, LDS_BYTES) != hipSuccess || per_cu < 1) fprintf(stderr, "kernel_launch: note: occupancy query reports %d workgroups per CU\n", per_cu);
        (void)hipGetLastError();
        grid = cus;
    }
    if (grid < 0) return;
    if (hipMemsetAsync((char*)d_ws + WS_CTL, 0, CTL_ZERO_BYTES, stream) != hipSuccess) { fprintf(stderr, "kernel_launch: memset failed\n"); return; }
    Ptrs p{}; for (int i = 0; i < 35; ++i) p.in[i] = (const float*)d_in[i]; p.out = (float*)d_out; p.ws = (unsigned char*)d_ws;
    hipLaunchKernelGGL(mega_fwd, dim3(grid), dim3(512), LDS_BYTES, stream, p);
    const hipError_t le = hipPeekAtLastError();
    if (le != hipSuccess) fprintf(stderr, "kernel_launch: launch failed: %s\n", hipGetErrorName(le));
}
```

```cpp
#define TAIL_MIXERS 1
#define RES_4X8 1
#define RES_NOSTAGGER 1
#define MLA_NOSWAP 1
#define CONV_NT 1
#include <hip/hip_runtime.h>
#include <cstdio>
#include <cstdint>
#include <cmath>

namespace {
typedef unsigned short u16;
constexpr int D = 2048, NB = 4, S = 4096, CTX = 256, SB = S + CTX, R = NB * SB, DFF = 5504, NMODV = 9 * D, DEPTH = 4;
constexpr int QKVA_LD = 1280;
constexpr float NORM_EPS = 1e-6f;

constexpr size_t al(size_t x) { return (x + 255) / 256 * 256; }
constexpr size_t WS_CTL = 0;
constexpr size_t WS_X = 1u << 20;
constexpr size_t WS_HB = WS_X + al((size_t)R * D * 4);
constexpr size_t WS_ACT = WS_HB + al((size_t)R * D * 2);
constexpr size_t WS_MODP = WS_ACT + al((size_t)R * DFF * 2);
constexpr size_t WS_MOD = WS_MODP + al((size_t)16 * DEPTH * 5 * NMODV * 4);
constexpr size_t WS_ROPE = WS_MOD + al((size_t)DEPTH * 5 * NMODV * 4);
constexpr size_t WS_TW = WS_ROPE + al(64 * 16 * 2 * 4);
constexpr size_t WS_FS = WS_TW + al(8192 * 8);
constexpr size_t WS_FT256 = WS_FS + al((size_t)2 * 2048 * 4104 * 8);
constexpr size_t WS_MIX = WS_FT256 + al((size_t)8192 * 256 * 4);
constexpr size_t WS_FT4096 = WS_MIX;
constexpr size_t WS_QKVA = WS_MIX;
constexpr size_t WS_QL = WS_QKVA + al((size_t)R * QKVA_LD * 4);
constexpr size_t WS_CKV = WS_QL + al((size_t)R * 512 * 2);
constexpr size_t WS_KR = WS_CKV + al((size_t)R * 512 * 2);
constexpr size_t WS_Q = WS_KR + al((size_t)R * 64 * 2);
constexpr size_t WS_KN = WS_Q + al((size_t)R * 3072 * 2);
constexpr size_t WS_V = WS_KN + al((size_t)R * D * 2);
constexpr size_t WS_O = WS_V + al((size_t)R * D * 2);
constexpr size_t WS_MLA_END = WS_O + al((size_t)R * D * 2);
constexpr size_t WS_UT = WS_MIX;
constexpr size_t WS_ZT = WS_UT + al((size_t)3 * D * R * 4);
constexpr size_t WS_HY_END = WS_ZT + al((size_t)D * R * 2);
constexpr size_t WS_QKV = WS_MIX;
constexpr size_t WS_WO = WS_QKV + al((size_t)R * 2560 * 2);
constexpr size_t WS_WIN_END = WS_WO + al((size_t)R * D * 2);
constexpr size_t WS_END = (WS_MLA_END > WS_HY_END ? (WS_MLA_END > WS_WIN_END ? WS_MLA_END : WS_WIN_END) : (WS_HY_END > WS_WIN_END ? WS_HY_END : WS_WIN_END));
constexpr size_t SZ_WGU = (size_t)2 * DFF * D * 2, SZ_WD = (size_t)D * DFF * 2;
constexpr size_t WS_WGU = al(WS_END);
constexpr size_t WS_WD = WS_WGU + 8 * SZ_WGU;
constexpr size_t WS_WDQKV = WS_WD + 8 * SZ_WD;
constexpr size_t WS_WUQ = WS_WDQKV + 2 * (size_t)QKVA_LD * D * 2;
constexpr size_t WS_WUKV = WS_WUQ + 2 * (size_t)3072 * 512 * 2;
constexpr size_t WS_WMO = WS_WUKV + 2 * (size_t)4096 * 512 * 2;
constexpr size_t WS_WHIN = WS_WMO + 2 * (size_t)D * D * 2;
constexpr size_t WS_WHOUT = WS_WHIN + (size_t)3 * D * D * 2;
constexpr size_t WS_WWQKV = WS_WHOUT + (size_t)D * D * 2;
constexpr size_t WS_WWO = WS_WWQKV + (size_t)2560 * D * 2;
constexpr size_t WS_SLAB = WS_WWO + (size_t)D * D * 2;
constexpr size_t WS_FS256 = WS_SLAB + (size_t)8 * 4 * 256 * D * 4;
constexpr size_t WS_TOTAL = WS_FS256 + (size_t)2 * 2048 * 264 * 8;
static_assert(WS_TOTAL < 2000000000ull, "workspace map exceeds the guaranteed size");

__device__ __forceinline__ float bf2f(u16 b) { return __uint_as_float(((unsigned)b) << 16); }
__device__ __forceinline__ unsigned pk2(float lo, float hi) { unsigned r; asm("v_cvt_pk_bf16_f32 %0, %1, %2" : "=v"(r) : "v"(lo), "v"(hi)); return r; }
__device__ __forceinline__ u16 f2bf(float f) { return (u16)(pk2(f, f) & 0xffffu); }
template <int X> __device__ __forceinline__ float swz_xor(float v) { return __int_as_float(__builtin_amdgcn_ds_swizzle(__float_as_int(v), 0x1f | (X << 10))); }
__device__ __forceinline__ float wave_sum(float v) {
    v += swz_xor<1>(v); v += swz_xor<2>(v); v += swz_xor<4>(v); v += swz_xor<8>(v); v += swz_xor<16>(v);
    auto rr = __builtin_amdgcn_permlane32_swap(__float_as_uint(v), __float_as_uint(v), false, false); return __uint_as_float(rr[0]) + __uint_as_float(rr[1]);
}
__device__ __forceinline__ float wave_max(float v) {
    v = fmaxf(v, swz_xor<1>(v)); v = fmaxf(v, swz_xor<2>(v)); v = fmaxf(v, swz_xor<4>(v)); v = fmaxf(v, swz_xor<8>(v)); v = fmaxf(v, swz_xor<16>(v));
    auto rr = __builtin_amdgcn_permlane32_swap(__float_as_uint(v), __float_as_uint(v), false, false); return fmaxf(__uint_as_float(rr[0]), __uint_as_float(rr[1]));
}
__device__ __forceinline__ int modidx_of_row(int r) { const int b = r / SB, j = r - b * SB; return j < CTX ? 4 : b; }
__device__ __forceinline__ float silu_f(float x) { return x / (1.f + expf(-x)); }

struct Ptrs {
    const float* in[35];
    float* out;
    unsigned char* ws;
};
typedef const __attribute__((address_space(4))) Ptrs* KP;
__device__ __forceinline__ KP kargs() { KP q = (KP)__builtin_amdgcn_kernarg_segment_ptr(); asm volatile("" : "+s"(q)); return q; }
enum { I_X = 0, I_C, I_CTX, I_CCTX, I_MODW, I_MODB, I_NORMG, I_FINALG, I_WG, I_WU, I_WD, I_DQ, I_GQ, I_UQ, I_DKV, I_GKV, I_UKV, I_MWO,
       I_HWIN, I_HCW, I_HCB, I_FW1, I_FB1, I_FW2, I_FB2, I_FW3, I_FB3, I_FFREQ, I_FW4, I_DECAY, I_SKIP, I_HWOUT, I_WQKV, I_SINK, I_WWO };


}

namespace pg8 {
#define PG8_LAS __attribute__((address_space(3)))
typedef unsigned short bf16_t;
typedef short bf16x8 __attribute__((ext_vector_type(8)));
typedef float f32x4 __attribute__((ext_vector_type(4)));
typedef unsigned u32x4 __attribute__((ext_vector_type(4)));
constexpr int BM = 256, BK = 64, HALF = 128, HTB = HALF * BK * 2  , STAGE_BYTES = 8 * HTB, NXCD = 8, WGM = 8;

__host__ __device__ __forceinline__ int lds_byte(int r, int c) { const int st = (r >> 4) * 2 + (c >> 5), rr = r & 15, cc = c & 31, ob = rr * 64 + cc * 2; return st * 1024 + (ob ^ (((ob >> 9) & 1) << 5)); }
__host__ __device__ __forceinline__ void stage_rc(int b, int& R, int& C) { const int st = b / 1024, sb = b % 1024, swz = sb ^ (((sb >> 9) & 1) << 5); R = (st >> 1) * 16 + swz / 64; C = (st & 1) * 32 + (swz % 64) / 2; }
__host__ __device__ __forceinline__ int perm32(int rho) { const int n = rho >> 4, i = rho & 15; return 8 * (i >> 2) + 4 * n + (i & 3); }

struct Unit { int pm, pn; int kt0 = 0, nt = 0, sp = -1; };
struct Gemm { const bf16_t* A; const bf16_t* Bt; int M, N, K; };

struct StaticOrder {
    int nM, nN, nwg, G, c;
    __host__ __device__ __forceinline__ void init(int M, int N, int G_, int c_) { nM = M / BM; nN = N / BM; nwg = nM * nN; G = G_; c = c_; }
    __host__ __device__ __forceinline__ bool next(int i, Unit& u) const {
        const long L = (long)i * G + c; if (L >= nwg) return false;
        int wgid = (int)L; { const int q = nwg / NXCD, r = nwg % NXCD, xcd = wgid % NXCD, off = wgid / NXCD; wgid = (xcd < r ? xcd * (q + 1) : r * (q + 1) + (xcd - r) * q) + off; }
        const int nig = WGM * nN, gid = wgid / nig, fm = gid * WGM, gsz = (nM - fm) < WGM ? (nM - fm) : WGM;
        u.pm = fm + ((wgid % nig) % gsz); u.pn = (wgid % nig) / gsz; return true;
    }
    __device__ __forceinline__ void a_ready(const Unit&) const {}
    __device__ __forceinline__ void done(const Unit&) const {}
};


__device__ __forceinline__ unsigned cvt_pk_bf16(float lo, float hi) { unsigned r; asm("v_cvt_pk_bf16_f32 %0, %1, %2" : "=v"(r) : "v"(lo), "v"(hi)); return r; }
typedef float f32x2 __attribute__((ext_vector_type(2)));

struct EpiF32 {
    static constexpr bool PERM = false, AFTER_DRAIN = false;
    float* C; int ldc;
    __device__ __forceinline__ void operator()(const f32x4 (&acc)[2][2][4][2], const Unit& u, int wr, int wc, int fr, int fq) const {
        const int row0 = u.pm * BM + wr * 64 + fr, col0 = u.pn * BM + wc * 32 + 4 * fq;
#pragma unroll
        for (int ai = 0; ai < 2; ++ai)
#pragma unroll
            for (int m = 0; m < 4; ++m) { float* rowp = C + (size_t)(row0 + ai * HALF + m * 16) * ldc + col0;
#pragma unroll
                for (int bj = 0; bj < 2; ++bj)
#pragma unroll
                    for (int n = 0; n < 2; ++n) *(f32x4*)(rowp + bj * HALF + n * 16) = acc[ai][bj][m][n]; }
    }
};
struct EpiBf16 {
    static constexpr bool PERM = true, AFTER_DRAIN = false;
    bf16_t* C; int ldc;
    __device__ __forceinline__ void operator()(const f32x4 (&acc)[2][2][4][2], const Unit& u, int wr, int wc, int fr, int fq) const {
        const int row0 = u.pm * BM + wr * 64 + fr, col0 = u.pn * BM + wc * 32 + 8 * fq;
#pragma unroll
        for (int ai = 0; ai < 2; ++ai)
#pragma unroll
            for (int m = 0; m < 4; ++m)
#pragma unroll
                for (int bj = 0; bj < 2; ++bj) { const f32x4 v0 = acc[ai][bj][m][0], v1 = acc[ai][bj][m][1];
                    u32x4 w; w.x = cvt_pk_bf16(v0[0], v0[1]); w.y = cvt_pk_bf16(v0[2], v0[3]); w.z = cvt_pk_bf16(v1[0], v1[1]); w.w = cvt_pk_bf16(v1[2], v1[3]);
                    *(u32x4*)(C + (size_t)(row0 + ai * HALF + m * 16) * ldc + col0 + bj * HALF) = w; }
    }
};
__device__ __forceinline__ unsigned swiglu_pk(float g0, float g1, float u0, float u1) {
    const f32x2 g = {g0, g1}, u = {u0, u1};
    const f32x2 t = g * -1.4426950408889634f;
    f32x2 e; e.x = __builtin_amdgcn_exp2f(t.x); e.y = __builtin_amdgcn_exp2f(t.y);
    const f32x2 d = e + 1.0f;
    f32x2 r; r.x = __builtin_amdgcn_rcpf(d.x); r.y = __builtin_amdgcn_rcpf(d.y);
    const f32x2 o = (g * u) * r;
    unsigned w; asm("v_cvt_pk_bf16_f32 %0, %1, %2" : "=v"(w) : "v"(o.x), "v"(o.y)); return w;
}
struct EpiSwiGLU {
    static constexpr bool PERM = true, AFTER_DRAIN = false;
    bf16_t* act;
    __device__ __forceinline__ void operator()(const f32x4 (&acc)[2][2][4][2], const Unit& u, int wr, int wc, int fr, int fq) const {
        const int row0 = u.pm * BM + wr * 64 + fr, col0 = u.pn * HALF + wc * 32 + 8 * fq;
#pragma unroll
        for (int ai = 0; ai < 2; ++ai)
#pragma unroll
            for (int m = 0; m < 4; ++m) { const f32x4 g0 = acc[ai][0][m][0], g1 = acc[ai][0][m][1], u0 = acc[ai][1][m][0], u1 = acc[ai][1][m][1];
                u32x4 w; w.x = swiglu_pk(g0[0], g0[1], u0[0], u0[1]); w.y = swiglu_pk(g0[2], g0[3], u0[2], u0[3]); w.z = swiglu_pk(g1[0], g1[1], u1[0], u1[1]); w.w = swiglu_pk(g1[2], g1[3], u1[2], u1[3]);
                *(u32x4*)(act + ((size_t)(col0 >> 6) * R + (row0 + ai * HALF + m * 16)) * 64 + (col0 & 63)) = w; }
    }
};
typedef _Float16 f16x2 __attribute__((ext_vector_type(2)));
__device__ __forceinline__ float h16_lim() { float l; asm volatile("s_mov_b32 %0, 0x477fe000" : "=s"(l)); return l; }
__device__ __forceinline__ unsigned pkh2(float lo, float hi, float lim) { f16x2 h; h[0] = (_Float16)__builtin_amdgcn_fmed3f(lo, -lim, lim); h[1] = (_Float16)__builtin_amdgcn_fmed3f(hi, -lim, lim); return __builtin_bit_cast(unsigned, h); }
__device__ __forceinline__ float h2f_lo(unsigned w) { const f16x2 h = __builtin_bit_cast(f16x2, w); return (float)h[0]; }
__device__ __forceinline__ float h2f_hi(unsigned w) { const f16x2 h = __builtin_bit_cast(f16x2, w); return (float)h[1]; }
struct EpiResGate {
    static constexpr bool PERM = true, AFTER_DRAIN = false;
    bf16_t* X; const float* modl; int slot; float coef; bf16_t* slab;
    __device__ __forceinline__ void operator()(const f32x4 (&acc)[2][2][4][2], const Unit& u, int wr, int wc, int fr, int fq) const {
        const int col0 = u.pn * BM + wc * 32 + 8 * fq;
        const int q = u.pm % 17, midx = q == 0 ? 4 : u.pm / 17;
        if (u.sp >= 0) {
            bf16_t* sp = slab + ((size_t)(u.sp * 4 + u.pm / 17) * 256 + wr * 64 + fr) * D + col0;
#pragma unroll
            for (int ai = 0; ai < 2; ++ai)
#pragma unroll
                for (int m = 0; m < 4; ++m) { bf16_t* rowp = sp + (size_t)(ai * HALF + m * 16) * D;
#pragma unroll
                    for (int bj = 0; bj < 2; ++bj) { const f32x4 v0 = acc[ai][bj][m][0], v1 = acc[ai][bj][m][1];
                        u32x4 w; w.x = cvt_pk_bf16(v0[0], v0[1]); w.y = cvt_pk_bf16(v0[2], v0[3]); w.z = cvt_pk_bf16(v1[0], v1[1]); w.w = cvt_pk_bf16(v1[2], v1[3]);
                        *(u32x4*)(rowp + bj * HALF) = w; } }
            return;
        }
        const int row0 = u.pm * BM + wr * 64 + fr; const float lim = h16_lim();
        const float* gp = modl + ((size_t)midx * 9 + 3 * slot + 2) * D + col0;
        f32x4 gv[2][2];
#pragma unroll
        for (int bj = 0; bj < 2; ++bj)
#pragma unroll
            for (int n = 0; n < 2; ++n) gv[bj][n] = *(const f32x4*)(gp + bj * HALF + 4 * n) * coef;
#pragma unroll
        for (int ai = 0; ai < 2; ++ai)
#pragma unroll
            for (int m = 0; m < 4; ++m) { bf16_t* rowp = X + (size_t)(row0 + ai * HALF + m * 16) * D + col0;
#pragma unroll
                for (int bj = 0; bj < 2; ++bj) { u32x4* px = (u32x4*)(rowp + bj * HALF); const u32x4 xo = *px;
                    const f32x4 a0 = (f32x4){h2f_lo(xo.x), h2f_hi(xo.x), h2f_lo(xo.y), h2f_hi(xo.y)} + gv[bj][0] * acc[ai][bj][m][0];
                    const f32x4 a1 = (f32x4){h2f_lo(xo.z), h2f_hi(xo.z), h2f_lo(xo.w), h2f_hi(xo.w)} + gv[bj][1] * acc[ai][bj][m][1];
                    u32x4 w; w.x = pkh2(a0[0], a0[1], lim); w.y = pkh2(a0[2], a0[3], lim); w.z = pkh2(a1[0], a1[1], lim); w.w = pkh2(a1[2], a1[3], lim);
                    *px = w; } }
    }
};
struct EpiF16 {
    static constexpr bool PERM = true, AFTER_DRAIN = false;
    bf16_t* C; int ldc;
    __device__ __forceinline__ void operator()(const f32x4 (&acc)[2][2][4][2], const Unit& u, int wr, int wc, int fr, int fq) const {
        const int row0 = u.pm * BM + wr * 64 + fr, col0 = u.pn * BM + wc * 32 + 8 * fq; const float lim = h16_lim();
#pragma unroll
        for (int ai = 0; ai < 2; ++ai)
#pragma unroll
            for (int m = 0; m < 4; ++m)
#pragma unroll
                for (int bj = 0; bj < 2; ++bj) { const f32x4 v0 = acc[ai][bj][m][0], v1 = acc[ai][bj][m][1];
                    u32x4 w; w.x = pkh2(v0[0], v0[1], lim); w.y = pkh2(v0[2], v0[3], lim); w.z = pkh2(v1[0], v1[1], lim); w.w = pkh2(v1[2], v1[3], lim);
                    *(u32x4*)(C + (size_t)(row0 + ai * HALF + m * 16) * ldc + col0 + bj * HALF) = w; }
    }
};
struct ResOrder {
    StaticOrder so; int G, c, K; bool nosplit;
    __device__ __forceinline__ void init(int K_, int G_, int c_, bool nosplit_ = false) { so.init(64 * BM, 2048, G_, c_); G = G_; c = c_; K = K_; nosplit = nosplit_; }
    __device__ __forceinline__ bool next(int i, Unit& u) const {
        int ii = i;
#ifndef RES_NOSTAGGER
        if (G == 256 && ((c >> 3) & 1) && !nosplit) ii = i == 0 ? 2 : i - 1;
#endif
        const long L = (long)ii * G + c;
        if (i > 2 && G == 256) return false;
        if (L >= 768 || (nosplit && L >= 512)) return false;
        const bool full = L < 512;
        Unit v; v.pm = 0; v.pn = 0; so.next(full ? ii : 0, v);
        const int it = full ? 0 : (int)(L - 512), cu = it >> 3, s = it & 7, np = K / 128, p0 = (np * s) / 8, p1 = (np * (s + 1)) / 8;
#ifdef RES_4X8
        { const int off = (v.pm & 7) + 8 * v.pn; v.pm = (v.pm & ~7) + (off & 3) + 4 * (off >> 5); v.pn = (off >> 2) & 7; }
#endif
        const int pm = full ? (v.pm >> 4) * 17 + 1 + (v.pm & 15) : 17 * (cu >> 3), pn = full ? v.pn : (cu & 7);
        u.pm = pm; u.pn = pn; u.kt0 = full ? 0 : 2 * p0; u.nt = full ? 0 : 2 * (p1 - p0); u.sp = full ? -1 : s;
        return true;
    }
    __device__ __forceinline__ void a_ready(const Unit&) const {}
    __device__ __forceinline__ void done(const Unit&) const {}
};
struct UpOrder {
    StaticOrder so68, so64; bool latent_only;
    __device__ __forceinline__ void init(int N, int G_, int c_, bool latent_only_) { so68.init(68 * BM, N, G_, c_); so64.init(64 * BM, N, G_, c_); latent_only = latent_only_; }
    __device__ __forceinline__ bool next(int i, Unit& u) const {
        Unit a, b; a.pm = 0; a.pn = 0; b.pm = 0; b.pn = 0;
        const bool ok68 = so68.next(i, a), ok64 = so64.next(i, b);
        const int pm = latent_only ? (b.pm >> 4) * 17 + 1 + (b.pm & 15) : a.pm, pn = latent_only ? b.pn : a.pn;
        u.pm = pm; u.pn = pn; u.kt0 = 0; u.nt = 0; u.sp = -1;
        return latent_only ? ok64 : ok68;
    }
    __device__ __forceinline__ void a_ready(const Unit&) const {}
    __device__ __forceinline__ void done(const Unit&) const {}
};
struct EpiKV {
    static constexpr bool PERM = true, AFTER_DRAIN = false;
    bf16_t* KN; bf16_t* V;
    __device__ __forceinline__ void operator()(const f32x4 (&acc)[2][2][4][2], const Unit& u, int wr, int wc, int fr, int fq) const {
        const int row0 = u.pm * BM + wr * 64 + fr, col0 = u.pn * HALF + wc * 32 + 8 * fq;
#pragma unroll
        for (int ai = 0; ai < 2; ++ai)
#pragma unroll
            for (int m = 0; m < 4; ++m)
#pragma unroll
                for (int bj = 0; bj < 2; ++bj) { const f32x4 v0 = acc[ai][bj][m][0], v1 = acc[ai][bj][m][1];
                    u32x4 w; w.x = cvt_pk_bf16(v0[0], v0[1]); w.y = cvt_pk_bf16(v0[2], v0[3]); w.z = cvt_pk_bf16(v1[0], v1[1]); w.w = cvt_pk_bf16(v1[2], v1[3]);
                    *(u32x4*)((bj ? V : KN) + (size_t)(row0 + ai * HALF + m * 16) * D + col0) = w; }
    }
};
template <int MODE> struct EpiRope {
    static constexpr bool PERM = false, AFTER_DRAIN = false;
    bf16_t* C; int ldc; const float* rope;
    __device__ __forceinline__ void operator()(const f32x4 (&acc)[2][2][4][2], const Unit& u, int wr, int wc, int fr, int fq) const {
        typedef unsigned u32x2 __attribute__((ext_vector_type(2)));
        const int row0 = u.pm * BM + wr * 64 + fr, col0 = u.pn * BM + wc * 32 + 4 * fq;
        const int q = u.pm % 17; const bool isctx = q == 0; const int t0 = (q - 1) * 256 + wr * 64 + fr;
#pragma unroll
        for (int bj = 0; bj < 2; ++bj) {
            const int g32 = 8 * u.pn + 4 * bj + wc; int ty;
            if (MODE == 0) { const int gi = g32 % 6; ty = gi == 4 ? 1 : (gi == 5 ? 2 : 0); } else { ty = g32 < 72 ? 1 + (g32 & 1) : 0; }
            if (isctx) ty = 0;
#pragma unroll
            for (int ai = 0; ai < 2; ++ai)
#pragma unroll
                for (int m = 0; m < 4; ++m) { f32x4 x1 = acc[ai][bj][m][0], x2 = acc[ai][bj][m][1];
                    if (ty) { const int t = t0 + ai * HALF + m * 16, pos = ty == 1 ? (t >> 6) : (t & 63); const f32x4* rp = (const f32x4*)(rope + (size_t)(pos * 16 + 4 * fq) * 2); const f32x4 r0 = rp[0], r1 = rp[1];
                        const f32x4 cs = {r0[0], r0[2], r1[0], r1[2]}, sn = {r0[1], r0[3], r1[1], r1[3]}; const f32x4 o1 = x1 * cs - x2 * sn, o2 = x2 * cs + x1 * sn; x1 = o1; x2 = o2; }
                    bf16_t* rowp = C + (size_t)(row0 + ai * HALF + m * 16) * ldc + col0 + bj * HALF;
                    u32x2 w0, w1; w0.x = cvt_pk_bf16(x1[0], x1[1]); w0.y = cvt_pk_bf16(x1[2], x1[3]); w1.x = cvt_pk_bf16(x2[0], x2[1]); w1.y = cvt_pk_bf16(x2[2], x2[3]);
                    *(u32x2*)rowp = w0; *(u32x2*)(rowp + 16) = w1; }
        }
    }
};

template <class E_> struct EpiNever {
    static constexpr bool PERM = E_::PERM, AFTER_DRAIN = false;
    E_ e; bool on;
    __device__ __forceinline__ void operator()(const f32x4 (&acc)[2][2][4][2], const Unit& u, int wr, int wc, int fr, int fq) const { if (on) e(acc, u, wr, wc, fr, fq); }
};
template <class Epi, class Sched, bool ALIGN_EPI = false, bool SP2 = false, int AUXA = 0, bool ABLK = false>
__device__ __forceinline__ void gemm_phase(PG8_LAS unsigned char* lds, const Gemm g, const Sched& S, const Epi& E) {
    int tid_ = threadIdx.x; asm volatile("" : "+v"(tid_));
    const int tid = tid_, wid = __builtin_amdgcn_readfirstlane(tid >> 6), lane = tid & 63, wr = wid >> 2, wc = wid & 3, fr = lane & 15, fq = lane >> 4;
    const int K = g.K, nt = K / BK;
    unsigned voffA[2], voffB[2];
#pragma unroll
    for (int i = 0; i < 2; ++i) { int R, C; stage_rc(tid * 16 + i * 8192, R, C); const int Rb = Epi::PERM ? ((R & ~31) + perm32(R & 31)) : R;
        voffA[i] = ABLK ? (unsigned)(R * BK + C) * 2u : (unsigned)(R * K + C) * 2u; voffB[i] = (unsigned)(Rb * K + C) * 2u; }
    const size_t kstep = (size_t)(BK * 2);
    const size_t hstep = (size_t)HALF * K * 2;
    const size_t tstep = 2 * hstep;
    const size_t kstepA = ABLK ? (size_t)g.M * (BK * 2) : kstep, hstepA = ABLK ? (size_t)HALF * (BK * 2) : hstep, tstepA = 2 * hstepA;
    const unsigned ldsw = (unsigned)wid * 1024u;
    const int aoff = lds_byte(wr * 64 + fr, fq * 8), boff = lds_byte(wc * 32 + fr, fq * 8);
#define PG8_SA(b, h) (((b) * 2 + (h)) * HTB)
#define PG8_SB(b, h) ((4 + (b) * 2 + (h)) * HTB)
#define PG8_STAGE(bufoff, gbase, voff, aux) do { _Pragma("unroll") for (int _i = 0; _i < 2; ++_i) \
        __builtin_amdgcn_global_load_lds((const unsigned*)((const char*)(gbase) + (voff)[_i]), (PG8_LAS unsigned*)(lds + (bufoff) + ldsw + _i * 8192), 16, 0, aux); } while (0)
#define PG8_LDA(dst, b, h) do { _Pragma("unroll") for (int m = 0; m < 4; ++m) _Pragma("unroll") for (int k = 0; k < 2; ++k) dst[m][k] = *(const PG8_LAS bf16x8*)(lds + PG8_SA(b, h) + aoff + m * 2048 + k * 1024); } while (0)
#define PG8_LDB(dst, b, h) do { _Pragma("unroll") for (int n = 0; n < 2; ++n) _Pragma("unroll") for (int k = 0; k < 2; ++k) dst[n][k] = *(const PG8_LAS bf16x8*)(lds + PG8_SB(b, h) + boff + n * 2048 + k * 1024); } while (0)
#define PG8_MMA(ai, bj, At, Bt) do { __builtin_amdgcn_s_setprio(1); _Pragma("unroll") for (int m = 0; m < 4; ++m) _Pragma("unroll") for (int n = 0; n < 2; ++n) _Pragma("unroll") for (int k = 0; k < 2; ++k) \
        acc[ai][bj][m][n] = __builtin_amdgcn_mfma_f32_16x16x32_bf16(Bt[n][k], At[m][k], acc[ai][bj][m][n], 0, 0, 0); __builtin_amdgcn_s_setprio(0); } while (0)
#define PG8_WAIT_V(n) asm volatile("s_waitcnt vmcnt(" #n ")" ::: "memory")
#define PG8_WAIT_L(n) asm volatile("s_waitcnt lgkmcnt(" #n ")" ::: "memory")
#define PG8_BAR __builtin_amdgcn_s_barrier()
#define PG8_SCHED __builtin_amdgcn_sched_barrier(0)
    Unit cur, nxt; int ui = 0;
    if (!S.next(0, cur)) return;
    f32x4 acc[2][2][4][2];
#pragma unroll
    for (int a = 0; a < 2; ++a)
#pragma unroll
        for (int b = 0; b < 2; ++b)
#pragma unroll
            for (int m = 0; m < 4; ++m)
#pragma unroll
                for (int n = 0; n < 2; ++n) acc[a][b][m][n] = (f32x4){0.f, 0.f, 0.f, 0.f};
    bf16x8 At[4][2], B0[2][2], B1[2][2];
    const char* cA = (const char*)g.A + (size_t)cur.pm * tstepA + (size_t)cur.kt0 * kstepA; const char* cB = (const char*)g.Bt + (size_t)cur.pn * tstep + (size_t)cur.kt0 * kstep;
    S.a_ready(cur);
    if constexpr (SP2) {
        PG8_STAGE(PG8_SB(0, 0), cB, voffB, 0); PG8_STAGE(PG8_SB(0, 1), cB + hstep, voffB, 0); PG8_STAGE(PG8_SA(0, 0), cA, voffA, AUXA); PG8_STAGE(PG8_SA(0, 1), cA + hstepA, voffA, AUXA);
        if (wr == 1) PG8_BAR;
        PG8_WAIT_V(2); PG8_BAR;
        PG8_STAGE(PG8_SB(1, 0), cB + kstep, voffB, 0); PG8_STAGE(PG8_SA(1, 0), cA + kstepA, voffA, AUXA); PG8_STAGE(PG8_SB(1, 1), cB + hstep + kstep, voffB, 0);
        PG8_WAIT_V(6); PG8_BAR;
    } else {
        PG8_STAGE(PG8_SB(0, 0), cB, voffB, 0); PG8_STAGE(PG8_SA(0, 0), cA, voffA, AUXA); PG8_STAGE(PG8_SB(0, 1), cB + hstep, voffB, 0); PG8_STAGE(PG8_SA(0, 1), cA + hstepA, voffA, AUXA);
        if (wr == 1) PG8_BAR;
        PG8_WAIT_V(4); PG8_BAR;
        PG8_STAGE(PG8_SB(1, 0), cB + kstep, voffB, 0); PG8_STAGE(PG8_SA(1, 0), cA + kstepA, voffA, AUXA); PG8_STAGE(PG8_SB(1, 1), cB + hstep + kstep, voffB, 0);
        PG8_WAIT_V(6); PG8_BAR;
    }
    for (;;) {
        const bool has_next = S.next(ui + 1, nxt);
        const char* nA = has_next ? (const char*)g.A + (size_t)nxt.pm * tstepA + (size_t)nxt.kt0 * kstepA : cA; const char* nB = has_next ? (const char*)g.Bt + (size_t)nxt.pn * tstep + (size_t)nxt.kt0 * kstep : cB;
        const int cnt = cur.nt ? cur.nt : nt;
        for (int t = 0; t < cnt; t += 2) {
            const bool last = (t == cnt - 2);
            const char* a1 = cA + (size_t)(t + 1) * kstepA;
            const char* a2 = last ? nA : cA + (size_t)(t + 2) * kstepA; const char* b2 = last ? nB : cB + (size_t)(t + 2) * kstep;
            const char* a3 = a2 + kstepA; const char* b3 = b2 + kstep;
            if (last && has_next) S.a_ready(nxt);
            if constexpr (SP2) {
            PG8_LDB(B0, 0, 0); PG8_LDB(B1, 0, 1); PG8_SCHED; PG8_LDA(At, 0, 0); PG8_STAGE(PG8_SA(1, 1), a1 + hstepA, voffA, AUXA);
            PG8_WAIT_V(8); PG8_WAIT_L(0); PG8_BAR; PG8_MMA(0, 0, At, B0); PG8_MMA(0, 1, At, B1); PG8_BAR; PG8_SCHED;
            PG8_LDA(At, 0, 1); PG8_STAGE(PG8_SB(0, 0), b2, voffB, 0); PG8_STAGE(PG8_SB(0, 1), b2 + hstep, voffB, 0); PG8_STAGE(PG8_SA(0, 0), a2, voffA, AUXA);
            PG8_WAIT_V(8); PG8_WAIT_L(0); PG8_BAR; PG8_MMA(1, 0, At, B0); PG8_MMA(1, 1, At, B1); PG8_BAR; PG8_SCHED;
            PG8_LDB(B0, 1, 0); PG8_LDB(B1, 1, 1); PG8_SCHED; PG8_LDA(At, 1, 0); PG8_STAGE(PG8_SA(0, 1), a2 + hstepA, voffA, AUXA);
            PG8_WAIT_V(8); PG8_WAIT_L(0); PG8_BAR; PG8_MMA(0, 0, At, B0); PG8_MMA(0, 1, At, B1); PG8_BAR; PG8_SCHED;
            PG8_LDA(At, 1, 1); PG8_STAGE(PG8_SB(1, 0), b3, voffB, 0); PG8_STAGE(PG8_SB(1, 1), b3 + hstep, voffB, 0); PG8_STAGE(PG8_SA(1, 0), a3, voffA, AUXA);
            PG8_WAIT_V(8); PG8_WAIT_L(0); PG8_BAR; PG8_MMA(1, 0, At, B0); PG8_MMA(1, 1, At, B1); PG8_BAR; PG8_SCHED;
            } else {
            PG8_LDB(B0, 0, 0); PG8_SCHED; PG8_LDA(At, 0, 0); PG8_STAGE(PG8_SA(1, 1), a1 + hstepA, voffA, AUXA);
            PG8_WAIT_L(8); PG8_BAR; PG8_WAIT_L(0); PG8_MMA(0, 0, At, B0); PG8_BAR; PG8_SCHED;
            PG8_LDB(B1, 0, 1); PG8_STAGE(PG8_SB(0, 0), b2, voffB, 0);
            PG8_BAR; PG8_WAIT_L(0); PG8_MMA(0, 1, At, B1); PG8_BAR;
            PG8_LDA(At, 0, 1); PG8_STAGE(PG8_SA(0, 0), a2, voffA, AUXA);
            PG8_BAR; PG8_WAIT_L(0); PG8_MMA(1, 0, At, B0); PG8_BAR; PG8_SCHED;
            PG8_STAGE(PG8_SB(0, 1), b2 + hstep, voffB, 0);
            PG8_WAIT_V(6); PG8_BAR; PG8_MMA(1, 1, At, B1); PG8_BAR;
            PG8_LDB(B0, 1, 0); PG8_SCHED; PG8_LDA(At, 1, 0); PG8_STAGE(PG8_SA(0, 1), a2 + hstepA, voffA, AUXA);
            PG8_WAIT_L(8); PG8_BAR; PG8_WAIT_L(0); PG8_MMA(0, 0, At, B0); PG8_BAR; PG8_SCHED;
            PG8_LDB(B1, 1, 1); PG8_STAGE(PG8_SB(1, 0), b3, voffB, 0);
            PG8_BAR; PG8_WAIT_L(0); PG8_MMA(0, 1, At, B1); PG8_BAR;
            PG8_LDA(At, 1, 1); PG8_STAGE(PG8_SA(1, 0), a3, voffA, AUXA);
            PG8_BAR; PG8_WAIT_L(0); PG8_MMA(1, 0, At, B0); PG8_BAR; PG8_SCHED;
            PG8_STAGE(PG8_SB(1, 1), b3 + hstep, voffB, 0);
            PG8_WAIT_V(6); PG8_BAR; PG8_MMA(1, 1, At, B1); PG8_BAR;
            }
        }
        if constexpr (ALIGN_EPI) { if (wr == 0) PG8_BAR; }
        if constexpr (!Epi::AFTER_DRAIN) { E(acc, cur, wr, wc, fr, fq); S.done(cur); }
        if (!has_next) break;
#pragma unroll
        for (int a = 0; a < 2; ++a)
#pragma unroll
            for (int b = 0; b < 2; ++b)
#pragma unroll
                for (int m = 0; m < 4; ++m)
#pragma unroll
                    for (int n = 0; n < 2; ++n) acc[a][b][m][n] = (f32x4){0.f, 0.f, 0.f, 0.f};
        cur = nxt; cA = nA; cB = nB; ++ui;
        if constexpr (ALIGN_EPI) { if (wr == 1) PG8_BAR; }
    }
    PG8_WAIT_V(0);
    if constexpr (!ALIGN_EPI) { if (wr == 0) PG8_BAR; }
    PG8_BAR;
    if constexpr (Epi::AFTER_DRAIN) { E.fused(acc, cur, wr, wc, fr, fq, lds, wid, lane); S.done(cur); }
#undef PG8_SA
#undef PG8_SB
#undef PG8_STAGE
#undef PG8_LDA
#undef PG8_LDB
#undef PG8_MMA
#undef PG8_WAIT_V
#undef PG8_WAIT_L
#undef PG8_BAR
#undef PG8_SCHED
}
}

namespace {

#define LAS __attribute__((address_space(3)))
__device__ __forceinline__ void conv_item(const float* __restrict__ W, int K, int N, u16* __restrict__ WT, int rowbase, float* scr, int kb, int nb, int lane) {
    const int k0 = 64 * kb, n0 = 32 * nb;
#pragma unroll
    for (int i = 0; i < 8; ++i) { const int kk = 8 * i + (lane >> 3), cc = (lane & 7) * 4; const float4 w4 = *(const float4*)(W + (size_t)(k0 + kk) * N + n0 + cc);
        float* sp = scr + kk * 33 + cc; sp[0] = w4.x; sp[1] = w4.y; sp[2] = w4.z; sp[3] = w4.w; }
    asm volatile("s_waitcnt lgkmcnt(0)" ::: "memory");
    const int c = lane & 7;
#pragma unroll
    for (int j = 0; j < 4; ++j) { const int n = (lane >> 3) + 8 * j; const float* s = scr + (8 * c) * 33 + n;
        uint4 o; o.x = pk2(s[0 * 33], s[1 * 33]); o.y = pk2(s[2 * 33], s[3 * 33]); o.z = pk2(s[4 * 33], s[5 * 33]); o.w = pk2(s[6 * 33], s[7 * 33]);
        *(uint4*)(WT + (size_t)(rowbase + n) * K + k0 + 8 * c) = o; }
    asm volatile("s_waitcnt lgkmcnt(0)" ::: "memory");
}
__device__ __forceinline__ void conv_ld(const float* __restrict__ W, int N, int it, int nnb, int lane, float4 (&w)[8]) {
    const int kb = it / nnb, nb = it % nnb; const float* src = W + (size_t)(64 * kb + (lane >> 3)) * N + 32 * nb + (lane & 7) * 4;
#pragma unroll
    for (int i = 0; i < 8; ++i) {
#ifdef CONV_NT
        typedef float cv_f4 __attribute__((ext_vector_type(4)));
        const cv_f4 v = __builtin_nontemporal_load((const cv_f4*)(src + (size_t)(8 * i) * N)); w[i] = make_float4(v.x, v.y, v.z, v.w);
#else
        w[i] = *(const float4*)(src + (size_t)(8 * i) * N);
#endif
    }
}
__device__ __forceinline__ void conv_st(const float4 (&w)[8], int K, u16* __restrict__ WT, int rowbase, float* scr, int k0, int lane) {
#pragma unroll
    for (int i = 0; i < 8; ++i) { const int kk = 8 * i + (lane >> 3), cc = (lane & 7) * 4; float* sp = scr + kk * 33 + cc; sp[0] = w[i].x; sp[1] = w[i].y; sp[2] = w[i].z; sp[3] = w[i].w; }
    asm volatile("s_waitcnt lgkmcnt(0)" ::: "memory");
    const int c = lane & 7;
#pragma unroll
    for (int j = 0; j < 4; ++j) { const int n = (lane >> 3) + 8 * j; const float* s = scr + (8 * c) * 33 + n;
        uint4 o; o.x = pk2(s[0 * 33], s[1 * 33]); o.y = pk2(s[2 * 33], s[3 * 33]); o.z = pk2(s[4 * 33], s[5 * 33]); o.w = pk2(s[6 * 33], s[7 * 33]);
#ifdef CONV_NT
        { typedef unsigned cv_u4 __attribute__((ext_vector_type(4))); cv_u4 ov; ov.x = o.x; ov.y = o.y; ov.z = o.z; ov.w = o.w; __builtin_nontemporal_store(ov, (cv_u4*)(WT + (size_t)(rowbase + n) * K + k0 + 8 * c)); } }
#else
        *(uint4*)(WT + (size_t)(rowbase + n) * K + k0 + 8 * c) = o; }
#endif
    asm volatile("s_waitcnt lgkmcnt(0)" ::: "memory");
}
__device__ __forceinline__ void conv_matrix(const float* W, int K, int N, u16* WT, int roff, int GU, float* scr, int gw, int ngw, int lane) {
    const int nnb = N / 32, nitems = (K / 64) * nnb;
    if (gw < nitems) {
        float4 w[8]; conv_ld(W, N, gw, nnb, lane, w);
        for (int it = gw; it < nitems; it += ngw) { const int kb = it / nnb, nb = it % nnb, n0 = 32 * nb;
            float4 wn[8];
            if (it + ngw < nitems) conv_ld(W, N, it + ngw, nnb, lane, wn);
            else {
#pragma unroll
                for (int i = 0; i < 8; ++i) wn[i] = w[i]; }
            const int rowbase = GU == 0 ? roff + n0 : 256 * (n0 / 128) + (GU == 2 ? 128 : 0) + (n0 % 128);
            conv_st(w, K, WT, rowbase, scr, 64 * kb, lane);
#pragma unroll
            for (int i = 0; i < 8; ++i) w[i] = wn[i]; }
    }
}
struct ConvDesc { const float* W; u16* WT; int K, N, roff, GU; };
#ifdef TAIL_MIXERS
#define PRO_B1 29
#else
#define PRO_B1 38
#endif
constexpr size_t CTL_CONVTAB = 40960;
__device__ __forceinline__ void conv_all(KP p, ConvDesc* tab, float* scr, int gw, int ngw, int lane, int a0, int a1, int b0, int b1) {
    unsigned char* ws = p->ws;
    int t = threadIdx.x; asm volatile("" : "+v"(t));
    if (t < 38) {
        ConvDesc d;
        if (t < 24) { const int lf = t / 3, w = t % 3;
            if (w == 0) d = ConvDesc{p->in[I_WG] + (size_t)lf * D * DFF, (u16*)(ws + WS_WGU + lf * SZ_WGU), D, DFF, 0, 1};
            else if (w == 1) d = ConvDesc{p->in[I_WU] + (size_t)lf * D * DFF, (u16*)(ws + WS_WGU + lf * SZ_WGU), D, DFF, 0, 2};
            else d = ConvDesc{p->in[I_WD] + (size_t)lf * DFF * D, (u16*)(ws + WS_WD + lf * SZ_WD), DFF, D, 0, 0};
        } else if (t < 34) { const int j = (t - 24) / 5, w = (t - 24) % 5; u16* wdq = (u16*)(ws + WS_WDQKV) + (size_t)j * QKVA_LD * D;
            if (w == 0) d = ConvDesc{p->in[I_DQ] + (size_t)j * D * 512, wdq, D, 512, 0, 0};
            else if (w == 1) d = ConvDesc{p->in[I_DKV] + (size_t)j * D * 576, wdq, D, 576, 512, 0};
            else if (w == 2) d = ConvDesc{p->in[I_UQ] + (size_t)j * 512 * 3072, (u16*)(ws + WS_WUQ) + (size_t)j * 3072 * 512, 512, 3072, 0, 0};
            else if (w == 3) d = ConvDesc{p->in[I_UKV] + (size_t)j * 512 * 4096, (u16*)(ws + WS_WUKV) + (size_t)j * 4096 * 512, 512, 4096, 0, 0};
            else d = ConvDesc{p->in[I_MWO] + (size_t)j * D * D, (u16*)(ws + WS_WMO) + (size_t)j * D * D, D, D, 0, 0};
        } else if (t == 34) d = ConvDesc{p->in[I_HWIN], (u16*)(ws + WS_WHIN), D, 3 * D, 0, 0};
        else if (t == 35) d = ConvDesc{p->in[I_HWOUT], (u16*)(ws + WS_WHOUT), D, D, 0, 0};
        else if (t == 36) d = ConvDesc{p->in[I_WQKV], (u16*)(ws + WS_WWQKV), D, 2560, 0, 0};
        else d = ConvDesc{p->in[I_WWO], (u16*)(ws + WS_WWO), D, D, 0, 0};
        tab[t] = d; if (gw == 0) ((ConvDesc*)(ws + WS_CTL + CTL_CONVTAB))[t] = d;
    }
    __syncthreads();
#pragma unroll 1
    for (int m = a0; m < b1; m = (m + 1 == a1 ? b0 : m + 1)) { const ConvDesc d = tab[m]; conv_matrix(d.W, d.K, d.N, d.WT, d.roff, d.GU, scr, gw, ngw, lane); }
    for (int j = 0; j < 2; ++j) { u16* wdq = (u16*)(ws + WS_WDQKV) + (size_t)j * QKVA_LD * D;
        for (int i = gw * 64 + lane; i < (QKVA_LD - 1088) * D / 8; i += ngw * 64) ((uint4*)(wdq + (size_t)1088 * D))[i] = make_uint4(0u, 0u, 0u, 0u); }
    __syncthreads();
}
__device__ __forceinline__ unsigned long long rfl64(unsigned long long v) { return ((unsigned long long)(unsigned)__builtin_amdgcn_readfirstlane((int)(v >> 32)) << 32) | (unsigned)__builtin_amdgcn_readfirstlane((int)v); }
__device__ __forceinline__ void conv_tail(const ConvDesc* gtab, float* scr, int gw, int ngw, int lane, int a0, int a1, int b0, int b1) {
#pragma unroll 1
    for (int m = a0; m < b1; m = (m + 1 == a1 ? b0 : m + 1)) { const ConvDesc d = gtab[m]; conv_matrix((const float*)rfl64((unsigned long long)d.W), __builtin_amdgcn_readfirstlane(d.K), __builtin_amdgcn_readfirstlane(d.N), (u16*)rfl64((unsigned long long)d.WT), __builtin_amdgcn_readfirstlane(d.roff), __builtin_amdgcn_readfirstlane(d.GU), scr, gw, ngw, lane); }
    __syncthreads();
}

#define XB_TMO      128
#define XB_XCNT(j)  (256  + 64 * (j))
#define XB_XSUB(j)  (1280 + 64 * (j))
#define XB_XGEN(j)  (2304 + 64 * (j))
#define XB_TOP      3328
#define XB_TOPGEN   3392
#define XCD_BAR_WORDS 3456
#define XB_SPIN_CAP (1u << 22)

__device__ __forceinline__ unsigned xb_ld(unsigned* p)              { return __hip_atomic_load(p, __ATOMIC_RELAXED, __HIP_MEMORY_SCOPE_AGENT); }
__device__ __forceinline__ unsigned xb_add(unsigned* p, unsigned v) { return __hip_atomic_fetch_add(p, v, __ATOMIC_RELAXED, __HIP_MEMORY_SCOPE_AGENT); }
__device__ __forceinline__ unsigned xb_xcc_id() { return (unsigned)__builtin_amdgcn_s_getreg((3 << 11) | 20) & 0xFu; }
#define XB_SPIN(cond, bar) do { unsigned _sp = 0; while (cond) { __builtin_amdgcn_s_sleep(1); \
    if ((++_sp & 255u) == 0u) { if (xb_ld(&(bar)[XB_TMO])) break; if (_sp > XB_SPIN_CAP) { atomicAdd(&(bar)[XB_TMO], 1u); break; } } } } while (0)

struct XcdBarrier {
    unsigned* bar; unsigned x;
    volatile LAS unsigned* st;
};

__device__ __forceinline__ XcdBarrier xcd_barrier_post(unsigned* bar, volatile LAS unsigned* st) {
    XcdBarrier b; b.bar = bar; b.x = xb_xcc_id(); b.st = st;
    if (threadIdx.x == 0) (void)xb_add(&bar[XB_XCNT(b.x)], 1u);
    return b;
}
__device__ __forceinline__ void xcd_barrier_complete(unsigned* bar, unsigned x, unsigned& nloc, unsigned& nx) {
    const unsigned G = gridDim.x * gridDim.y * gridDim.z;
    unsigned sum, cnt, mine, sp = 0u;
    for (;;) {
        sum = 0u; cnt = 0u; mine = 0u;
#pragma unroll
        for (unsigned j = 0; j < 16; ++j) { const unsigned c = xb_ld(&bar[XB_XCNT(j)]); sum += c; cnt += (c > 0u) ? 1u : 0u; mine = (j == x) ? c : mine; }
        if (sum == G) break;
        __builtin_amdgcn_s_sleep(1);
        if ((++sp & 255u) == 0u) { if (xb_ld(&bar[XB_TMO])) break; if (sp > XB_SPIN_CAP) { atomicAdd(&bar[XB_TMO], 1u); break; } }
    }
    nloc = mine > 0u ? mine : 1u; nx = cnt > 0u ? cnt : 1u;
}

__device__ __forceinline__ void xcd_barrier(const XcdBarrier& b) {
    asm volatile("s_waitcnt vmcnt(0)" ::: "memory");
    __syncthreads();
    if (threadIdx.x == 0) {
        unsigned* bar = b.bar;
        unsigned xq = xb_xcc_id(); asm volatile("" : "+s"(xq));
        __builtin_amdgcn_s_waitcnt(0);
        unsigned nloc = b.st[0], nx = b.st[1];
        if (nloc == 0u) { xcd_barrier_complete(bar, xq, nloc, nx); b.st[0] = nloc; b.st[1] = nx; }
        const unsigned old = xb_add(&bar[XB_XSUB(xq)], 1u);
        const unsigned gen = old / nloc;
        if (old + 1u == (gen + 1u) * nloc) {
            __builtin_amdgcn_fence(__ATOMIC_RELEASE, "agent");
            asm volatile("s_waitcnt vmcnt(0)" ::: "memory");
            const unsigned og = xb_add(&bar[XB_TOP], 1u);
            const unsigned tg = og / nx;
            if (og + 1u == (tg + 1u) * nx) xb_add(&bar[XB_TOPGEN], 1u);
            else XB_SPIN(xb_ld(&bar[XB_TOPGEN]) == tg, bar);
            __builtin_amdgcn_fence(__ATOMIC_ACQUIRE, "agent");
            xb_add(&bar[XB_XGEN(xq)], 1u);
            asm volatile("s_waitcnt vmcnt(0)" ::: "memory");
        } else {
            XB_SPIN(xb_ld(&bar[XB_XGEN(xq)]) == gen, bar);
            __builtin_amdgcn_fence(__ATOMIC_ACQUIRE, "agent");
            asm volatile("s_waitcnt vmcnt(0)" ::: "memory");
        }
    }
    __syncthreads();
}


#define PH __device__ __forceinline__
#define LDSWAIT() asm volatile("s_waitcnt lgkmcnt(0)" ::: "memory")
__device__ __forceinline__ int otid() { int t = threadIdx.x; asm volatile("" : "+v"(t)); return t; }
PH void ph_modp(KP p, float* sc, int wg, int nwg) {
    const int TID = otid();
    for (int i = TID; i < 5 * D; i += 512) { const int m = i / D, k = i % D; const float v = m < 4 ? p->in[I_C][m * D + k] : p->in[I_CCTX][k]; sc[i] = silu_f(v); }
    __syncthreads();
    const int wave = TID >> 6, lane = TID & 63;
    float* MODP = (float*)(p->ws + WS_MODP);
    const int nitems = DEPTH * 72 * 16;
    for (int item = wg * 8 + wave; item < nitems; item += nwg * 8) {
        const int kc = item % 16, cg = (item / 16) % 72, layer = item / (16 * 72);
        const int col = cg * 256 + lane * 4;
        const float* w = p->in[I_MODW] + (size_t)layer * D * NMODV + (size_t)(kc * 128) * NMODV + col;
        float acc[5][4];
#pragma unroll
        for (int m = 0; m < 5; ++m) { acc[m][0] = acc[m][1] = acc[m][2] = acc[m][3] = 0.f; }
#pragma unroll 8
        for (int k = 0; k < 128; ++k) {
            const float4 wv = *(const float4*)(w + (size_t)k * NMODV);
#pragma unroll
            for (int m = 0; m < 5; ++m) { const float s = sc[m * D + kc * 128 + k]; acc[m][0] += s * wv.x; acc[m][1] += s * wv.y; acc[m][2] += s * wv.z; acc[m][3] += s * wv.w; }
        }
#pragma unroll
        for (int m = 0; m < 5; ++m) *(float4*)(MODP + ((size_t)(kc * DEPTH + layer) * 5 + m) * NMODV + col) = make_float4(acc[m][0], acc[m][1], acc[m][2], acc[m][3]);
    }
    __syncthreads();
}
PH void ph_modr(KP p, int wg, int nwg) {
    const int TID = otid();
    const float* MODP = (const float*)(p->ws + WS_MODP); float* MOD = (float*)(p->ws + WS_MOD);
    const int n = DEPTH * 5 * NMODV;
    for (int i = wg * 512 + TID; i < n; i += nwg * 512) {
        const int col = i % NMODV, layer = i / (5 * NMODV);
        float s = p->in[I_MODB][layer * NMODV + col];
        for (int kc = 0; kc < 16; ++kc) s += MODP[(size_t)kc * n + i];
        MOD[i] = s;
    }
}
PH void ph_tables(KP p, int wg, int nwg) {
    const int TID = otid();
    float* rope = (float*)(p->ws + WS_ROPE); float* tw = (float*)(p->ws + WS_TW);
    for (int i = wg * 512 + TID; i < 8192; i += nwg * 512) {
        if (i < 64 * 16) { const int pos = i / 16, k = i % 16; const float inv = (float)exp2(-(double)k / 16.0 * 13.287712379549449); const float ang = (float)pos * inv;
            rope[2 * i] = (float)cos((double)ang); rope[2 * i + 1] = (float)sin((double)ang); }
        const double a = -2.0 * 3.14159265358979323846 * (double)i / 8192.0; tw[2 * i] = (float)cos(a); tw[2 * i + 1] = (float)sin(a);
    }
}
template <int NR> PH void mod_rows(KP p, const int (&r)[NR], int nvalid, int layer, int slot, const float* pgate, float pcoef, bool first, bool fold, int lane) {
    u16* X = (u16*)(p->ws + WS_X); u16* HB = (u16*)(p->ws + WS_HB); const float* MOD = (const float*)(p->ws + WS_MOD); const u16* SLAB = (const u16*)(p->ws + WS_SLAB);
    const float* g = p->in[I_NORMG] + ((size_t)layer * 3 + slot) * D;
    float4 v[NR][4][2]; float rs[NR];
    const int b0 = r[0] / SB, j0 = r[0] - b0 * SB;
#pragma unroll
    for (int k = 0; k < NR; ++k) { if (k >= nvalid) { rs[k] = 0.f; continue; }
        uint4* xr = (uint4*)(X + (size_t)r[k] * D);
        const int b = r[k] / SB, j = r[k] - b * SB;
        if (first) {
            const float4* xs = j < CTX ? (const float4*)(p->in[I_CTX] + ((size_t)b * CTX + j) * D) : (const float4*)(p->in[I_X] + ((size_t)b * S + (j - CTX)) * D);
#pragma unroll
            for (int i = 0; i < 4; ++i) { const int c8 = lane + 64 * i; v[k][i][0] = xs[2 * c8]; v[k][i][1] = xs[2 * c8 + 1]; }
        } else {
#pragma unroll
            for (int i = 0; i < 4; ++i) { const uint4 q = xr[lane + 64 * i];
                v[k][i][0] = make_float4(pg8::h2f_lo(q.x), pg8::h2f_hi(q.x), pg8::h2f_lo(q.y), pg8::h2f_hi(q.y)); v[k][i][1] = make_float4(pg8::h2f_lo(q.z), pg8::h2f_hi(q.z), pg8::h2f_lo(q.w), pg8::h2f_hi(q.w)); }
        }
        if (NR == 1 && fold) {
#pragma unroll
            for (int i = 0; i < 4; ++i) { const int c8 = lane + 64 * i; float4 a0 = make_float4(0.f, 0.f, 0.f, 0.f), a1 = a0;
#pragma unroll
                for (int s = 0; s < 8; ++s) { const uint4 q = ((const uint4*)(SLAB + ((size_t)(s * 4 + b) * 256 + j) * D))[c8];
                    a0.x += __uint_as_float(q.x << 16); a0.y += __uint_as_float(q.x & 0xffff0000u); a0.z += __uint_as_float(q.y << 16); a0.w += __uint_as_float(q.y & 0xffff0000u);
                    a1.x += __uint_as_float(q.z << 16); a1.y += __uint_as_float(q.z & 0xffff0000u); a1.z += __uint_as_float(q.w << 16); a1.w += __uint_as_float(q.w & 0xffff0000u); }
                const float4 g0 = ((const float4*)pgate)[2 * c8], g1 = ((const float4*)pgate)[2 * c8 + 1];
                v[k][i][0].x += pcoef * g0.x * a0.x; v[k][i][0].y += pcoef * g0.y * a0.y; v[k][i][0].z += pcoef * g0.z * a0.z; v[k][i][0].w += pcoef * g0.w * a0.w;
                v[k][i][1].x += pcoef * g1.x * a1.x; v[k][i][1].y += pcoef * g1.y * a1.y; v[k][i][1].z += pcoef * g1.z * a1.z; v[k][i][1].w += pcoef * g1.w * a1.w; }
        }
        if (first || (NR == 1 && fold)) { const float lim = pg8::h16_lim();
#pragma unroll
            for (int i = 0; i < 4; ++i) xr[lane + 64 * i] = make_uint4(pg8::pkh2(v[k][i][0].x, v[k][i][0].y, lim), pg8::pkh2(v[k][i][0].z, v[k][i][0].w, lim), pg8::pkh2(v[k][i][1].x, v[k][i][1].y, lim), pg8::pkh2(v[k][i][1].z, v[k][i][1].w, lim));
        }
        float ss = 0.f;
#pragma unroll
        for (int i = 0; i < 4; ++i)
#pragma unroll
            for (int h = 0; h < 2; ++h) ss += v[k][i][h].x * v[k][i][h].x + v[k][i][h].y * v[k][i][h].y + v[k][i][h].z * v[k][i][h].z + v[k][i][h].w * v[k][i][h].w;
        rs[k] = rsqrtf(wave_sum(ss) * (1.f / D) + NORM_EPS);
    }
    const float* mb = MOD + ((size_t)(layer * 5 + (j0 < CTX ? 4 : b0)) * 9 + 3 * slot) * D;
#pragma unroll
    for (int i = 0; i < 4; ++i) { const int c8 = lane + 64 * i;
        float4 gs[2], sh[2];
#pragma unroll
        for (int h = 0; h < 2; ++h) { const float4 gg = ((const float4*)g)[2 * c8 + h], sl = ((const float4*)(mb + D))[2 * c8 + h]; sh[h] = ((const float4*)mb)[2 * c8 + h];
            gs[h] = make_float4(gg.x * (1.f + sl.x), gg.y * (1.f + sl.y), gg.z * (1.f + sl.z), gg.w * (1.f + sl.w)); }
#pragma unroll
        for (int k = 0; k < NR; ++k) { if (k >= nvalid) continue; unsigned ow[4];
#pragma unroll
            for (int h = 0; h < 2; ++h) { const float4 x = v[k][i][h];
                const float a = x.x * rs[k] * gs[h].x + sh[h].x, bq = x.y * rs[k] * gs[h].y + sh[h].y, c = x.z * rs[k] * gs[h].z + sh[h].z, d = x.w * rs[k] * gs[h].w + sh[h].w;
                ow[2 * h] = pk2(a, bq); ow[2 * h + 1] = pk2(c, d); }
            ((uint4*)(HB + (size_t)r[k] * D))[c8] = make_uint4(ow[0], ow[1], ow[2], ow[3]); } }
}
PH void ph_modulate(KP p, int layer, int slot, const float* pgate, float pcoef, int wg, int nwg, bool first = false) {
    const int TID = otid();
    const int wave = TID >> 6, lane = TID & 63, w = wg * 8 + wave, nw = nwg * 8;
    const int cw = pgate != nullptr ? 6 : 1;
    const int base = (NB * S + cw * NB * CTX + nw - 1) / nw;
    const int nctx_before = w < NB * CTX ? w : NB * CTX;
    int l0 = w * base - cw * nctx_before, l1 = l0 + base - (w < NB * CTX ? cw : 0);
    if (nw < NB * CTX) { l0 = (int)((long)w * (NB * S) / nw); l1 = (int)((long)(w + 1) * (NB * S) / nw); }
    if (l0 > NB * S) l0 = NB * S; if (l1 > NB * S) l1 = NB * S; if (w == nw - 1) l1 = NB * S;
    const int nc = w < NB * CTX ? (NB * CTX - 1 - w) / nw + 1 : 0;
    for (int it = 0; it < nc; ++it) { const int c = w + it * nw; const int r1[1] = {(c >> 8) * SB + (c & 255)}; mod_rows<1>(p, r1, 1, layer, slot, pgate, pcoef, first, pgate != nullptr, lane); }
    for (int l = l0; l < l1; ) {
        int n = l1 - l; if (n > 4) n = 4; const int left = 4096 - (l & 4095); if (n > left) n = left;
        const int rb = (l >> 12) * SB + CTX + (l & 4095); const int r4[4] = {rb, rb + 1, rb + 2, rb + 3};
        mod_rows<4>(p, r4, n, layer, slot, nullptr, 0.f, first, false, lane);
        l += n;
    }
}
PH void ph_final(KP p, int wg, int nwg) {
    const int TID = otid();
    const u16* X = (const u16*)(p->ws + WS_X); const float* g = p->in[I_FINALG];
    const int wave = TID >> 6, lane = TID & 63;
    for (int q = wg * 8 + wave; q < NB * S; q += nwg * 8) {
        const int b = q / S, t = q - b * S, r = b * SB + CTX + t;
        const uint4* xr = (const uint4*)(X + (size_t)r * D);
        float4 v[4][2]; float ss = 0.f;
#pragma unroll
        for (int i = 0; i < 4; ++i) { const uint4 w = xr[lane + 64 * i];
            v[i][0] = make_float4(pg8::h2f_lo(w.x), pg8::h2f_hi(w.x), pg8::h2f_lo(w.y), pg8::h2f_hi(w.y)); v[i][1] = make_float4(pg8::h2f_lo(w.z), pg8::h2f_hi(w.z), pg8::h2f_lo(w.w), pg8::h2f_hi(w.w));
#pragma unroll
            for (int h = 0; h < 2; ++h) ss += v[i][h].x * v[i][h].x + v[i][h].y * v[i][h].y + v[i][h].z * v[i][h].z + v[i][h].w * v[i][h].w; }
        const float rs = rsqrtf(wave_sum(ss) * (1.f / D) + NORM_EPS);
        float4* o = (float4*)(p->out + (size_t)q * D);
#pragma unroll
        for (int i = 0; i < 4; ++i)
#pragma unroll
            for (int h = 0; h < 2; ++h) { const int c4 = 2 * (lane + 64 * i) + h; const float4 gg = ((const float4*)g)[c4]; const float4 x = v[i][h]; o[c4] = make_float4(x.x * rs * gg.x, x.y * rs * gg.y, x.z * rs * gg.z, x.w * rs * gg.w); }
    }
}
PH void ph_mla_norm(KP p, int jm, int wg, int nwg) {
    const int TID = otid();
    const _Float16* A = (const _Float16*)(p->ws + WS_QKVA); u16* QL = (u16*)(p->ws + WS_QL); u16* CKV = (u16*)(p->ws + WS_CKV); u16* KR = (u16*)(p->ws + WS_KR);
    const float* gq = p->in[I_GQ] + jm * 512; const float* gkv = p->in[I_GKV] + jm * 512; const float* rope = (const float*)(p->ws + WS_ROPE);
    const int wave = TID >> 6, lane = TID & 63;
    for (int r = wg * 8 + wave; r < R; r += nwg * 8) {
        const _Float16* a = A + (size_t)r * QKVA_LD;
        const uint4 qw = ((const uint4*)a)[lane], kw = ((const uint4*)(a + 512))[lane];
        const float4 q0 = make_float4(pg8::h2f_lo(qw.x), pg8::h2f_hi(qw.x), pg8::h2f_lo(qw.y), pg8::h2f_hi(qw.y)), q1 = make_float4(pg8::h2f_lo(qw.z), pg8::h2f_hi(qw.z), pg8::h2f_lo(qw.w), pg8::h2f_hi(qw.w));
        const float4 k0 = make_float4(pg8::h2f_lo(kw.x), pg8::h2f_hi(kw.x), pg8::h2f_lo(kw.y), pg8::h2f_hi(kw.y)), k1 = make_float4(pg8::h2f_lo(kw.z), pg8::h2f_hi(kw.z), pg8::h2f_lo(kw.w), pg8::h2f_hi(kw.w));
        const float sq = wave_sum(q0.x * q0.x + q0.y * q0.y + q0.z * q0.z + q0.w * q0.w + q1.x * q1.x + q1.y * q1.y + q1.z * q1.z + q1.w * q1.w);
        const float sk = wave_sum(k0.x * k0.x + k0.y * k0.y + k0.z * k0.z + k0.w * k0.w + k1.x * k1.x + k1.y * k1.y + k1.z * k1.z + k1.w * k1.w);
        const float rq = rsqrtf(sq * (1.f / 512) + NORM_EPS), rk = rsqrtf(sk * (1.f / 512) + NORM_EPS);
        const float4 g0 = ((const float4*)gq)[lane * 2], g1 = ((const float4*)gq)[lane * 2 + 1], h0 = ((const float4*)gkv)[lane * 2], h1 = ((const float4*)gkv)[lane * 2 + 1];
        uint4 oq, ok;
        oq.x = pk2(q0.x * rq * g0.x, q0.y * rq * g0.y); oq.y = pk2(q0.z * rq * g0.z, q0.w * rq * g0.w); oq.z = pk2(q1.x * rq * g1.x, q1.y * rq * g1.y); oq.w = pk2(q1.z * rq * g1.z, q1.w * rq * g1.w);
        ok.x = pk2(k0.x * rk * h0.x, k0.y * rk * h0.y); ok.y = pk2(k0.z * rk * h0.z, k0.w * rk * h0.w); ok.z = pk2(k1.x * rk * h1.x, k1.y * rk * h1.y); ok.w = pk2(k1.z * rk * h1.z, k1.w * rk * h1.w);
        ((uint4*)(QL + (size_t)r * 512))[lane] = oq; ((uint4*)(CKV + (size_t)r * 512))[lane] = ok;
        if (lane < 32) {
            const int b = r / SB, j = r - b * SB; const int half = lane >> 4, i = lane & 15;
            const float x1 = (float)a[1024 + 32 * half + i], x2 = (float)a[1024 + 32 * half + 16 + i];
            float o1 = x1, o2 = x2;
            if (j >= CTX) { const int t = j - CTX, pos = half ? (t & 63) : (t >> 6); const float cs = rope[(pos * 16 + i) * 2], sn = rope[(pos * 16 + i) * 2 + 1]; o1 = x1 * cs - x2 * sn; o2 = x2 * cs + x1 * sn; }
            KR[(size_t)r * 64 + 32 * half + i] = f2bf(o1); KR[(size_t)r * 64 + 32 * half + 16 + i] = f2bf(o2);
        }
    }
}
PH void ph_transpose(const u16* __restrict__ ZT, u16* __restrict__ Z, u16* tile, int wg, int nwg) {
    const int TID = otid();
    const int ld = TID >> 3, lr = (TID & 7) * 8;
    const int sr = TID & 63, sd = (TID >> 6) * 8;
    for (int u = wg; u < (R / 64) * (D / 64); u += nwg) {
        const int r0 = (u % (R / 64)) * 64, d0 = (u / (R / 64)) * 64;
        const uint4 v = *(const uint4*)(ZT + (size_t)(d0 + ld) * R + r0 + lr);
        *(uint4*)(tile + ld * 72 + lr) = v;
        __syncthreads();
        unsigned w[4];
#pragma unroll
        for (int k = 0; k < 4; ++k) w[k] = (unsigned)tile[(sd + 2 * k) * 72 + sr] | ((unsigned)tile[(sd + 2 * k + 1) * 72 + sr] << 16);
        *(uint4*)(Z + (size_t)(r0 + sr) * D + d0 + sd) = make_uint4(w[0], w[1], w[2], w[3]);
        __syncthreads();
    }
}
template <int NP> PH void filt_unit(KP p, float* lds, int L, int l0, float* FT, int tid) {
    float* zf = lds; float* ha = lds + 8 * 33; float* hb = ha + 512; float* h3t = hb + 512; float* tp = h3t + 512;
    const float* w1 = p->in[I_FW1]; const float* b1 = p->in[I_FB1]; const float* w2 = p->in[I_FW2]; const float* b2 = p->in[I_FB2]; const float* w3 = p->in[I_FW3]; const float* b3 = p->in[I_FB3]; const float* fr = p->in[I_FFREQ];
    const float* w4 = p->in[I_FW4]; const float* decay = p->in[I_DECAY];
    { int tf = tid; asm volatile("" : "+v"(tf));
      for (int idx = tf; idx < NP * 33; idx += 512) { const int pp = idx / 33, c = idx % 33, l = l0 + pp; const float t = (float)l / (float)(L - 1);
        float v;
        if (c == 0) { v = t; tp[pp] = t; }
        else { const int k = (c - 1) & 15; const float f = 1e-4f + (float)k * ((15.0f - 1e-4f) / 15.0f); const float w = 6.283185307179586f * (float)l / (float)L; const double a = (double)(f * w);
            v = c <= 16 ? (float)cos(a) : (float)(-sin(a)); }
        zf[pp * 33 + c] = v; } }
    __syncthreads();
    { int tj = tid; asm volatile("" : "+v"(tj)); const int pp = tj >> 6, j = tj & 63; if (pp < NP) { float s = b1[j]; for (int c = 0; c < 33; ++c) s += zf[pp * 33 + c] * w1[c * 64 + j]; ha[pp * 64 + j] = sinf(fr[j] * s); } }
    __syncthreads();
    { int tj = tid; asm volatile("" : "+v"(tj)); const int pp = tj >> 6, j = tj & 63; if (pp < NP) { float s = b2[j]; for (int c = 0; c < 64; ++c) s += ha[pp * 64 + c] * w2[c * 64 + j]; hb[pp * 64 + j] = sinf(fr[j] * s); } }
    __syncthreads();
    { int tj = tid; asm volatile("" : "+v"(tj)); const int pp = tj >> 6, j = tj & 63; if (pp < NP) { float s = b3[j]; for (int c = 0; c < 64; ++c) s += hb[pp * 64 + c] * w3[c * 64 + j]; h3t[j * 8 + pp] = sinf(fr[j] * s); } }
    __syncthreads();
#pragma unroll 1
    for (int m = 0; m < 4; ++m) {
        int tq = tid; asm volatile("" : "+v"(tq));
        const int n4 = (tq + 512 * m) * 4; float acc[NP][4];
#pragma unroll
        for (int q = 0; q < NP; ++q) { acc[q][0] = 0.f; acc[q][1] = 0.f; acc[q][2] = 0.f; acc[q][3] = 0.f; }
        const float* wp = w4 + n4;
#pragma unroll 1
        for (int k0 = 0; k0 < 64; k0 += 8) {
            float4 wv[8];
#pragma unroll
            for (int kk = 0; kk < 8; ++kk) wv[kk] = *(const float4*)(wp + (size_t)kk * 8192);
            wp += 8 * 8192;
#pragma unroll
            for (int kk = 0; kk < 8; ++kk) { float hh[8];
                if (NP == 8) { const float4 h0 = *(const float4*)(h3t + (k0 + kk) * 8), h1 = *(const float4*)(h3t + (k0 + kk) * 8 + 4); hh[0] = h0.x; hh[1] = h0.y; hh[2] = h0.z; hh[3] = h0.w; hh[4] = h1.x; hh[5] = h1.y; hh[6] = h1.z; hh[7] = h1.w; }
                else hh[0] = h3t[(k0 + kk) * 8];
#pragma unroll
                for (int q = 0; q < NP; ++q) { acc[q][0] += hh[q] * wv[kk].x; acc[q][1] += hh[q] * wv[kk].y; acc[q][2] += hh[q] * wv[kk].z; acc[q][3] += hh[q] * wv[kk].w; } }
        }
        const float4 dc4 = *(const float4*)(decay + n4); const float dc[4] = {fabsf(dc4.x), fabsf(dc4.y), fabsf(dc4.z), fabsf(dc4.w)};
        float* o = FT + (size_t)n4 * L + l0;
#pragma unroll
        for (int c = 0; c < 4; ++c) { float e[NP];
#pragma unroll
            for (int q = 0; q < NP; ++q) e[q] = acc[q][c] * __builtin_amdgcn_exp2f(-1.4426950408889634f * tp[q] * dc[c]);
            if (NP == 8) { *(float4*)o = make_float4(e[0], e[1], e[2], e[3]); *(float4*)(o + 4) = make_float4(e[4], e[5], e[6], e[7]); } else o[0] = e[0];
            o += L; }
    }
    __syncthreads();
}
PH void ph_filters(KP p, float* lds, int wg, int nwg) {
    const int TID = otid();
    for (int unit = wg; unit < 512; unit += nwg) filt_unit<8>(p, lds, 4096, unit * 8, (float*)(p->ws + WS_FT4096), TID);
    for (int q = wg; q < 256; q += nwg) filt_unit<1>(p, lds, 256, q, (float*)(p->ws + WS_FT256), TID);
}
PH void ph_nattn_mla(const u16* __restrict__ Q, const u16* __restrict__ KN, const u16* __restrict__ KR, const u16* __restrict__ V, u16* __restrict__ O, float* lds, int wg, int nwg) {
    const int TID = otid();
    const int wave = TID >> 6, lane = TID & 63;
    float* pp = lds + wave * (SB + 192); float* qq = pp + SB;
    for (int item = wg * 8 + wave; item < R * 16; item += nwg * 8) {
        const int r = item >> 4, h = item & 15;
        const int b = r / SB, j = r - b * SB, nk = j < CTX ? CTX : SB, kb = b * SB;
        for (int c = lane; c < 192; c += 64) qq[c] = bf2f(Q[(size_t)r * 3072 + h * 192 + c]);
        LDSWAIT();
        const float scale = 0.07216878364870322f;
        float mx = -3.0e38f;
        for (int key = lane; key < nk; key += 64) {
            const uint4* kn = (const uint4*)(KN + (size_t)(kb + key) * D + h * 128); const uint4* kr = (const uint4*)(KR + (size_t)(kb + key) * 64);
            float s = 0.f;
#pragma unroll 4
            for (int c8 = 0; c8 < 24; ++c8) { const uint4 w = c8 < 16 ? kn[c8] : kr[c8 - 16]; const float* q8 = qq + c8 * 8;
                s += q8[0] * __uint_as_float(w.x << 16) + q8[1] * __uint_as_float(w.x & 0xffff0000u) + q8[2] * __uint_as_float(w.y << 16) + q8[3] * __uint_as_float(w.y & 0xffff0000u)
                   + q8[4] * __uint_as_float(w.z << 16) + q8[5] * __uint_as_float(w.z & 0xffff0000u) + q8[6] * __uint_as_float(w.w << 16) + q8[7] * __uint_as_float(w.w & 0xffff0000u); }
            s *= scale; pp[key] = s; mx = fmaxf(mx, s);
        }
        mx = wave_max(mx);
        float sum = 0.f;
        for (int key = lane; key < nk; key += 64) { const float e = expf(pp[key] - mx); pp[key] = e; sum += e; }
        sum = wave_sum(sum);
        LDSWAIT();
        float o0 = 0.f, o1 = 0.f;
        const u16* vb = V + (size_t)kb * D + h * 128 + lane;
        for (int key = 0; key < nk; ++key) { const float pv = pp[key]; o0 += pv * bf2f(vb[(size_t)key * D]); o1 += pv * bf2f(vb[(size_t)key * D + 64]); }
        const float inv = 1.f / sum;
        O[(size_t)r * D + h * 128 + lane] = f2bf(o0 * inv); O[(size_t)r * D + h * 128 + 64 + lane] = f2bf(o1 * inv);
        LDSWAIT();
    }
}
PH void ph_nattn_win(const u16* __restrict__ QKV, const float* __restrict__ sink, u16* __restrict__ O, float* lds, int wg, int nwg) {
    const int TID = otid();
    const int wave = TID >> 6, lane = TID & 63;
    float* pp = lds + wave * 640; float* qq = pp + 576;
    for (int item = wg * 8 + wave; item < R * 32; item += nwg * 8) {
        const int r = item >> 5, qh = item & 31, kvh = qh >> 3;
        const int b = r / SB, j = r - b * SB, kb = b * SB;
        qq[lane] = bf2f(QKV[(size_t)r * 2560 + qh * 64 + lane]);
        LDSWAIT();
        int lo = 0, nwin = 0; if (j >= CTX) { const int t = j - CTX; lo = t - 128 < 0 ? 0 : t - 128; const int hi = t + 128 > S - 1 ? S - 1 : t + 128; nwin = hi - lo + 1; }
        const int nk = CTX + nwin;
        float mx = sink[qh];
        for (int key = lane; key < nk; key += 64) {
            const int krow = kb + (key < CTX ? key : CTX + lo + (key - CTX));
            const uint4* kk = (const uint4*)(QKV + (size_t)krow * 2560 + 2048 + kvh * 64);
            float s = 0.f;
#pragma unroll
            for (int c8 = 0; c8 < 8; ++c8) { const uint4 w = kk[c8]; const float* q8 = qq + c8 * 8;
                s += q8[0] * __uint_as_float(w.x << 16) + q8[1] * __uint_as_float(w.x & 0xffff0000u) + q8[2] * __uint_as_float(w.y << 16) + q8[3] * __uint_as_float(w.y & 0xffff0000u)
                   + q8[4] * __uint_as_float(w.z << 16) + q8[5] * __uint_as_float(w.z & 0xffff0000u) + q8[6] * __uint_as_float(w.w << 16) + q8[7] * __uint_as_float(w.w & 0xffff0000u); }
            s *= 0.125f; pp[key] = s; mx = fmaxf(mx, s);
        }
        mx = wave_max(mx);
        float sum = 0.f;
        for (int key = lane; key < nk; key += 64) { const float e = expf(pp[key] - mx); pp[key] = e; sum += e; }
        sum = wave_sum(sum) + expf(sink[qh] - mx);
        LDSWAIT();
        float o = 0.f;
        for (int key = 0; key < nk; ++key) { const int krow = kb + (key < CTX ? key : CTX + lo + (key - CTX)); o += pp[key] * bf2f(QKV[(size_t)krow * 2560 + 2304 + kvh * 64 + lane]); }
        O[(size_t)r * D + qh * 64 + lane] = f2bf(o / sum);
        LDSWAIT();
    }
}

namespace att {
typedef short bf16x8 __attribute__((ext_vector_type(8)));
typedef short s16x4 __attribute__((ext_vector_type(4)));
typedef float f32x16 __attribute__((ext_vector_type(16)));
typedef unsigned u32x4 __attribute__((ext_vector_type(4)));
#define ALDS __attribute__((address_space(3)))
#define ASBAR() __builtin_amdgcn_sched_barrier(0)
__device__ __forceinline__ int crow(int r, int hi) { return (r & 3) + 8 * (r >> 2) + 4 * hi; }
__device__ __forceinline__ unsigned cvtpk(float lo, float hi) { unsigned r; asm("v_cvt_pk_bf16_f32 %0, %1, %2" : "=v"(r) : "v"(lo), "v"(hi)); return r; }
template <int STRIDE> __device__ __forceinline__ int kswz(int row, int colB) { return row * STRIDE + (colB ^ (((row >> 1) & 7) << 4)); }
template <int DV> __device__ __forceinline__ int v_st(int k, int c) { const int kk = (k & ~0xC) | ((k & 4) << 1) | ((k & 8) >> 1); return ((kk >> 3) * (DV / 32) + (c >> 5)) * 512 + ((kk & 7) * 32 + (c & 31)) * 2; }
__device__ __forceinline__ int v_rd_base(int lane) { return ((lane & 3) << 3) | (((lane >> 2) & 3) << 6) | (((lane >> 4) & 1) << 5) | (((lane >> 5) & 1) << 8); }
template <int DV> constexpr int v_rd_off(int d0, int ks, int half) { return d0 * 512 + ks * (2 * (DV / 32) * 512) + half * ((DV / 32) * 512); }
template <int OFF> __device__ __forceinline__ s16x4 tr_read(int vb) { s16x4 r; asm volatile("ds_read_b64_tr_b16 %0, %1 offset:%2" : "=&v"(r) : "v"(vb), "i"(OFF) : "memory"); return r; }
__device__ __forceinline__ void partialSM(f32x16& p0, f32x16& p1, float& m_reg, float& mn, float& alpha, const float C, const float THRR) {
    float pmax = p0[0];
#pragma unroll
    for (int r = 1; r < 16; ++r) pmax = fmaxf(pmax, p0[r]);
#pragma unroll
    for (int r = 0; r < 16; ++r) pmax = fmaxf(pmax, p1[r]);
    { auto rr = __builtin_amdgcn_permlane32_swap(__float_as_uint(pmax), __float_as_uint(pmax), false, false); pmax = fmaxf(__uint_as_float(rr[0]), __uint_as_float(rr[1])); }
    if (__builtin_expect(__all(pmax - m_reg <= THRR), 1)) { mn = m_reg; alpha = 1.f; }
    else { mn = fmaxf(m_reg, pmax); alpha = __builtin_amdgcn_exp2f((m_reg - mn) * C); m_reg = mn; }
    const float mnC = -mn * C;
#pragma unroll
    for (int r = 0; r < 16; ++r) p0[r] = fmaf(p0[r], C, mnC);
#pragma unroll
    for (int r = 0; r < 16; ++r) p1[r] = fmaf(p1[r], C, mnC);
#pragma unroll
    for (int r = 0; r < 16; ++r) p0[r] = __builtin_amdgcn_exp2f(p0[r]);
}
__device__ __forceinline__ void finishSM(f32x16& p0, f32x16& p1, float alpha, float& l_reg, bf16x8& pa0, bf16x8& pa1, bf16x8& pa2, bf16x8& pa3) {
#pragma unroll
    for (int r = 0; r < 16; ++r) p1[r] = __builtin_amdgcn_exp2f(p1[r]);
    float ps = 0;
#pragma unroll
    for (int r = 0; r < 16; ++r) ps += p0[r];
#pragma unroll
    for (int r = 0; r < 16; ++r) ps += p1[r];
    { auto rr = __builtin_amdgcn_permlane32_swap(__float_as_uint(ps), __float_as_uint(ps), false, false); ps = __uint_as_float(rr[0]) + __uint_as_float(rr[1]); }
    l_reg = l_reg * alpha + ps;
#define ATT_PK4(P, BASE, OUT) do { unsigned a0 = cvtpk(P[BASE + 0], P[BASE + 1]), a1 = cvtpk(P[BASE + 2], P[BASE + 3]);   \
    unsigned b0 = cvtpk(P[BASE + 4], P[BASE + 5]), b1 = cvtpk(P[BASE + 6], P[BASE + 7]);                              \
    auto r0 = __builtin_amdgcn_permlane32_swap(a0, b0, false, false); auto r1 = __builtin_amdgcn_permlane32_swap(a1, b1, false, false); \
    u32x4 w = {r0[0], r1[0], r0[1], r1[1]}; OUT = *reinterpret_cast<bf16x8*>(&w); } while (0)
    ATT_PK4(p0, 0, pa0); ATT_PK4(p0, 8, pa1); ATT_PK4(p1, 0, pa2); ATT_PK4(p1, 8, pa3);
#undef ATT_PK4
}
template <int DQK, int KST> __device__ __forceinline__ void qkt(f32x16& p0, f32x16& p1, const ALDS char* Ks, const bf16x8* qr, int r32, int hi) {
    p0 = f32x16{}; p1 = f32x16{};
#pragma unroll
    for (int d0 = 0; d0 < DQK / 16; ++d0) { const int cb = (d0 * 16 + hi * 8) * 2;
        const bf16x8 b0 = *reinterpret_cast<const ALDS bf16x8*>(Ks + kswz<KST>(r32, cb));
        const bf16x8 b1 = *reinterpret_cast<const ALDS bf16x8*>(Ks + kswz<KST>(32 + r32, cb));
        p0 = __builtin_amdgcn_mfma_f32_32x32x16_bf16(b0, qr[d0], p0, 0, 0, 0);
        p1 = __builtin_amdgcn_mfma_f32_32x32x16_bf16(b1, qr[d0], p1, 0, 0, 0); }
}
template <int D0, int DV> __device__ __forceinline__ void pv_one(f32x16& od, int vb, bf16x8 pa0, bf16x8 pa1, bf16x8 pa2, bf16x8 pa3) {
    const s16x4 l0 = tr_read<v_rd_off<DV>(D0, 0, 0)>(vb), h0 = tr_read<v_rd_off<DV>(D0, 0, 1)>(vb), l1 = tr_read<v_rd_off<DV>(D0, 1, 0)>(vb), h1 = tr_read<v_rd_off<DV>(D0, 1, 1)>(vb);
    const s16x4 l2 = tr_read<v_rd_off<DV>(D0, 2, 0)>(vb), h2 = tr_read<v_rd_off<DV>(D0, 2, 1)>(vb), l3 = tr_read<v_rd_off<DV>(D0, 3, 0)>(vb), h3 = tr_read<v_rd_off<DV>(D0, 3, 1)>(vb);
    asm volatile("s_waitcnt lgkmcnt(0)" ::: "memory"); ASBAR();
#define ATT_PK(L, H) (bf16x8){L[0], L[1], L[2], L[3], H[0], H[1], H[2], H[3]}
    od = __builtin_amdgcn_mfma_f32_32x32x16_bf16(pa0, ATT_PK(l0, h0), od, 0, 0, 0);
    od = __builtin_amdgcn_mfma_f32_32x32x16_bf16(pa1, ATT_PK(l1, h1), od, 0, 0, 0);
    od = __builtin_amdgcn_mfma_f32_32x32x16_bf16(pa2, ATT_PK(l2, h2), od, 0, 0, 0);
    od = __builtin_amdgcn_mfma_f32_32x32x16_bf16(pa3, ATT_PK(l3, h3), od, 0, 0, 0);
#undef ATT_PK
}

constexpr int MLA_LDS_BYTES = 2 * 16384 + 2 * 24576 + 2048;
__device__ __forceinline__ void mla_unit(const u16* __restrict__ Qb, const u16* __restrict__ KNh, const u16* __restrict__ KRb, const u16* __restrict__ Vh, u16* __restrict__ Ob, int nkeys, ALDS char* lds, int tid) {
    constexpr int SHV = 16384, SHK = 24576;
    constexpr float SCALE = 0.07216878364870322f, C = SCALE * 1.4426950408889634f, THRR = 8.f / SCALE;
    const int wid = tid >> 6, lane = tid & 63, r32 = lane & 31, hi = lane >> 5;
    ALDS char* V_lds = lds; ALDS char* K_lds = lds + 2 * SHV;
    ALDS float* wsc = (ALDS float*)(lds + 2 * SHV + 2 * SHK) + wid * 64; ALDS float* li_l = wsc; ALDS float* al_l = wsc + 32;
    float m_reg = -1e30f, l_reg = 0.f; f32x16 o[4] = {}; bf16x8 qr[12];
    const u16* Qw = Qb + (unsigned)((wid * 32 + r32) * 3072 + hi * 8);
#pragma unroll
    for (int d0 = 0; d0 < 12; ++d0) qr[d0] = *reinterpret_cast<const bf16x8*>(Qw + d0 * 16);
    const int sr = tid >> 4, sc = (tid & 15) * 8, krr = tid >> 3, krc = (tid & 7) * 8;
    const int vst0 = v_st<128>(sr, sc), vst1 = v_st<128>(32 + sr, sc);
    const int kst0 = kswz<384>(sr, sc * 2), kst1 = kswz<384>(32 + sr, sc * 2), kst2 = kswz<384>(krr, (128 + krc) * 2);
    const int vb0 = (int)(unsigned)(uintptr_t)V_lds + v_rd_base(lane);
    bf16x8 vs0, vs1, ks0, ks1, kr0;
const unsigned goff = (unsigned)(sr * 2048 + sc), kroff = (unsigned)(krr * 64 + krc);
#define MLA_SLOAD(k0) do { const u16* vp = Vh + (size_t)(k0) * 2048; const u16* kp = KNh + (size_t)(k0) * 2048; \
    vs0 = *reinterpret_cast<const bf16x8*>(vp + goff); vs1 = *reinterpret_cast<const bf16x8*>(vp + 32 * 2048 + goff); \
    ks0 = *reinterpret_cast<const bf16x8*>(kp + goff); ks1 = *reinterpret_cast<const bf16x8*>(kp + 32 * 2048 + goff); \
    kr0 = *reinterpret_cast<const bf16x8*>(KRb + (size_t)(k0) * 64 + kroff); } while (0)
#define MLA_SWRITE(b) do { *reinterpret_cast<ALDS bf16x8*>(V_lds + (b) * SHV + vst0) = vs0; *reinterpret_cast<ALDS bf16x8*>(V_lds + (b) * SHV + vst1) = vs1; \
    *reinterpret_cast<ALDS bf16x8*>(K_lds + (b) * SHK + kst0) = ks0; *reinterpret_cast<ALDS bf16x8*>(K_lds + (b) * SHK + kst1) = ks1; *reinterpret_cast<ALDS bf16x8*>(K_lds + (b) * SHK + kst2) = kr0; } while (0)
    const int NT = nkeys / 64;
    MLA_SLOAD(0); MLA_SWRITE(0); __syncthreads();
    for (int j = 0; j < NT; ++j) {
        const int b = j & 1;
        if (j + 1 < NT) MLA_SLOAD((j + 1) * 64);
        f32x16 p0, p1; float mn, alpha; bf16x8 pa0, pa1, pa2, pa3;
        qkt<192, 384>(p0, p1, K_lds + b * SHK, qr, r32, hi);
        partialSM(p0, p1, m_reg, mn, alpha, C, THRR);
        if (__any(alpha < 1.f)) { if (hi == 0) al_l[r32] = alpha; asm volatile("s_waitcnt lgkmcnt(0)" ::: "memory");
#pragma unroll
            for (int d = 0; d < 4; ++d)
#pragma unroll
                for (int r = 0; r < 16; ++r) o[d][r] *= al_l[crow(r, hi)]; }
        finishSM(p0, p1, alpha, l_reg, pa0, pa1, pa2, pa3); ASBAR();
        const int vb = vb0 + b * SHV;
        pv_one<0, 128>(o[0], vb, pa0, pa1, pa2, pa3); pv_one<1, 128>(o[1], vb, pa0, pa1, pa2, pa3); pv_one<2, 128>(o[2], vb, pa0, pa1, pa2, pa3); pv_one<3, 128>(o[3], vb, pa0, pa1, pa2, pa3);
        if (j + 1 < NT) MLA_SWRITE(b ^ 1);
        __syncthreads();
    }
#undef MLA_SLOAD
#undef MLA_SWRITE
    if (hi == 0) li_l[r32] = l_reg;
    asm volatile("s_waitcnt lgkmcnt(0)" ::: "memory");
    ALDS char* ost = lds + wid * 8704;
#pragma unroll
    for (int r = 0; r < 16; ++r) { const int orow = crow(r, hi); const float rl = __builtin_amdgcn_rcpf(li_l[orow]);
#pragma unroll
        for (int d0 = 0; d0 < 4; ++d0) *reinterpret_cast<ALDS u16*>(ost + orow * 272 + (d0 * 32 + r32) * 2) = f2bf(o[d0][r] * rl); }
    asm volatile("s_waitcnt lgkmcnt(0)" ::: "memory");
#pragma unroll
    for (int i = 0; i < 8; ++i) { const int row = i * 4 + (lane >> 4), ch = lane & 15; const u32x4 v = *reinterpret_cast<const ALDS u32x4*>(ost + row * 272 + ch * 16);
        *reinterpret_cast<u32x4*>(Ob + (unsigned)((wid * 32 + row) * 2048 + ch * 8)) = v; }
    __syncthreads();
}

constexpr int MLA2_LDS_BYTES = 2 * 16384 + 2 * 24576 + 2048 + 8 * 4096;
__device__ __forceinline__ void qkt_mla(f32x16& p0, f32x16& p1, const ALDS char* Ks, const bf16x8* qr, const ALDS char* qrl, int r32, int hi) {
    p0 = f32x16{}; p1 = f32x16{};
    const int kb[4] = {kswz<384>(r32, (0 * 16 + hi * 8) * 2), kswz<384>(r32, (1 * 16 + hi * 8) * 2), kswz<384>(r32, (2 * 16 + hi * 8) * 2), kswz<384>(r32, (3 * 16 + hi * 8) * 2)};
    bf16x8 b0[3], b1[3], qf[3];
#define QKT_LD(d0) do { b0[(d0) % 3] = *reinterpret_cast<const ALDS bf16x8*>(Ks + kb[(d0) & 3] + ((d0) >> 2) * 128); b1[(d0) % 3] = *reinterpret_cast<const ALDS bf16x8*>(Ks + kb[(d0) & 3] + ((d0) >> 2) * 128 + 32 * 384); \
        if ((d0) >= 8) qf[(d0) % 3] = *reinterpret_cast<const ALDS bf16x8*>(qrl + ((d0) - 8) * 1024); } while (0)
    QKT_LD(0); QKT_LD(1);
#define QKT_STEP(d0) do { if ((d0) + 2 < 12) QKT_LD((d0) + 2); \
        { const bf16x8 q = (d0) < 8 ? qr[(d0) < 8 ? (d0) : 0] : qf[(d0) % 3]; \
          p0 = __builtin_amdgcn_mfma_f32_32x32x16_bf16(b0[(d0) % 3], q, p0, 0, 0, 0); p1 = __builtin_amdgcn_mfma_f32_32x32x16_bf16(b1[(d0) % 3], q, p1, 0, 0, 0); } \
        __builtin_amdgcn_sched_group_barrier(0x100, (d0) + 2 < 12 ? ((d0) + 2 >= 8 ? 3 : 2) : 0, 0);     \
        __builtin_amdgcn_sched_group_barrier(0x008, 2, 0); } while (0)
    QKT_STEP(0); QKT_STEP(1); QKT_STEP(2); QKT_STEP(3); QKT_STEP(4); QKT_STEP(5); QKT_STEP(6); QKT_STEP(7); QKT_STEP(8); QKT_STEP(9); QKT_STEP(10); QKT_STEP(11);
#undef QKT_STEP
#undef QKT_LD
}
template <int OFF> __device__ __forceinline__ bf16x8 lds_rd128(int a) { bf16x8 r; asm volatile("ds_read_b128 %0, %1 offset:%2" : "=&v"(r) : "v"(a), "i"(OFF) : "memory"); return r; }
template <int KOFF> __device__ __forceinline__ void qkt_mla_p(f32x16& p0, f32x16& p1, const int (&ka)[4], int qa, const bf16x8* qr) {
    p0 = f32x16{}; p1 = f32x16{};
    bf16x8 b0[2], b1[2], qf[2];
#define QL(d0) do { b0[(d0) & 1] = lds_rd128<KOFF + ((d0) >> 2) * 128>(ka[(d0) & 3]); b1[(d0) & 1] = lds_rd128<KOFF + ((d0) >> 2) * 128 + 32 * 384>(ka[(d0) & 3]); \
        if ((d0) >= 8) qf[(d0) & 1] = lds_rd128<((d0) >= 8 ? (d0) - 8 : 0) * 1024>(qa); } while (0)
#define QN(d0) ((d0) >= 12 ? 0 : (d0) >= 8 ? 3 : 2)
#define QS(d0) do { if ((d0) + 1 < 12) QL((d0) + 1); \
        asm volatile("s_waitcnt lgkmcnt(%0)" :: "i"(QN((d0) + 1)) : "memory"); ASBAR(); \
        { const bf16x8 q = (d0) < 8 ? qr[(d0) < 8 ? (d0) : 0] : qf[(d0) & 1]; \
          p0 = __builtin_amdgcn_mfma_f32_32x32x16_bf16(b0[(d0) & 1], q, p0, 0, 0, 0); p1 = __builtin_amdgcn_mfma_f32_32x32x16_bf16(b1[(d0) & 1], q, p1, 0, 0, 0); } ASBAR(); } while (0)
    QL(0);
    QS(0); QS(1); QS(2); QS(3); QS(4); QS(5); QS(6); QS(7); QS(8); QS(9); QS(10); QS(11);
#undef QS
#undef QN
#undef QL
}
template <int ABL = 0, int ORDER = 0> __device__ __forceinline__ void mla_unit2(const u16* __restrict__ Qb, const u16* __restrict__ KNh, const u16* __restrict__ KRb, const u16* __restrict__ Vh, u16* __restrict__ Ob, int nkeys, ALDS char* lds, int tid) {
    constexpr int SHV = 16384, SHK = 24576;
    constexpr float SCALE = 0.07216878364870322f, C = SCALE * 1.4426950408889634f, THRR = 8.f / SCALE;
    const int wid = __builtin_amdgcn_readfirstlane(tid >> 6), lane = tid & 63, r32 = lane & 31, hi = lane >> 5;
    ALDS char* V_lds = lds; ALDS char* K_lds = lds + 2 * SHV;
    ALDS float* wsc = (ALDS float*)(lds + 2 * SHV + 2 * SHK) + wid * 64; ALDS float* li_l = wsc; ALDS float* al_l = wsc + 32;
    ALDS char* qrl = lds + 2 * SHV + 2 * SHK + 2048 + wid * 4096 + lane * 16;
    float m_reg = -1e30f, l_reg = 0.f; f32x16 o[4] = {}; bf16x8 qr[8];
    const u16* Qw = Qb + (unsigned)((wid * 32 + r32) * 3072 + hi * 8);
#pragma unroll
    for (int d0 = 0; d0 < 8; ++d0) qr[d0] = *reinterpret_cast<const bf16x8*>(Qw + d0 * 16);
#pragma unroll
    for (int d0 = 8; d0 < 12; ++d0) *reinterpret_cast<ALDS bf16x8*>(qrl + (d0 - 8) * 1024) = *reinterpret_cast<const bf16x8*>(Qw + d0 * 16);
    const int vb0 = (int)(unsigned)(uintptr_t)V_lds + v_rd_base(lane);
    int ka[4]; { const int kbase = (int)(unsigned)(uintptr_t)K_lds;
#pragma unroll
      for (int r = 0; r < 4; ++r) ka[r] = kbase + kswz<384>(r32, (r * 16 + hi * 8) * 2); }
    const int qa = (int)(unsigned)(uintptr_t)qrl;
    bf16x8 vs0, vs1, ks0, ks1, kr0;
    const unsigned goff = (unsigned)((tid >> 4) * 2048 + (tid & 15) * 8), kroff = (unsigned)((tid >> 3) * 64 + (tid & 7) * 8);
    const int vst0 = v_st<128>(tid >> 4, (tid & 15) * 8), kst0 = kswz<384>(tid >> 4, (tid & 15) * 16), kst2 = kswz<384>(tid >> 3, (128 + (tid & 7) * 8) * 2);
    constexpr int vst1o = 8192, kst1o = 32 * 384;
#define MLA_SLOAD(k0) do { \
    const u16* vp = Vh + (size_t)(k0) * 2048; const u16* kp = KNh + (size_t)(k0) * 2048; \
    if (!(ABL & 1)) { vs0 = *reinterpret_cast<const bf16x8*>(vp + goff); vs1 = *reinterpret_cast<const bf16x8*>(vp + 32 * 2048 + goff); \
    ks0 = *reinterpret_cast<const bf16x8*>(kp + goff); ks1 = *reinterpret_cast<const bf16x8*>(kp + 32 * 2048 + goff); \
    kr0 = *reinterpret_cast<const bf16x8*>(KRb + (size_t)(k0) * 64 + kroff); } } while (0)
#define MLA_SWRITE(b) do { \
    if (!(ABL & 1)) { *reinterpret_cast<ALDS bf16x8*>(V_lds + (b) * SHV + vst0) = vs0; *reinterpret_cast<ALDS bf16x8*>(V_lds + (b) * SHV + vst0 + vst1o) = vs1; \
    *reinterpret_cast<ALDS bf16x8*>(K_lds + (b) * SHK + kst0) = ks0; *reinterpret_cast<ALDS bf16x8*>(K_lds + (b) * SHK + kst0 + kst1o) = ks1; *reinterpret_cast<ALDS bf16x8*>(K_lds + (b) * SHK + kst2) = kr0; } } while (0)
#define MLA_RESC(a) do { if (__any((a) < 1.f)) { if (hi == 0) al_l[r32] = (a); asm volatile("s_waitcnt lgkmcnt(0)" ::: "memory"); \
    _Pragma("unroll") for (int d = 0; d < 4; ++d) _Pragma("unroll") for (int r = 0; r < 16; ++r) o[d][r] *= al_l[crow(r, hi)]; } } while (0)
#define MLA_PV(vb) do { pv_one<0, 128>(o[0], (vb), pa0, pa1, pa2, pa3); pv_one<1, 128>(o[1], (vb), pa0, pa1, pa2, pa3); pv_one<2, 128>(o[2], (vb), pa0, pa1, pa2, pa3); pv_one<3, 128>(o[3], (vb), pa0, pa1, pa2, pa3); } while (0)
#define ABL_PSM(P0, P1, MN, AL) do { if (ABL & 2) { MN = m_reg; AL = 1.f; } else partialSM(P0, P1, m_reg, MN, AL, C, THRR); } while (0)
#define ABL_FSM(P0, P1, AL) do { if (ABL & 2) { u32x4 w_ = {__float_as_uint(P0[0]), __float_as_uint(P0[1]), __float_as_uint(P1[0]), __float_as_uint(P1[1])}; pa0 = *reinterpret_cast<bf16x8*>(&w_); pa1 = pa0; pa2 = pa0; pa3 = pa0; l_reg += 1.f; } else finishSM(P0, P1, AL, l_reg, pa0, pa1, pa2, pa3); } while (0)
    f32x16 pA0, pA1, pB0, pB1; float mnA, mnB, alA, alB; bf16x8 pa0, pa1, pa2, pa3; const int NT = nkeys / 64;
    MLA_SLOAD(0); asm volatile("s_waitcnt vmcnt(0)" ::: "memory"); MLA_SWRITE(0); __syncthreads();
    qkt_mla_p<0>(pA0, pA1, ka, qa, qr); ABL_PSM(pA0, pA1, mnA, alA);
    MLA_SLOAD(64); asm volatile("s_waitcnt vmcnt(0)" ::: "memory"); MLA_SWRITE(1); __syncthreads();
    constexpr bool lead = ORDER == 0;
#define MLA_STEP(Q0, Q1, KB, P0, P1, ALP, VB, MNQ, ALQ) do { \
        if (lead) { ASBAR(); qkt_mla_p<KB>(Q0, Q1, ka, qa, qr); ABL_FSM(P0, P1, ALP); ASBAR(); MLA_PV(VB); ABL_PSM(Q0, Q1, MNQ, ALQ); } \
        else { ASBAR(); ABL_FSM(P0, P1, ALP); ASBAR(); qkt_mla_p<KB>(Q0, Q1, ka, qa, qr); ASBAR(); ABL_PSM(Q0, Q1, MNQ, ALQ); ASBAR(); MLA_PV(VB); } } while (0)
    for (int j = 1; j + 1 < NT; j += 2) {
        MLA_SLOAD((j + 1) * 64);
        MLA_STEP(pB0, pB1, SHK, pA0, pA1, alA, vb0, mnB, alB);
        __syncthreads(); asm volatile("s_waitcnt vmcnt(0)" ::: "memory"); MLA_SWRITE(0);
        MLA_RESC(alB); __syncthreads();
        MLA_SLOAD((j + 2) * 64);
        MLA_STEP(pA0, pA1, 0, pB0, pB1, alB, vb0 + SHV, mnA, alA);
        __syncthreads(); asm volatile("s_waitcnt vmcnt(0)" ::: "memory"); MLA_SWRITE(1);
        MLA_RESC(alA); __syncthreads();
    }
#undef MLA_STEP
    ASBAR(); qkt_mla_p<SHK>(pB0, pB1, ka, qa, qr);
    ABL_FSM(pA0, pA1, alA); ASBAR();
    MLA_PV(vb0); ABL_PSM(pB0, pB1, mnB, alB);
    __syncthreads(); MLA_RESC(alB);
    ABL_FSM(pB0, pB1, alB); ASBAR();
    MLA_PV(vb0 + SHV);
#undef MLA_SLOAD
#undef MLA_SWRITE
#undef MLA_RESC
#undef MLA_PV
#undef ABL_PSM
#undef ABL_FSM
    __syncthreads();
    if (hi == 0) li_l[r32] = l_reg;
    { const int lane = (int)__builtin_amdgcn_mbcnt_hi(~0u, __builtin_amdgcn_mbcnt_lo(~0u, 0u)), r32 = lane & 31, hi = lane >> 5;
    asm volatile("s_waitcnt lgkmcnt(0)" ::: "memory");
    ALDS char* ost = lds + wid * 8704;
#pragma unroll
    for (int r = 0; r < 16; ++r) { const int orow = crow(r, hi); const float rl = __builtin_amdgcn_rcpf(li_l[orow]);
#pragma unroll
        for (int d0 = 0; d0 < 4; ++d0) *reinterpret_cast<ALDS u16*>(ost + orow * 272 + (d0 * 32 + r32) * 2) = f2bf(o[d0][r] * rl); }
    asm volatile("s_waitcnt lgkmcnt(0)" ::: "memory");
#pragma unroll
    for (int i = 0; i < 8; ++i) { const int row = i * 4 + (lane >> 4), ch = lane & 15; const u32x4 v = *reinterpret_cast<const ALDS u32x4*>(ost + row * 272 + ch * 16);
        *reinterpret_cast<u32x4*>(Ob + (unsigned)((wid * 32 + row) * 2048 + ch * 8)) = v; } }
    __syncthreads();
}

constexpr int WIN_LDS_BYTES = 4 * 8192 + 2048 + 8 * 4608;
__device__ __forceinline__ void win_unit(const u16* __restrict__ QKV, u16* __restrict__ O, const float* __restrict__ sink, int kb, int qrow0, int p0, int kvh, ALDS char* lds, int tid) {
    constexpr int SHK = 8192, SHV = 8192;
    constexpr float SCALE = 0.125f, C = SCALE * 1.4426950408889634f, THRR = 8.f / SCALE;
    const int wid = tid >> 6, lane = tid & 63, r32 = lane & 31, hi = lane >> 5, qh = kvh * 8 + wid;
    ALDS char* K_lds = lds; ALDS char* V_lds = lds + 2 * SHK;
    ALDS float* wsc = (ALDS float*)(lds + 2 * SHK + 2 * SHV) + wid * 64; ALDS float* li_l = wsc; ALDS float* al_l = wsc + 32;
    float m_reg = sink[qh] * (1.0f / SCALE), l_reg = 1.f; f32x16 o[2] = {}; bf16x8 qr[4];
    const u16* Qw = QKV + (size_t)(qrow0 + r32) * 2560 + qh * 64 + hi * 8;
#pragma unroll
    for (int d0 = 0; d0 < 4; ++d0) qr[d0] = *reinterpret_cast<const bf16x8*>(Qw + d0 * 16);
    const int srow = tid >> 3, scol = (tid & 7) * 8;
    const int vst = v_st<64>(srow, scol), kst = kswz<128>(srow, scol * 2);
    const int vb0 = (int)(unsigned)(uintptr_t)V_lds + v_rd_base(lane);
    const unsigned goff = (unsigned)(srow * 2560 + scol);
    int wlo = 0, NT = 4;
    if (p0 >= 0) { const int lo = p0 - 128 < 0 ? 0 : p0 - 128, hiP = p0 + 159 > S - 1 ? S - 1 : p0 + 159; wlo = lo >> 6; NT = 4 + (hiP >> 6) - wlo + 1; }
    bf16x8 ks, vs;
#define WIN_TROW(j) ((j) < 4 ? kb + 64 * (j) : kb + CTX + 64 * (wlo + (j) - 4))
#define WIN_SLOAD(j) do { const u16* rp = QKV + (size_t)WIN_TROW(j) * 2560; ks = *reinterpret_cast<const bf16x8*>(rp + 2048 + kvh * 64 + goff); vs = *reinterpret_cast<const bf16x8*>(rp + 2304 + kvh * 64 + goff); } while (0)
#define WIN_SWRITE(b) do { *reinterpret_cast<ALDS bf16x8*>(K_lds + (b) * SHK + kst) = ks; *reinterpret_cast<ALDS bf16x8*>(V_lds + (b) * SHV + vst) = vs; } while (0)
    WIN_SLOAD(0); WIN_SWRITE(0); __syncthreads();
    for (int j = 0; j < NT; ++j) {
        const int b = j & 1;
        if (j + 1 < NT) WIN_SLOAD(j + 1);
        f32x16 p0v, p1v; float mn, alpha; bf16x8 pa0, pa1, pa2, pa3;
        qkt<64, 128>(p0v, p1v, K_lds + b * SHK, qr, r32, hi);
        if (j >= 4) { const int dq0 = (p0 + r32) - 64 * (wlo + j - 4);
#pragma unroll
            for (int r = 0; r < 16; ++r) { const int dq = dq0 - crow(r, hi); if (dq > 128 || dq < -128) p0v[r] = -1e30f; if (dq - 32 > 128 || dq - 32 < -128) p1v[r] = -1e30f; } }
        partialSM(p0v, p1v, m_reg, mn, alpha, C, THRR);
        if (__any(alpha < 1.f)) { if (hi == 0) al_l[r32] = alpha; asm volatile("s_waitcnt lgkmcnt(0)" ::: "memory");
#pragma unroll
            for (int d = 0; d < 2; ++d)
#pragma unroll
                for (int r = 0; r < 16; ++r) o[d][r] *= al_l[crow(r, hi)]; }
        finishSM(p0v, p1v, alpha, l_reg, pa0, pa1, pa2, pa3); ASBAR();
        const int vb = vb0 + b * SHV;
        pv_one<0, 64>(o[0], vb, pa0, pa1, pa2, pa3); pv_one<1, 64>(o[1], vb, pa0, pa1, pa2, pa3);
        if (j + 1 < NT) WIN_SWRITE(b ^ 1);
        __syncthreads();
    }
#undef WIN_TROW
#undef WIN_SLOAD
#undef WIN_SWRITE
    if (hi == 0) li_l[r32] = l_reg;
    asm volatile("s_waitcnt lgkmcnt(0)" ::: "memory");
    ALDS char* ost = lds + 2 * SHK + 2 * SHV + 2048 + wid * 4608;
#pragma unroll
    for (int r = 0; r < 16; ++r) { const int orow = crow(r, hi); const float rl = __builtin_amdgcn_rcpf(li_l[orow]);
#pragma unroll
        for (int d0 = 0; d0 < 2; ++d0) *reinterpret_cast<ALDS u16*>(ost + orow * 144 + (d0 * 32 + r32) * 2) = f2bf(o[d0][r] * rl); }
    asm volatile("s_waitcnt lgkmcnt(0)" ::: "memory");
#pragma unroll
    for (int i = 0; i < 4; ++i) { const int row = i * 8 + (lane >> 3), ch = lane & 7; const u32x4 v = *reinterpret_cast<const ALDS u32x4*>(ost + row * 144 + ch * 16);
        *reinterpret_cast<u32x4*>(O + (size_t)(qrow0 + row) * 2048 + qh * 64 + ch * 8) = v; }
    __syncthreads();
}
}
#ifndef MLA_UNIT
#define MLA_UNIT mla_unit2<0, 0>
#endif
template <int ABL = 0> PH void ph_attn_mla(const u16* __restrict__ Q, const u16* __restrict__ KN, const u16* __restrict__ KR, const u16* __restrict__ V, u16* __restrict__ O, unsigned char* lds, int wg, int nwg, bool need_ctx) {
    const int TID = otid();
    const int vcu = (nwg % 8 == 0) ? (wg % 8) * (nwg / 8) + wg / 8 : wg;
    for (int u = vcu; u < (need_ctx ? NB * 16 * 17 : NB * 16 * 16); u += nwg) {
        int bh, qb; if (u < NB * 16 * 16) { bh = u >> 4; qb = 1 + (u & 15); } else { bh = u - NB * 16 * 16; qb = 0; }
        const int b = bh >> 4, h = bh & 15; const size_t kb = (size_t)b * SB, q0 = kb + (size_t)qb * 256;
        int tu = TID; asm volatile("" : "+v"(tu));
#ifndef MLA_NOSWAP
        if (__builtin_amdgcn_readfirstlane(tu >> 6) < 4) att::mla_unit2<ABL, 0>(Q + q0 * 3072 + h * 192, KN + kb * D + h * 128, KR + kb * 64, V + kb * D + h * 128, O + q0 * D + h * 128, qb == 0 ? CTX : SB, (ALDS char*)lds, tu);
        else att::mla_unit2<ABL, 1>(Q + q0 * 3072 + h * 192, KN + kb * D + h * 128, KR + kb * 64, V + kb * D + h * 128, O + q0 * D + h * 128, qb == 0 ? CTX : SB, (ALDS char*)lds, tu);
#else
        att::mla_unit2<ABL, 0>(Q + q0 * 3072 + h * 192, KN + kb * D + h * 128, KR + kb * 64, V + kb * D + h * 128, O + q0 * D + h * 128, qb == 0 ? CTX : SB, (ALDS char*)lds, tu);
#endif
    }
}

PH void ph_attn_win(const u16* __restrict__ QKV, const float* __restrict__ sink, u16* __restrict__ O, unsigned char* lds, int wg, int nwg) {
    const int TID = otid();
    for (int u = wg; u < NB * 4 * 136; u += nwg) {
        const int pb = u % 136, bk = u / 136, b = bk >> 2, kvh = bk & 3, kb = b * SB;
        const int p0 = pb < 128 ? pb * 32 : -1, qrow0 = pb < 128 ? kb + CTX + pb * 32 : kb + (pb - 128) * 32;
        int tu = TID; asm volatile("" : "+v"(tu));
        att::win_unit(QKV, O, sink, kb, qrow0, p0, kvh, (ALDS char*)lds, tu);
    }
}

#ifndef FFT_HD
#define FFT_HD __device__ __forceinline__
#define FFT_OPQ(t) asm volatile("" : "+v"(t))
#else
#define FFT_OPQ(t)
#endif
typedef float cf __attribute__((ext_vector_type(2)));
FFT_HD cf cswap(cf a) { return __builtin_shufflevector(a, a, 1, 0); }
FFT_HD cf cmul(cf a, cf b) { return a * b.xx + cswap(a) * (cf){-b.y, b.y}; }
FFT_HD cf cmulc(cf a, cf b) { return a * b.xx + cswap(a) * (cf){b.y, -b.y}; }
FFT_HD cf cadd(cf a, cf b) { return a + b; }
FFT_HD cf csub(cf a, cf b) { return a - b; }
FFT_HD int fidx(int a) { return a + (a >> 5) + (a >> 9); }
constexpr int FFT_N = 8192, FFT_BUF = FFT_N + FFT_N / 32 + FFT_N / 512;
FFT_HD int fpos(int k) { return ((k & 15) << 9) | (((k >> 4) & 15) << 5) | (((k >> 8) & 15) << 1) | ((k >> 12) & 1); }
template <bool INV, bool ZHI = false> FFT_HD void dft16(cf (&v)[16]) {
    constexpr float C1 = 0.9238795325112867f, S1 = 0.3826834323650898f, C2 = 0.7071067811865476f;
    const float wr[8] = {1.f, C1, C2, S1, 0.f, -S1, -C2, -C1};
    const float wi[8] = {0.f, S1, C2, C1, 1.f, C1, C2, S1};
#pragma unroll
    for (int s = 0; s < 4; ++s) {
        const int half = 8 >> s;
#pragma unroll
        for (int i = 0; i < 16; ++i) {
            if ((i & half) == 0) {
                const int j = i + half, tw = (i & (half - 1)) << s;
                const cf a = v[i], b = v[j];
                const bool z = ZHI && s == 0;
                if (!z) v[i] = cadd(a, b);
                const cf d = z ? a : csub(a, b);
                if (tw == 0) v[j] = d;
                else if (tw == 4) v[j] = INV ? (cf){-d.y, d.x} : (cf){d.y, -d.x};
                else { const float c = wr[tw], sn = INV ? -wi[tw] : wi[tw]; v[j] = d * (cf){c, c} + cswap(d) * (cf){sn, -sn}; }
            }
        }
    }
#pragma unroll
    for (int i = 0; i < 16; ++i) { const int r = ((i & 1) << 3) | ((i & 2) << 1) | ((i & 4) >> 1) | ((i & 8) >> 3); if (r > i) { const cf t = v[i]; v[i] = v[r]; v[r] = t; } }
}
template <int M, bool INV, class BufT, class TwT> FFT_HD void fft_pass16(BufT buf, TwT tw, int tid) {
    FFT_OPQ(tid);
    const int blk = tid / M, n2 = tid % M, base = blk * 16 * M + n2;
    constexpr int ST = M + (M >> 5) + (M >> 9); const int a0 = fidx(base);
    cf v[16];
#pragma unroll
    for (int j = 0; j < 16; ++j) v[j] = buf.get(a0 + j * ST);
    cf w[16];
    if (M > 1) { const cf w1 = tw.get(n2 * (FFT_N / (16 * M))); w[1] = w1; w[2] = cmul(w1, w1); w[3] = cmul(w[2], w1); w[4] = cmul(w[2], w[2]); w[5] = cmul(w[4], w1); w[6] = cmul(w[3], w[3]); w[7] = cmul(w[6], w1);
        w[8] = cmul(w[4], w[4]); w[9] = cmul(w[8], w1); w[10] = cmul(w[5], w[5]); w[11] = cmul(w[10], w1); w[12] = cmul(w[6], w[6]); w[13] = cmul(w[12], w1); w[14] = cmul(w[7], w[7]); w[15] = cmul(w[14], w1); }
    if (INV) { if (M > 1) {
#pragma unroll
        for (int k = 1; k < 16; ++k) v[k] = cmulc(v[k], w[k]); } }
    dft16<INV>(v);
    if (!INV) { if (M > 1) {
#pragma unroll
        for (int k = 1; k < 16; ++k) v[k] = cmul(v[k], w[k]); } }
#pragma unroll
    for (int j = 0; j < 16; ++j) buf.set(a0 + j * ST, v[j]);
}
template <class BufT> FFT_HD void fft_pass2(BufT buf, int tid) {
    FFT_OPQ(tid);
    const int a0 = fidx(2 * tid);
#pragma unroll
    for (int i = 0; i < 8; ++i) { const int e = a0 + 1058 * i; const cf a = buf.get(e), b = buf.get(e + 1); buf.set(e, cadd(a, b)); buf.set(e + 1, csub(a, b)); }
}
#ifndef FFT_HOST_TEST
#define FFT_SYNC() __syncthreads()
template <class BufT, class TwT> FFT_HD void fft_fwd(BufT buf, TwT tw, int tid) {
    fft_pass16<512, false>(buf, tw, tid); FFT_SYNC(); fft_pass16<32, false>(buf, tw, tid); FFT_SYNC(); fft_pass16<2, false>(buf, tw, tid); FFT_SYNC(); fft_pass2(buf, tid); FFT_SYNC();
}
template <class BufT, class TwT> FFT_HD void fft_inv(BufT buf, TwT tw, int tid) {
    fft_pass2(buf, tid); FFT_SYNC(); fft_pass16<2, true>(buf, tw, tid); FFT_SYNC(); fft_pass16<32, true>(buf, tw, tid); FFT_SYNC(); fft_pass16<512, true>(buf, tw, tid); FFT_SYNC();
}
#endif
FFT_HD void spec_pair(cf a, cf b, cf fd, cf fe, cf& ya, cf& yb) {
    const cf zd = cf{a.x + b.x, a.y - b.y};
    const cf ze = cf{a.y + b.y, b.x - a.x};
    const cf P = cmul(zd, fd), Q = cmul(ze, fe);
    ya = cf{P.x - Q.y, P.y + Q.x};
    yb = cf{P.x + Q.y, Q.x - P.y};
}

#ifndef FFT_HOST_TEST
typedef float f32x2v __attribute__((ext_vector_type(2)));
struct LdsCf { LAS f32x2v* p; __device__ __forceinline__ cf get(int i) const { return p[i]; } __device__ __forceinline__ void set(int i, cf v) const { p[i] = v; } };
constexpr int FS_LD = 4104;
PH void ph_filter_fft(KP p, unsigned char* ldsraw, int wg, int nwg) {
    const int TID = otid();
    const LdsCf buf{(LAS f32x2v*)ldsraw}, tw{(LAS f32x2v*)ldsraw + FFT_BUF};
    const cf* twg = (const cf*)(p->ws + WS_TW);
    for (int i = TID; i < FFT_N; i += 512) tw.set(i, twg[i]);
    __syncthreads();
    const float* FT = (const float*)(p->ws + WS_FT4096); cf* FS = (cf*)(p->ws + WS_FS);
    for (int u = wg; u < 2048; u += nwg) {
        const int n = u & 1, d = (u >> 1) * 2;
        const float* ff0 = FT + (size_t)(n * 4096 + d) * 4096; const float* ff1 = ff0 + 4096; const float* fb0 = FT + (size_t)(n * 4096 + 2048 + d) * 4096; const float* fb1 = fb0 + 4096;
#pragma unroll
        for (int i = 0; i < 16; ++i) { const int k = TID + 512 * i; cf v;
            if (k < 4096) v = cf{ff0[k], ff1[k]}; else if (k == 4096) v = cf{0.f, 0.f}; else v = cf{fb0[8192 - k], fb1[8192 - k]};
            buf.set(fidx(k), v); }
        __syncthreads();
        fft_fwd(buf, tw, TID);
        const float s = 1.0f / (4.0f * FFT_N);
        cf* fd = FS + (size_t)(n * 2048 + d) * FS_LD; cf* fe = fd + FS_LD;
        int tq = TID; FFT_OPQ(tq);
#pragma unroll
        for (int i = 0; i < 9; ++i) { const int w = tq + 512 * i; if (w <= 4096) { const cf a = buf.get(fidx(fpos(w))), b = buf.get(fidx(fpos((FFT_N - w) & (FFT_N - 1))));
            fd[w] = cf{(a.x + b.x) * s, (a.y - b.y) * s}; fe[w] = cf{(a.y + b.y) * s, (b.x - a.x) * s}; } }
        __syncthreads();
    }
}
#endif

#ifndef FFT_HOST_TEST
constexpr int FS2_LD = 264;
FFT_HD int fpos512(int k) { return ((k & 15) << 5) | (((k >> 4) & 15) << 1) | ((k >> 8) & 1); }
template <class BufT, class TwT> FFT_HD void fft512_fwd(BufT buf, TwT tw, int tid) { fft_pass16<32, false>(buf, tw, tid); FFT_SYNC(); fft_pass16<2, false>(buf, tw, tid); FFT_SYNC(); fft_pass2(buf, tid); FFT_SYNC(); }
template <class BufT, class TwT> FFT_HD void fft512_inv(BufT buf, TwT tw, int tid) { fft_pass2(buf, tid); FFT_SYNC(); fft_pass16<2, true>(buf, tw, tid); FFT_SYNC(); fft_pass16<32, true>(buf, tw, tid); FFT_SYNC(); }
PH void ph_filter_fft256(KP p, unsigned char* ldsraw, int wg, int nwg) {
    const int TID = otid();
    const LdsCf buf{(LAS f32x2v*)ldsraw}, tw{(LAS f32x2v*)ldsraw + FFT_BUF};
    const cf* twg = (const cf*)(p->ws + WS_TW);
    for (int i = TID; i < FFT_N; i += 512) tw.set(i, twg[i]);
    __syncthreads();
    const float* FT = (const float*)(p->ws + WS_FT256); cf* FS = (cf*)(p->ws + WS_FS256);
    for (int u = wg; u < 128; u += nwg) {
        int tq = TID; FFT_OPQ(tq);
#pragma unroll 1
        for (int i = 0; i < 16; ++i) { const int combo = u * 16 + i, n = combo & 1, d = (combo >> 1) * 2, k = tq; cf v;
            const float* ff0 = FT + (size_t)(n * 4096 + d) * 256; const float* fb0 = FT + (size_t)(n * 4096 + 2048 + d) * 256;
            if (k < 256) v = cf{ff0[k], ff0[256 + k]}; else if (k == 256) v = cf{0.f, 0.f}; else v = cf{fb0[512 - k], fb0[256 + 512 - k]};
            buf.set(fidx(i * 512 + k), v); }
        __syncthreads();
        fft512_fwd(buf, tw, TID);
        const float s = 1.0f / (4.0f * 512.0f);
        int tw2 = TID; FFT_OPQ(tw2);
        if (tw2 <= 256) {
#pragma unroll 1
            for (int i = 0; i < 16; ++i) { const int combo = u * 16 + i, n = combo & 1, d = (combo >> 1) * 2, w = tw2;
                const cf a = buf.get(fidx(i * 512 + fpos512(w))), b = buf.get(fidx(i * 512 + fpos512((512 - w) & 511)));
                cf* fd = FS + (size_t)(n * 2048 + d) * FS2_LD; cf* fe = fd + FS2_LD;
                fd[w] = cf{(a.x + b.x) * s, (a.y - b.y) * s}; fe[w] = cf{(a.y + b.y) * s, (b.x - a.x) * s}; } }
        __syncthreads();
    }
}
PH void ph_hyena_fft256(KP p, unsigned char* ldsraw, int wg, int nwg) {
    const int TID = otid();
    const LdsCf buf{(LAS f32x2v*)ldsraw}, tw{(LAS f32x2v*)ldsraw + FFT_BUF};
    const cf* twg = (const cf*)(p->ws + WS_TW);
    for (int i = TID; i < FFT_N; i += 512) tw.set(i, twg[i]);
    __syncthreads();
    const _Float16* UT = (const _Float16*)(p->ws + WS_UT); u16* ZT = (u16*)(p->ws + WS_ZT); const cf* FS = (const cf*)(p->ws + WS_FS256);
    const float* cw = p->in[I_HCW]; const float* cb = p->in[I_HCB]; const float* skip = p->in[I_SKIP];
    for (int u = wg; u < 256; u += nwg) {
        int tz = TID; FFT_OPQ(tz);
        auto sconv = [&](int ch, int rb, int t) { const _Float16* uu = UT + (size_t)ch * R + rb; const float um = t > 0 ? (float)uu[t - 1] : 0.f, u0 = (float)uu[t], up = t < CTX - 1 ? (float)uu[t + 1] : 0.f;
            return um * cw[ch] + u0 * cw[3 * D + ch] + up * cw[6 * D + ch] + cb[ch]; };
        float z[16][2];
#pragma unroll
        for (int i = 0; i < 16; ++i) { const int seq = u * 16 + i, d = (seq >> 2) * 2, rb = (seq & 3) * SB; if (tz < 256) { z[i][0] = sconv(d, rb, tz); z[i][1] = sconv(d + 1, rb, tz); } else { z[i][0] = 0.f; z[i][1] = 0.f; } }
#pragma unroll 1
        for (int n = 0; n < 2; ++n) {
            int ts = TID; FFT_OPQ(ts);
#pragma unroll
            for (int i = 0; i < 16; ++i) buf.set(fidx(i * 512 + ts), cf{z[i][0], z[i][1]});
            __syncthreads();
            fft512_fwd(buf, tw, TID);
            int tq = TID; FFT_OPQ(tq);
            if (tq <= 256) {
#pragma unroll 1
                for (int i = 0; i < 16; ++i) { const int seq = u * 16 + i, d = (seq >> 2) * 2, w = tq; const cf* fd = FS + (size_t)(n * 2048 + d) * FS2_LD; const cf* fe = fd + FS2_LD;
                    const int pw = fidx(i * 512 + fpos512(w)), pn = fidx(i * 512 + fpos512((512 - w) & 511));
                    const cf a = buf.get(pw), bb = buf.get(pn); cf ya, yb; spec_pair(a, bb, fd[w], fe[w], ya, yb); buf.set(pw, ya); if (pn != pw) buf.set(pn, yb); } }
            __syncthreads();
            fft512_inv(buf, tw, TID);
            int tg = TID; FFT_OPQ(tg);
            if (tg < 256) {
#pragma unroll
                for (int i = 0; i < 16; ++i) { const int seq = u * 16 + i, d = (seq >> 2) * 2, rb = (seq & 3) * SB; const cf y = buf.get(fidx(i * 512 + tg));
                    z[i][0] = sconv((n + 1) * D + d, rb, tg) * (y.x + z[i][0] * skip[n * D + d]); z[i][1] = sconv((n + 1) * D + d + 1, rb, tg) * (y.y + z[i][1] * skip[n * D + d + 1]); } }
            __syncthreads();
        }
        int to = TID; FFT_OPQ(to);
        if (to < 256) {
#pragma unroll
            for (int i = 0; i < 16; ++i) { const int seq = u * 16 + i, d = (seq >> 2) * 2, rb = (seq & 3) * SB; ZT[(size_t)d * R + rb + to] = f2bf(z[i][0]); ZT[(size_t)(d + 1) * R + rb + to] = f2bf(z[i][1]); } }
    }
}
#endif

#ifndef FFT_HOST_TEST
template <int M, bool INV, bool HALF_ = false> FFT_HD void fft_pass16x2(const LdsCf bufA, const LdsCf bufB, const LdsCf tw, int tid) {
    FFT_OPQ(tid);
    const int blk = tid / M, n2 = tid % M, base = blk * 16 * M + n2;
    constexpr int ST = M + (M >> 5) + (M >> 9); const int a0 = fidx(base);
    cf va[16], vb[16];
#pragma unroll
    for (int j = 0; j < 16; ++j) { if (HALF_ && !INV && j >= 8) { va[j] = cf{0.f, 0.f}; vb[j] = cf{0.f, 0.f}; } else { va[j] = bufA.get(a0 + j * ST); vb[j] = bufB.get(a0 + j * ST); } }
    cf w[16];
    if (M > 1) { const cf w1 = tw.get(n2 * (FFT_N / (16 * M))); w[1] = w1; w[2] = cmul(w1, w1); w[3] = cmul(w[2], w1); w[4] = cmul(w[2], w[2]); w[5] = cmul(w[4], w1); w[6] = cmul(w[3], w[3]); w[7] = cmul(w[6], w1);
        w[8] = cmul(w[4], w[4]); w[9] = cmul(w[8], w1); w[10] = cmul(w[5], w[5]); w[11] = cmul(w[10], w1); w[12] = cmul(w[6], w[6]); w[13] = cmul(w[12], w1); w[14] = cmul(w[7], w[7]); w[15] = cmul(w[14], w1); }
    if (INV) { if (M > 1) {
#pragma unroll
        for (int k = 1; k < 16; ++k) { va[k] = cmulc(va[k], w[k]); vb[k] = cmulc(vb[k], w[k]); } } }
    dft16<INV, HALF_ && !INV>(va); dft16<INV, HALF_ && !INV>(vb);
    if (!INV) { if (M > 1) {
#pragma unroll
        for (int k = 1; k < 16; ++k) { va[k] = cmul(va[k], w[k]); vb[k] = cmul(vb[k], w[k]); } } }
#pragma unroll
    for (int j = 0; j < 16; ++j) { if (HALF_ && INV && j >= 8) continue; bufA.set(a0 + j * ST, va[j]); bufB.set(a0 + j * ST, vb[j]); }
}
FFT_HD void fft_pass2x2(const LdsCf bufA, const LdsCf bufB, int tid) {
    FFT_OPQ(tid);
    const int a0 = fidx(2 * tid);
#pragma unroll
    for (int i = 0; i < 8; ++i) { const int e = a0 + 1058 * i; const cf a = bufA.get(e), b = bufA.get(e + 1), c = bufB.get(e), d = bufB.get(e + 1);
        bufA.set(e, cadd(a, b)); bufA.set(e + 1, csub(a, b)); bufB.set(e, cadd(c, d)); bufB.set(e + 1, csub(c, d)); }
}
FFT_HD void fft_fwd_x2(const LdsCf a, const LdsCf b, const LdsCf tw, int tid) {
    fft_pass16x2<512, false>(a, b, tw, tid); FFT_SYNC(); fft_pass16x2<32, false>(a, b, tw, tid); FFT_SYNC(); fft_pass16x2<2, false>(a, b, tw, tid); FFT_SYNC(); fft_pass2x2(a, b, tid); FFT_SYNC();
}
FFT_HD void fft_fwd_x2_zp(const LdsCf a, const LdsCf b, const LdsCf tw, int tid) {
    fft_pass16x2<512, false, true>(a, b, tw, tid); FFT_SYNC(); fft_pass16x2<32, false>(a, b, tw, tid); FFT_SYNC(); fft_pass16x2<2, false>(a, b, tw, tid); FFT_SYNC(); fft_pass2x2(a, b, tid); FFT_SYNC();
}
FFT_HD void fft_inv_x2_zp(const LdsCf a, const LdsCf b, const LdsCf tw, int tid) {
    fft_pass2x2(a, b, tid); FFT_SYNC(); fft_pass16x2<2, true>(a, b, tw, tid); FFT_SYNC(); fft_pass16x2<32, true>(a, b, tw, tid); FFT_SYNC(); fft_pass16x2<512, true, true>(a, b, tw, tid); FFT_SYNC();
}
FFT_HD void fft_inv_x2(const LdsCf a, const LdsCf b, const LdsCf tw, int tid) {
    fft_pass2x2(a, b, tid); FFT_SYNC(); fft_pass16x2<2, true>(a, b, tw, tid); FFT_SYNC(); fft_pass16x2<32, true>(a, b, tw, tid); FFT_SYNC(); fft_pass16x2<512, true>(a, b, tw, tid); FFT_SYNC();
}
PH void ph_hyena_fft2(KP p, unsigned char* ldsraw, int wg, int nwg, bool skipfft = false) {
    const int TID = otid();
    const LdsCf bufA{(LAS f32x2v*)ldsraw}, bufB{(LAS f32x2v*)ldsraw + FFT_BUF}, tw{(LAS f32x2v*)ldsraw + 2 * FFT_BUF};
    const cf* twg = (const cf*)(p->ws + WS_TW);
    tw.set(TID, twg[TID]);
    __syncthreads();
    const _Float16* UT = (const _Float16*)(p->ws + WS_UT); u16* ZT = (u16*)(p->ws + WS_ZT); const cf* FS = (const cf*)(p->ws + WS_FS);
    const float* cw = p->in[I_HCW]; const float* cb = p->in[I_HCB]; const float* skip = p->in[I_SKIP];
    const int per = (2048 + nwg - 1) / nwg; const int u1 = (wg + 1) * per < 2048 ? (wg + 1) * per : 2048;
    for (int u = wg * per; u < u1; ++u) {
        const int d = (u >> 1) * 2, b0 = (u & 1) * 2;
        auto sconv4 = [&](int ch, int rb, int t0, float (&o)[4]) { const _Float16* uu = UT + (size_t)ch * R + rb + t0; const uint2 cq = *(const uint2*)uu;
            const float4 c4 = make_float4(pg8::h2f_lo(cq.x), pg8::h2f_hi(cq.x), pg8::h2f_lo(cq.y), pg8::h2f_hi(cq.y));
            const float um = t0 > 0 ? (float)uu[-1] : 0.f, up = t0 + 4 < S ? (float)uu[4] : 0.f, w0 = cw[ch], w1 = cw[3 * D + ch], w2 = cw[6 * D + ch], bb = cb[ch];
            o[0] = um * w0 + c4.x * w1 + c4.y * w2 + bb; o[1] = c4.x * w0 + c4.y * w1 + c4.z * w2 + bb; o[2] = c4.y * w0 + c4.z * w1 + c4.w * w2 + bb; o[3] = c4.z * w0 + c4.w * w1 + up * w2 + bb; };
        const int rbA = b0 * SB + CTX, rbB = rbA + SB;
        float za[2][4][2], zb[2][4][2];
        { int tz = TID; FFT_OPQ(tz);
#pragma unroll
          for (int i = 0; i < 2; ++i) { const int t0 = 4 * tz + 2048 * i; float q0[4], q1[4], q2[4], q3[4]; sconv4(d, rbA, t0, q0); sconv4(d + 1, rbA, t0, q1); sconv4(d, rbB, t0, q2); sconv4(d + 1, rbB, t0, q3);
#pragma unroll
              for (int k = 0; k < 4; ++k) { za[i][k][0] = q0[k]; za[i][k][1] = q1[k]; zb[i][k][0] = q2[k]; zb[i][k][1] = q3[k]; } } }
#pragma unroll 1
        for (int n = 0; n < 2; ++n) {
            int ts = TID; FFT_OPQ(ts);
#pragma unroll
            for (int i = 0; i < 2; ++i)
#pragma unroll
                for (int k = 0; k < 4; ++k) { const int e = fidx(4 * ts) + 2116 * i + k; bufA.set(e, cf{za[i][k][0], za[i][k][1]}); bufB.set(e, cf{zb[i][k][0], zb[i][k][1]}); }
            __syncthreads();
            if (!skipfft) fft_fwd_x2_zp(bufA, bufB, tw, TID);
            const cf* fd = FS + (size_t)(n * 2048 + d) * FS_LD; const cf* fe = fd + FS_LD;
            int tq = TID; FFT_OPQ(tq);
            const int pw0 = fidx(fpos(tq)), pn1 = fidx(fpos((FFT_N - tq - 512) & (FFT_N - 1)));
#pragma unroll
            for (int i = 0; i < 8; ++i) { const int w = tq + 512 * i; const bool self = i == 0 && tq == 0; const int pw = pw0 + 4 * i, pn = self ? pw : pn1 - 4 * (i - 1); const cf fdw = fd[w], few = fe[w];
                { const cf a = bufA.get(pw), bb = bufA.get(pn); cf ya, yb; spec_pair(a, bb, fdw, few, ya, yb); bufA.set(pw, ya); if (!self) bufA.set(pn, yb); }
                { const cf a = bufB.get(pw), bb = bufB.get(pn); cf ya, yb; spec_pair(a, bb, fdw, few, ya, yb); bufB.set(pw, ya); if (!self) bufB.set(pn, yb); } }
            if (TID == 0) { const int pw = fidx(fpos(4096)); const cf fdw = fd[4096], few = fe[4096]; cf ya, yb;
                { const cf a = bufA.get(pw); spec_pair(a, a, fdw, few, ya, yb); bufA.set(pw, ya); } { const cf a = bufB.get(pw); spec_pair(a, a, fdw, few, ya, yb); bufB.set(pw, ya); } }
            __syncthreads();
            if (!skipfft) fft_inv_x2_zp(bufA, bufB, tw, TID);
            const float sk0 = skip[n * D + d], sk1 = skip[n * D + d + 1];
            int ty = TID; FFT_OPQ(ty);
#pragma unroll
            for (int i = 0; i < 2; ++i) { const int t0 = 4 * ty + 2048 * i; float g0[4], g1[4], g2[4], g3[4]; sconv4((n + 1) * D + d, rbA, t0, g0); sconv4((n + 1) * D + d + 1, rbA, t0, g1); sconv4((n + 1) * D + d, rbB, t0, g2); sconv4((n + 1) * D + d + 1, rbB, t0, g3);
#pragma unroll
                for (int k = 0; k < 4; ++k) { const int e = fidx(4 * ty) + 2116 * i + k; const cf ya = bufA.get(e), yb = bufB.get(e);
                    za[i][k][0] = g0[k] * (ya.x + za[i][k][0] * sk0); za[i][k][1] = g1[k] * (ya.y + za[i][k][1] * sk1);
                    zb[i][k][0] = g2[k] * (yb.x + zb[i][k][0] * sk0); zb[i][k][1] = g3[k] * (yb.y + zb[i][k][1] * sk1); } }
            __syncthreads();
        }
        int to = TID; FFT_OPQ(to);
#pragma unroll
        for (int i = 0; i < 2; ++i) { const int t0 = 4 * to + 2048 * i;
#pragma unroll
            for (int c = 0; c < 2; ++c) {
                *(uint2*)(ZT + (size_t)(d + c) * R + rbA + t0) = make_uint2(pk2(za[i][0][c], za[i][1][c]), pk2(za[i][2][c], za[i][3][c]));
                *(uint2*)(ZT + (size_t)(d + c) * R + rbB + t0) = make_uint2(pk2(zb[i][0][c], zb[i][1][c]), pk2(zb[i][2][c], zb[i][3][c])); } }
    }
}
#endif

#ifndef UP_ALIGN
#define UP_ALIGN true
#endif
#ifndef UP_SP2
#define UP_SP2 true
#endif
#ifndef DN_ALIGN
#define DN_ALIGN true
#endif
#ifndef DN_SP2
#define DN_SP2 true
#endif
#ifndef DN_AUXA
#define DN_AUXA 0
#endif
constexpr int LDS_BYTES = 155648;
constexpr int LDS_MISC = LDS_BYTES - 256;
constexpr int CW_BAR = 4096;
constexpr size_t CTL_ZERO_BYTES = 65536;

__global__ void __launch_bounds__(512, 2) mega_fwd(Ptrs p_unused) {
#define p kargs()
    extern __shared__ __attribute__((aligned(16))) unsigned char lds[];
    const int tid = threadIdx.x; int wg = blockIdx.x, nwg = gridDim.x;
    volatile LAS unsigned* MISC = (volatile LAS unsigned*)((LAS unsigned char*)lds + LDS_MISC);
    if (tid < 64) MISC[tid] = 0u;
    __syncthreads();
    XcdBarrier bar = xcd_barrier_post((unsigned*)(p->ws + WS_CTL) + CW_BAR, MISC + 8);
#define GRID_BAR() do { xcd_barrier(bar); asm volatile("" : "+s"(ws), "+s"(wg), "+s"(nwg)); } while (0)
    PG8_LAS unsigned char* ring = (PG8_LAS unsigned char*)lds;
    unsigned char* ws = p->ws;
#define X ((u16*)(ws + WS_X))
#define HB ((u16*)(ws + WS_HB))
#define ACT ((u16*)(ws + WS_ACT))
#define MOD ((const float*)(ws + WS_MOD))
#define rope ((const float*)(ws + WS_ROPE))

#ifndef NO_PRO
    ph_modp(p, (float*)lds, wg, nwg);
#ifdef PROBE_MODP
    ph_modp(p, (float*)lds, wg, nwg);
#endif
    ph_tables(p, wg, nwg);
    ph_filters(p, (float*)lds, wg, nwg);
#ifdef PROBE_FILT
    ph_filters(p, (float*)lds, wg, nwg);
#endif
    { int t2 = threadIdx.x; asm volatile("" : "+v"(t2)); conv_all(p, (ConvDesc*)(lds + 8 * 64 * 33 * 4), (float*)lds + (t2 >> 6) * (64 * 33), wg * 8 + (t2 >> 6), nwg * 8, t2 & 63, 0, 3, 24, PRO_B1); }
#ifdef PROBE_CONV
    { int t2 = threadIdx.x; asm volatile("" : "+v"(t2)); conv_all(p, (ConvDesc*)(lds + 8 * 64 * 33 * 4), (float*)lds + (t2 >> 6) * (64 * 33), wg * 8 + (t2 >> 6), nwg * 8, t2 & 63, 0, 3, 24, PRO_B1); }
#endif
#endif
#ifdef PROBE_PRO
    GRID_BAR();
    ph_modp(p, (float*)lds, wg, nwg);
    ph_tables(p, wg, nwg);
    ph_filters(p, (float*)lds, wg, nwg);
    { int t2 = threadIdx.x; asm volatile("" : "+v"(t2)); conv_all(p, (ConvDesc*)(lds + 8 * 64 * 33 * 4), (float*)lds + (t2 >> 6) * (64 * 33), wg * 8 + (t2 >> 6), nwg * 8, t2 & 63, 0, 3, 24, PRO_B1); }
#endif
    GRID_BAR();
    ph_modr(p, wg, nwg);
    ph_filter_fft(p, lds, wg, nwg);
#ifdef PROBE_P1
    GRID_BAR();
    ph_modr(p, wg, nwg);
    ph_filter_fft(p, lds, wg, nwg);
    ph_filter_fft256(p, lds, nwg - 1 - wg, nwg);
#endif
#ifdef PROBE_FFFT
    ph_filter_fft(p, lds, wg, nwg);
#endif
    ph_filter_fft256(p, lds, nwg - 1 - wg, nwg);
    GRID_BAR();

    for (int layer = 0; layer < DEPTH; ++layer) {
        const int kind = layer % 3, jm = layer / 3;
#define modl (MOD + (size_t)layer * 5 * 9 * D)
#pragma unroll 1
        for (int f = 0; f < 2; ++f) {
            const int slot = f == 0 ? 0 : 2, lf = layer * 2 + f; const bool lastffn = layer == DEPTH - 1 && f == 1;
            { const float* pg = nullptr; if (f == 1) pg = lastffn ? nullptr : modl + (size_t)(4 * 9 + 3 * 1 + 2) * D; else if (layer > 0) pg = modl - (size_t)5 * 9 * D + (size_t)(4 * 9 + 3 * 2 + 2) * D;
              ph_modulate(p, layer, slot, pg, f == 1 ? 1.0f : 0.5f, wg, nwg, layer == 0 && f == 0);
#ifdef PROBE_THIN
              GRID_BAR(); ph_modulate(p, layer, slot, nullptr, 0.f, wg, nwg);
#endif
            }
            GRID_BAR();
            { pg8::Gemm g{HB, (const u16*)(ws + WS_WGU + lf * SZ_WGU), R, 2 * DFF, D}; pg8::UpOrder So; So.init(g.N, nwg, wg, lastffn);
              pg8::gemm_phase<pg8::EpiSwiGLU, pg8::UpOrder, UP_ALIGN, UP_SP2>(ring, g, So, pg8::EpiSwiGLU{ACT}); }
#ifdef PROBE_UP_NOEPI
            GRID_BAR();
            { pg8::Gemm g{HB, (const u16*)(ws + WS_WGU + lf * SZ_WGU), R, 2 * DFF, D}; pg8::UpOrder So; So.init(g.N, nwg, wg, lastffn);
              pg8::gemm_phase<pg8::EpiNever<pg8::EpiSwiGLU>, pg8::UpOrder, UP_ALIGN, UP_SP2>(ring, g, So, pg8::EpiNever<pg8::EpiSwiGLU>{pg8::EpiSwiGLU{ACT}, nwg == 12345}); }
#endif
#ifdef PROBE_UP
            GRID_BAR();
            { pg8::Gemm g{HB, (const u16*)(ws + WS_WGU + lf * SZ_WGU), R, 2 * DFF, D}; pg8::UpOrder So; So.init(g.N, nwg, wg, lastffn);
              pg8::gemm_phase<pg8::EpiSwiGLU, pg8::UpOrder, UP_ALIGN, UP_SP2>(ring, g, So, pg8::EpiSwiGLU{ACT}); }
#endif
#ifndef NO_TAILCONV
            if (!lastffn) {
                const int rem = (68 * 43) % nwg;
                if (wg >= rem) {
                    const int a0 = 3 * (lf + 1); int b0 = a0 + 3, b1 = a0 + 3;
#ifdef TAIL_MIXERS
                    if (f == 1) { const int k2 = (layer + 1) % 3; b0 = k2 == 1 ? 34 : k2 == 2 ? 36 : 24 + 5 * ((layer + 1) / 3); b1 = k2 == 0 ? b0 + 5 : b0 + 2; }
#endif
                    __syncthreads();
                    int t2 = threadIdx.x; asm volatile("" : "+v"(t2));
                    conv_tail((const ConvDesc*)(ws + WS_CTL + CTL_CONVTAB), (float*)lds + (t2 >> 6) * (64 * 33), (wg - rem) * 8 + (t2 >> 6), (nwg - rem) * 8, t2 & 63, a0, a0 + 3, b0, b1);
#ifdef PROBE_TAIL
                    conv_tail((const ConvDesc*)(ws + WS_CTL + CTL_CONVTAB), (float*)lds + (t2 >> 6) * (64 * 33), (wg - rem) * 8 + (t2 >> 6), (nwg - rem) * 8, t2 & 63, a0, a0 + 3, b0, b1);
#endif
                }
            }
#endif
            GRID_BAR();
            { pg8::Gemm g{ACT, (const u16*)(ws + WS_WD + lf * SZ_WD), R, D, DFF}; pg8::ResOrder So; So.init(DFF, nwg, wg, lastffn);
              pg8::gemm_phase<pg8::EpiResGate, pg8::ResOrder, DN_ALIGN, DN_SP2, DN_AUXA, true>(ring, g, So, pg8::EpiResGate{X, modl, slot, 0.5f, (u16*)(ws + WS_SLAB)}); }
            GRID_BAR();
#ifdef PROBE_DOWN
            { pg8::Gemm g{ACT, (const u16*)(ws + WS_WD + lf * SZ_WD), R, D, DFF}; pg8::ResOrder So; So.init(DFF, nwg, wg, lastffn);
              pg8::gemm_phase<pg8::EpiResGate, pg8::ResOrder, true, true, 0, true>(ring, g, So, pg8::EpiResGate{X, modl, slot, 0.0f, (u16*)(ws + WS_SLAB)}); }
            GRID_BAR();
#endif
#ifdef PROBE_DOWN_NOEPI
            { pg8::Gemm g{ACT, (const u16*)(ws + WS_WD + lf * SZ_WD), R, D, DFF}; pg8::ResOrder So; So.init(DFF, nwg, wg, lastffn);
              pg8::gemm_phase<pg8::EpiNever<pg8::EpiResGate>, pg8::ResOrder, true, true, 0, true>(ring, g, So, pg8::EpiNever<pg8::EpiResGate>{pg8::EpiResGate{X, modl, slot, 0.0f, (u16*)(ws + WS_SLAB)}, nwg == 12345}); }
            GRID_BAR();
#endif
            if (f == 0) {
                ph_modulate(p, layer, 1, modl + (size_t)(4 * 9 + 3 * 0 + 2) * D, 0.5f, wg, nwg);
#ifdef PROBE_THIN
                GRID_BAR(); ph_modulate(p, layer, 1, nullptr, 0.f, wg, nwg);
#endif
                GRID_BAR();
                const u16* Ao; const u16* Wo;
                if (kind == 0) {
                    u16* QKVA = (u16*)(ws + WS_QKVA);     u16* QL = (u16*)(ws + WS_QL); u16* CKV = (u16*)(ws + WS_CKV); u16* KR = (u16*)(ws + WS_KR); u16* Q = (u16*)(ws + WS_Q); u16* KN = (u16*)(ws + WS_KN); u16* V = (u16*)(ws + WS_V); u16* O = (u16*)(ws + WS_O);
                    { pg8::Gemm g{HB, (const u16*)(ws + WS_WDQKV) + (size_t)jm * QKVA_LD * D, R, QKVA_LD, D}; pg8::StaticOrder So; So.init(g.M, g.N, nwg, wg);
                      pg8::gemm_phase<pg8::EpiF16, pg8::StaticOrder, true, true>(ring, g, So, pg8::EpiF16{QKVA, QKVA_LD}); }
                    GRID_BAR();
                    ph_mla_norm(p, jm, wg, nwg);
                    GRID_BAR();
                    { pg8::Gemm g{QL, (const u16*)(ws + WS_WUQ) + (size_t)jm * 3072 * 512, R, 3072, 512}; pg8::UpOrder So; So.init(g.N, nwg, wg, layer == DEPTH - 1);
                      pg8::gemm_phase<pg8::EpiRope<0>, pg8::UpOrder, true, true>(ring, g, So, pg8::EpiRope<0>{Q, 3072, rope}); }
                    { pg8::Gemm g{CKV, (const u16*)(ws + WS_WUKV) + (size_t)jm * 4096 * 512, R, 4096, 512}; pg8::StaticOrder So; So.init(g.M, g.N, nwg, nwg - 1 - wg);
                      pg8::gemm_phase<pg8::EpiKV, pg8::StaticOrder, true, true>(ring, g, So, pg8::EpiKV{KN, V}); }
                    GRID_BAR();
#ifdef PROBE_MLAPRE
                    { pg8::Gemm g{HB, (const u16*)(ws + WS_WDQKV) + (size_t)jm * QKVA_LD * D, R, QKVA_LD, D}; pg8::StaticOrder So; So.init(g.M, g.N, nwg, wg);
                      pg8::gemm_phase<pg8::EpiF16, pg8::StaticOrder, true, true>(ring, g, So, pg8::EpiF16{QKVA, QKVA_LD}); }
                    GRID_BAR();
                    ph_mla_norm(p, jm, wg, nwg);
                    GRID_BAR();
                    { pg8::Gemm g{QL, (const u16*)(ws + WS_WUQ) + (size_t)jm * 3072 * 512, R, 3072, 512}; pg8::UpOrder So; So.init(g.N, nwg, wg, layer == DEPTH - 1);
                      pg8::gemm_phase<pg8::EpiRope<0>, pg8::UpOrder, true, true>(ring, g, So, pg8::EpiRope<0>{Q, 3072, rope}); }
                    { pg8::Gemm g{CKV, (const u16*)(ws + WS_WUKV) + (size_t)jm * 4096 * 512, R, 4096, 512}; pg8::StaticOrder So; So.init(g.M, g.N, nwg, nwg - 1 - wg);
                      pg8::gemm_phase<pg8::EpiKV, pg8::StaticOrder, true, true>(ring, g, So, pg8::EpiKV{KN, V}); }
                    GRID_BAR();
#endif
#ifndef NO_NAIVE
#ifdef PROBE_ATTN
#pragma unroll 1
                    for (int rep = 0; rep < 2; ++rep)
#endif
#ifdef PROBE_ATTN_ABL
                    ph_attn_mla<PROBE_ATTN_ABL>(Q, KN, KR, V, O, lds, wg, nwg, layer < DEPTH - 1);
#endif
                    ph_attn_mla(Q, KN, KR, V, O, lds, wg, nwg, layer < DEPTH - 1);
#endif
                    Ao = O; Wo = (const u16*)(ws + WS_WMO) + (size_t)jm * D * D;
                } else if (kind == 1) {
                    u16* UT = (u16*)(ws + WS_UT); u16* ZT = (u16*)(ws + WS_ZT);
                    { pg8::Gemm g{(const u16*)(ws + WS_WHIN), HB, 3 * D, R, D}; pg8::StaticOrder So; So.init(g.M, g.N, nwg, wg);
                      pg8::gemm_phase<pg8::EpiF16, pg8::StaticOrder, true, true>(ring, g, So, pg8::EpiF16{UT, R}); }
#ifdef PROBE_HIN
                    GRID_BAR();
                    { pg8::Gemm g{(const u16*)(ws + WS_WHIN), HB, 3 * D, R, D}; pg8::StaticOrder So; So.init(g.M, g.N, nwg, wg);
                      pg8::gemm_phase<pg8::EpiF16, pg8::StaticOrder, true, true>(ring, g, So, pg8::EpiF16{UT, R}); }
#endif
                    GRID_BAR();
#ifndef NO_NAIVE
#ifdef PROBE_HYF
#pragma unroll 1
                    for (int rep = 0; rep < 2; ++rep)
#endif
#ifdef PROBE_HYF_NOFFT
#pragma unroll 1
                    for (int rep = 0; rep < 2; ++rep)
                    ph_hyena_fft2(p, lds, wg, nwg, rep == 0);
#else
                    ph_hyena_fft2(p, lds, wg, nwg);
#endif
                    ph_hyena_fft256(p, lds, wg, nwg);
#ifdef PROBE_HYC
                    ph_hyena_fft256(p, lds, wg, nwg);
#endif
#endif
                    GRID_BAR();
                    ph_transpose(ZT, HB, (u16*)lds, wg, nwg);
                    Ao = HB; Wo = (const u16*)(ws + WS_WHOUT);
                } else {
                    u16* QKV = (u16*)(ws + WS_QKV); u16* O = (u16*)(ws + WS_WO);
                    { pg8::Gemm g{HB, (const u16*)(ws + WS_WWQKV), R, 2560, D}; pg8::StaticOrder So; So.init(g.M, g.N, nwg, wg);
                      pg8::gemm_phase<pg8::EpiRope<1>, pg8::StaticOrder, true, true>(ring, g, So, pg8::EpiRope<1>{QKV, 2560, rope}); }
                    GRID_BAR();
#ifndef NO_NAIVE
#ifdef PROBE_WIN
#pragma unroll 1
                    for (int rep = 0; rep < 2; ++rep)
#endif
                    ph_attn_win(QKV, p->in[I_SINK], O, lds, wg, nwg);
#endif
                    Ao = O; Wo = (const u16*)(ws + WS_WWO);
                }
                GRID_BAR();
                { pg8::Gemm g{Ao, Wo, R, D, D}; pg8::ResOrder So; So.init(D, nwg, wg, layer == DEPTH - 1);
                  pg8::gemm_phase<pg8::EpiResGate, pg8::ResOrder, true, true>(ring, g, So, pg8::EpiResGate{X, modl, 1, 1.0f, (u16*)(ws + WS_SLAB)}); }
                GRID_BAR();
#ifdef PROBE_WO
                { pg8::Gemm g{Ao, Wo, R, D, D}; pg8::ResOrder So; So.init(D, nwg, wg, layer == DEPTH - 1);
                  pg8::gemm_phase<pg8::EpiResGate, pg8::ResOrder, true, true>(ring, g, So, pg8::EpiResGate{X, modl, 1, 0.0f, (u16*)(ws + WS_SLAB)}); }
                GRID_BAR();
#endif
            }
        }
    }
    ph_final(p, wg, nwg);
#undef p
#undef X
#undef HB
#undef ACT
#undef MOD
#undef rope
#undef modl
}
}

extern "C" void kernel_launch(void* const* d_in, const int* in_sizes, int n_in, void* d_out, int out_size, void* d_ws, size_t ws_size, hipStream_t stream) {
    static int grid = 0;
    if (grid == 0) {
        if (n_in != 35 || ws_size < WS_TOTAL || out_size != NB * S * D) { fprintf(stderr, "kernel_launch: unexpected shapes (n_in %d, ws %zu need %zu, out %d)\n", n_in, ws_size, (size_t)WS_TOTAL, out_size); grid = -1; return; }
        int dev = 0, cus = 0, per_cu = 0;
        if (hipGetDevice(&dev) != hipSuccess || hipDeviceGetAttribute(&cus, hipDeviceAttributeMultiprocessorCount, dev) != hipSuccess || cus <= 0) { fprintf(stderr, "kernel_launch: device query failed\n"); grid = -1; return; }
        if (hipFuncSetAttribute((const void*)mega_fwd, hipFuncAttributeMaxDynamicSharedMemorySize, LDS_BYTES) != hipSuccess) { fprintf(stderr, "kernel_launch: hipFuncSetAttribute failed\n"); grid = -1; return; }
        if (hipOccupancyMaxActiveBlocksPerMultiprocessor(&per_cu, (const void*)mega_fwd, 512, LDS_BYTES) != hipSuccess || per_cu < 1) fprintf(stderr, "kernel_launch: note: occupancy query reports %d workgroups per CU\n", per_cu);
        (void)hipGetLastError();
        grid = cus;
    }
    if (grid < 0) return;
    if (hipMemsetAsync((char*)d_ws + WS_CTL, 0, CTL_ZERO_BYTES, stream) != hipSuccess) { fprintf(stderr, "kernel_launch: memset failed\n"); return; }
    Ptrs p{}; for (int i = 0; i < 35; ++i) p.in[i] = (const float*)d_in[i]; p.out = (float*)d_out; p.ws = (unsigned char*)d_ws;
    hipLaunchKernelGGL(mega_fwd, dim3(grid), dim3(512), LDS_BYTES, stream, p);
    const hipError_t le = hipPeekAtLastError();
    if (le != hipSuccess) fprintf(stderr, "kernel_launch: launch failed: %s\n", hipGetErrorName(le));
}
```

```cpp
#define TAIL_MIXERS 1
#define RES_4X8 1
#define RES_NOSTAGGER 1
#define MLA_NOSWAP 1
#define QROPE_REG 1
#define CONV_NT 1
#include <hip/hip_runtime.h>
#include <cstdio>
#include <cstdint>
#include <cmath>

namespace {
typedef unsigned short u16;
constexpr int D = 2048, NB = 4, S = 4096, CTX = 256, SB = S + CTX, R = NB * SB, DFF = 5504, NMODV = 9 * D, DEPTH = 4;
constexpr int QKVA_LD = 1280;
constexpr float NORM_EPS = 1e-6f;

constexpr size_t al(size_t x) { return (x + 255) / 256 * 256; }
constexpr size_t WS_CTL = 0;
constexpr size_t WS_X = 1u << 20;
constexpr size_t WS_HB = WS_X + al((size_t)R * D * 4);
constexpr size_t WS_ACT = WS_HB + al((size_t)R * D * 2);
constexpr size_t WS_MODP = WS_ACT + al((size_t)R * DFF * 2);
constexpr size_t WS_MOD = WS_MODP + al((size_t)16 * DEPTH * 5 * NMODV * 4);
constexpr size_t WS_ROPE = WS_MOD + al((size_t)DEPTH * 5 * NMODV * 4);
constexpr size_t WS_TW = WS_ROPE + al(64 * 16 * 2 * 4);
constexpr size_t WS_FS = WS_TW + al(8192 * 8);
constexpr size_t WS_FT256 = WS_FS + al((size_t)2 * 2048 * 4104 * 8);
constexpr size_t WS_MIX = WS_FT256 + al((size_t)8192 * 256 * 4);
constexpr size_t WS_FT4096 = WS_MIX;
constexpr size_t WS_QKVA = WS_MIX;
constexpr size_t WS_QL = WS_QKVA + al((size_t)R * QKVA_LD * 4);
constexpr size_t WS_CKV = WS_QL + al((size_t)R * 512 * 2);
constexpr size_t WS_KR = WS_CKV + al((size_t)R * 512 * 2);
constexpr size_t WS_Q = WS_KR + al((size_t)R * 64 * 2);
constexpr size_t WS_KN = WS_Q + al((size_t)R * 3072 * 2);
constexpr size_t WS_V = WS_KN + al((size_t)R * D * 2);
constexpr size_t WS_O = WS_V + al((size_t)R * D * 2);
constexpr size_t WS_MLA_END = WS_O + al((size_t)R * D * 2);
constexpr size_t WS_UT = WS_MIX;
constexpr size_t WS_ZT = WS_UT + al((size_t)3 * D * R * 4);
constexpr size_t WS_HY_END = WS_ZT + al((size_t)D * R * 2);
constexpr size_t WS_QKV = WS_MIX;
constexpr size_t WS_WO = WS_QKV + al((size_t)R * 2560 * 2);
constexpr size_t WS_WIN_END = WS_WO + al((size_t)R * D * 2);
constexpr size_t WS_END = (WS_MLA_END > WS_HY_END ? (WS_MLA_END > WS_WIN_END ? WS_MLA_END : WS_WIN_END) : (WS_HY_END > WS_WIN_END ? WS_HY_END : WS_WIN_END));
constexpr size_t SZ_WGU = (size_t)2 * DFF * D * 2, SZ_WD = (size_t)D * DFF * 2;
constexpr size_t WS_WGU = al(WS_END);
constexpr size_t WS_WD = WS_WGU + 8 * SZ_WGU;
constexpr size_t WS_WDQKV = WS_WD + 8 * SZ_WD;
constexpr size_t WS_WUQ = WS_WDQKV + 2 * (size_t)QKVA_LD * D * 2;
constexpr size_t WS_WUKV = WS_WUQ + 2 * (size_t)3072 * 512 * 2;
constexpr size_t WS_WMO = WS_WUKV + 2 * (size_t)4096 * 512 * 2;
constexpr size_t WS_WHIN = WS_WMO + 2 * (size_t)D * D * 2;
constexpr size_t WS_WHOUT = WS_WHIN + (size_t)3 * D * D * 2;
constexpr size_t WS_WWQKV = WS_WHOUT + (size_t)D * D * 2;
constexpr size_t WS_WWO = WS_WWQKV + (size_t)2560 * D * 2;
constexpr size_t WS_SLAB = WS_WWO + (size_t)D * D * 2;
constexpr size_t WS_FS256 = WS_SLAB + (size_t)8 * 4 * 256 * D * 4;
constexpr size_t WS_TOTAL = WS_FS256 + (size_t)2 * 2048 * 264 * 8;
static_assert(WS_TOTAL < 2000000000ull, "workspace map exceeds the guaranteed size");

__device__ __forceinline__ float bf2f(u16 b) { return __uint_as_float(((unsigned)b) << 16); }
__device__ __forceinline__ unsigned pk2(float lo, float hi) { unsigned r; asm("v_cvt_pk_bf16_f32 %0, %1, %2" : "=v"(r) : "v"(lo), "v"(hi)); return r; }
__device__ __forceinline__ u16 f2bf(float f) { return (u16)(pk2(f, f) & 0xffffu); }
template <int X> __device__ __forceinline__ float swz_xor(float v) { return __int_as_float(__builtin_amdgcn_ds_swizzle(__float_as_int(v), 0x1f | (X << 10))); }
__device__ __forceinline__ float wave_sum(float v) {
    v += swz_xor<1>(v); v += swz_xor<2>(v); v += swz_xor<4>(v); v += swz_xor<8>(v); v += swz_xor<16>(v);
    auto rr = __builtin_amdgcn_permlane32_swap(__float_as_uint(v), __float_as_uint(v), false, false); return __uint_as_float(rr[0]) + __uint_as_float(rr[1]);
}
__device__ __forceinline__ float wave_max(float v) {
    v = fmaxf(v, swz_xor<1>(v)); v = fmaxf(v, swz_xor<2>(v)); v = fmaxf(v, swz_xor<4>(v)); v = fmaxf(v, swz_xor<8>(v)); v = fmaxf(v, swz_xor<16>(v));
    auto rr = __builtin_amdgcn_permlane32_swap(__float_as_uint(v), __float_as_uint(v), false, false); return fmaxf(__uint_as_float(rr[0]), __uint_as_float(rr[1]));
}
__device__ __forceinline__ int modidx_of_row(int r) { const int b = r / SB, j = r - b * SB; return j < CTX ? 4 : b; }
__device__ __forceinline__ float silu_f(float x) { return x / (1.f + expf(-x)); }

struct Ptrs {
    const float* in[35];
    float* out;
    unsigned char* ws;
};
typedef const __attribute__((address_space(4))) Ptrs* KP;
__device__ __forceinline__ KP kargs() { KP q = (KP)__builtin_amdgcn_kernarg_segment_ptr(); asm volatile("" : "+s"(q)); return q; }
enum { I_X = 0, I_C, I_CTX, I_CCTX, I_MODW, I_MODB, I_NORMG, I_FINALG, I_WG, I_WU, I_WD, I_DQ, I_GQ, I_UQ, I_DKV, I_GKV, I_UKV, I_MWO,
       I_HWIN, I_HCW, I_HCB, I_FW1, I_FB1, I_FW2, I_FB2, I_FW3, I_FB3, I_FFREQ, I_FW4, I_DECAY, I_SKIP, I_HWOUT, I_WQKV, I_SINK, I_WWO };


}

namespace pg8 {
#define PG8_LAS __attribute__((address_space(3)))
typedef unsigned short bf16_t;
typedef short bf16x8 __attribute__((ext_vector_type(8)));
typedef float f32x4 __attribute__((ext_vector_type(4)));
typedef unsigned u32x4 __attribute__((ext_vector_type(4)));
constexpr int BM = 256, BK = 64, HALF = 128, HTB = HALF * BK * 2  , STAGE_BYTES = 8 * HTB, NXCD = 8, WGM = 8;

__host__ __device__ __forceinline__ int lds_byte(int r, int c) { const int st = (r >> 4) * 2 + (c >> 5), rr = r & 15, cc = c & 31, ob = rr * 64 + cc * 2; return st * 1024 + (ob ^ (((ob >> 9) & 1) << 5)); }
__host__ __device__ __forceinline__ void stage_rc(int b, int& R, int& C) { const int st = b / 1024, sb = b % 1024, swz = sb ^ (((sb >> 9) & 1) << 5); R = (st >> 1) * 16 + swz / 64; C = (st & 1) * 32 + (swz % 64) / 2; }
__host__ __device__ __forceinline__ int perm32(int rho) { const int n = rho >> 4, i = rho & 15; return 8 * (i >> 2) + 4 * n + (i & 3); }

struct Unit { int pm, pn; int kt0 = 0, nt = 0, sp = -1; };
struct Gemm { const bf16_t* A; const bf16_t* Bt; int M, N, K; };

struct StaticOrder {
    int nM, nN, nwg, G, c;
    __host__ __device__ __forceinline__ void init(int M, int N, int G_, int c_) { nM = M / BM; nN = N / BM; nwg = nM * nN; G = G_; c = c_; }
    __host__ __device__ __forceinline__ bool next(int i, Unit& u) const {
        const long L = (long)i * G + c; if (L >= nwg) return false;
        int wgid = (int)L; { const int q = nwg / NXCD, r = nwg % NXCD, xcd = wgid % NXCD, off = wgid / NXCD; wgid = (xcd < r ? xcd * (q + 1) : r * (q + 1) + (xcd - r) * q) + off; }
        const int nig = WGM * nN, gid = wgid / nig, fm = gid * WGM, gsz = (nM - fm) < WGM ? (nM - fm) : WGM;
        u.pm = fm + ((wgid % nig) % gsz); u.pn = (wgid % nig) / gsz; return true;
    }
    __device__ __forceinline__ void a_ready(const Unit&) const {}
    __device__ __forceinline__ void done(const Unit&) const {}
};


__device__ __forceinline__ unsigned cvt_pk_bf16(float lo, float hi) { unsigned r; asm("v_cvt_pk_bf16_f32 %0, %1, %2" : "=v"(r) : "v"(lo), "v"(hi)); return r; }
typedef float f32x2 __attribute__((ext_vector_type(2)));

struct EpiF32 {
    static constexpr bool PERM = false, AFTER_DRAIN = false;
    float* C; int ldc;
    __device__ __forceinline__ void operator()(const f32x4 (&acc)[2][2][4][2], const Unit& u, int wr, int wc, int fr, int fq) const {
        const int row0 = u.pm * BM + wr * 64 + fr, col0 = u.pn * BM + wc * 32 + 4 * fq;
#pragma unroll
        for (int ai = 0; ai < 2; ++ai)
#pragma unroll
            for (int m = 0; m < 4; ++m) { float* rowp = C + (size_t)(row0 + ai * HALF + m * 16) * ldc + col0;
#pragma unroll
                for (int bj = 0; bj < 2; ++bj)
#pragma unroll
                    for (int n = 0; n < 2; ++n) *(f32x4*)(rowp + bj * HALF + n * 16) = acc[ai][bj][m][n]; }
    }
};
struct EpiBf16 {
    static constexpr bool PERM = true, AFTER_DRAIN = false;
    bf16_t* C; int ldc;
    __device__ __forceinline__ void operator()(const f32x4 (&acc)[2][2][4][2], const Unit& u, int wr, int wc, int fr, int fq) const {
        const int row0 = u.pm * BM + wr * 64 + fr, col0 = u.pn * BM + wc * 32 + 8 * fq;
#pragma unroll
        for (int ai = 0; ai < 2; ++ai)
#pragma unroll
            for (int m = 0; m < 4; ++m)
#pragma unroll
                for (int bj = 0; bj < 2; ++bj) { const f32x4 v0 = acc[ai][bj][m][0], v1 = acc[ai][bj][m][1];
                    u32x4 w; w.x = cvt_pk_bf16(v0[0], v0[1]); w.y = cvt_pk_bf16(v0[2], v0[3]); w.z = cvt_pk_bf16(v1[0], v1[1]); w.w = cvt_pk_bf16(v1[2], v1[3]);
                    *(u32x4*)(C + (size_t)(row0 + ai * HALF + m * 16) * ldc + col0 + bj * HALF) = w; }
    }
};
__device__ __forceinline__ unsigned swiglu_pk(float g0, float g1, float u0, float u1) {
    const f32x2 g = {g0, g1}, u = {u0, u1};
    const f32x2 t = g * -1.4426950408889634f;
    f32x2 e; e.x = __builtin_amdgcn_exp2f(t.x); e.y = __builtin_amdgcn_exp2f(t.y);
    const f32x2 d = e + 1.0f;
    f32x2 r; r.x = __builtin_amdgcn_rcpf(d.x); r.y = __builtin_amdgcn_rcpf(d.y);
    const f32x2 o = (g * u) * r;
    unsigned w; asm("v_cvt_pk_bf16_f32 %0, %1, %2" : "=v"(w) : "v"(o.x), "v"(o.y)); return w;
}
struct EpiSwiGLU {
    static constexpr bool PERM = true, AFTER_DRAIN = false;
    bf16_t* act;
    __device__ __forceinline__ void operator()(const f32x4 (&acc)[2][2][4][2], const Unit& u, int wr, int wc, int fr, int fq) const {
        const int row0 = u.pm * BM + wr * 64 + fr, col0 = u.pn * HALF + wc * 32 + 8 * fq;
#pragma unroll
        for (int ai = 0; ai < 2; ++ai)
#pragma unroll
            for (int m = 0; m < 4; ++m) { const f32x4 g0 = acc[ai][0][m][0], g1 = acc[ai][0][m][1], u0 = acc[ai][1][m][0], u1 = acc[ai][1][m][1];
                u32x4 w; w.x = swiglu_pk(g0[0], g0[1], u0[0], u0[1]); w.y = swiglu_pk(g0[2], g0[3], u0[2], u0[3]); w.z = swiglu_pk(g1[0], g1[1], u1[0], u1[1]); w.w = swiglu_pk(g1[2], g1[3], u1[2], u1[3]);
                *(u32x4*)(act + (size_t)(row0 + ai * HALF + m * 16) * DFF + col0) = w; }
    }
};
typedef _Float16 f16x2 __attribute__((ext_vector_type(2)));
__device__ __forceinline__ float h16_lim() { float l; asm volatile("s_mov_b32 %0, 0x477fe000" : "=s"(l)); return l; }
__device__ __forceinline__ unsigned pkh2(float lo, float hi, float lim) { f16x2 h; h[0] = (_Float16)__builtin_amdgcn_fmed3f(lo, -lim, lim); h[1] = (_Float16)__builtin_amdgcn_fmed3f(hi, -lim, lim); return __builtin_bit_cast(unsigned, h); }
__device__ __forceinline__ float h2f_lo(unsigned w) { const f16x2 h = __builtin_bit_cast(f16x2, w); return (float)h[0]; }
__device__ __forceinline__ float h2f_hi(unsigned w) { const f16x2 h = __builtin_bit_cast(f16x2, w); return (float)h[1]; }
struct EpiResGate {
    static constexpr bool PERM = true, AFTER_DRAIN = false;
    bf16_t* X; const float* modl; int slot; float coef; bf16_t* slab;
    __device__ __forceinline__ void operator()(const f32x4 (&acc)[2][2][4][2], const Unit& u, int wr, int wc, int fr, int fq) const {
        const int col0 = u.pn * BM + wc * 32 + 8 * fq;
        const int q = u.pm % 17, midx = q == 0 ? 4 : u.pm / 17;
        if (u.sp >= 0) {
            bf16_t* sp = slab + ((size_t)(u.sp * 4 + u.pm / 17) * 256 + wr * 64 + fr) * D + col0;
#pragma unroll
            for (int ai = 0; ai < 2; ++ai)
#pragma unroll
                for (int m = 0; m < 4; ++m) { bf16_t* rowp = sp + (size_t)(ai * HALF + m * 16) * D;
#pragma unroll
                    for (int bj = 0; bj < 2; ++bj) { const f32x4 v0 = acc[ai][bj][m][0], v1 = acc[ai][bj][m][1];
                        u32x4 w; w.x = cvt_pk_bf16(v0[0], v0[1]); w.y = cvt_pk_bf16(v0[2], v0[3]); w.z = cvt_pk_bf16(v1[0], v1[1]); w.w = cvt_pk_bf16(v1[2], v1[3]);
                        *(u32x4*)(rowp + bj * HALF) = w; } }
            return;
        }
        const int row0 = u.pm * BM + wr * 64 + fr; const float lim = h16_lim();
        const float* gp = modl + ((size_t)midx * 9 + 3 * slot + 2) * D + col0;
        f32x4 gv[2][2];
#pragma unroll
        for (int bj = 0; bj < 2; ++bj)
#pragma unroll
            for (int n = 0; n < 2; ++n) gv[bj][n] = *(const f32x4*)(gp + bj * HALF + 4 * n) * coef;
#pragma unroll
        for (int ai = 0; ai < 2; ++ai)
#pragma unroll
            for (int m = 0; m < 4; ++m) { bf16_t* rowp = X + (size_t)(row0 + ai * HALF + m * 16) * D + col0;
#pragma unroll
                for (int bj = 0; bj < 2; ++bj) { u32x4* px = (u32x4*)(rowp + bj * HALF); const u32x4 xo = *px;
                    const f32x4 a0 = (f32x4){h2f_lo(xo.x), h2f_hi(xo.x), h2f_lo(xo.y), h2f_hi(xo.y)} + gv[bj][0] * acc[ai][bj][m][0];
                    const f32x4 a1 = (f32x4){h2f_lo(xo.z), h2f_hi(xo.z), h2f_lo(xo.w), h2f_hi(xo.w)} + gv[bj][1] * acc[ai][bj][m][1];
                    u32x4 w; w.x = pkh2(a0[0], a0[1], lim); w.y = pkh2(a0[2], a0[3], lim); w.z = pkh2(a1[0], a1[1], lim); w.w = pkh2(a1[2], a1[3], lim);
                    *px = w; } }
    }
};
struct EpiF16 {
    static constexpr bool PERM = true, AFTER_DRAIN = false;
    bf16_t* C; int ldc;
    __device__ __forceinline__ void operator()(const f32x4 (&acc)[2][2][4][2], const Unit& u, int wr, int wc, int fr, int fq) const {
        const int row0 = u.pm * BM + wr * 64 + fr, col0 = u.pn * BM + wc * 32 + 8 * fq; const float lim = h16_lim();
#pragma unroll
        for (int ai = 0; ai < 2; ++ai)
#pragma unroll
            for (int m = 0; m < 4; ++m)
#pragma unroll
                for (int bj = 0; bj < 2; ++bj) { const f32x4 v0 = acc[ai][bj][m][0], v1 = acc[ai][bj][m][1];
                    u32x4 w; w.x = pkh2(v0[0], v0[1], lim); w.y = pkh2(v0[2], v0[3], lim); w.z = pkh2(v1[0], v1[1], lim); w.w = pkh2(v1[2], v1[3], lim);
                    *(u32x4*)(C + (size_t)(row0 + ai * HALF + m * 16) * ldc + col0 + bj * HALF) = w; }
    }
};
struct ResOrder {
    StaticOrder so; int G, c, K; bool nosplit;
    __device__ __forceinline__ void init(int K_, int G_, int c_, bool nosplit_ = false) { so.init(64 * BM, 2048, G_, c_); G = G_; c = c_; K = K_; nosplit = nosplit_; }
    __device__ __forceinline__ bool next(int i, Unit& u) const {
        int ii = i;
#ifndef RES_NOSTAGGER
        if (G == 256 && ((c >> 3) & 1) && !nosplit) ii = i == 0 ? 2 : i - 1;
#endif
        const long L = (long)ii * G + c;
        if (i > 2 && G == 256) return false;
        if (L >= 768 || (nosplit && L >= 512)) return false;
        const bool full = L < 512;
        Unit v; v.pm = 0; v.pn = 0; so.next(full ? ii : 0, v);
        const int it = full ? 0 : (int)(L - 512), cu = it >> 3, s = it & 7, np = K / 128, p0 = (np * s) / 8, p1 = (np * (s + 1)) / 8;
#ifdef RES_4X8
        { const int off = (v.pm & 7) + 8 * v.pn; v.pm = (v.pm & ~7) + (off & 3) + 4 * (off >> 5); v.pn = (off >> 2) & 7; }
#endif
        const int pm = full ? (v.pm >> 4) * 17 + 1 + (v.pm & 15) : 17 * (cu >> 3), pn = full ? v.pn : (cu & 7);
        u.pm = pm; u.pn = pn; u.kt0 = full ? 0 : 2 * p0; u.nt = full ? 0 : 2 * (p1 - p0); u.sp = full ? -1 : s;
        return true;
    }
    __device__ __forceinline__ void a_ready(const Unit&) const {}
    __device__ __forceinline__ void done(const Unit&) const {}
};
struct UpOrder {
    StaticOrder so68, so64; bool latent_only;
    __device__ __forceinline__ void init(int N, int G_, int c_, bool latent_only_) { so68.init(68 * BM, N, G_, c_); so64.init(64 * BM, N, G_, c_); latent_only = latent_only_; }
    __device__ __forceinline__ bool next(int i, Unit& u) const {
        Unit a, b; a.pm = 0; a.pn = 0; b.pm = 0; b.pn = 0;
        const bool ok68 = so68.next(i, a), ok64 = so64.next(i, b);
        const int pm = latent_only ? (b.pm >> 4) * 17 + 1 + (b.pm & 15) : a.pm, pn = latent_only ? b.pn : a.pn;
        u.pm = pm; u.pn = pn; u.kt0 = 0; u.nt = 0; u.sp = -1;
        return latent_only ? ok64 : ok68;
    }
    __device__ __forceinline__ void a_ready(const Unit&) const {}
    __device__ __forceinline__ void done(const Unit&) const {}
};
struct EpiKV {
    static constexpr bool PERM = true, AFTER_DRAIN = false;
    bf16_t* KN; bf16_t* V;
    __device__ __forceinline__ void operator()(const f32x4 (&acc)[2][2][4][2], const Unit& u, int wr, int wc, int fr, int fq) const {
        const int row0 = u.pm * BM + wr * 64 + fr, col0 = u.pn * HALF + wc * 32 + 8 * fq;
#pragma unroll
        for (int ai = 0; ai < 2; ++ai)
#pragma unroll
            for (int m = 0; m < 4; ++m)
#pragma unroll
                for (int bj = 0; bj < 2; ++bj) { const f32x4 v0 = acc[ai][bj][m][0], v1 = acc[ai][bj][m][1];
                    u32x4 w; w.x = cvt_pk_bf16(v0[0], v0[1]); w.y = cvt_pk_bf16(v0[2], v0[3]); w.z = cvt_pk_bf16(v1[0], v1[1]); w.w = cvt_pk_bf16(v1[2], v1[3]);
                    *(u32x4*)((bj ? V : KN) + (size_t)(row0 + ai * HALF + m * 16) * D + col0) = w; }
    }
};
template <int MODE> struct EpiRope {
    static constexpr bool PERM = false, AFTER_DRAIN = false;
    bf16_t* C; int ldc; const float* rope;
    __device__ __forceinline__ void operator()(const f32x4 (&acc)[2][2][4][2], const Unit& u, int wr, int wc, int fr, int fq) const {
        typedef unsigned u32x2 __attribute__((ext_vector_type(2)));
        const int row0 = u.pm * BM + wr * 64 + fr, col0 = u.pn * BM + wc * 32 + 4 * fq;
        const int q = u.pm % 17; const bool isctx = q == 0; const int t0 = (q - 1) * 256 + wr * 64 + fr;
#pragma unroll
        for (int bj = 0; bj < 2; ++bj) {
            const int g32 = 8 * u.pn + 4 * bj + wc; int ty;
            if (MODE == 0) { const int gi = g32 % 6; ty = gi == 4 ? 1 : (gi == 5 ? 2 : 0); } else { ty = g32 < 72 ? 1 + (g32 & 1) : 0; }
            if (isctx) ty = 0;
#pragma unroll
            for (int ai = 0; ai < 2; ++ai)
#pragma unroll
                for (int m = 0; m < 4; ++m) { f32x4 x1 = acc[ai][bj][m][0], x2 = acc[ai][bj][m][1];
                    if (ty) { const int t = t0 + ai * HALF + m * 16, pos = ty == 1 ? (t >> 6) : (t & 63); const f32x4* rp = (const f32x4*)(rope + (size_t)(pos * 16 + 4 * fq) * 2); const f32x4 r0 = rp[0], r1 = rp[1];
                        const f32x4 cs = {r0[0], r0[2], r1[0], r1[2]}, sn = {r0[1], r0[3], r1[1], r1[3]}; const f32x4 o1 = x1 * cs - x2 * sn, o2 = x2 * cs + x1 * sn; x1 = o1; x2 = o2; }
                    bf16_t* rowp = C + (size_t)(row0 + ai * HALF + m * 16) * ldc + col0 + bj * HALF;
                    u32x2 w0, w1; w0.x = cvt_pk_bf16(x1[0], x1[1]); w0.y = cvt_pk_bf16(x1[2], x1[3]); w1.x = cvt_pk_bf16(x2[0], x2[1]); w1.y = cvt_pk_bf16(x2[2], x2[3]);
                    *(u32x2*)rowp = w0; *(u32x2*)(rowp + 16) = w1; }
        }
    }
};

template <class E_> struct EpiNever {
    static constexpr bool PERM = E_::PERM, AFTER_DRAIN = false;
    E_ e; bool on;
    __device__ __forceinline__ void operator()(const f32x4 (&acc)[2][2][4][2], const Unit& u, int wr, int wc, int fr, int fq) const { if (on) e(acc, u, wr, wc, fr, fq); }
};
template <class Epi, class Sched, bool ALIGN_EPI = false, bool SP2 = false, int AUXA = 0>
__device__ __forceinline__ void gemm_phase(PG8_LAS unsigned char* lds, const Gemm g, const Sched& S, const Epi& E) {
    int tid_ = threadIdx.x; asm volatile("" : "+v"(tid_));
    const int tid = tid_, wid = __builtin_amdgcn_readfirstlane(tid >> 6), lane = tid & 63, wr = wid >> 2, wc = wid & 3, fr = lane & 15, fq = lane >> 4;
    const int K = g.K, nt = K / BK;
    unsigned voffA[2], voffB[2];
#pragma unroll
    for (int i = 0; i < 2; ++i) { int R, C; stage_rc(tid * 16 + i * 8192, R, C); const int Rb = Epi::PERM ? ((R & ~31) + perm32(R & 31)) : R;
        voffA[i] = (unsigned)(R * K + C) * 2u; voffB[i] = (unsigned)(Rb * K + C) * 2u; }
    const size_t kstep = (size_t)(BK * 2);
    const size_t hstep = (size_t)HALF * K * 2;
    const size_t tstep = 2 * hstep;
    const unsigned ldsw = (unsigned)wid * 1024u;
    const int aoff = lds_byte(wr * 64 + fr, fq * 8), boff = lds_byte(wc * 32 + fr, fq * 8);
#define PG8_SA(b, h) (((b) * 2 + (h)) * HTB)
#define PG8_SB(b, h) ((4 + (b) * 2 + (h)) * HTB)
#define PG8_STAGE(bufoff, gbase, voff, aux) do { _Pragma("unroll") for (int _i = 0; _i < 2; ++_i) \
        __builtin_amdgcn_global_load_lds((const unsigned*)((const char*)(gbase) + (voff)[_i]), (PG8_LAS unsigned*)(lds + (bufoff) + ldsw + _i * 8192), 16, 0, aux); } while (0)
#define PG8_LDA(dst, b, h) do { _Pragma("unroll") for (int m = 0; m < 4; ++m) _Pragma("unroll") for (int k = 0; k < 2; ++k) dst[m][k] = *(const PG8_LAS bf16x8*)(lds + PG8_SA(b, h) + aoff + m * 2048 + k * 1024); } while (0)
#define PG8_LDB(dst, b, h) do { _Pragma("unroll") for (int n = 0; n < 2; ++n) _Pragma("unroll") for (int k = 0; k < 2; ++k) dst[n][k] = *(const PG8_LAS bf16x8*)(lds + PG8_SB(b, h) + boff + n * 2048 + k * 1024); } while (0)
#define PG8_MMA(ai, bj, At, Bt) do { __builtin_amdgcn_s_setprio(1); _Pragma("unroll") for (int m = 0; m < 4; ++m) _Pragma("unroll") for (int n = 0; n < 2; ++n) _Pragma("unroll") for (int k = 0; k < 2; ++k) \
        acc[ai][bj][m][n] = __builtin_amdgcn_mfma_f32_16x16x32_bf16(Bt[n][k], At[m][k], acc[ai][bj][m][n], 0, 0, 0); __builtin_amdgcn_s_setprio(0); } while (0)
#define PG8_WAIT_V(n) asm volatile("s_waitcnt vmcnt(" #n ")" ::: "memory")
#define PG8_WAIT_L(n) asm volatile("s_waitcnt lgkmcnt(" #n ")" ::: "memory")
#define PG8_BAR __builtin_amdgcn_s_barrier()
#define PG8_SCHED __builtin_amdgcn_sched_barrier(0)
    Unit cur, nxt; int ui = 0;
    if (!S.next(0, cur)) return;
    f32x4 acc[2][2][4][2];
#pragma unroll
    for (int a = 0; a < 2; ++a)
#pragma unroll
        for (int b = 0; b < 2; ++b)
#pragma unroll
            for (int m = 0; m < 4; ++m)
#pragma unroll
                for (int n = 0; n < 2; ++n) acc[a][b][m][n] = (f32x4){0.f, 0.f, 0.f, 0.f};
    bf16x8 At[4][2], B0[2][2], B1[2][2];
    const char* cA = (const char*)g.A + (size_t)cur.pm * tstep + (size_t)cur.kt0 * kstep; const char* cB = (const char*)g.Bt + (size_t)cur.pn * tstep + (size_t)cur.kt0 * kstep;
    S.a_ready(cur);
    if constexpr (SP2) {
        PG8_STAGE(PG8_SB(0, 0), cB, voffB, 0); PG8_STAGE(PG8_SB(0, 1), cB + hstep, voffB, 0); PG8_STAGE(PG8_SA(0, 0), cA, voffA, AUXA); PG8_STAGE(PG8_SA(0, 1), cA + hstep, voffA, AUXA);
        if (wr == 1) PG8_BAR;
        PG8_WAIT_V(2); PG8_BAR;
        PG8_STAGE(PG8_SB(1, 0), cB + kstep, voffB, 0); PG8_STAGE(PG8_SA(1, 0), cA + kstep, voffA, AUXA); PG8_STAGE(PG8_SB(1, 1), cB + hstep + kstep, voffB, 0);
        PG8_WAIT_V(6); PG8_BAR;
    } else {
        PG8_STAGE(PG8_SB(0, 0), cB, voffB, 0); PG8_STAGE(PG8_SA(0, 0), cA, voffA, AUXA); PG8_STAGE(PG8_SB(0, 1), cB + hstep, voffB, 0); PG8_STAGE(PG8_SA(0, 1), cA + hstep, voffA, AUXA);
        if (wr == 1) PG8_BAR;
        PG8_WAIT_V(4); PG8_BAR;
        PG8_STAGE(PG8_SB(1, 0), cB + kstep, voffB, 0); PG8_STAGE(PG8_SA(1, 0), cA + kstep, voffA, AUXA); PG8_STAGE(PG8_SB(1, 1), cB + hstep + kstep, voffB, 0);
        PG8_WAIT_V(6); PG8_BAR;
    }
    for (;;) {
        const bool has_next = S.next(ui + 1, nxt);
        const char* nA = has_next ? (const char*)g.A + (size_t)nxt.pm * tstep + (size_t)nxt.kt0 * kstep : cA; const char* nB = has_next ? (const char*)g.Bt + (size_t)nxt.pn * tstep + (size_t)nxt.kt0 * kstep : cB;
        const int cnt = cur.nt ? cur.nt : nt;
        for (int t = 0; t < cnt; t += 2) {
            const bool last = (t == cnt - 2);
            const char* a1 = cA + (size_t)(t + 1) * kstep;
            const char* a2 = last ? nA : cA + (size_t)(t + 2) * kstep; const char* b2 = last ? nB : cB + (size_t)(t + 2) * kstep;
            const char* a3 = a2 + kstep; const char* b3 = b2 + kstep;
            if (last && has_next) S.a_ready(nxt);
            if constexpr (SP2) {
            PG8_LDB(B0, 0, 0); PG8_LDB(B1, 0, 1); PG8_SCHED; PG8_LDA(At, 0, 0); PG8_STAGE(PG8_SA(1, 1), a1 + hstep, voffA, AUXA);
            PG8_WAIT_V(8); PG8_WAIT_L(0); PG8_BAR; PG8_MMA(0, 0, At, B0); PG8_MMA(0, 1, At, B1); PG8_BAR; PG8_SCHED;
            PG8_LDA(At, 0, 1); PG8_STAGE(PG8_SB(0, 0), b2, voffB, 0); PG8_STAGE(PG8_SB(0, 1), b2 + hstep, voffB, 0); PG8_STAGE(PG8_SA(0, 0), a2, voffA, AUXA);
            PG8_WAIT_V(8); PG8_WAIT_L(0); PG8_BAR; PG8_MMA(1, 0, At, B0); PG8_MMA(1, 1, At, B1); PG8_BAR; PG8_SCHED;
            PG8_LDB(B0, 1, 0); PG8_LDB(B1, 1, 1); PG8_SCHED; PG8_LDA(At, 1, 0); PG8_STAGE(PG8_SA(0, 1), a2 + hstep, voffA, AUXA);
            PG8_WAIT_V(8); PG8_WAIT_L(0); PG8_BAR; PG8_MMA(0, 0, At, B0); PG8_MMA(0, 1, At, B1); PG8_BAR; PG8_SCHED;
            PG8_LDA(At, 1, 1); PG8_STAGE(PG8_SB(1, 0), b3, voffB, 0); PG8_STAGE(PG8_SB(1, 1), b3 + hstep, voffB, 0); PG8_STAGE(PG8_SA(1, 0), a3, voffA, AUXA);
            PG8_WAIT_V(8); PG8_WAIT_L(0); PG8_BAR; PG8_MMA(1, 0, At, B0); PG8_MMA(1, 1, At, B1); PG8_BAR; PG8_SCHED;
            } else {
            PG8_LDB(B0, 0, 0); PG8_SCHED; PG8_LDA(At, 0, 0); PG8_STAGE(PG8_SA(1, 1), a1 + hstep, voffA, AUXA);
            PG8_WAIT_L(8); PG8_BAR; PG8_WAIT_L(0); PG8_MMA(0, 0, At, B0); PG8_BAR; PG8_SCHED;
            PG8_LDB(B1, 0, 1); PG8_STAGE(PG8_SB(0, 0), b2, voffB, 0);
            PG8_BAR; PG8_WAIT_L(0); PG8_MMA(0, 1, At, B1); PG8_BAR;
            PG8_LDA(At, 0, 1); PG8_STAGE(PG8_SA(0, 0), a2, voffA, AUXA);
            PG8_BAR; PG8_WAIT_L(0); PG8_MMA(1, 0, At, B0); PG8_BAR; PG8_SCHED;
            PG8_STAGE(PG8_SB(0, 1), b2 + hstep, voffB, 0);
            PG8_WAIT_V(6); PG8_BAR; PG8_MMA(1, 1, At, B1); PG8_BAR;
            PG8_LDB(B0, 1, 0); PG8_SCHED; PG8_LDA(At, 1, 0); PG8_STAGE(PG8_SA(0, 1), a2 + hstep, voffA, AUXA);
            PG8_WAIT_L(8); PG8_BAR; PG8_WAIT_L(0); PG8_MMA(0, 0, At, B0); PG8_BAR; PG8_SCHED;
            PG8_LDB(B1, 1, 1); PG8_STAGE(PG8_SB(1, 0), b3, voffB, 0);
            PG8_BAR; PG8_WAIT_L(0); PG8_MMA(0, 1, At, B1); PG8_BAR;
            PG8_LDA(At, 1, 1); PG8_STAGE(PG8_SA(1, 0), a3, voffA, AUXA);
            PG8_BAR; PG8_WAIT_L(0); PG8_MMA(1, 0, At, B0); PG8_BAR; PG8_SCHED;
            PG8_STAGE(PG8_SB(1, 1), b3 + hstep, voffB, 0);
            PG8_WAIT_V(6); PG8_BAR; PG8_MMA(1, 1, At, B1); PG8_BAR;
            }
        }
        if constexpr (ALIGN_EPI) { if (wr == 0) PG8_BAR; }
        if constexpr (!Epi::AFTER_DRAIN) { E(acc, cur, wr, wc, fr, fq); S.done(cur); }
        if (!has_next) break;
#pragma unroll
        for (int a = 0; a < 2; ++a)
#pragma unroll
            for (int b = 0; b < 2; ++b)
#pragma unroll
                for (int m = 0; m < 4; ++m)
#pragma unroll
                    for (int n = 0; n < 2; ++n) acc[a][b][m][n] = (f32x4){0.f, 0.f, 0.f, 0.f};
        cur = nxt; cA = nA; cB = nB; ++ui;
        if constexpr (ALIGN_EPI) { if (wr == 1) PG8_BAR; }
    }
    PG8_WAIT_V(0);
    if constexpr (!ALIGN_EPI) { if (wr == 0) PG8_BAR; }
    PG8_BAR;
    if constexpr (Epi::AFTER_DRAIN) { E.fused(acc, cur, wr, wc, fr, fq, lds, wid, lane); S.done(cur); }
#undef PG8_SA
#undef PG8_SB
#undef PG8_STAGE
#undef PG8_LDA
#undef PG8_LDB
#undef PG8_MMA
#undef PG8_WAIT_V
#undef PG8_WAIT_L
#undef PG8_BAR
#undef PG8_SCHED
}
}

namespace {

#define LAS __attribute__((address_space(3)))
__device__ __forceinline__ void conv_item(const float* __restrict__ W, int K, int N, u16* __restrict__ WT, int rowbase, float* scr, int kb, int nb, int lane) {
    const int k0 = 64 * kb, n0 = 32 * nb;
#pragma unroll
    for (int i = 0; i < 8; ++i) { const int kk = 8 * i + (lane >> 3), cc = (lane & 7) * 4; const float4 w4 = *(const float4*)(W + (size_t)(k0 + kk) * N + n0 + cc);
        float* sp = scr + kk * 33 + cc; sp[0] = w4.x; sp[1] = w4.y; sp[2] = w4.z; sp[3] = w4.w; }
    asm volatile("s_waitcnt lgkmcnt(0)" ::: "memory");
    const int c = lane & 7;
#pragma unroll
    for (int j = 0; j < 4; ++j) { const int n = (lane >> 3) + 8 * j; const float* s = scr + (8 * c) * 33 + n;
        uint4 o; o.x = pk2(s[0 * 33], s[1 * 33]); o.y = pk2(s[2 * 33], s[3 * 33]); o.z = pk2(s[4 * 33], s[5 * 33]); o.w = pk2(s[6 * 33], s[7 * 33]);
        *(uint4*)(WT + (size_t)(rowbase + n) * K + k0 + 8 * c) = o; }
    asm volatile("s_waitcnt lgkmcnt(0)" ::: "memory");
}
__device__ __forceinline__ void conv_ld(const float* __restrict__ W, int N, int it, int nnb, int lane, float4 (&w)[8]) {
    const int kb = it / nnb, nb = it % nnb; const float* src = W + (size_t)(64 * kb + (lane >> 3)) * N + 32 * nb + (lane & 7) * 4;
#pragma unroll
    for (int i = 0; i < 8; ++i) {
#ifdef CONV_NT
        typedef float cv_f4 __attribute__((ext_vector_type(4)));
        const cv_f4 v = __builtin_nontemporal_load((const cv_f4*)(src + (size_t)(8 * i) * N)); w[i] = make_float4(v.x, v.y, v.z, v.w);
#else
        w[i] = *(const float4*)(src + (size_t)(8 * i) * N);
#endif
    }
}
__device__ __forceinline__ void conv_st(const float4 (&w)[8], int K, u16* __restrict__ WT, int rowbase, float* scr, int k0, int lane) {
#pragma unroll
    for (int i = 0; i < 8; ++i) { const int kk = 8 * i + (lane >> 3), cc = (lane & 7) * 4; float* sp = scr + kk * 33 + cc; sp[0] = w[i].x; sp[1] = w[i].y; sp[2] = w[i].z; sp[3] = w[i].w; }
    asm volatile("s_waitcnt lgkmcnt(0)" ::: "memory");
    const int c = lane & 7;
#pragma unroll
    for (int j = 0; j < 4; ++j) { const int n = (lane >> 3) + 8 * j; const float* s = scr + (8 * c) * 33 + n;
        uint4 o; o.x = pk2(s[0 * 33], s[1 * 33]); o.y = pk2(s[2 * 33], s[3 * 33]); o.z = pk2(s[4 * 33], s[5 * 33]); o.w = pk2(s[6 * 33], s[7 * 33]);
#ifdef CONV_NT
        { typedef unsigned cv_u4 __attribute__((ext_vector_type(4))); cv_u4 ov; ov.x = o.x; ov.y = o.y; ov.z = o.z; ov.w = o.w; __builtin_nontemporal_store(ov, (cv_u4*)(WT + (size_t)(rowbase + n) * K + k0 + 8 * c)); } }
#else
        *(uint4*)(WT + (size_t)(rowbase + n) * K + k0 + 8 * c) = o; }
#endif
    asm volatile("s_waitcnt lgkmcnt(0)" ::: "memory");
}
__device__ __forceinline__ void conv_matrix(const float* W, int K, int N, u16* WT, int roff, int GU, float* scr, int gw, int ngw, int lane) {
    const int nnb = N / 32, nitems = (K / 64) * nnb;
    if (gw < nitems) {
        float4 w[8]; conv_ld(W, N, gw, nnb, lane, w);
        for (int it = gw; it < nitems; it += ngw) { const int kb = it / nnb, nb = it % nnb, n0 = 32 * nb;
            float4 wn[8];
            if (it + ngw < nitems) conv_ld(W, N, it + ngw, nnb, lane, wn);
            else {
#pragma unroll
                for (int i = 0; i < 8; ++i) wn[i] = w[i]; }
            const int rowbase = GU == 0 ? roff + n0 : 256 * (n0 / 128) + (GU == 2 ? 128 : 0) + (n0 % 128);
            conv_st(w, K, WT, rowbase, scr, 64 * kb, lane);
#pragma unroll
            for (int i = 0; i < 8; ++i) w[i] = wn[i]; }
    }
}
struct ConvDesc { const float* W; u16* WT; int K, N, roff, GU; };
#ifdef TAIL_MIXERS
#define PRO_B1 29
#else
#define PRO_B1 38
#endif
constexpr size_t CTL_CONVTAB = 40960;
__device__ __forceinline__ void conv_all(KP p, ConvDesc* tab, float* scr, int gw, int ngw, int lane, int a0, int a1, int b0, int b1) {
    unsigned char* ws = p->ws;
    int t = threadIdx.x; asm volatile("" : "+v"(t));
    if (t < 38) {
        ConvDesc d;
        if (t < 24) { const int lf = t / 3, w = t % 3;
            if (w == 0) d = ConvDesc{p->in[I_WG] + (size_t)lf * D * DFF, (u16*)(ws + WS_WGU + lf * SZ_WGU), D, DFF, 0, 1};
            else if (w == 1) d = ConvDesc{p->in[I_WU] + (size_t)lf * D * DFF, (u16*)(ws + WS_WGU + lf * SZ_WGU), D, DFF, 0, 2};
            else d = ConvDesc{p->in[I_WD] + (size_t)lf * DFF * D, (u16*)(ws + WS_WD + lf * SZ_WD), DFF, D, 0, 0};
        } else if (t < 34) { const int j = (t - 24) / 5, w = (t - 24) % 5; u16* wdq = (u16*)(ws + WS_WDQKV) + (size_t)j * QKVA_LD * D;
            if (w == 0) d = ConvDesc{p->in[I_DQ] + (size_t)j * D * 512, wdq, D, 512, 0, 0};
            else if (w == 1) d = ConvDesc{p->in[I_DKV] + (size_t)j * D * 576, wdq, D, 576, 512, 0};
            else if (w == 2) d = ConvDesc{p->in[I_UQ] + (size_t)j * 512 * 3072, (u16*)(ws + WS_WUQ) + (size_t)j * 3072 * 512, 512, 3072, 0, 0};
            else if (w == 3) d = ConvDesc{p->in[I_UKV] + (size_t)j * 512 * 4096, (u16*)(ws + WS_WUKV) + (size_t)j * 4096 * 512, 512, 4096, 0, 0};
            else d = ConvDesc{p->in[I_MWO] + (size_t)j * D * D, (u16*)(ws + WS_WMO) + (size_t)j * D * D, D, D, 0, 0};
        } else if (t == 34) d = ConvDesc{p->in[I_HWIN], (u16*)(ws + WS_WHIN), D, 3 * D, 0, 0};
        else if (t == 35) d = ConvDesc{p->in[I_HWOUT], (u16*)(ws + WS_WHOUT), D, D, 0, 0};
        else if (t == 36) d = ConvDesc{p->in[I_WQKV], (u16*)(ws + WS_WWQKV), D, 2560, 0, 0};
        else d = ConvDesc{p->in[I_WWO], (u16*)(ws + WS_WWO), D, D, 0, 0};
        tab[t] = d; if (gw == 0) ((ConvDesc*)(ws + WS_CTL + CTL_CONVTAB))[t] = d;
    }
    __syncthreads();
#pragma unroll 1
    for (int m = a0; m < b1; m = (m + 1 == a1 ? b0 : m + 1)) { const ConvDesc d = tab[m]; conv_matrix(d.W, d.K, d.N, d.WT, d.roff, d.GU, scr, gw, ngw, lane); }
    for (int j = 0; j < 2; ++j) { u16* wdq = (u16*)(ws + WS_WDQKV) + (size_t)j * QKVA_LD * D;
        for (int i = gw * 64 + lane; i < (QKVA_LD - 1088) * D / 8; i += ngw * 64) ((uint4*)(wdq + (size_t)1088 * D))[i] = make_uint4(0u, 0u, 0u, 0u); }
    __syncthreads();
}
__device__ __forceinline__ unsigned long long rfl64(unsigned long long v) { return ((unsigned long long)(unsigned)__builtin_amdgcn_readfirstlane((int)(v >> 32)) << 32) | (unsigned)__builtin_amdgcn_readfirstlane((int)v); }
__device__ __forceinline__ void conv_tail(const ConvDesc* gtab, float* scr, int gw, int ngw, int lane, int a0, int a1, int b0, int b1) {
#pragma unroll 1
    for (int m = a0; m < b1; m = (m + 1 == a1 ? b0 : m + 1)) { const ConvDesc d = gtab[m]; conv_matrix((const float*)rfl64((unsigned long long)d.W), __builtin_amdgcn_readfirstlane(d.K), __builtin_amdgcn_readfirstlane(d.N), (u16*)rfl64((unsigned long long)d.WT), __builtin_amdgcn_readfirstlane(d.roff), __builtin_amdgcn_readfirstlane(d.GU), scr, gw, ngw, lane); }
    __syncthreads();
}

#define XB_TMO      128
#define XB_XCNT(j)  (256  + 64 * (j))
#define XB_XSUB(j)  (1280 + 64 * (j))
#define XB_XGEN(j)  (2304 + 64 * (j))
#define XB_TOP      3328
#define XB_TOPGEN   3392
#define XCD_BAR_WORDS 3456
#define XB_SPIN_CAP (1u << 22)

__device__ __forceinline__ unsigned xb_ld(unsigned* p)              { return __hip_atomic_load(p, __ATOMIC_RELAXED, __HIP_MEMORY_SCOPE_AGENT); }
__device__ __forceinline__ unsigned xb_add(unsigned* p, unsigned v) { return __hip_atomic_fetch_add(p, v, __ATOMIC_RELAXED, __HIP_MEMORY_SCOPE_AGENT); }
__device__ __forceinline__ unsigned xb_xcc_id() { return (unsigned)__builtin_amdgcn_s_getreg((3 << 11) | 20) & 0xFu; }
#define XB_SPIN(cond, bar) do { unsigned _sp = 0; while (cond) { __builtin_amdgcn_s_sleep(1); \
    if ((++_sp & 255u) == 0u) { if (xb_ld(&(bar)[XB_TMO])) break; if (_sp > XB_SPIN_CAP) { atomicAdd(&(bar)[XB_TMO], 1u); break; } } } } while (0)

struct XcdBarrier {
    unsigned* bar; unsigned x;
    volatile LAS unsigned* st;
};

__device__ __forceinline__ XcdBarrier xcd_barrier_post(unsigned* bar, volatile LAS unsigned* st) {
    XcdBarrier b; b.bar = bar; b.x = xb_xcc_id(); b.st = st;
    if (threadIdx.x == 0) (void)xb_add(&bar[XB_XCNT(b.x)], 1u);
    return b;
}
__device__ __forceinline__ void xcd_barrier_complete(unsigned* bar, unsigned x, unsigned& nloc, unsigned& nx) {
    const unsigned G = gridDim.x * gridDim.y * gridDim.z;
    unsigned sum, cnt, mine, sp = 0u;
    for (;;) {
        sum = 0u; cnt = 0u; mine = 0u;
#pragma unroll
        for (unsigned j = 0; j < 16; ++j) { const unsigned c = xb_ld(&bar[XB_XCNT(j)]); sum += c; cnt += (c > 0u) ? 1u : 0u; mine = (j == x) ? c : mine; }
        if (sum == G) break;
        __builtin_amdgcn_s_sleep(1);
        if ((++sp & 255u) == 0u) { if (xb_ld(&bar[XB_TMO])) break; if (sp > XB_SPIN_CAP) { atomicAdd(&bar[XB_TMO], 1u); break; } }
    }
    nloc = mine > 0u ? mine : 1u; nx = cnt > 0u ? cnt : 1u;
}

__device__ __forceinline__ void xcd_barrier(const XcdBarrier& b) {
    asm volatile("s_waitcnt vmcnt(0)" ::: "memory");
    __syncthreads();
    if (threadIdx.x == 0) {
        unsigned* bar = b.bar;
        unsigned xq = xb_xcc_id(); asm volatile("" : "+s"(xq));
        __builtin_amdgcn_s_waitcnt(0);
        unsigned nloc = b.st[0], nx = b.st[1];
        if (nloc == 0u) { xcd_barrier_complete(bar, xq, nloc, nx); b.st[0] = nloc; b.st[1] = nx; }
        const unsigned old = xb_add(&bar[XB_XSUB(xq)], 1u);
        const unsigned gen = old / nloc;
        if (old + 1u == (gen + 1u) * nloc) {
            __builtin_amdgcn_fence(__ATOMIC_RELEASE, "agent");
            asm volatile("s_waitcnt vmcnt(0)" ::: "memory");
            const unsigned og = xb_add(&bar[XB_TOP], 1u);
            const unsigned tg = og / nx;
            if (og + 1u == (tg + 1u) * nx) xb_add(&bar[XB_TOPGEN], 1u);
            else XB_SPIN(xb_ld(&bar[XB_TOPGEN]) == tg, bar);
            __builtin_amdgcn_fence(__ATOMIC_ACQUIRE, "agent");
            xb_add(&bar[XB_XGEN(xq)], 1u);
            asm volatile("s_waitcnt vmcnt(0)" ::: "memory");
        } else {
            XB_SPIN(xb_ld(&bar[XB_XGEN(xq)]) == gen, bar);
            __builtin_amdgcn_fence(__ATOMIC_ACQUIRE, "agent");
            asm volatile("s_waitcnt vmcnt(0)" ::: "memory");
        }
    }
    __syncthreads();
}


#define PH __device__ __forceinline__
#define LDSWAIT() asm volatile("s_waitcnt lgkmcnt(0)" ::: "memory")
__device__ __forceinline__ int otid() { int t = threadIdx.x; asm volatile("" : "+v"(t)); return t; }
PH void ph_modp(KP p, float* sc, int wg, int nwg) {
    const int TID = otid();
    for (int i = TID; i < 5 * D; i += 512) { const int m = i / D, k = i % D; const float v = m < 4 ? p->in[I_C][m * D + k] : p->in[I_CCTX][k]; sc[i] = silu_f(v); }
    __syncthreads();
    const int wave = TID >> 6, lane = TID & 63;
    float* MODP = (float*)(p->ws + WS_MODP);
    const int nitems = DEPTH * 72 * 16;
    for (int item = wg * 8 + wave; item < nitems; item += nwg * 8) {
        const int kc = item % 16, cg = (item / 16) % 72, layer = item / (16 * 72);
        const int col = cg * 256 + lane * 4;
        const float* w = p->in[I_MODW] + (size_t)layer * D * NMODV + (size_t)(kc * 128) * NMODV + col;
        float acc[5][4];
#pragma unroll
        for (int m = 0; m < 5; ++m) { acc[m][0] = acc[m][1] = acc[m][2] = acc[m][3] = 0.f; }
#pragma unroll 8
        for (int k = 0; k < 128; ++k) {
            const float4 wv = *(const float4*)(w + (size_t)k * NMODV);
#pragma unroll
            for (int m = 0; m < 5; ++m) { const float s = sc[m * D + kc * 128 + k]; acc[m][0] += s * wv.x; acc[m][1] += s * wv.y; acc[m][2] += s * wv.z; acc[m][3] += s * wv.w; }
        }
#pragma unroll
        for (int m = 0; m < 5; ++m) *(float4*)(MODP + ((size_t)(kc * DEPTH + layer) * 5 + m) * NMODV + col) = make_float4(acc[m][0], acc[m][1], acc[m][2], acc[m][3]);
    }
    __syncthreads();
}
PH void ph_modr(KP p, int wg, int nwg) {
    const int TID = otid();
    const float* MODP = (const float*)(p->ws + WS_MODP); float* MOD = (float*)(p->ws + WS_MOD);
    const int n = DEPTH * 5 * NMODV;
    for (int i = wg * 512 + TID; i < n; i += nwg * 512) {
        const int col = i % NMODV, layer = i / (5 * NMODV);
        float s = p->in[I_MODB][layer * NMODV + col];
        for (int kc = 0; kc < 16; ++kc) s += MODP[(size_t)kc * n + i];
        MOD[i] = s;
    }
}
PH void ph_tables(KP p, int wg, int nwg) {
    const int TID = otid();
    float* rope = (float*)(p->ws + WS_ROPE); float* tw = (float*)(p->ws + WS_TW);
    for (int i = wg * 512 + TID; i < 8192; i += nwg * 512) {
        if (i < 64 * 16) { const int pos = i / 16, k = i % 16; const float inv = (float)exp2(-(double)k / 16.0 * 13.287712379549449); const float ang = (float)pos * inv;
            rope[2 * i] = (float)cos((double)ang); rope[2 * i + 1] = (float)sin((double)ang); }
        const double a = -2.0 * 3.14159265358979323846 * (double)i / 8192.0; tw[2 * i] = (float)cos(a); tw[2 * i + 1] = (float)sin(a);
    }
}
template <int NR> PH void mod_rows(KP p, const int (&r)[NR], int nvalid, int layer, int slot, const float* pgate, float pcoef, bool first, bool fold, int lane) {
    u16* X = (u16*)(p->ws + WS_X); u16* HB = (u16*)(p->ws + WS_HB); const float* MOD = (const float*)(p->ws + WS_MOD); const u16* SLAB = (const u16*)(p->ws + WS_SLAB);
    const float* g = p->in[I_NORMG] + ((size_t)layer * 3 + slot) * D;
    float4 v[NR][4][2]; float rs[NR];
    const int b0 = r[0] / SB, j0 = r[0] - b0 * SB;
#pragma unroll
    for (int k = 0; k < NR; ++k) { if (k >= nvalid) { rs[k] = 0.f; continue; }
        uint4* xr = (uint4*)(X + (size_t)r[k] * D);
        const int b = r[k] / SB, j = r[k] - b * SB;
        if (first) {
            const float4* xs = j < CTX ? (const float4*)(p->in[I_CTX] + ((size_t)b * CTX + j) * D) : (const float4*)(p->in[I_X] + ((size_t)b * S + (j - CTX)) * D);
#pragma unroll
            for (int i = 0; i < 4; ++i) { const int c8 = lane + 64 * i; v[k][i][0] = xs[2 * c8]; v[k][i][1] = xs[2 * c8 + 1]; }
        } else {
#pragma unroll
            for (int i = 0; i < 4; ++i) { const uint4 q = xr[lane + 64 * i];
                v[k][i][0] = make_float4(pg8::h2f_lo(q.x), pg8::h2f_hi(q.x), pg8::h2f_lo(q.y), pg8::h2f_hi(q.y)); v[k][i][1] = make_float4(pg8::h2f_lo(q.z), pg8::h2f_hi(q.z), pg8::h2f_lo(q.w), pg8::h2f_hi(q.w)); }
        }
        if (NR == 1 && fold) {
#pragma unroll
            for (int i = 0; i < 4; ++i) { const int c8 = lane + 64 * i; float4 a0 = make_float4(0.f, 0.f, 0.f, 0.f), a1 = a0;
#pragma unroll
                for (int s = 0; s < 8; ++s) { const uint4 q = ((const uint4*)(SLAB + ((size_t)(s * 4 + b) * 256 + j) * D))[c8];
                    a0.x += __uint_as_float(q.x << 16); a0.y += __uint_as_float(q.x & 0xffff0000u); a0.z += __uint_as_float(q.y << 16); a0.w += __uint_as_float(q.y & 0xffff0000u);
                    a1.x += __uint_as_float(q.z << 16); a1.y += __uint_as_float(q.z & 0xffff0000u); a1.z += __uint_as_float(q.w << 16); a1.w += __uint_as_float(q.w & 0xffff0000u); }
                const float4 g0 = ((const float4*)pgate)[2 * c8], g1 = ((const float4*)pgate)[2 * c8 + 1];
                v[k][i][0].x += pcoef * g0.x * a0.x; v[k][i][0].y += pcoef * g0.y * a0.y; v[k][i][0].z += pcoef * g0.z * a0.z; v[k][i][0].w += pcoef * g0.w * a0.w;
                v[k][i][1].x += pcoef * g1.x * a1.x; v[k][i][1].y += pcoef * g1.y * a1.y; v[k][i][1].z += pcoef * g1.z * a1.z; v[k][i][1].w += pcoef * g1.w * a1.w; }
        }
        if (first || (NR == 1 && fold)) { const float lim = pg8::h16_lim();
#pragma unroll
            for (int i = 0; i < 4; ++i) xr[lane + 64 * i] = make_uint4(pg8::pkh2(v[k][i][0].x, v[k][i][0].y, lim), pg8::pkh2(v[k][i][0].z, v[k][i][0].w, lim), pg8::pkh2(v[k][i][1].x, v[k][i][1].y, lim), pg8::pkh2(v[k][i][1].z, v[k][i][1].w, lim));
        }
        float ss = 0.f;
#pragma unroll
        for (int i = 0; i < 4; ++i)
#pragma unroll
            for (int h = 0; h < 2; ++h) ss += v[k][i][h].x * v[k][i][h].x + v[k][i][h].y * v[k][i][h].y + v[k][i][h].z * v[k][i][h].z + v[k][i][h].w * v[k][i][h].w;
        rs[k] = rsqrtf(wave_sum(ss) * (1.f / D) + NORM_EPS);
    }
    const float* mb = MOD + ((size_t)(layer * 5 + (j0 < CTX ? 4 : b0)) * 9 + 3 * slot) * D;
#pragma unroll
    for (int i = 0; i < 4; ++i) { const int c8 = lane + 64 * i;
        float4 gs[2], sh[2];
#pragma unroll
        for (int h = 0; h < 2; ++h) { const float4 gg = ((const float4*)g)[2 * c8 + h], sl = ((const float4*)(mb + D))[2 * c8 + h]; sh[h] = ((const float4*)mb)[2 * c8 + h];
            gs[h] = make_float4(gg.x * (1.f + sl.x), gg.y * (1.f + sl.y), gg.z * (1.f + sl.z), gg.w * (1.f + sl.w)); }
#pragma unroll
        for (int k = 0; k < NR; ++k) { if (k >= nvalid) continue; unsigned ow[4];
#pragma unroll
            for (int h = 0; h < 2; ++h) { const float4 x = v[k][i][h];
                const float a = x.x * rs[k] * gs[h].x + sh[h].x, bq = x.y * rs[k] * gs[h].y + sh[h].y, c = x.z * rs[k] * gs[h].z + sh[h].z, d = x.w * rs[k] * gs[h].w + sh[h].w;
                ow[2 * h] = pk2(a, bq); ow[2 * h + 1] = pk2(c, d); }
            ((uint4*)(HB + (size_t)r[k] * D))[c8] = make_uint4(ow[0], ow[1], ow[2], ow[3]); } }
}
PH void ph_modulate(KP p, int layer, int slot, const float* pgate, float pcoef, int wg, int nwg, bool first = false) {
    const int TID = otid();
    const int wave = TID >> 6, lane = TID & 63, w = wg * 8 + wave, nw = nwg * 8;
    const int cw = pgate != nullptr ? 6 : 1;
    const int base = (NB * S + cw * NB * CTX + nw - 1) / nw;
    const int nctx_before = w < NB * CTX ? w : NB * CTX;
    int l0 = w * base - cw * nctx_before, l1 = l0 + base - (w < NB * CTX ? cw : 0);
    if (nw < NB * CTX) { l0 = (int)((long)w * (NB * S) / nw); l1 = (int)((long)(w + 1) * (NB * S) / nw); }
    if (l0 > NB * S) l0 = NB * S; if (l1 > NB * S) l1 = NB * S; if (w == nw - 1) l1 = NB * S;
    const int nc = w < NB * CTX ? (NB * CTX - 1 - w) / nw + 1 : 0;
    for (int it = 0; it < nc; ++it) { const int c = w + it * nw; const int r1[1] = {(c >> 8) * SB + (c & 255)}; mod_rows<1>(p, r1, 1, layer, slot, pgate, pcoef, first, pgate != nullptr, lane); }
    for (int l = l0; l < l1; ) {
        int n = l1 - l; if (n > 4) n = 4; const int left = 4096 - (l & 4095); if (n > left) n = left;
        const int rb = (l >> 12) * SB + CTX + (l & 4095); const int r4[4] = {rb, rb + 1, rb + 2, rb + 3};
        mod_rows<4>(p, r4, n, layer, slot, nullptr, 0.f, first, false, lane);
        l += n;
    }
}
PH void ph_final(KP p, int wg, int nwg) {
    const int TID = otid();
    const u16* X = (const u16*)(p->ws + WS_X); const float* g = p->in[I_FINALG];
    const int wave = TID >> 6, lane = TID & 63;
    for (int q = wg * 8 + wave; q < NB * S; q += nwg * 8) {
        const int b = q / S, t = q - b * S, r = b * SB + CTX + t;
        const uint4* xr = (const uint4*)(X + (size_t)r * D);
        float4 v[4][2]; float ss = 0.f;
#pragma unroll
        for (int i = 0; i < 4; ++i) { const uint4 w = xr[lane + 64 * i];
            v[i][0] = make_float4(pg8::h2f_lo(w.x), pg8::h2f_hi(w.x), pg8::h2f_lo(w.y), pg8::h2f_hi(w.y)); v[i][1] = make_float4(pg8::h2f_lo(w.z), pg8::h2f_hi(w.z), pg8::h2f_lo(w.w), pg8::h2f_hi(w.w));
#pragma unroll
            for (int h = 0; h < 2; ++h) ss += v[i][h].x * v[i][h].x + v[i][h].y * v[i][h].y + v[i][h].z * v[i][h].z + v[i][h].w * v[i][h].w; }
        const float rs = rsqrtf(wave_sum(ss) * (1.f / D) + NORM_EPS);
        float4* o = (float4*)(p->out + (size_t)q * D);
#pragma unroll
        for (int i = 0; i < 4; ++i)
#pragma unroll
            for (int h = 0; h < 2; ++h) { const int c4 = 2 * (lane + 64 * i) + h; const float4 gg = ((const float4*)g)[c4]; const float4 x = v[i][h]; o[c4] = make_float4(x.x * rs * gg.x, x.y * rs * gg.y, x.z * rs * gg.z, x.w * rs * gg.w); }
    }
}
PH void ph_mla_norm(KP p, int jm, int wg, int nwg) {
    const int TID = otid();
    const _Float16* A = (const _Float16*)(p->ws + WS_QKVA); u16* QL = (u16*)(p->ws + WS_QL); u16* CKV = (u16*)(p->ws + WS_CKV); u16* KR = (u16*)(p->ws + WS_KR);
    const float* gq = p->in[I_GQ] + jm * 512; const float* gkv = p->in[I_GKV] + jm * 512; const float* rope = (const float*)(p->ws + WS_ROPE);
    const int wave = TID >> 6, lane = TID & 63;
    for (int r = wg * 8 + wave; r < R; r += nwg * 8) {
        const _Float16* a = A + (size_t)r * QKVA_LD;
        const uint4 qw = ((const uint4*)a)[lane], kw = ((const uint4*)(a + 512))[lane];
        const float4 q0 = make_float4(pg8::h2f_lo(qw.x), pg8::h2f_hi(qw.x), pg8::h2f_lo(qw.y), pg8::h2f_hi(qw.y)), q1 = make_float4(pg8::h2f_lo(qw.z), pg8::h2f_hi(qw.z), pg8::h2f_lo(qw.w), pg8::h2f_hi(qw.w));
        const float4 k0 = make_float4(pg8::h2f_lo(kw.x), pg8::h2f_hi(kw.x), pg8::h2f_lo(kw.y), pg8::h2f_hi(kw.y)), k1 = make_float4(pg8::h2f_lo(kw.z), pg8::h2f_hi(kw.z), pg8::h2f_lo(kw.w), pg8::h2f_hi(kw.w));
        const float sq = wave_sum(q0.x * q0.x + q0.y * q0.y + q0.z * q0.z + q0.w * q0.w + q1.x * q1.x + q1.y * q1.y + q1.z * q1.z + q1.w * q1.w);
        const float sk = wave_sum(k0.x * k0.x + k0.y * k0.y + k0.z * k0.z + k0.w * k0.w + k1.x * k1.x + k1.y * k1.y + k1.z * k1.z + k1.w * k1.w);
        const float rq = rsqrtf(sq * (1.f / 512) + NORM_EPS), rk = rsqrtf(sk * (1.f / 512) + NORM_EPS);
        const float4 g0 = ((const float4*)gq)[lane * 2], g1 = ((const float4*)gq)[lane * 2 + 1], h0 = ((const float4*)gkv)[lane * 2], h1 = ((const float4*)gkv)[lane * 2 + 1];
        uint4 oq, ok;
        oq.x = pk2(q0.x * rq * g0.x, q0.y * rq * g0.y); oq.y = pk2(q0.z * rq * g0.z, q0.w * rq * g0.w); oq.z = pk2(q1.x * rq * g1.x, q1.y * rq * g1.y); oq.w = pk2(q1.z * rq * g1.z, q1.w * rq * g1.w);
        ok.x = pk2(k0.x * rk * h0.x, k0.y * rk * h0.y); ok.y = pk2(k0.z * rk * h0.z, k0.w * rk * h0.w); ok.z = pk2(k1.x * rk * h1.x, k1.y * rk * h1.y); ok.w = pk2(k1.z * rk * h1.z, k1.w * rk * h1.w);
        ((uint4*)(QL + (size_t)r * 512))[lane] = oq; ((uint4*)(CKV + (size_t)r * 512))[lane] = ok;
        if (lane < 32) {
            const int b = r / SB, j = r - b * SB; const int half = lane >> 4, i = lane & 15;
            const float x1 = (float)a[1024 + 32 * half + i], x2 = (float)a[1024 + 32 * half + 16 + i];
            float o1 = x1, o2 = x2;
            if (j >= CTX) { const int t = j - CTX, pos = half ? (t & 63) : (t >> 6); const float cs = rope[(pos * 16 + i) * 2], sn = rope[(pos * 16 + i) * 2 + 1]; o1 = x1 * cs - x2 * sn; o2 = x2 * cs + x1 * sn; }
            KR[(size_t)r * 64 + 32 * half + i] = f2bf(o1); KR[(size_t)r * 64 + 32 * half + 16 + i] = f2bf(o2);
        }
    }
}
PH void ph_transpose(const u16* __restrict__ ZT, u16* __restrict__ Z, u16* tile, int wg, int nwg) {
    const int TID = otid();
    const int ld = TID >> 3, lr = (TID & 7) * 8;
    const int sr = TID & 63, sd = (TID >> 6) * 8;
    for (int u = wg; u < (R / 64) * (D / 64); u += nwg) {
        const int r0 = (u % (R / 64)) * 64, d0 = (u / (R / 64)) * 64;
        const uint4 v = *(const uint4*)(ZT + (size_t)(d0 + ld) * R + r0 + lr);
        *(uint4*)(tile + ld * 72 + lr) = v;
        __syncthreads();
        unsigned w[4];
#pragma unroll
        for (int k = 0; k < 4; ++k) w[k] = (unsigned)tile[(sd + 2 * k) * 72 + sr] | ((unsigned)tile[(sd + 2 * k + 1) * 72 + sr] << 16);
        *(uint4*)(Z + (size_t)(r0 + sr) * D + d0 + sd) = make_uint4(w[0], w[1], w[2], w[3]);
        __syncthreads();
    }
}
template <int NP> PH void filt_unit(KP p, float* lds, int L, int l0, float* FT, int tid) {
    float* zf = lds; float* ha = lds + 8 * 33; float* hb = ha + 512; float* h3t = hb + 512; float* tp = h3t + 512;
    const float* w1 = p->in[I_FW1]; const float* b1 = p->in[I_FB1]; const float* w2 = p->in[I_FW2]; const float* b2 = p->in[I_FB2]; const float* w3 = p->in[I_FW3]; const float* b3 = p->in[I_FB3]; const float* fr = p->in[I_FFREQ];
    const float* w4 = p->in[I_FW4]; const float* decay = p->in[I_DECAY];
    { int tf = tid; asm volatile("" : "+v"(tf));
      for (int idx = tf; idx < NP * 33; idx += 512) { const int pp = idx / 33, c = idx % 33, l = l0 + pp; const float t = (float)l / (float)(L - 1);
        float v;
        if (c == 0) { v = t; tp[pp] = t; }
        else { const int k = (c - 1) & 15; const float f = 1e-4f + (float)k * ((15.0f - 1e-4f) / 15.0f); const float w = 6.283185307179586f * (float)l / (float)L; const double a = (double)(f * w);
            v = c <= 16 ? (float)cos(a) : (float)(-sin(a)); }
        zf[pp * 33 + c] = v; } }
    __syncthreads();
    { int tj = tid; asm volatile("" : "+v"(tj)); const int pp = tj >> 6, j = tj & 63; if (pp < NP) { float s = b1[j]; for (int c = 0; c < 33; ++c) s += zf[pp * 33 + c] * w1[c * 64 + j]; ha[pp * 64 + j] = sinf(fr[j] * s); } }
    __syncthreads();
    { int tj = tid; asm volatile("" : "+v"(tj)); const int pp = tj >> 6, j = tj & 63; if (pp < NP) { float s = b2[j]; for (int c = 0; c < 64; ++c) s += ha[pp * 64 + c] * w2[c * 64 + j]; hb[pp * 64 + j] = sinf(fr[j] * s); } }
    __syncthreads();
    { int tj = tid; asm volatile("" : "+v"(tj)); const int pp = tj >> 6, j = tj & 63; if (pp < NP) { float s = b3[j]; for (int c = 0; c < 64; ++c) s += hb[pp * 64 + c] * w3[c * 64 + j]; h3t[j * 8 + pp] = sinf(fr[j] * s); } }
    __syncthreads();
#pragma unroll 1
    for (int m = 0; m < 4; ++m) {
        int tq = tid; asm volatile("" : "+v"(tq));
        const int n4 = (tq + 512 * m) * 4; float acc[NP][4];
#pragma unroll
        for (int q = 0; q < NP; ++q) { acc[q][0] = 0.f; acc[q][1] = 0.f; acc[q][2] = 0.f; acc[q][3] = 0.f; }
        const float* wp = w4 + n4;
#pragma unroll 1
        for (int k0 = 0; k0 < 64; k0 += 8) {
            float4 wv[8];
#pragma unroll
            for (int kk = 0; kk < 8; ++kk) wv[kk] = *(const float4*)(wp + (size_t)kk * 8192);
            wp += 8 * 8192;
#pragma unroll
            for (int kk = 0; kk < 8; ++kk) { float hh[8];
                if (NP == 8) { const float4 h0 = *(const float4*)(h3t + (k0 + kk) * 8), h1 = *(const float4*)(h3t + (k0 + kk) * 8 + 4); hh[0] = h0.x; hh[1] = h0.y; hh[2] = h0.z; hh[3] = h0.w; hh[4] = h1.x; hh[5] = h1.y; hh[6] = h1.z; hh[7] = h1.w; }
                else hh[0] = h3t[(k0 + kk) * 8];
#pragma unroll
                for (int q = 0; q < NP; ++q) { acc[q][0] += hh[q] * wv[kk].x; acc[q][1] += hh[q] * wv[kk].y; acc[q][2] += hh[q] * wv[kk].z; acc[q][3] += hh[q] * wv[kk].w; } }
        }
        const float4 dc4 = *(const float4*)(decay + n4); const float dc[4] = {fabsf(dc4.x), fabsf(dc4.y), fabsf(dc4.z), fabsf(dc4.w)};
        float* o = FT + (size_t)n4 * L + l0;
#pragma unroll
        for (int c = 0; c < 4; ++c) { float e[NP];
#pragma unroll
            for (int q = 0; q < NP; ++q) e[q] = acc[q][c] * __builtin_amdgcn_exp2f(-1.4426950408889634f * tp[q] * dc[c]);
            if (NP == 8) { *(float4*)o = make_float4(e[0], e[1], e[2], e[3]); *(float4*)(o + 4) = make_float4(e[4], e[5], e[6], e[7]); } else o[0] = e[0];
            o += L; }
    }
    __syncthreads();
}
PH void ph_filters(KP p, float* lds, int wg, int nwg) {
    const int TID = otid();
    for (int unit = wg; unit < 512; unit += nwg) filt_unit<8>(p, lds, 4096, unit * 8, (float*)(p->ws + WS_FT4096), TID);
    for (int q = wg; q < 256; q += nwg) filt_unit<1>(p, lds, 256, q, (float*)(p->ws + WS_FT256), TID);
}
PH void ph_nattn_mla(const u16* __restrict__ Q, const u16* __restrict__ KN, const u16* __restrict__ KR, const u16* __restrict__ V, u16* __restrict__ O, float* lds, int wg, int nwg) {
    const int TID = otid();
    const int wave = TID >> 6, lane = TID & 63;
    float* pp = lds + wave * (SB + 192); float* qq = pp + SB;
    for (int item = wg * 8 + wave; item < R * 16; item += nwg * 8) {
        const int r = item >> 4, h = item & 15;
        const int b = r / SB, j = r - b * SB, nk = j < CTX ? CTX : SB, kb = b * SB;
        for (int c = lane; c < 192; c += 64) qq[c] = bf2f(Q[(size_t)r * 3072 + h * 192 + c]);
        LDSWAIT();
        const float scale = 0.07216878364870322f;
        float mx = -3.0e38f;
        for (int key = lane; key < nk; key += 64) {
            const uint4* kn = (const uint4*)(KN + (size_t)(kb + key) * D + h * 128); const uint4* kr = (const uint4*)(KR + (size_t)(kb + key) * 64);
            float s = 0.f;
#pragma unroll 4
            for (int c8 = 0; c8 < 24; ++c8) { const uint4 w = c8 < 16 ? kn[c8] : kr[c8 - 16]; const float* q8 = qq + c8 * 8;
                s += q8[0] * __uint_as_float(w.x << 16) + q8[1] * __uint_as_float(w.x & 0xffff0000u) + q8[2] * __uint_as_float(w.y << 16) + q8[3] * __uint_as_float(w.y & 0xffff0000u)
                   + q8[4] * __uint_as_float(w.z << 16) + q8[5] * __uint_as_float(w.z & 0xffff0000u) + q8[6] * __uint_as_float(w.w << 16) + q8[7] * __uint_as_float(w.w & 0xffff0000u); }
            s *= scale; pp[key] = s; mx = fmaxf(mx, s);
        }
        mx = wave_max(mx);
        float sum = 0.f;
        for (int key = lane; key < nk; key += 64) { const float e = expf(pp[key] - mx); pp[key] = e; sum += e; }
        sum = wave_sum(sum);
        LDSWAIT();
        float o0 = 0.f, o1 = 0.f;
        const u16* vb = V + (size_t)kb * D + h * 128 + lane;
        for (int key = 0; key < nk; ++key) { const float pv = pp[key]; o0 += pv * bf2f(vb[(size_t)key * D]); o1 += pv * bf2f(vb[(size_t)key * D + 64]); }
        const float inv = 1.f / sum;
        O[(size_t)r * D + h * 128 + lane] = f2bf(o0 * inv); O[(size_t)r * D + h * 128 + 64 + lane] = f2bf(o1 * inv);
        LDSWAIT();
    }
}
PH void ph_nattn_win(const u16* __restrict__ QKV, const float* __restrict__ sink, u16* __restrict__ O, float* lds, int wg, int nwg) {
    const int TID = otid();
    const int wave = TID >> 6, lane = TID & 63;
    float* pp = lds + wave * 640; float* qq = pp + 576;
    for (int item = wg * 8 + wave; item < R * 32; item += nwg * 8) {
        const int r = item >> 5, qh = item & 31, kvh = qh >> 3;
        const int b = r / SB, j = r - b * SB, kb = b * SB;
        qq[lane] = bf2f(QKV[(size_t)r * 2560 + qh * 64 + lane]);
        LDSWAIT();
        int lo = 0, nwin = 0; if (j >= CTX) { const int t = j - CTX; lo = t - 128 < 0 ? 0 : t - 128; const int hi = t + 128 > S - 1 ? S - 1 : t + 128; nwin = hi - lo + 1; }
        const int nk = CTX + nwin;
        float mx = sink[qh];
        for (int key = lane; key < nk; key += 64) {
            const int krow = kb + (key < CTX ? key : CTX + lo + (key - CTX));
            const uint4* kk = (const uint4*)(QKV + (size_t)krow * 2560 + 2048 + kvh * 64);
            float s = 0.f;
#pragma unroll
            for (int c8 = 0; c8 < 8; ++c8) { const uint4 w = kk[c8]; const float* q8 = qq + c8 * 8;
                s += q8[0] * __uint_as_float(w.x << 16) + q8[1] * __uint_as_float(w.x & 0xffff0000u) + q8[2] * __uint_as_float(w.y << 16) + q8[3] * __uint_as_float(w.y & 0xffff0000u)
                   + q8[4] * __uint_as_float(w.z << 16) + q8[5] * __uint_as_float(w.z & 0xffff0000u) + q8[6] * __uint_as_float(w.w << 16) + q8[7] * __uint_as_float(w.w & 0xffff0000u); }
            s *= 0.125f; pp[key] = s; mx = fmaxf(mx, s);
        }
        mx = wave_max(mx);
        float sum = 0.f;
        for (int key = lane; key < nk; key += 64) { const float e = expf(pp[key] - mx); pp[key] = e; sum += e; }
        sum = wave_sum(sum) + expf(sink[qh] - mx);
        LDSWAIT();
        float o = 0.f;
        for (int key = 0; key < nk; ++key) { const int krow = kb + (key < CTX ? key : CTX + lo + (key - CTX)); o += pp[key] * bf2f(QKV[(size_t)krow * 2560 + 2304 + kvh * 64 + lane]); }
        O[(size_t)r * D + qh * 64 + lane] = f2bf(o / sum);
        LDSWAIT();
    }
}

namespace att {
typedef short bf16x8 __attribute__((ext_vector_type(8)));
typedef short s16x4 __attribute__((ext_vector_type(4)));
typedef float f32x16 __attribute__((ext_vector_type(16)));
typedef unsigned u32x4 __attribute__((ext_vector_type(4)));
#define ALDS __attribute__((address_space(3)))
#define ASBAR() __builtin_amdgcn_sched_barrier(0)
__device__ __forceinline__ int crow(int r, int hi) { return (r & 3) + 8 * (r >> 2) + 4 * hi; }
__device__ __forceinline__ unsigned cvtpk(float lo, float hi) { unsigned r; asm("v_cvt_pk_bf16_f32 %0, %1, %2" : "=v"(r) : "v"(lo), "v"(hi)); return r; }
template <int STRIDE> __device__ __forceinline__ int kswz(int row, int colB) { return row * STRIDE + (colB ^ (((row >> 1) & 7) << 4)); }
template <int DV> __device__ __forceinline__ int v_st(int k, int c) { const int kk = (k & ~0xC) | ((k & 4) << 1) | ((k & 8) >> 1); return ((kk >> 3) * (DV / 32) + (c >> 5)) * 512 + ((kk & 7) * 32 + (c & 31)) * 2; }
__device__ __forceinline__ int v_rd_base(int lane) { return ((lane & 3) << 3) | (((lane >> 2) & 3) << 6) | (((lane >> 4) & 1) << 5) | (((lane >> 5) & 1) << 8); }
template <int DV> constexpr int v_rd_off(int d0, int ks, int half) { return d0 * 512 + ks * (2 * (DV / 32) * 512) + half * ((DV / 32) * 512); }
template <int OFF> __device__ __forceinline__ s16x4 tr_read(int vb) { s16x4 r; asm volatile("ds_read_b64_tr_b16 %0, %1 offset:%2" : "=&v"(r) : "v"(vb), "i"(OFF) : "memory"); return r; }
__device__ __forceinline__ void partialSM(f32x16& p0, f32x16& p1, float& m_reg, float& mn, float& alpha, const float C, const float THRR) {
    float pmax = p0[0];
#pragma unroll
    for (int r = 1; r < 16; ++r) pmax = fmaxf(pmax, p0[r]);
#pragma unroll
    for (int r = 0; r < 16; ++r) pmax = fmaxf(pmax, p1[r]);
    { auto rr = __builtin_amdgcn_permlane32_swap(__float_as_uint(pmax), __float_as_uint(pmax), false, false); pmax = fmaxf(__uint_as_float(rr[0]), __uint_as_float(rr[1])); }
    if (__builtin_expect(__all(pmax - m_reg <= THRR), 1)) { mn = m_reg; alpha = 1.f; }
    else { mn = fmaxf(m_reg, pmax); alpha = __builtin_amdgcn_exp2f((m_reg - mn) * C); m_reg = mn; }
    const float mnC = -mn * C;
#pragma unroll
    for (int r = 0; r < 16; ++r) p0[r] = fmaf(p0[r], C, mnC);
#pragma unroll
    for (int r = 0; r < 16; ++r) p1[r] = fmaf(p1[r], C, mnC);
#pragma unroll
    for (int r = 0; r < 16; ++r) p0[r] = __builtin_amdgcn_exp2f(p0[r]);
}
__device__ __forceinline__ void finishSM(f32x16& p0, f32x16& p1, float alpha, float& l_reg, bf16x8& pa0, bf16x8& pa1, bf16x8& pa2, bf16x8& pa3) {
#pragma unroll
    for (int r = 0; r < 16; ++r) p1[r] = __builtin_amdgcn_exp2f(p1[r]);
    float ps = 0;
#pragma unroll
    for (int r = 0; r < 16; ++r) ps += p0[r];
#pragma unroll
    for (int r = 0; r < 16; ++r) ps += p1[r];
    { auto rr = __builtin_amdgcn_permlane32_swap(__float_as_uint(ps), __float_as_uint(ps), false, false); ps = __uint_as_float(rr[0]) + __uint_as_float(rr[1]); }
    l_reg = l_reg * alpha + ps;
#define ATT_PK4(P, BASE, OUT) do { unsigned a0 = cvtpk(P[BASE + 0], P[BASE + 1]), a1 = cvtpk(P[BASE + 2], P[BASE + 3]);   \
    unsigned b0 = cvtpk(P[BASE + 4], P[BASE + 5]), b1 = cvtpk(P[BASE + 6], P[BASE + 7]);                              \
    auto r0 = __builtin_amdgcn_permlane32_swap(a0, b0, false, false); auto r1 = __builtin_amdgcn_permlane32_swap(a1, b1, false, false); \
    u32x4 w = {r0[0], r1[0], r0[1], r1[1]}; OUT = *reinterpret_cast<bf16x8*>(&w); } while (0)
    ATT_PK4(p0, 0, pa0); ATT_PK4(p0, 8, pa1); ATT_PK4(p1, 0, pa2); ATT_PK4(p1, 8, pa3);
#undef ATT_PK4
}
template <int DQK, int KST> __device__ __forceinline__ void qkt(f32x16& p0, f32x16& p1, const ALDS char* Ks, const bf16x8* qr, int r32, int hi) {
    p0 = f32x16{}; p1 = f32x16{};
#pragma unroll
    for (int d0 = 0; d0 < DQK / 16; ++d0) { const int cb = (d0 * 16 + hi * 8) * 2;
        const bf16x8 b0 = *reinterpret_cast<const ALDS bf16x8*>(Ks + kswz<KST>(r32, cb));
        const bf16x8 b1 = *reinterpret_cast<const ALDS bf16x8*>(Ks + kswz<KST>(32 + r32, cb));
        p0 = __builtin_amdgcn_mfma_f32_32x32x16_bf16(b0, qr[d0], p0, 0, 0, 0);
        p1 = __builtin_amdgcn_mfma_f32_32x32x16_bf16(b1, qr[d0], p1, 0, 0, 0); }
}
template <int D0, int DV> __device__ __forceinline__ void pv_one(f32x16& od, int vb, bf16x8 pa0, bf16x8 pa1, bf16x8 pa2, bf16x8 pa3) {
    const s16x4 l0 = tr_read<v_rd_off<DV>(D0, 0, 0)>(vb), h0 = tr_read<v_rd_off<DV>(D0, 0, 1)>(vb), l1 = tr_read<v_rd_off<DV>(D0, 1, 0)>(vb), h1 = tr_read<v_rd_off<DV>(D0, 1, 1)>(vb);
    const s16x4 l2 = tr_read<v_rd_off<DV>(D0, 2, 0)>(vb), h2 = tr_read<v_rd_off<DV>(D0, 2, 1)>(vb), l3 = tr_read<v_rd_off<DV>(D0, 3, 0)>(vb), h3 = tr_read<v_rd_off<DV>(D0, 3, 1)>(vb);
    asm volatile("s_waitcnt lgkmcnt(0)" ::: "memory"); ASBAR();
#define ATT_PK(L, H) (bf16x8){L[0], L[1], L[2], L[3], H[0], H[1], H[2], H[3]}
    od = __builtin_amdgcn_mfma_f32_32x32x16_bf16(pa0, ATT_PK(l0, h0), od, 0, 0, 0);
    od = __builtin_amdgcn_mfma_f32_32x32x16_bf16(pa1, ATT_PK(l1, h1), od, 0, 0, 0);
    od = __builtin_amdgcn_mfma_f32_32x32x16_bf16(pa2, ATT_PK(l2, h2), od, 0, 0, 0);
    od = __builtin_amdgcn_mfma_f32_32x32x16_bf16(pa3, ATT_PK(l3, h3), od, 0, 0, 0);
#undef ATT_PK
}

constexpr int MLA_LDS_BYTES = 2 * 16384 + 2 * 24576 + 2048;
__device__ __forceinline__ void mla_unit(const u16* __restrict__ Qb, const u16* __restrict__ KNh, const u16* __restrict__ KRb, const u16* __restrict__ Vh, u16* __restrict__ Ob, int nkeys, ALDS char* lds, int tid) {
    constexpr int SHV = 16384, SHK = 24576;
    constexpr float SCALE = 0.07216878364870322f, C = SCALE * 1.4426950408889634f, THRR = 8.f / SCALE;
    const int wid = tid >> 6, lane = tid & 63, r32 = lane & 31, hi = lane >> 5;
    ALDS char* V_lds = lds; ALDS char* K_lds = lds + 2 * SHV;
    ALDS float* wsc = (ALDS float*)(lds + 2 * SHV + 2 * SHK) + wid * 64; ALDS float* li_l = wsc; ALDS float* al_l = wsc + 32;
    float m_reg = -1e30f, l_reg = 0.f; f32x16 o[4] = {}; bf16x8 qr[12];
    const u16* Qw = Qb + (unsigned)((wid * 32 + r32) * 3072 + hi * 8);
#pragma unroll
    for (int d0 = 0; d0 < 12; ++d0) qr[d0] = *reinterpret_cast<const bf16x8*>(Qw + d0 * 16);
    const int sr = tid >> 4, sc = (tid & 15) * 8, krr = tid >> 3, krc = (tid & 7) * 8;
    const int vst0 = v_st<128>(sr, sc), vst1 = v_st<128>(32 + sr, sc);
    const int kst0 = kswz<384>(sr, sc * 2), kst1 = kswz<384>(32 + sr, sc * 2), kst2 = kswz<384>(krr, (128 + krc) * 2);
    const int vb0 = (int)(unsigned)(uintptr_t)V_lds + v_rd_base(lane);
    bf16x8 vs0, vs1, ks0, ks1, kr0;
const unsigned goff = (unsigned)(sr * 2048 + sc), kroff = (unsigned)(krr * 64 + krc);
#define MLA_SLOAD(k0) do { const u16* vp = Vh + (size_t)(k0) * 2048; const u16* kp = KNh + (size_t)(k0) * 2048; \
    vs0 = *reinterpret_cast<const bf16x8*>(vp + goff); vs1 = *reinterpret_cast<const bf16x8*>(vp + 32 * 2048 + goff); \
    ks0 = *reinterpret_cast<const bf16x8*>(kp + goff); ks1 = *reinterpret_cast<const bf16x8*>(kp + 32 * 2048 + goff); \
    kr0 = *reinterpret_cast<const bf16x8*>(KRb + (size_t)(k0) * 64 + kroff); } while (0)
#define MLA_SWRITE(b) do { *reinterpret_cast<ALDS bf16x8*>(V_lds + (b) * SHV + vst0) = vs0; *reinterpret_cast<ALDS bf16x8*>(V_lds + (b) * SHV + vst1) = vs1; \
    *reinterpret_cast<ALDS bf16x8*>(K_lds + (b) * SHK + kst0) = ks0; *reinterpret_cast<ALDS bf16x8*>(K_lds + (b) * SHK + kst1) = ks1; *reinterpret_cast<ALDS bf16x8*>(K_lds + (b) * SHK + kst2) = kr0; } while (0)
    const int NT = nkeys / 64;
    MLA_SLOAD(0); MLA_SWRITE(0); __syncthreads();
    for (int j = 0; j < NT; ++j) {
        const int b = j & 1;
        if (j + 1 < NT) MLA_SLOAD((j + 1) * 64);
        f32x16 p0, p1; float mn, alpha; bf16x8 pa0, pa1, pa2, pa3;
        qkt<192, 384>(p0, p1, K_lds + b * SHK, qr, r32, hi);
        partialSM(p0, p1, m_reg, mn, alpha, C, THRR);
        if (__any(alpha < 1.f)) { if (hi == 0) al_l[r32] = alpha; asm volatile("s_waitcnt lgkmcnt(0)" ::: "memory");
#pragma unroll
            for (int d = 0; d < 4; ++d)
#pragma unroll
                for (int r = 0; r < 16; ++r) o[d][r] *= al_l[crow(r, hi)]; }
        finishSM(p0, p1, alpha, l_reg, pa0, pa1, pa2, pa3); ASBAR();
        const int vb = vb0 + b * SHV;
        pv_one<0, 128>(o[0], vb, pa0, pa1, pa2, pa3); pv_one<1, 128>(o[1], vb, pa0, pa1, pa2, pa3); pv_one<2, 128>(o[2], vb, pa0, pa1, pa2, pa3); pv_one<3, 128>(o[3], vb, pa0, pa1, pa2, pa3);
        if (j + 1 < NT) MLA_SWRITE(b ^ 1);
        __syncthreads();
    }
#undef MLA_SLOAD
#undef MLA_SWRITE
    if (hi == 0) li_l[r32] = l_reg;
    asm volatile("s_waitcnt lgkmcnt(0)" ::: "memory");
    ALDS char* ost = lds + wid * 8704;
#pragma unroll
    for (int r = 0; r < 16; ++r) { const int orow = crow(r, hi); const float rl = __builtin_amdgcn_rcpf(li_l[orow]);
#pragma unroll
        for (int d0 = 0; d0 < 4; ++d0) *reinterpret_cast<ALDS u16*>(ost + orow * 272 + (d0 * 32 + r32) * 2) = f2bf(o[d0][r] * rl); }
    asm volatile("s_waitcnt lgkmcnt(0)" ::: "memory");
#pragma unroll
    for (int i = 0; i < 8; ++i) { const int row = i * 4 + (lane >> 4), ch = lane & 15; const u32x4 v = *reinterpret_cast<const ALDS u32x4*>(ost + row * 272 + ch * 16);
        *reinterpret_cast<u32x4*>(Ob + (unsigned)((wid * 32 + row) * 2048 + ch * 8)) = v; }
    __syncthreads();
}

constexpr int MLA2_LDS_BYTES = 2 * 16384 + 2 * 24576 + 2048 + 8 * 4096;
__device__ __forceinline__ void qkt_mla(f32x16& p0, f32x16& p1, const ALDS char* Ks, const bf16x8* qr, const ALDS char* qrl, int r32, int hi) {
    p0 = f32x16{}; p1 = f32x16{};
    const int kb[4] = {kswz<384>(r32, (0 * 16 + hi * 8) * 2), kswz<384>(r32, (1 * 16 + hi * 8) * 2), kswz<384>(r32, (2 * 16 + hi * 8) * 2), kswz<384>(r32, (3 * 16 + hi * 8) * 2)};
    bf16x8 b0[3], b1[3], qf[3];
#define QKT_LD(d0) do { b0[(d0) % 3] = *reinterpret_cast<const ALDS bf16x8*>(Ks + kb[(d0) & 3] + ((d0) >> 2) * 128); b1[(d0) % 3] = *reinterpret_cast<const ALDS bf16x8*>(Ks + kb[(d0) & 3] + ((d0) >> 2) * 128 + 32 * 384); \
        if ((d0) >= 8) qf[(d0) % 3] = *reinterpret_cast<const ALDS bf16x8*>(qrl + ((d0) - 8) * 1024); } while (0)
    QKT_LD(0); QKT_LD(1);
#define QKT_STEP(d0) do { if ((d0) + 2 < 12) QKT_LD((d0) + 2); \
        { const bf16x8 q = (d0) < 8 ? qr[(d0) < 8 ? (d0) : 0] : qf[(d0) % 3]; \
          p0 = __builtin_amdgcn_mfma_f32_32x32x16_bf16(b0[(d0) % 3], q, p0, 0, 0, 0); p1 = __builtin_amdgcn_mfma_f32_32x32x16_bf16(b1[(d0) % 3], q, p1, 0, 0, 0); } \
        __builtin_amdgcn_sched_group_barrier(0x100, (d0) + 2 < 12 ? ((d0) + 2 >= 8 ? 3 : 2) : 0, 0);     \
        __builtin_amdgcn_sched_group_barrier(0x008, 2, 0); } while (0)
    QKT_STEP(0); QKT_STEP(1); QKT_STEP(2); QKT_STEP(3); QKT_STEP(4); QKT_STEP(5); QKT_STEP(6); QKT_STEP(7); QKT_STEP(8); QKT_STEP(9); QKT_STEP(10); QKT_STEP(11);
#undef QKT_STEP
#undef QKT_LD
}
template <int OFF> __device__ __forceinline__ bf16x8 lds_rd128(int a) { bf16x8 r; asm volatile("ds_read_b128 %0, %1 offset:%2" : "=&v"(r) : "v"(a), "i"(OFF) : "memory"); return r; }
#ifdef QROPE_REG
#define QKT_QF(d0) do { } while (0)
#define QKT_Q(d0) qr[(d0)]
#define QKT_NQ 0
#else
#define QKT_QF(d0) do { if ((d0) >= 8) qf[(d0) & 1] = lds_rd128<((d0) >= 8 ? (d0) - 8 : 0) * 1024>(qa); } while (0)
#define QKT_Q(d0) ((d0) < 8 ? qr[(d0) < 8 ? (d0) : 0] : qf[(d0) & 1])
#define QKT_NQ 1
#endif
template <int KOFF> __device__ __forceinline__ void qkt_mla_p(f32x16& p0, f32x16& p1, const int (&ka)[4], int qa, const bf16x8* qr) {
    p0 = f32x16{}; p1 = f32x16{};
    bf16x8 b0[2], b1[2], qf[2];
#define QL(d0) do { b0[(d0) & 1] = lds_rd128<KOFF + ((d0) >> 2) * 128>(ka[(d0) & 3]); b1[(d0) & 1] = lds_rd128<KOFF + ((d0) >> 2) * 128 + 32 * 384>(ka[(d0) & 3]); \
        QKT_QF(d0); } while (0)
#define QN(d0) ((d0) >= 12 ? 0 : (d0) >= 8 ? 2 + QKT_NQ : 2)
#define QS(d0) do { if ((d0) + 1 < 12) QL((d0) + 1); \
        asm volatile("s_waitcnt lgkmcnt(%0)" :: "i"(QN((d0) + 1)) : "memory"); ASBAR(); \
        { const bf16x8 q = QKT_Q(d0); \
          p0 = __builtin_amdgcn_mfma_f32_32x32x16_bf16(b0[(d0) & 1], q, p0, 0, 0, 0); p1 = __builtin_amdgcn_mfma_f32_32x32x16_bf16(b1[(d0) & 1], q, p1, 0, 0, 0); } ASBAR(); } while (0)
    QL(0);
    QS(0); QS(1); QS(2); QS(3); QS(4); QS(5); QS(6); QS(7); QS(8); QS(9); QS(10); QS(11);
#undef QS
#undef QN
#undef QL
}
template <int ABL = 0, int ORDER = 0> __device__ __forceinline__ void mla_unit2(const u16* __restrict__ Qb, const u16* __restrict__ KNh, const u16* __restrict__ KRb, const u16* __restrict__ Vh, u16* __restrict__ Ob, int nkeys, ALDS char* lds, int tid) {
    constexpr int SHV = 16384, SHK = 24576;
    constexpr float SCALE = 0.07216878364870322f, C = SCALE * 1.4426950408889634f, THRR = 8.f / SCALE;
    const int wid = __builtin_amdgcn_readfirstlane(tid >> 6), lane = tid & 63, r32 = lane & 31, hi = lane >> 5;
    ALDS char* V_lds = lds; ALDS char* K_lds = lds + 2 * SHV;
    ALDS float* wsc = (ALDS float*)(lds + 2 * SHV + 2 * SHK) + wid * 64; ALDS float* li_l = wsc; ALDS float* al_l = wsc + 32;
    ALDS char* qrl = lds + 2 * SHV + 2 * SHK + 2048 + wid * 4096 + lane * 16;
    float m_reg = -1e30f, l_reg = 0.f; f32x16 o[4] = {};
#ifdef QROPE_REG
    bf16x8 qr[12];
    const u16* Qw = Qb + (unsigned)((wid * 32 + r32) * 3072 + hi * 8);
#pragma unroll
    for (int d0 = 0; d0 < 12; ++d0) qr[d0] = *reinterpret_cast<const bf16x8*>(Qw + d0 * 16);
#else
    bf16x8 qr[8];
    const u16* Qw = Qb + (unsigned)((wid * 32 + r32) * 3072 + hi * 8);
#pragma unroll
    for (int d0 = 0; d0 < 8; ++d0) qr[d0] = *reinterpret_cast<const bf16x8*>(Qw + d0 * 16);
#pragma unroll
    for (int d0 = 8; d0 < 12; ++d0) *reinterpret_cast<ALDS bf16x8*>(qrl + (d0 - 8) * 1024) = *reinterpret_cast<const bf16x8*>(Qw + d0 * 16);
#endif
    const int vb0 = (int)(unsigned)(uintptr_t)V_lds + v_rd_base(lane);
    int ka[4]; { const int kbase = (int)(unsigned)(uintptr_t)K_lds;
#pragma unroll
      for (int r = 0; r < 4; ++r) ka[r] = kbase + kswz<384>(r32, (r * 16 + hi * 8) * 2); }
    const int qa = (int)(unsigned)(uintptr_t)qrl;
    bf16x8 vs0, vs1, ks0, ks1, kr0;
    const unsigned goff = (unsigned)((tid >> 4) * 2048 + (tid & 15) * 8), kroff = (unsigned)((tid >> 3) * 64 + (tid & 7) * 8);
    const int vst0 = v_st<128>(tid >> 4, (tid & 15) * 8), kst0 = kswz<384>(tid >> 4, (tid & 15) * 16), kst2 = kswz<384>(tid >> 3, (128 + (tid & 7) * 8) * 2);
    constexpr int vst1o = 8192, kst1o = 32 * 384;
#define MLA_SLOAD(k0) do { \
    const u16* vp = Vh + (size_t)(k0) * 2048; const u16* kp = KNh + (size_t)(k0) * 2048; \
    if (!(ABL & 1)) { vs0 = *reinterpret_cast<const bf16x8*>(vp + goff); vs1 = *reinterpret_cast<const bf16x8*>(vp + 32 * 2048 + goff); \
    ks0 = *reinterpret_cast<const bf16x8*>(kp + goff); ks1 = *reinterpret_cast<const bf16x8*>(kp + 32 * 2048 + goff); \
    kr0 = *reinterpret_cast<const bf16x8*>(KRb + (size_t)(k0) * 64 + kroff); } } while (0)
#define MLA_SWRITE(b) do { \
    if (!(ABL & 1)) { *reinterpret_cast<ALDS bf16x8*>(V_lds + (b) * SHV + vst0) = vs0; *reinterpret_cast<ALDS bf16x8*>(V_lds + (b) * SHV + vst0 + vst1o) = vs1; \
    *reinterpret_cast<ALDS bf16x8*>(K_lds + (b) * SHK + kst0) = ks0; *reinterpret_cast<ALDS bf16x8*>(K_lds + (b) * SHK + kst0 + kst1o) = ks1; *reinterpret_cast<ALDS bf16x8*>(K_lds + (b) * SHK + kst2) = kr0; } } while (0)
#define MLA_RESC(a) do { if (__any((a) < 1.f)) { if (hi == 0) al_l[r32] = (a); asm volatile("s_waitcnt lgkmcnt(0)" ::: "memory"); \
    _Pragma("unroll") for (int d = 0; d < 4; ++d) _Pragma("unroll") for (int r = 0; r < 16; ++r) o[d][r] *= al_l[crow(r, hi)]; } } while (0)
#define MLA_PV(vb) do { pv_one<0, 128>(o[0], (vb), pa0, pa1, pa2, pa3); pv_one<1, 128>(o[1], (vb), pa0, pa1, pa2, pa3); pv_one<2, 128>(o[2], (vb), pa0, pa1, pa2, pa3); pv_one<3, 128>(o[3], (vb), pa0, pa1, pa2, pa3); } while (0)
#define ABL_PSM(P0, P1, MN, AL) do { if (ABL & 2) { MN = m_reg; AL = 1.f; } else partialSM(P0, P1, m_reg, MN, AL, C, THRR); } while (0)
#define ABL_FSM(P0, P1, AL) do { if (ABL & 2) { u32x4 w_ = {__float_as_uint(P0[0]), __float_as_uint(P0[1]), __float_as_uint(P1[0]), __float_as_uint(P1[1])}; pa0 = *reinterpret_cast<bf16x8*>(&w_); pa1 = pa0; pa2 = pa0; pa3 = pa0; l_reg += 1.f; } else finishSM(P0, P1, AL, l_reg, pa0, pa1, pa2, pa3); } while (0)
    f32x16 pA0, pA1, pB0, pB1; float mnA, mnB, alA, alB; bf16x8 pa0, pa1, pa2, pa3; const int NT = nkeys / 64;
    MLA_SLOAD(0); asm volatile("s_waitcnt vmcnt(0)" ::: "memory"); MLA_SWRITE(0); __syncthreads();
    qkt_mla_p<0>(pA0, pA1, ka, qa, qr); ABL_PSM(pA0, pA1, mnA, alA);
    MLA_SLOAD(64); asm volatile("s_waitcnt vmcnt(0)" ::: "memory"); MLA_SWRITE(1); __syncthreads();
    constexpr bool lead = ORDER == 0;
#define MLA_STEP(Q0, Q1, KB, P0, P1, ALP, VB, MNQ, ALQ) do { \
        if (lead) { ASBAR(); qkt_mla_p<KB>(Q0, Q1, ka, qa, qr); ABL_FSM(P0, P1, ALP); ASBAR(); MLA_PV(VB); ABL_PSM(Q0, Q1, MNQ, ALQ); } \
        else { ASBAR(); ABL_FSM(P0, P1, ALP); ASBAR(); qkt_mla_p<KB>(Q0, Q1, ka, qa, qr); ASBAR(); ABL_PSM(Q0, Q1, MNQ, ALQ); ASBAR(); MLA_PV(VB); } } while (0)
    for (int j = 1; j + 1 < NT; j += 2) {
        MLA_SLOAD((j + 1) * 64);
        MLA_STEP(pB0, pB1, SHK, pA0, pA1, alA, vb0, mnB, alB);
        __syncthreads(); asm volatile("s_waitcnt vmcnt(0)" ::: "memory"); MLA_SWRITE(0);
        MLA_RESC(alB); __syncthreads();
        MLA_SLOAD((j + 2) * 64);
        MLA_STEP(pA0, pA1, 0, pB0, pB1, alB, vb0 + SHV, mnA, alA);
        __syncthreads(); asm volatile("s_waitcnt vmcnt(0)" ::: "memory"); MLA_SWRITE(1);
        MLA_RESC(alA); __syncthreads();
    }
#undef MLA_STEP
    ASBAR(); qkt_mla_p<SHK>(pB0, pB1, ka, qa, qr);
    ABL_FSM(pA0, pA1, alA); ASBAR();
    MLA_PV(vb0); ABL_PSM(pB0, pB1, mnB, alB);
    __syncthreads(); MLA_RESC(alB);
    ABL_FSM(pB0, pB1, alB); ASBAR();
    MLA_PV(vb0 + SHV);
#undef MLA_SLOAD
#undef MLA_SWRITE
#undef MLA_RESC
#undef MLA_PV
#undef ABL_PSM
#undef ABL_FSM
    __syncthreads();
    if (hi == 0) li_l[r32] = l_reg;
    { const int lane = (int)__builtin_amdgcn_mbcnt_hi(~0u, __builtin_amdgcn_mbcnt_lo(~0u, 0u)), r32 = lane & 31, hi = lane >> 5;
    asm volatile("s_waitcnt lgkmcnt(0)" ::: "memory");
    ALDS char* ost = lds + wid * 8704;
#pragma unroll
    for (int r = 0; r < 16; ++r) { const int orow = crow(r, hi); const float rl = __builtin_amdgcn_rcpf(li_l[orow]);
#pragma unroll
        for (int d0 = 0; d0 < 4; ++d0) *reinterpret_cast<ALDS u16*>(ost + orow * 272 + (d0 * 32 + r32) * 2) = f2bf(o[d0][r] * rl); }
    asm volatile("s_waitcnt lgkmcnt(0)" ::: "memory");
#pragma unroll
    for (int i = 0; i < 8; ++i) { const int row = i * 4 + (lane >> 4), ch = lane & 15; const u32x4 v = *reinterpret_cast<const ALDS u32x4*>(ost + row * 272 + ch * 16);
        *reinterpret_cast<u32x4*>(Ob + (unsigned)((wid * 32 + row) * 2048 + ch * 8)) = v; } }
    __syncthreads();
}

constexpr int WIN_LDS_BYTES = 4 * 8192 + 2048 + 8 * 4608;
__device__ __forceinline__ void win_unit(const u16* __restrict__ QKV, u16* __restrict__ O, const float* __restrict__ sink, int kb, int qrow0, int p0, int kvh, ALDS char* lds, int tid) {
    constexpr int SHK = 8192, SHV = 8192;
    constexpr float SCALE = 0.125f, C = SCALE * 1.4426950408889634f, THRR = 8.f / SCALE;
    const int wid = tid >> 6, lane = tid & 63, r32 = lane & 31, hi = lane >> 5, qh = kvh * 8 + wid;
    ALDS char* K_lds = lds; ALDS char* V_lds = lds + 2 * SHK;
    ALDS float* wsc = (ALDS float*)(lds + 2 * SHK + 2 * SHV) + wid * 64; ALDS float* li_l = wsc; ALDS float* al_l = wsc + 32;
    float m_reg = sink[qh] * (1.0f / SCALE), l_reg = 1.f; f32x16 o[2] = {}; bf16x8 qr[4];
    const u16* Qw = QKV + (size_t)(qrow0 + r32) * 2560 + qh * 64 + hi * 8;
#pragma unroll
    for (int d0 = 0; d0 < 4; ++d0) qr[d0] = *reinterpret_cast<const bf16x8*>(Qw + d0 * 16);
    const int srow = tid >> 3, scol = (tid & 7) * 8;
    const int vst = v_st<64>(srow, scol), kst = kswz<128>(srow, scol * 2);
    const int vb0 = (int)(unsigned)(uintptr_t)V_lds + v_rd_base(lane);
    const unsigned goff = (unsigned)(srow * 2560 + scol);
    int wlo = 0, NT = 4;
    if (p0 >= 0) { const int lo = p0 - 128 < 0 ? 0 : p0 - 128, hiP = p0 + 159 > S - 1 ? S - 1 : p0 + 159; wlo = lo >> 6; NT = 4 + (hiP >> 6) - wlo + 1; }
    bf16x8 ks, vs;
#define WIN_TROW(j) ((j) < 4 ? kb + 64 * (j) : kb + CTX + 64 * (wlo + (j) - 4))
#define WIN_SLOAD(j) do { const u16* rp = QKV + (size_t)WIN_TROW(j) * 2560; ks = *reinterpret_cast<const bf16x8*>(rp + 2048 + kvh * 64 + goff); vs = *reinterpret_cast<const bf16x8*>(rp + 2304 + kvh * 64 + goff); } while (0)
#define WIN_SWRITE(b) do { *reinterpret_cast<ALDS bf16x8*>(K_lds + (b) * SHK + kst) = ks; *reinterpret_cast<ALDS bf16x8*>(V_lds + (b) * SHV + vst) = vs; } while (0)
    WIN_SLOAD(0); WIN_SWRITE(0); __syncthreads();
    for (int j = 0; j < NT; ++j) {
        const int b = j & 1;
        if (j + 1 < NT) WIN_SLOAD(j + 1);
        f32x16 p0v, p1v; float mn, alpha; bf16x8 pa0, pa1, pa2, pa3;
        qkt<64, 128>(p0v, p1v, K_lds + b * SHK, qr, r32, hi);
        if (j >= 4) { const int dq0 = (p0 + r32) - 64 * (wlo + j - 4);
#pragma unroll
            for (int r = 0; r < 16; ++r) { const int dq = dq0 - crow(r, hi); if (dq > 128 || dq < -128) p0v[r] = -1e30f; if (dq - 32 > 128 || dq - 32 < -128) p1v[r] = -1e30f; } }
        partialSM(p0v, p1v, m_reg, mn, alpha, C, THRR);
        if (__any(alpha < 1.f)) { if (hi == 0) al_l[r32] = alpha; asm volatile("s_waitcnt lgkmcnt(0)" ::: "memory");
#pragma unroll
            for (int d = 0; d < 2; ++d)
#pragma unroll
                for (int r = 0; r < 16; ++r) o[d][r] *= al_l[crow(r, hi)]; }
        finishSM(p0v, p1v, alpha, l_reg, pa0, pa1, pa2, pa3); ASBAR();
        const int vb = vb0 + b * SHV;
        pv_one<0, 64>(o[0], vb, pa0, pa1, pa2, pa3); pv_one<1, 64>(o[1], vb, pa0, pa1, pa2, pa3);
        if (j + 1 < NT) WIN_SWRITE(b ^ 1);
        __syncthreads();
    }
#undef WIN_TROW
#undef WIN_SLOAD
#undef WIN_SWRITE
    if (hi == 0) li_l[r32] = l_reg;
    asm volatile("s_waitcnt lgkmcnt(0)" ::: "memory");
    ALDS char* ost = lds + 2 * SHK + 2 * SHV + 2048 + wid * 4608;
#pragma unroll
    for (int r = 0; r < 16; ++r) { const int orow = crow(r, hi); const float rl = __builtin_amdgcn_rcpf(li_l[orow]);
#pragma unroll
        for (int d0 = 0; d0 < 2; ++d0) *reinterpret_cast<ALDS u16*>(ost + orow * 144 + (d0 * 32 + r32) * 2) = f2bf(o[d0][r] * rl); }
    asm volatile("s_waitcnt lgkmcnt(0)" ::: "memory");
#pragma unroll
    for (int i = 0; i < 4; ++i) { const int row = i * 8 + (lane >> 3), ch = lane & 7; const u32x4 v = *reinterpret_cast<const ALDS u32x4*>(ost + row * 144 + ch * 16);
        *reinterpret_cast<u32x4*>(O + (size_t)(qrow0 + row) * 2048 + qh * 64 + ch * 8) = v; }
    __syncthreads();
}
}
#ifndef MLA_UNIT
#define MLA_UNIT mla_unit2<0, 0>
#endif
template <int ABL = 0> PH void ph_attn_mla(const u16* __restrict__ Q, const u16* __restrict__ KN, const u16* __restrict__ KR, const u16* __restrict__ V, u16* __restrict__ O, unsigned char* lds, int wg, int nwg, bool need_ctx) {
    const int TID = otid();
    const int vcu = (nwg % 8 == 0) ? (wg % 8) * (nwg / 8) + wg / 8 : wg;
    for (int u = vcu; u < (need_ctx ? NB * 16 * 17 : NB * 16 * 16); u += nwg) {
        int bh, qb; if (u < NB * 16 * 16) { bh = u >> 4; qb = 1 + (u & 15); } else { bh = u - NB * 16 * 16; qb = 0; }
        const int b = bh >> 4, h = bh & 15; const size_t kb = (size_t)b * SB, q0 = kb + (size_t)qb * 256;
        int tu = TID; asm volatile("" : "+v"(tu));
#ifndef MLA_NOSWAP
        if (__builtin_amdgcn_readfirstlane(tu >> 6) < 4) att::mla_unit2<ABL, 0>(Q + q0 * 3072 + h * 192, KN + kb * D + h * 128, KR + kb * 64, V + kb * D + h * 128, O + q0 * D + h * 128, qb == 0 ? CTX : SB, (ALDS char*)lds, tu);
        else att::mla_unit2<ABL, 1>(Q + q0 * 3072 + h * 192, KN + kb * D + h * 128, KR + kb * 64, V + kb * D + h * 128, O + q0 * D + h * 128, qb == 0 ? CTX : SB, (ALDS char*)lds, tu);
#else
        att::mla_unit2<ABL, 0>(Q + q0 * 3072 + h * 192, KN + kb * D + h * 128, KR + kb * 64, V + kb * D + h * 128, O + q0 * D + h * 128, qb == 0 ? CTX : SB, (ALDS char*)lds, tu);
#endif
    }
}

PH void ph_attn_win(const u16* __restrict__ QKV, const float* __restrict__ sink, u16* __restrict__ O, unsigned char* lds, int wg, int nwg) {
    const int TID = otid();
    for (int u = wg; u < NB * 4 * 136; u += nwg) {
        const int pb = u % 136, bk = u / 136, b = bk >> 2, kvh = bk & 3, kb = b * SB;
        const int p0 = pb < 128 ? pb * 32 : -1, qrow0 = pb < 128 ? kb + CTX + pb * 32 : kb + (pb - 128) * 32;
        int tu = TID; asm volatile("" : "+v"(tu));
        att::win_unit(QKV, O, sink, kb, qrow0, p0, kvh, (ALDS char*)lds, tu);
    }
}

#ifndef FFT_HD
#define FFT_HD __device__ __forceinline__
#define FFT_OPQ(t) asm volatile("" : "+v"(t))
#else
#define FFT_OPQ(t)
#endif
typedef float cf __attribute__((ext_vector_type(2)));
FFT_HD cf cswap(cf a) { return __builtin_shufflevector(a, a, 1, 0); }
FFT_HD cf cmul(cf a, cf b) { return a * b.xx + cswap(a) * (cf){-b.y, b.y}; }
FFT_HD cf cmulc(cf a, cf b) { return a * b.xx + cswap(a) * (cf){b.y, -b.y}; }
FFT_HD cf cadd(cf a, cf b) { return a + b; }
FFT_HD cf csub(cf a, cf b) { return a - b; }
FFT_HD int fidx(int a) { return a + (a >> 5) + (a >> 9); }
constexpr int FFT_N = 8192, FFT_BUF = FFT_N + FFT_N / 32 + FFT_N / 512;
FFT_HD int fpos(int k) { return ((k & 15) << 9) | (((k >> 4) & 15) << 5) | (((k >> 8) & 15) << 1) | ((k >> 12) & 1); }
template <bool INV, bool ZHI = false> FFT_HD void dft16(cf (&v)[16]) {
    constexpr float C1 = 0.9238795325112867f, S1 = 0.3826834323650898f, C2 = 0.7071067811865476f;
    const float wr[8] = {1.f, C1, C2, S1, 0.f, -S1, -C2, -C1};
    const float wi[8] = {0.f, S1, C2, C1, 1.f, C1, C2, S1};
#pragma unroll
    for (int s = 0; s < 4; ++s) {
        const int half = 8 >> s;
#pragma unroll
        for (int i = 0; i < 16; ++i) {
            if ((i & half) == 0) {
                const int j = i + half, tw = (i & (half - 1)) << s;
                const cf a = v[i], b = v[j];
                const bool z = ZHI && s == 0;
                if (!z) v[i] = cadd(a, b);
                const cf d = z ? a : csub(a, b);
                if (tw == 0) v[j] = d;
                else if (tw == 4) v[j] = INV ? (cf){-d.y, d.x} : (cf){d.y, -d.x};
                else { const float c = wr[tw], sn = INV ? -wi[tw] : wi[tw]; v[j] = d * (cf){c, c} + cswap(d) * (cf){sn, -sn}; }
            }
        }
    }
#pragma unroll
    for (int i = 0; i < 16; ++i) { const int r = ((i & 1) << 3) | ((i & 2) << 1) | ((i & 4) >> 1) | ((i & 8) >> 3); if (r > i) { const cf t = v[i]; v[i] = v[r]; v[r] = t; } }
}
template <int M, bool INV, class BufT, class TwT> FFT_HD void fft_pass16(BufT buf, TwT tw, int tid) {
    FFT_OPQ(tid);
    const int blk = tid / M, n2 = tid % M, base = blk * 16 * M + n2;
    constexpr int ST = M + (M >> 5) + (M >> 9); const int a0 = fidx(base);
    cf v[16];
#pragma unroll
    for (int j = 0; j < 16; ++j) v[j] = buf.get(a0 + j * ST);
    cf w[16];
    if (M > 1) { const cf w1 = tw.get(n2 * (FFT_N / (16 * M))); w[1] = w1; w[2] = cmul(w1, w1); w[3] = cmul(w[2], w1); w[4] = cmul(w[2], w[2]); w[5] = cmul(w[4], w1); w[6] = cmul(w[3], w[3]); w[7] = cmul(w[6], w1);
        w[8] = cmul(w[4], w[4]); w[9] = cmul(w[8], w1); w[10] = cmul(w[5], w[5]); w[11] = cmul(w[10], w1); w[12] = cmul(w[6], w[6]); w[13] = cmul(w[12], w1); w[14] = cmul(w[7], w[7]); w[15] = cmul(w[14], w1); }
    if (INV) { if (M > 1) {
#pragma unroll
        for (int k = 1; k < 16; ++k) v[k] = cmulc(v[k], w[k]); } }
    dft16<INV>(v);
    if (!INV) { if (M > 1) {
#pragma unroll
        for (int k = 1; k < 16; ++k) v[k] = cmul(v[k], w[k]); } }
#pragma unroll
    for (int j = 0; j < 16; ++j) buf.set(a0 + j * ST, v[j]);
}
template <class BufT> FFT_HD void fft_pass2(BufT buf, int tid) {
    FFT_OPQ(tid);
    const int a0 = fidx(2 * tid);
#pragma unroll
    for (int i = 0; i < 8; ++i) { const int e = a0 + 1058 * i; const cf a = buf.get(e), b = buf.get(e + 1); buf.set(e, cadd(a, b)); buf.set(e + 1, csub(a, b)); }
}
#ifndef FFT_HOST_TEST
#define FFT_SYNC() __syncthreads()
template <class BufT, class TwT> FFT_HD void fft_fwd(BufT buf, TwT tw, int tid) {
    fft_pass16<512, false>(buf, tw, tid); FFT_SYNC(); fft_pass16<32, false>(buf, tw, tid); FFT_SYNC(); fft_pass16<2, false>(buf, tw, tid); FFT_SYNC(); fft_pass2(buf, tid); FFT_SYNC();
}
template <class BufT, class TwT> FFT_HD void fft_inv(BufT buf, TwT tw, int tid) {
    fft_pass2(buf, tid); FFT_SYNC(); fft_pass16<2, true>(buf, tw, tid); FFT_SYNC(); fft_pass16<32, true>(buf, tw, tid); FFT_SYNC(); fft_pass16<512, true>(buf, tw, tid); FFT_SYNC();
}
#endif
FFT_HD void spec_pair(cf a, cf b, cf fd, cf fe, cf& ya, cf& yb) {
    const cf zd = cf{a.x + b.x, a.y - b.y};
    const cf ze = cf{a.y + b.y, b.x - a.x};
    const cf P = cmul(zd, fd), Q = cmul(ze, fe);
    ya = cf{P.x - Q.y, P.y + Q.x};
    yb = cf{P.x + Q.y, Q.x - P.y};
}

#ifndef FFT_HOST_TEST
typedef float f32x2v __attribute__((ext_vector_type(2)));
struct LdsCf { LAS f32x2v* p; __device__ __forceinline__ cf get(int i) const { return p[i]; } __device__ __forceinline__ void set(int i, cf v) const { p[i] = v; } };
constexpr int FS_LD = 4104;
PH void ph_filter_fft(KP p, unsigned char* ldsraw, int wg, int nwg) {
    const int TID = otid();
    const LdsCf buf{(LAS f32x2v*)ldsraw}, tw{(LAS f32x2v*)ldsraw + FFT_BUF};
    const cf* twg = (const cf*)(p->ws + WS_TW);
    for (int i = TID; i < FFT_N; i += 512) tw.set(i, twg[i]);
    __syncthreads();
    const float* FT = (const float*)(p->ws + WS_FT4096); cf* FS = (cf*)(p->ws + WS_FS);
    for (int u = wg; u < 2048; u += nwg) {
        const int n = u & 1, d = (u >> 1) * 2;
        const float* ff0 = FT + (size_t)(n * 4096 + d) * 4096; const float* ff1 = ff0 + 4096; const float* fb0 = FT + (size_t)(n * 4096 + 2048 + d) * 4096; const float* fb1 = fb0 + 4096;
#pragma unroll
        for (int i = 0; i < 16; ++i) { const int k = TID + 512 * i; cf v;
            if (k < 4096) v = cf{ff0[k], ff1[k]}; else if (k == 4096) v = cf{0.f, 0.f}; else v = cf{fb0[8192 - k], fb1[8192 - k]};
            buf.set(fidx(k), v); }
        __syncthreads();
        fft_fwd(buf, tw, TID);
        const float s = 1.0f / (4.0f * FFT_N);
        cf* fd = FS + (size_t)(n * 2048 + d) * FS_LD; cf* fe = fd + FS_LD;
        int tq = TID; FFT_OPQ(tq);
#pragma unroll
        for (int i = 0; i < 9; ++i) { const int w = tq + 512 * i; if (w <= 4096) { const cf a = buf.get(fidx(fpos(w))), b = buf.get(fidx(fpos((FFT_N - w) & (FFT_N - 1))));
            fd[w] = cf{(a.x + b.x) * s, (a.y - b.y) * s}; fe[w] = cf{(a.y + b.y) * s, (b.x - a.x) * s}; } }
        __syncthreads();
    }
}
#endif

#ifndef FFT_HOST_TEST
constexpr int FS2_LD = 264;
FFT_HD int fpos512(int k) { return ((k & 15) << 5) | (((k >> 4) & 15) << 1) | ((k >> 8) & 1); }
template <class BufT, class TwT> FFT_HD void fft512_fwd(BufT buf, TwT tw, int tid) { fft_pass16<32, false>(buf, tw, tid); FFT_SYNC(); fft_pass16<2, false>(buf, tw, tid); FFT_SYNC(); fft_pass2(buf, tid); FFT_SYNC(); }
template <class BufT, class TwT> FFT_HD void fft512_inv(BufT buf, TwT tw, int tid) { fft_pass2(buf, tid); FFT_SYNC(); fft_pass16<2, true>(buf, tw, tid); FFT_SYNC(); fft_pass16<32, true>(buf, tw, tid); FFT_SYNC(); }
PH void ph_filter_fft256(KP p, unsigned char* ldsraw, int wg, int nwg) {
    const int TID = otid();
    const LdsCf buf{(LAS f32x2v*)ldsraw}, tw{(LAS f32x2v*)ldsraw + FFT_BUF};
    const cf* twg = (const cf*)(p->ws + WS_TW);
    for (int i = TID; i < FFT_N; i += 512) tw.set(i, twg[i]);
    __syncthreads();
    const float* FT = (const float*)(p->ws + WS_FT256); cf* FS = (cf*)(p->ws + WS_FS256);
    for (int u = wg; u < 128; u += nwg) {
        int tq = TID; FFT_OPQ(tq);
#pragma unroll 1
        for (int i = 0; i < 16; ++i) { const int combo = u * 16 + i, n = combo & 1, d = (combo >> 1) * 2, k = tq; cf v;
            const float* ff0 = FT + (size_t)(n * 4096 + d) * 256; const float* fb0 = FT + (size_t)(n * 4096 + 2048 + d) * 256;
            if (k < 256) v = cf{ff0[k], ff0[256 + k]}; else if (k == 256) v = cf{0.f, 0.f}; else v = cf{fb0[512 - k], fb0[256 + 512 - k]};
            buf.set(fidx(i * 512 + k), v); }
        __syncthreads();
        fft512_fwd(buf, tw, TID);
        const float s = 1.0f / (4.0f * 512.0f);
        int tw2 = TID; FFT_OPQ(tw2);
        if (tw2 <= 256) {
#pragma unroll 1
            for (int i = 0; i < 16; ++i) { const int combo = u * 16 + i, n = combo & 1, d = (combo >> 1) * 2, w = tw2;
                const cf a = buf.get(fidx(i * 512 + fpos512(w))), b = buf.get(fidx(i * 512 + fpos512((512 - w) & 511)));
                cf* fd = FS + (size_t)(n * 2048 + d) * FS2_LD; cf* fe = fd + FS2_LD;
                fd[w] = cf{(a.x + b.x) * s, (a.y - b.y) * s}; fe[w] = cf{(a.y + b.y) * s, (b.x - a.x) * s}; } }
        __syncthreads();
    }
}
PH void ph_hyena_fft256(KP p, unsigned char* ldsraw, int wg, int nwg) {
    const int TID = otid();
    const LdsCf buf{(LAS f32x2v*)ldsraw}, tw{(LAS f32x2v*)ldsraw + FFT_BUF};
    const cf* twg = (const cf*)(p->ws + WS_TW);
    for (int i = TID; i < FFT_N; i += 512) tw.set(i, twg[i]);
    __syncthreads();
    const _Float16* UT = (const _Float16*)(p->ws + WS_UT); u16* ZT = (u16*)(p->ws + WS_ZT); const cf* FS = (const cf*)(p->ws + WS_FS256);
    const float* cw = p->in[I_HCW]; const float* cb = p->in[I_HCB]; const float* skip = p->in[I_SKIP];
    for (int u = wg; u < 256; u += nwg) {
        int tz = TID; FFT_OPQ(tz);
        auto sconv = [&](int ch, int rb, int t) { const _Float16* uu = UT + (size_t)ch * R + rb; const float um = t > 0 ? (float)uu[t - 1] : 0.f, u0 = (float)uu[t], up = t < CTX - 1 ? (float)uu[t + 1] : 0.f;
            return um * cw[ch] + u0 * cw[3 * D + ch] + up * cw[6 * D + ch] + cb[ch]; };
        float z[16][2];
#pragma unroll
        for (int i = 0; i < 16; ++i) { const int seq = u * 16 + i, d = (seq >> 2) * 2, rb = (seq & 3) * SB; if (tz < 256) { z[i][0] = sconv(d, rb, tz); z[i][1] = sconv(d + 1, rb, tz); } else { z[i][0] = 0.f; z[i][1] = 0.f; } }
#pragma unroll 1
        for (int n = 0; n < 2; ++n) {
            int ts = TID; FFT_OPQ(ts);
#pragma unroll
            for (int i = 0; i < 16; ++i) buf.set(fidx(i * 512 + ts), cf{z[i][0], z[i][1]});
            __syncthreads();
            fft512_fwd(buf, tw, TID);
            int tq = TID; FFT_OPQ(tq);
            if (tq <= 256) {
#pragma unroll 1
                for (int i = 0; i < 16; ++i) { const int seq = u * 16 + i, d = (seq >> 2) * 2, w = tq; const cf* fd = FS + (size_t)(n * 2048 + d) * FS2_LD; const cf* fe = fd + FS2_LD;
                    const int pw = fidx(i * 512 + fpos512(w)), pn = fidx(i * 512 + fpos512((512 - w) & 511));
                    const cf a = buf.get(pw), bb = buf.get(pn); cf ya, yb; spec_pair(a, bb, fd[w], fe[w], ya, yb); buf.set(pw, ya); if (pn != pw) buf.set(pn, yb); } }
            __syncthreads();
            fft512_inv(buf, tw, TID);
            int tg = TID; FFT_OPQ(tg);
            if (tg < 256) {
#pragma unroll
                for (int i = 0; i < 16; ++i) { const int seq = u * 16 + i, d = (seq >> 2) * 2, rb = (seq & 3) * SB; const cf y = buf.get(fidx(i * 512 + tg));
                    z[i][0] = sconv((n + 1) * D + d, rb, tg) * (y.x + z[i][0] * skip[n * D + d]); z[i][1] = sconv((n + 1) * D + d + 1, rb, tg) * (y.y + z[i][1] * skip[n * D + d + 1]); } }
            __syncthreads();
        }
        int to = TID; FFT_OPQ(to);
        if (to < 256) {
#pragma unroll
            for (int i = 0; i < 16; ++i) { const int seq = u * 16 + i, d = (seq >> 2) * 2, rb = (seq & 3) * SB; ZT[(size_t)d * R + rb + to] = f2bf(z[i][0]); ZT[(size_t)(d + 1) * R + rb + to] = f2bf(z[i][1]); } }
    }
}
#endif

#ifndef FFT_HOST_TEST
template <int M, bool INV, bool HALF_ = false> FFT_HD void fft_pass16x2(const LdsCf bufA, const LdsCf bufB, const LdsCf tw, int tid) {
    FFT_OPQ(tid);
    const int blk = tid / M, n2 = tid % M, base = blk * 16 * M + n2;
    constexpr int ST = M + (M >> 5) + (M >> 9); const int a0 = fidx(base);
    cf va[16], vb[16];
#pragma unroll
    for (int j = 0; j < 16; ++j) { if (HALF_ && !INV && j >= 8) { va[j] = cf{0.f, 0.f}; vb[j] = cf{0.f, 0.f}; } else { va[j] = bufA.get(a0 + j * ST); vb[j] = bufB.get(a0 + j * ST); } }
    cf w[16];
    if (M > 1) { const cf w1 = tw.get(n2 * (FFT_N / (16 * M))); w[1] = w1; w[2] = cmul(w1, w1); w[3] = cmul(w[2], w1); w[4] = cmul(w[2], w[2]); w[5] = cmul(w[4], w1); w[6] = cmul(w[3], w[3]); w[7] = cmul(w[6], w1);
        w[8] = cmul(w[4], w[4]); w[9] = cmul(w[8], w1); w[10] = cmul(w[5], w[5]); w[11] = cmul(w[10], w1); w[12] = cmul(w[6], w[6]); w[13] = cmul(w[12], w1); w[14] = cmul(w[7], w[7]); w[15] = cmul(w[14], w1); }
    if (INV) { if (M > 1) {
#pragma unroll
        for (int k = 1; k < 16; ++k) { va[k] = cmulc(va[k], w[k]); vb[k] = cmulc(vb[k], w[k]); } } }
    dft16<INV, HALF_ && !INV>(va); dft16<INV, HALF_ && !INV>(vb);
    if (!INV) { if (M > 1) {
#pragma unroll
        for (int k = 1; k < 16; ++k) { va[k] = cmul(va[k], w[k]); vb[k] = cmul(vb[k], w[k]); } } }
#pragma unroll
    for (int j = 0; j < 16; ++j) { if (HALF_ && INV && j >= 8) continue; bufA.set(a0 + j * ST, va[j]); bufB.set(a0 + j * ST, vb[j]); }
}
FFT_HD void fft_pass2x2(const LdsCf bufA, const LdsCf bufB, int tid) {
    FFT_OPQ(tid);
    const int a0 = fidx(2 * tid);
#pragma unroll
    for (int i = 0; i < 8; ++i) { const int e = a0 + 1058 * i; const cf a = bufA.get(e), b = bufA.get(e + 1), c = bufB.get(e), d = bufB.get(e + 1);
        bufA.set(e, cadd(a, b)); bufA.set(e + 1, csub(a, b)); bufB.set(e, cadd(c, d)); bufB.set(e + 1, csub(c, d)); }
}
FFT_HD void fft_fwd_x2(const LdsCf a, const LdsCf b, const LdsCf tw, int tid) {
    fft_pass16x2<512, false>(a, b, tw, tid); FFT_SYNC(); fft_pass16x2<32, false>(a, b, tw, tid); FFT_SYNC(); fft_pass16x2<2, false>(a, b, tw, tid); FFT_SYNC(); fft_pass2x2(a, b, tid); FFT_SYNC();
}
FFT_HD void fft_fwd_x2_zp(const LdsCf a, const LdsCf b, const LdsCf tw, int tid) {
    fft_pass16x2<512, false, true>(a, b, tw, tid); FFT_SYNC(); fft_pass16x2<32, false>(a, b, tw, tid); FFT_SYNC(); fft_pass16x2<2, false>(a, b, tw, tid); FFT_SYNC(); fft_pass2x2(a, b, tid); FFT_SYNC();
}
FFT_HD void fft_inv_x2_zp(const LdsCf a, const LdsCf b, const LdsCf tw, int tid) {
    fft_pass2x2(a, b, tid); FFT_SYNC(); fft_pass16x2<2, true>(a, b, tw, tid); FFT_SYNC(); fft_pass16x2<32, true>(a, b, tw, tid); FFT_SYNC(); fft_pass16x2<512, true, true>(a, b, tw, tid); FFT_SYNC();
}
FFT_HD void fft_inv_x2(const LdsCf a, const LdsCf b, const LdsCf tw, int tid) {
    fft_pass2x2(a, b, tid); FFT_SYNC(); fft_pass16x2<2, true>(a, b, tw, tid); FFT_SYNC(); fft_pass16x2<32, true>(a, b, tw, tid); FFT_SYNC(); fft_pass16x2<512, true>(a, b, tw, tid); FFT_SYNC();
}
PH void ph_hyena_fft2(KP p, unsigned char* ldsraw, int wg, int nwg, bool skipfft = false) {
    const int TID = otid();
    const LdsCf bufA{(LAS f32x2v*)ldsraw}, bufB{(LAS f32x2v*)ldsraw + FFT_BUF}, tw{(LAS f32x2v*)ldsraw + 2 * FFT_BUF};
    const cf* twg = (const cf*)(p->ws + WS_TW);
    tw.set(TID, twg[TID]);
    __syncthreads();
    const _Float16* UT = (const _Float16*)(p->ws + WS_UT); u16* ZT = (u16*)(p->ws + WS_ZT); const cf* FS = (const cf*)(p->ws + WS_FS);
    const float* cw = p->in[I_HCW]; const float* cb = p->in[I_HCB]; const float* skip = p->in[I_SKIP];
    const int per = (2048 + nwg - 1) / nwg; const int u1 = (wg + 1) * per < 2048 ? (wg + 1) * per : 2048;
    for (int u = wg * per; u < u1; ++u) {
        const int d = (u >> 1) * 2, b0 = (u & 1) * 2;
        auto sconv4 = [&](int ch, int rb, int t0, float (&o)[4]) { const _Float16* uu = UT + (size_t)ch * R + rb + t0; const uint2 cq = *(const uint2*)uu;
            const float4 c4 = make_float4(pg8::h2f_lo(cq.x), pg8::h2f_hi(cq.x), pg8::h2f_lo(cq.y), pg8::h2f_hi(cq.y));
            const float um = t0 > 0 ? (float)uu[-1] : 0.f, up = t0 + 4 < S ? (float)uu[4] : 0.f, w0 = cw[ch], w1 = cw[3 * D + ch], w2 = cw[6 * D + ch], bb = cb[ch];
            o[0] = um * w0 + c4.x * w1 + c4.y * w2 + bb; o[1] = c4.x * w0 + c4.y * w1 + c4.z * w2 + bb; o[2] = c4.y * w0 + c4.z * w1 + c4.w * w2 + bb; o[3] = c4.z * w0 + c4.w * w1 + up * w2 + bb; };
        const int rbA = b0 * SB + CTX, rbB = rbA + SB;
        float za[2][4][2], zb[2][4][2];
        { int tz = TID; FFT_OPQ(tz);
#pragma unroll
          for (int i = 0; i < 2; ++i) { const int t0 = 4 * tz + 2048 * i; float q0[4], q1[4], q2[4], q3[4]; sconv4(d, rbA, t0, q0); sconv4(d + 1, rbA, t0, q1); sconv4(d, rbB, t0, q2); sconv4(d + 1, rbB, t0, q3);
#pragma unroll
              for (int k = 0; k < 4; ++k) { za[i][k][0] = q0[k]; za[i][k][1] = q1[k]; zb[i][k][0] = q2[k]; zb[i][k][1] = q3[k]; } } }
#pragma unroll 1
        for (int n = 0; n < 2; ++n) {
            int ts = TID; FFT_OPQ(ts);
#pragma unroll
            for (int i = 0; i < 2; ++i)
#pragma unroll
                for (int k = 0; k < 4; ++k) { const int e = fidx(4 * ts) + 2116 * i + k; bufA.set(e, cf{za[i][k][0], za[i][k][1]}); bufB.set(e, cf{zb[i][k][0], zb[i][k][1]}); }
            __syncthreads();
            if (!skipfft) fft_fwd_x2_zp(bufA, bufB, tw, TID);
            const cf* fd = FS + (size_t)(n * 2048 + d) * FS_LD; const cf* fe = fd + FS_LD;
            int tq = TID; FFT_OPQ(tq);
            const int pw0 = fidx(fpos(tq)), pn1 = fidx(fpos((FFT_N - tq - 512) & (FFT_N - 1)));
#pragma unroll
            for (int i = 0; i < 8; ++i) { const int w = tq + 512 * i; const bool self = i == 0 && tq == 0; const int pw = pw0 + 4 * i, pn = self ? pw : pn1 - 4 * (i - 1); const cf fdw = fd[w], few = fe[w];
                { const cf a = bufA.get(pw), bb = bufA.get(pn); cf ya, yb; spec_pair(a, bb, fdw, few, ya, yb); bufA.set(pw, ya); if (!self) bufA.set(pn, yb); }
                { const cf a = bufB.get(pw), bb = bufB.get(pn); cf ya, yb; spec_pair(a, bb, fdw, few, ya, yb); bufB.set(pw, ya); if (!self) bufB.set(pn, yb); } }
            if (TID == 0) { const int pw = fidx(fpos(4096)); const cf fdw = fd[4096], few = fe[4096]; cf ya, yb;
                { const cf a = bufA.get(pw); spec_pair(a, a, fdw, few, ya, yb); bufA.set(pw, ya); } { const cf a = bufB.get(pw); spec_pair(a, a, fdw, few, ya, yb); bufB.set(pw, ya); } }
            __syncthreads();
            if (!skipfft) fft_inv_x2_zp(bufA, bufB, tw, TID);
            const float sk0 = skip[n * D + d], sk1 = skip[n * D + d + 1];
            int ty = TID; FFT_OPQ(ty);
#pragma unroll
            for (int i = 0; i < 2; ++i) { const int t0 = 4 * ty + 2048 * i; float g0[4], g1[4], g2[4], g3[4]; sconv4((n + 1) * D + d, rbA, t0, g0); sconv4((n + 1) * D + d + 1, rbA, t0, g1); sconv4((n + 1) * D + d, rbB, t0, g2); sconv4((n + 1) * D + d + 1, rbB, t0, g3);
#pragma unroll
                for (int k = 0; k < 4; ++k) { const int e = fidx(4 * ty) + 2116 * i + k; const cf ya = bufA.get(e), yb = bufB.get(e);
                    za[i][k][0] = g0[k] * (ya.x + za[i][k][0] * sk0); za[i][k][1] = g1[k] * (ya.y + za[i][k][1] * sk1);
                    zb[i][k][0] = g2[k] * (yb.x + zb[i][k][0] * sk0); zb[i][k][1] = g3[k] * (yb.y + zb[i][k][1] * sk1); } }
            __syncthreads();
        }
        int to = TID; FFT_OPQ(to);
#pragma unroll
        for (int i = 0; i < 2; ++i) { const int t0 = 4 * to + 2048 * i;
#pragma unroll
            for (int c = 0; c < 2; ++c) {
                *(uint2*)(ZT + (size_t)(d + c) * R + rbA + t0) = make_uint2(pk2(za[i][0][c], za[i][1][c]), pk2(za[i][2][c], za[i][3][c]));
                *(uint2*)(ZT + (size_t)(d + c) * R + rbB + t0) = make_uint2(pk2(zb[i][0][c], zb[i][1][c]), pk2(zb[i][2][c], zb[i][3][c])); } }
    }
}
#endif

#ifndef UP_ALIGN
#define UP_ALIGN true
#endif
#ifndef UP_SP2
#define UP_SP2 true
#endif
#ifndef DN_ALIGN
#define DN_ALIGN true
#endif
#ifndef DN_SP2
#define DN_SP2 true
#endif
#ifndef DN_AUXA
#define DN_AUXA 0
#endif
constexpr int LDS_BYTES = 155648;
constexpr int LDS_MISC = LDS_BYTES - 256;
constexpr int CW_BAR = 4096;
constexpr size_t CTL_ZERO_BYTES = 65536;

__global__ void __launch_bounds__(512, 2) mega_fwd(Ptrs p_unused) {
#define p kargs()
    extern __shared__ __attribute__((aligned(16))) unsigned char lds[];
    const int tid = threadIdx.x; int wg = blockIdx.x, nwg = gridDim.x;
    volatile LAS unsigned* MISC = (volatile LAS unsigned*)((LAS unsigned char*)lds + LDS_MISC);
    if (tid < 64) MISC[tid] = 0u;
    __syncthreads();
    XcdBarrier bar = xcd_barrier_post((unsigned*)(p->ws + WS_CTL) + CW_BAR, MISC + 8);
#define GRID_BAR() do { xcd_barrier(bar); asm volatile("" : "+s"(ws), "+s"(wg), "+s"(nwg)); } while (0)
    PG8_LAS unsigned char* ring = (PG8_LAS unsigned char*)lds;
    unsigned char* ws = p->ws;
#define X ((u16*)(ws + WS_X))
#define HB ((u16*)(ws + WS_HB))
#define ACT ((u16*)(ws + WS_ACT))
#define MOD ((const float*)(ws + WS_MOD))
#define rope ((const float*)(ws + WS_ROPE))

#ifndef NO_PRO
    ph_modp(p, (float*)lds, wg, nwg);
#ifdef PROBE_MODP
    ph_modp(p, (float*)lds, wg, nwg);
#endif
    ph_tables(p, wg, nwg);
    ph_filters(p, (float*)lds, wg, nwg);
#ifdef PROBE_FILT
    ph_filters(p, (float*)lds, wg, nwg);
#endif
    { int t2 = threadIdx.x; asm volatile("" : "+v"(t2)); conv_all(p, (ConvDesc*)(lds + 8 * 64 * 33 * 4), (float*)lds + (t2 >> 6) * (64 * 33), wg * 8 + (t2 >> 6), nwg * 8, t2 & 63, 0, 3, 24, PRO_B1); }
#ifdef PROBE_CONV
    { int t2 = threadIdx.x; asm volatile("" : "+v"(t2)); conv_all(p, (ConvDesc*)(lds + 8 * 64 * 33 * 4), (float*)lds + (t2 >> 6) * (64 * 33), wg * 8 + (t2 >> 6), nwg * 8, t2 & 63, 0, 3, 24, PRO_B1); }
#endif
#endif
#ifdef PROBE_PRO
    GRID_BAR();
    ph_modp(p, (float*)lds, wg, nwg);
    ph_tables(p, wg, nwg);
    ph_filters(p, (float*)lds, wg, nwg);
    { int t2 = threadIdx.x; asm volatile("" : "+v"(t2)); conv_all(p, (ConvDesc*)(lds + 8 * 64 * 33 * 4), (float*)lds + (t2 >> 6) * (64 * 33), wg * 8 + (t2 >> 6), nwg * 8, t2 & 63, 0, 3, 24, PRO_B1); }
#endif
    GRID_BAR();
    ph_modr(p, wg, nwg);
    ph_filter_fft(p, lds, wg, nwg);
#ifdef PROBE_P1
    GRID_BAR();
    ph_modr(p, wg, nwg);
    ph_filter_fft(p, lds, wg, nwg);
    ph_filter_fft256(p, lds, nwg - 1 - wg, nwg);
#endif
#ifdef PROBE_FFFT
    ph_filter_fft(p, lds, wg, nwg);
#endif
    ph_filter_fft256(p, lds, nwg - 1 - wg, nwg);
    GRID_BAR();

    for (int layer = 0; layer < DEPTH; ++layer) {
        const int kind = layer % 3, jm = layer / 3;
#define modl (MOD + (size_t)layer * 5 * 9 * D)
#pragma unroll 1
        for (int f = 0; f < 2; ++f) {
            const int slot = f == 0 ? 0 : 2, lf = layer * 2 + f; const bool lastffn = layer == DEPTH - 1 && f == 1;
            { const float* pg = nullptr; if (f == 1) pg = lastffn ? nullptr : modl + (size_t)(4 * 9 + 3 * 1 + 2) * D; else if (layer > 0) pg = modl - (size_t)5 * 9 * D + (size_t)(4 * 9 + 3 * 2 + 2) * D;
              ph_modulate(p, layer, slot, pg, f == 1 ? 1.0f : 0.5f, wg, nwg, layer == 0 && f == 0);
#ifdef PROBE_THIN
              GRID_BAR(); ph_modulate(p, layer, slot, nullptr, 0.f, wg, nwg);
#endif
            }
            GRID_BAR();
            { pg8::Gemm g{HB, (const u16*)(ws + WS_WGU + lf * SZ_WGU), R, 2 * DFF, D}; pg8::UpOrder So; So.init(g.N, nwg, wg, lastffn);
              pg8::gemm_phase<pg8::EpiSwiGLU, pg8::UpOrder, UP_ALIGN, UP_SP2>(ring, g, So, pg8::EpiSwiGLU{ACT}); }
#ifdef PROBE_UP_NOEPI
            GRID_BAR();
            { pg8::Gemm g{HB, (const u16*)(ws + WS_WGU + lf * SZ_WGU), R, 2 * DFF, D}; pg8::UpOrder So; So.init(g.N, nwg, wg, lastffn);
              pg8::gemm_phase<pg8::EpiNever<pg8::EpiSwiGLU>, pg8::UpOrder, UP_ALIGN, UP_SP2>(ring, g, So, pg8::EpiNever<pg8::EpiSwiGLU>{pg8::EpiSwiGLU{ACT}, nwg == 12345}); }
#endif
#ifdef PROBE_UP
            GRID_BAR();
            { pg8::Gemm g{HB, (const u16*)(ws + WS_WGU + lf * SZ_WGU), R, 2 * DFF, D}; pg8::UpOrder So; So.init(g.N, nwg, wg, lastffn);
              pg8::gemm_phase<pg8::EpiSwiGLU, pg8::UpOrder, UP_ALIGN, UP_SP2>(ring, g, So, pg8::EpiSwiGLU{ACT}); }
#endif
#ifndef NO_TAILCONV
            if (!lastffn) {
                const int rem = (68 * 43) % nwg;
                if (wg >= rem) {
                    const int a0 = 3 * (lf + 1); int b0 = a0 + 3, b1 = a0 + 3;
#ifdef TAIL_MIXERS
                    if (f == 1) { const int k2 = (layer + 1) % 3; b0 = k2 == 1 ? 34 : k2 == 2 ? 36 : 24 + 5 * ((layer + 1) / 3); b1 = k2 == 0 ? b0 + 5 : b0 + 2; }
#endif
                    __syncthreads();
                    int t2 = threadIdx.x; asm volatile("" : "+v"(t2));
                    conv_tail((const ConvDesc*)(ws + WS_CTL + CTL_CONVTAB), (float*)lds + (t2 >> 6) * (64 * 33), (wg - rem) * 8 + (t2 >> 6), (nwg - rem) * 8, t2 & 63, a0, a0 + 3, b0, b1);
#ifdef PROBE_TAIL
                    conv_tail((const ConvDesc*)(ws + WS_CTL + CTL_CONVTAB), (float*)lds + (t2 >> 6) * (64 * 33), (wg - rem) * 8 + (t2 >> 6), (nwg - rem) * 8, t2 & 63, a0, a0 + 3, b0, b1);
#endif
                }
            }
#endif
            GRID_BAR();
            { pg8::Gemm g{ACT, (const u16*)(ws + WS_WD + lf * SZ_WD), R, D, DFF}; pg8::ResOrder So; So.init(DFF, nwg, wg, lastffn);
              pg8::gemm_phase<pg8::EpiResGate, pg8::ResOrder, DN_ALIGN, DN_SP2, DN_AUXA>(ring, g, So, pg8::EpiResGate{X, modl, slot, 0.5f, (u16*)(ws + WS_SLAB)}); }
            GRID_BAR();
#ifdef PROBE_DOWN
            { pg8::Gemm g{ACT, (const u16*)(ws + WS_WD + lf * SZ_WD), R, D, DFF}; pg8::ResOrder So; So.init(DFF, nwg, wg, lastffn);
              pg8::gemm_phase<pg8::EpiResGate, pg8::ResOrder, true, true>(ring, g, So, pg8::EpiResGate{X, modl, slot, 0.0f, (u16*)(ws + WS_SLAB)}); }
            GRID_BAR();
#endif
#ifdef PROBE_DOWN_NOEPI
            { pg8::Gemm g{ACT, (const u16*)(ws + WS_WD + lf * SZ_WD), R, D, DFF}; pg8::ResOrder So; So.init(DFF, nwg, wg, lastffn);
              pg8::gemm_phase<pg8::EpiNever<pg8::EpiResGate>, pg8::ResOrder, true, true>(ring, g, So, pg8::EpiNever<pg8::EpiResGate>{pg8::EpiResGate{X, modl, slot, 0.0f, (u16*)(ws + WS_SLAB)}, nwg == 12345}); }
            GRID_BAR();
#endif
            if (f == 0) {
                ph_modulate(p, layer, 1, modl + (size_t)(4 * 9 + 3 * 0 + 2) * D, 0.5f, wg, nwg);
#ifdef PROBE_THIN
                GRID_BAR(); ph_modulate(p, layer, 1, nullptr, 0.f, wg, nwg);
#endif
                GRID_BAR();
                const u16* Ao; const u16* Wo;
                if (kind == 0) {
                    u16* QKVA = (u16*)(ws + WS_QKVA);     u16* QL = (u16*)(ws + WS_QL); u16* CKV = (u16*)(ws + WS_CKV); u16* KR = (u16*)(ws + WS_KR); u16* Q = (u16*)(ws + WS_Q); u16* KN = (u16*)(ws + WS_KN); u16* V = (u16*)(ws + WS_V); u16* O = (u16*)(ws + WS_O);
                    { pg8::Gemm g{HB, (const u16*)(ws + WS_WDQKV) + (size_t)jm * QKVA_LD * D, R, QKVA_LD, D}; pg8::StaticOrder So; So.init(g.M, g.N, nwg, wg);
                      pg8::gemm_phase<pg8::EpiF16, pg8::StaticOrder, true, true>(ring, g, So, pg8::EpiF16{QKVA, QKVA_LD}); }
                    GRID_BAR();
                    ph_mla_norm(p, jm, wg, nwg);
                    GRID_BAR();
                    { pg8::Gemm g{QL, (const u16*)(ws + WS_WUQ) + (size_t)jm * 3072 * 512, R, 3072, 512}; pg8::UpOrder So; So.init(g.N, nwg, wg, layer == DEPTH - 1);
                      pg8::gemm_phase<pg8::EpiRope<0>, pg8::UpOrder, true, true>(ring, g, So, pg8::EpiRope<0>{Q, 3072, rope}); }
                    { pg8::Gemm g{CKV, (const u16*)(ws + WS_WUKV) + (size_t)jm * 4096 * 512, R, 4096, 512}; pg8::StaticOrder So; So.init(g.M, g.N, nwg, nwg - 1 - wg);
                      pg8::gemm_phase<pg8::EpiKV, pg8::StaticOrder, true, true>(ring, g, So, pg8::EpiKV{KN, V}); }
                    GRID_BAR();
#ifdef PROBE_MLAPRE
                    { pg8::Gemm g{HB, (const u16*)(ws + WS_WDQKV) + (size_t)jm * QKVA_LD * D, R, QKVA_LD, D}; pg8::StaticOrder So; So.init(g.M, g.N, nwg, wg);
                      pg8::gemm_phase<pg8::EpiF16, pg8::StaticOrder, true, true>(ring, g, So, pg8::EpiF16{QKVA, QKVA_LD}); }
                    GRID_BAR();
                    ph_mla_norm(p, jm, wg, nwg);
                    GRID_BAR();
                    { pg8::Gemm g{QL, (const u16*)(ws + WS_WUQ) + (size_t)jm * 3072 * 512, R, 3072, 512}; pg8::UpOrder So; So.init(g.N, nwg, wg, layer == DEPTH - 1);
                      pg8::gemm_phase<pg8::EpiRope<0>, pg8::UpOrder, true, true>(ring, g, So, pg8::EpiRope<0>{Q, 3072, rope}); }
                    { pg8::Gemm g{CKV, (const u16*)(ws + WS_WUKV) + (size_t)jm * 4096 * 512, R, 4096, 512}; pg8::StaticOrder So; So.init(g.M, g.N, nwg, nwg - 1 - wg);
                      pg8::gemm_phase<pg8::EpiKV, pg8::StaticOrder, true, true>(ring, g, So, pg8::EpiKV{KN, V}); }
                    GRID_BAR();
#endif
#ifndef NO_NAIVE
#ifdef PROBE_ATTN
#pragma unroll 1
                    for (int rep = 0; rep < 2; ++rep)
#endif
#ifdef PROBE_ATTN_ABL
                    ph_attn_mla<PROBE_ATTN_ABL>(Q, KN, KR, V, O, lds, wg, nwg, layer < DEPTH - 1);
#endif
                    ph_attn_mla(Q, KN, KR, V, O, lds, wg, nwg, layer < DEPTH - 1);
#endif
                    Ao = O; Wo = (const u16*)(ws + WS_WMO) + (size_t)jm * D * D;
                } else if (kind == 1) {
                    u16* UT = (u16*)(ws + WS_UT); u16* ZT = (u16*)(ws + WS_ZT);
                    { pg8::Gemm g{(const u16*)(ws + WS_WHIN), HB, 3 * D, R, D}; pg8::StaticOrder So; So.init(g.M, g.N, nwg, wg);
                      pg8::gemm_phase<pg8::EpiF16, pg8::StaticOrder, true, true>(ring, g, So, pg8::EpiF16{UT, R}); }
#ifdef PROBE_HIN
                    GRID_BAR();
                    { pg8::Gemm g{(const u16*)(ws + WS_WHIN), HB, 3 * D, R, D}; pg8::StaticOrder So; So.init(g.M, g.N, nwg, wg);
                      pg8::gemm_phase<pg8::EpiF16, pg8::StaticOrder, true, true>(ring, g, So, pg8::EpiF16{UT, R}); }
#endif
                    GRID_BAR();
#ifndef NO_NAIVE
#ifdef PROBE_HYF
#pragma unroll 1
                    for (int rep = 0; rep < 2; ++rep)
#endif
#ifdef PROBE_HYF_NOFFT
#pragma unroll 1
                    for (int rep = 0; rep < 2; ++rep)
                    ph_hyena_fft2(p, lds, wg, nwg, rep == 0);
#else
                    ph_hyena_fft2(p, lds, wg, nwg);
#endif
                    ph_hyena_fft256(p, lds, wg, nwg);
#ifdef PROBE_HYC
                    ph_hyena_fft256(p, lds, wg, nwg);
#endif
#endif
                    GRID_BAR();
                    ph_transpose(ZT, HB, (u16*)lds, wg, nwg);
                    Ao = HB; Wo = (const u16*)(ws + WS_WHOUT);
                } else {
                    u16* QKV = (u16*)(ws + WS_QKV); u16* O = (u16*)(ws + WS_WO);
                    { pg8::Gemm g{HB, (const u16*)(ws + WS_WWQKV), R, 2560, D}; pg8::StaticOrder So; So.init(g.M, g.N, nwg, wg);
                      pg8::gemm_phase<pg8::EpiRope<1>, pg8::StaticOrder, true, true>(ring, g, So, pg8::EpiRope<1>{QKV, 2560, rope}); }
                    GRID_BAR();
#ifndef NO_NAIVE
#ifdef PROBE_WIN
#pragma unroll 1
                    for (int rep = 0; rep < 2; ++rep)
#endif
                    ph_attn_win(QKV, p->in[I_SINK], O, lds, wg, nwg);
#endif
                    Ao = O; Wo = (const u16*)(ws + WS_WWO);
                }
                GRID_BAR();
                { pg8::Gemm g{Ao, Wo, R, D, D}; pg8::ResOrder So; So.init(D, nwg, wg, layer == DEPTH - 1);
                  pg8::gemm_phase<pg8::EpiResGate, pg8::ResOrder, true, true>(ring, g, So, pg8::EpiResGate{X, modl, 1, 1.0f, (u16*)(ws + WS_SLAB)}); }
                GRID_BAR();
#ifdef PROBE_WO
                { pg8::Gemm g{Ao, Wo, R, D, D}; pg8::ResOrder So; So.init(D, nwg, wg, layer == DEPTH - 1);
                  pg8::gemm_phase<pg8::EpiResGate, pg8::ResOrder, true, true>(ring, g, So, pg8::EpiResGate{X, modl, 1, 0.0f, (u16*)(ws + WS_SLAB)}); }
                GRID_BAR();
#endif
            }
        }
    }
    ph_final(p, wg, nwg);
#undef p
#undef X
#undef HB
#undef ACT
#undef MOD
#undef rope
#undef modl
}
}

extern "C" void kernel_launch(void* const* d_in, const int* in_sizes, int n_in, void* d_out, int out_size, void* d_ws, size_t ws_size, hipStream_t stream) {
    static int grid = 0;
    if (grid == 0) {
        if (n_in != 35 || ws_size < WS_TOTAL || out_size != NB * S * D) { fprintf(stderr, "kernel_launch: unexpected shapes (n_in %d, ws %zu need %zu, out %d)\n", n_in, ws_size, (size_t)WS_TOTAL, out_size); grid = -1; return; }
        int dev = 0, cus = 0, per_cu = 0;
        if (hipGetDevice(&dev) != hipSuccess || hipDeviceGetAttribute(&cus, hipDeviceAttributeMultiprocessorCount, dev) != hipSuccess || cus <= 0) { fprintf(stderr, "kernel_launch: device query failed\n"); grid = -1; return; }
        if (hipFuncSetAttribute((const void*)mega_fwd, hipFuncAttributeMaxDynamicSharedMemorySize, LDS_BYTES) != hipSuccess) { fprintf(stderr, "kernel_launch: hipFuncSetAttribute failed\n"); grid = -1; return; }
        if (hipOccupancyMaxActiveBlocksPerMultiprocessor(&per_cu, (const void*)mega_fwd, 512, LDS_BYTES) != hipSuccess || per_cu < 1) fprintf(stderr, "kernel_launch: note: occupancy query reports %d workgroups per CU\n", per_cu);
        (void)hipGetLastError();
        grid = cus;
    }
    if (grid < 0) return;
    if (hipMemsetAsync((char*)d_ws + WS_CTL, 0, CTL_ZERO_BYTES, stream) != hipSuccess) { fprintf(stderr, "kernel_launch: memset failed\n"); return; }
    Ptrs p{}; for (int i = 0; i < 35; ++i) p.in[i] = (const float*)d_in[i]; p.out = (float*)d_out; p.ws = (unsigned char*)d_ws;
    hipLaunchKernelGGL(mega_fwd, dim3(grid), dim3(512), LDS_BYTES, stream, p);
    const hipError_t le = hipPeekAtLastError();
    if (le != hipSuccess) fprintf(stderr, "kernel_launch: launch failed: %s\n", hipGetErrorName(le));
}
```

```cpp
#define TAIL_MIXERS 1
#define RES_4X8 1
#define RES_NOSTAGGER 1
#define MLA_NOSWAP 1
#define QROPE_REG 1
#define CONV_NT 1
#include <hip/hip_runtime.h>
#include <cstdio>
#include <cstdint>
#include <cmath>

namespace {
typedef unsigned short u16;
constexpr int D = 2048, NB = 4, S = 4096, CTX = 256, SB = S + CTX, R = NB * SB, DFF = 5504, NMODV = 9 * D, DEPTH = 4;
constexpr int QKVA_LD = 1280;
constexpr float NORM_EPS = 1e-6f;

constexpr size_t al(size_t x) { return (x + 255) / 256 * 256; }
constexpr size_t WS_CTL = 0;
constexpr size_t WS_X = 1u << 20;
constexpr size_t WS_HB = WS_X + al((size_t)R * D * 4);
constexpr size_t WS_ACT = WS_HB + al((size_t)R * D * 2);
constexpr size_t WS_MODP = WS_ACT + al((size_t)R * DFF * 2);
constexpr size_t WS_MOD = WS_MODP + al((size_t)16 * DEPTH * 5 * NMODV * 4);
constexpr size_t WS_ROPE = WS_MOD + al((size_t)DEPTH * 5 * NMODV * 4);
constexpr size_t WS_TW = WS_ROPE + al(64 * 16 * 2 * 4);
constexpr size_t WS_FS = WS_TW + al(8192 * 8);
constexpr size_t WS_FT256 = WS_FS + al((size_t)2 * 2048 * 4104 * 8);
constexpr size_t WS_MIX = WS_FT256 + al((size_t)8192 * 256 * 4);
constexpr size_t WS_FT4096 = WS_MIX;
constexpr size_t WS_QKVA = WS_MIX;
constexpr size_t WS_QL = WS_QKVA + al((size_t)R * QKVA_LD * 4);
constexpr size_t WS_CKV = WS_QL + al((size_t)R * 512 * 2);
constexpr size_t WS_KR = WS_CKV + al((size_t)R * 512 * 2);
constexpr size_t WS_Q = WS_KR + al((size_t)R * 64 * 2);
constexpr size_t WS_KN = WS_Q + al((size_t)R * 3072 * 2);
constexpr size_t WS_V = WS_KN + al((size_t)R * D * 2);
constexpr size_t WS_O = WS_V + al((size_t)R * D * 2);
constexpr size_t WS_MLA_END = WS_O + al((size_t)R * D * 2);
constexpr size_t WS_UT = WS_MIX;
constexpr size_t WS_ZT = WS_UT + al((size_t)3 * D * R * 4);
constexpr size_t WS_HY_END = WS_ZT + al((size_t)D * R * 2);
constexpr size_t WS_QKV = WS_MIX;
constexpr size_t WS_WO = WS_QKV + al((size_t)R * 2560 * 2);
constexpr size_t WS_WIN_END = WS_WO + al((size_t)R * D * 2);
constexpr size_t WS_END = (WS_MLA_END > WS_HY_END ? (WS_MLA_END > WS_WIN_END ? WS_MLA_END : WS_WIN_END) : (WS_HY_END > WS_WIN_END ? WS_HY_END : WS_WIN_END));
constexpr size_t SZ_WGU = (size_t)2 * DFF * D * 2, SZ_WD = (size_t)D * DFF * 2;
constexpr size_t WS_WGU = al(WS_END);
constexpr size_t WS_WD = WS_WGU + 8 * SZ_WGU;
constexpr size_t WS_WDQKV = WS_WD + 8 * SZ_WD;
constexpr size_t WS_WUQ = WS_WDQKV + 2 * (size_t)QKVA_LD * D * 2;
constexpr size_t WS_WUKV = WS_WUQ + 2 * (size_t)3072 * 512 * 2;
constexpr size_t WS_WMO = WS_WUKV + 2 * (size_t)4096 * 512 * 2;
constexpr size_t WS_WHIN = WS_WMO + 2 * (size_t)D * D * 2;
constexpr size_t WS_WHOUT = WS_WHIN + (size_t)3 * D * D * 2;
constexpr size_t WS_WWQKV = WS_WHOUT + (size_t)D * D * 2;
constexpr size_t WS_WWO = WS_WWQKV + (size_t)2560 * D * 2;
constexpr size_t WS_SLAB = WS_WWO + (size_t)D * D * 2;
constexpr size_t WS_FS256 = WS_SLAB + (size_t)8 * 4 * 256 * D * 4;
constexpr size_t WS_TOTAL = WS_FS256 + (size_t)2 * 2048 * 264 * 8;
static_assert(WS_TOTAL < 2000000000ull, "workspace map exceeds the guaranteed size");

__device__ __forceinline__ float bf2f(u16 b) { return __uint_as_float(((unsigned)b) << 16); }
__device__ __forceinline__ unsigned pk2(float lo, float hi) { unsigned r; asm("v_cvt_pk_bf16_f32 %0, %1, %2" : "=v"(r) : "v"(lo), "v"(hi)); return r; }
__device__ __forceinline__ u16 f2bf(float f) { return (u16)(pk2(f, f) & 0xffffu); }
template <int X> __device__ __forceinline__ float swz_xor(float v) { return __int_as_float(__builtin_amdgcn_ds_swizzle(__float_as_int(v), 0x1f | (X << 10))); }
__device__ __forceinline__ float wave_sum(float v) {
    v += swz_xor<1>(v); v += swz_xor<2>(v); v += swz_xor<4>(v); v += swz_xor<8>(v); v += swz_xor<16>(v);
    auto rr = __builtin_amdgcn_permlane32_swap(__float_as_uint(v), __float_as_uint(v), false, false); return __uint_as_float(rr[0]) + __uint_as_float(rr[1]);
}
__device__ __forceinline__ float wave_max(float v) {
    v = fmaxf(v, swz_xor<1>(v)); v = fmaxf(v, swz_xor<2>(v)); v = fmaxf(v, swz_xor<4>(v)); v = fmaxf(v, swz_xor<8>(v)); v = fmaxf(v, swz_xor<16>(v));
    auto rr = __builtin_amdgcn_permlane32_swap(__float_as_uint(v), __float_as_uint(v), false, false); return fmaxf(__uint_as_float(rr[0]), __uint_as_float(rr[1]));
}
__device__ __forceinline__ int modidx_of_row(int r) { const int b = r / SB, j = r - b * SB; return j < CTX ? 4 : b; }
__device__ __forceinline__ float silu_f(float x) { return x / (1.f + expf(-x)); }

struct Ptrs {
    const float* in[35];
    float* out;
    unsigned char* ws;
};
typedef const __attribute__((address_space(4))) Ptrs* KP;
__device__ __forceinline__ KP kargs() { KP q = (KP)__builtin_amdgcn_kernarg_segment_ptr(); asm volatile("" : "+s"(q)); return q; }
enum { I_X = 0, I_C, I_CTX, I_CCTX, I_MODW, I_MODB, I_NORMG, I_FINALG, I_WG, I_WU, I_WD, I_DQ, I_GQ, I_UQ, I_DKV, I_GKV, I_UKV, I_MWO,
       I_HWIN, I_HCW, I_HCB, I_FW1, I_FB1, I_FW2, I_FB2, I_FW3, I_FB3, I_FFREQ, I_FW4, I_DECAY, I_SKIP, I_HWOUT, I_WQKV, I_SINK, I_WWO };


}

namespace pg8 {
#define PG8_LAS __attribute__((address_space(3)))
typedef unsigned short bf16_t;
typedef short bf16x8 __attribute__((ext_vector_type(8)));
typedef float f32x4 __attribute__((ext_vector_type(4)));
typedef unsigned u32x4 __attribute__((ext_vector_type(4)));
constexpr int BM = 256, BK = 64, HALF = 128, HTB = HALF * BK * 2  , STAGE_BYTES = 8 * HTB, NXCD = 8, WGM = 8;

__host__ __device__ __forceinline__ int lds_byte(int r, int c) { const int st = (r >> 4) * 2 + (c >> 5), rr = r & 15, cc = c & 31, ob = rr * 64 + cc * 2; return st * 1024 + (ob ^ (((ob >> 9) & 1) << 5)); }
__host__ __device__ __forceinline__ void stage_rc(int b, int& R, int& C) { const int st = b / 1024, sb = b % 1024, swz = sb ^ (((sb >> 9) & 1) << 5); R = (st >> 1) * 16 + swz / 64; C = (st & 1) * 32 + (swz % 64) / 2; }
__host__ __device__ __forceinline__ int perm32(int rho) { const int n = rho >> 4, i = rho & 15; return 8 * (i >> 2) + 4 * n + (i & 3); }

struct Unit { int pm, pn; int kt0 = 0, nt = 0, sp = -1; };
struct Gemm { const bf16_t* A; const bf16_t* Bt; int M, N, K; };

struct StaticOrder {
    int nM, nN, nwg, G, c;
    __host__ __device__ __forceinline__ void init(int M, int N, int G_, int c_) { nM = M / BM; nN = N / BM; nwg = nM * nN; G = G_; c = c_; }
    __host__ __device__ __forceinline__ bool next(int i, Unit& u) const {
        const long L = (long)i * G + c; if (L >= nwg) return false;
        int wgid = (int)L; { const int q = nwg / NXCD, r = nwg % NXCD, xcd = wgid % NXCD, off = wgid / NXCD; wgid = (xcd < r ? xcd * (q + 1) : r * (q + 1) + (xcd - r) * q) + off; }
        const int nig = WGM * nN, gid = wgid / nig, fm = gid * WGM, gsz = (nM - fm) < WGM ? (nM - fm) : WGM;
        u.pm = fm + ((wgid % nig) % gsz); u.pn = (wgid % nig) / gsz; return true;
    }
    __device__ __forceinline__ void a_ready(const Unit&) const {}
    __device__ __forceinline__ void done(const Unit&) const {}
};


__device__ __forceinline__ unsigned cvt_pk_bf16(float lo, float hi) { unsigned r; asm("v_cvt_pk_bf16_f32 %0, %1, %2" : "=v"(r) : "v"(lo), "v"(hi)); return r; }
typedef float f32x2 __attribute__((ext_vector_type(2)));

struct EpiF32 {
    static constexpr bool PERM = false, AFTER_DRAIN = false;
    float* C; int ldc;
    __device__ __forceinline__ void operator()(const f32x4 (&acc)[2][2][4][2], const Unit& u, int wr, int wc, int fr, int fq) const {
        const int row0 = u.pm * BM + wr * 64 + fr, col0 = u.pn * BM + wc * 32 + 4 * fq;
#pragma unroll
        for (int ai = 0; ai < 2; ++ai)
#pragma unroll
            for (int m = 0; m < 4; ++m) { float* rowp = C + (size_t)(row0 + ai * HALF + m * 16) * ldc + col0;
#pragma unroll
                for (int bj = 0; bj < 2; ++bj)
#pragma unroll
                    for (int n = 0; n < 2; ++n) *(f32x4*)(rowp + bj * HALF + n * 16) = acc[ai][bj][m][n]; }
    }
};
struct EpiBf16 {
    static constexpr bool PERM = true, AFTER_DRAIN = false;
    bf16_t* C; int ldc;
    __device__ __forceinline__ void operator()(const f32x4 (&acc)[2][2][4][2], const Unit& u, int wr, int wc, int fr, int fq) const {
        const int row0 = u.pm * BM + wr * 64 + fr, col0 = u.pn * BM + wc * 32 + 8 * fq;
#pragma unroll
        for (int ai = 0; ai < 2; ++ai)
#pragma unroll
            for (int m = 0; m < 4; ++m)
#pragma unroll
                for (int bj = 0; bj < 2; ++bj) { const f32x4 v0 = acc[ai][bj][m][0], v1 = acc[ai][bj][m][1];
                    u32x4 w; w.x = cvt_pk_bf16(v0[0], v0[1]); w.y = cvt_pk_bf16(v0[2], v0[3]); w.z = cvt_pk_bf16(v1[0], v1[1]); w.w = cvt_pk_bf16(v1[2], v1[3]);
                    *(u32x4*)(C + (size_t)(row0 + ai * HALF + m * 16) * ldc + col0 + bj * HALF) = w; }
    }
};
__device__ __forceinline__ unsigned swiglu_pk(float g0, float g1, float u0, float u1) {
    const f32x2 g = {g0, g1}, u = {u0, u1};
    const f32x2 t = g * -1.4426950408889634f;
    f32x2 e; e.x = __builtin_amdgcn_exp2f(t.x); e.y = __builtin_amdgcn_exp2f(t.y);
    const f32x2 d = e + 1.0f;
    f32x2 r; r.x = __builtin_amdgcn_rcpf(d.x); r.y = __builtin_amdgcn_rcpf(d.y);
    const f32x2 o = (g * u) * r;
    unsigned w; asm("v_cvt_pk_bf16_f32 %0, %1, %2" : "=v"(w) : "v"(o.x), "v"(o.y)); return w;
}
struct EpiSwiGLU {
    static constexpr bool PERM = true, AFTER_DRAIN = false;
    bf16_t* act;
    __device__ __forceinline__ void operator()(const f32x4 (&acc)[2][2][4][2], const Unit& u, int wr, int wc, int fr, int fq) const {
        const int row0 = u.pm * BM + wr * 64 + fr, col0 = u.pn * HALF + wc * 32 + 8 * fq;
#pragma unroll
        for (int ai = 0; ai < 2; ++ai)
#pragma unroll
            for (int m = 0; m < 4; ++m) { const f32x4 g0 = acc[ai][0][m][0], g1 = acc[ai][0][m][1], u0 = acc[ai][1][m][0], u1 = acc[ai][1][m][1];
                u32x4 w; w.x = swiglu_pk(g0[0], g0[1], u0[0], u0[1]); w.y = swiglu_pk(g0[2], g0[3], u0[2], u0[3]); w.z = swiglu_pk(g1[0], g1[1], u1[0], u1[1]); w.w = swiglu_pk(g1[2], g1[3], u1[2], u1[3]);
                *(u32x4*)(act + (size_t)(row0 + ai * HALF + m * 16) * DFF + col0) = w; }
    }
};
typedef _Float16 f16x2 __attribute__((ext_vector_type(2)));
__device__ __forceinline__ float h16_lim() { float l; asm volatile("s_mov_b32 %0, 0x477fe000" : "=s"(l)); return l; }
__device__ __forceinline__ unsigned pkh2(float lo, float hi, float lim) { f16x2 h; h[0] = (_Float16)__builtin_amdgcn_fmed3f(lo, -lim, lim); h[1] = (_Float16)__builtin_amdgcn_fmed3f(hi, -lim, lim); return __builtin_bit_cast(unsigned, h); }
__device__ __forceinline__ float h2f_lo(unsigned w) { const f16x2 h = __builtin_bit_cast(f16x2, w); return (float)h[0]; }
__device__ __forceinline__ float h2f_hi(unsigned w) { const f16x2 h = __builtin_bit_cast(f16x2, w); return (float)h[1]; }
struct EpiResGate {
    static constexpr bool PERM = true, AFTER_DRAIN = false;
    bf16_t* X; const float* modl; int slot; float coef; bf16_t* slab;
    __device__ __forceinline__ void operator()(const f32x4 (&acc)[2][2][4][2], const Unit& u, int wr, int wc, int fr, int fq) const {
        const int col0 = u.pn * BM + wc * 32 + 8 * fq;
        const int q = u.pm % 17, midx = q == 0 ? 4 : u.pm / 17;
        if (u.sp >= 0) {
            bf16_t* sp = slab + ((size_t)(u.sp * 4 + u.pm / 17) * 256 + wr * 64 + fr) * D + col0;
#pragma unroll
            for (int ai = 0; ai < 2; ++ai)
#pragma unroll
                for (int m = 0; m < 4; ++m) { bf16_t* rowp = sp + (size_t)(ai * HALF + m * 16) * D;
#pragma unroll
                    for (int bj = 0; bj < 2; ++bj) { const f32x4 v0 = acc[ai][bj][m][0], v1 = acc[ai][bj][m][1];
                        u32x4 w; w.x = cvt_pk_bf16(v0[0], v0[1]); w.y = cvt_pk_bf16(v0[2], v0[3]); w.z = cvt_pk_bf16(v1[0], v1[1]); w.w = cvt_pk_bf16(v1[2], v1[3]);
                        *(u32x4*)(rowp + bj * HALF) = w; } }
            return;
        }
        const int row0 = u.pm * BM + wr * 64 + fr; const float lim = h16_lim();
        const float* gp = modl + ((size_t)midx * 9 + 3 * slot + 2) * D + col0;
        f32x4 gv[2][2];
#pragma unroll
        for (int bj = 0; bj < 2; ++bj)
#pragma unroll
            for (int n = 0; n < 2; ++n) gv[bj][n] = *(const f32x4*)(gp + bj * HALF + 4 * n) * coef;
#pragma unroll
        for (int ai = 0; ai < 2; ++ai)
#pragma unroll
            for (int m = 0; m < 4; ++m) { bf16_t* rowp = X + (size_t)(row0 + ai * HALF + m * 16) * D + col0;
#pragma unroll
                for (int bj = 0; bj < 2; ++bj) { u32x4* px = (u32x4*)(rowp + bj * HALF); const u32x4 xo = *px;
                    const f32x4 a0 = (f32x4){h2f_lo(xo.x), h2f_hi(xo.x), h2f_lo(xo.y), h2f_hi(xo.y)} + gv[bj][0] * acc[ai][bj][m][0];
                    const f32x4 a1 = (f32x4){h2f_lo(xo.z), h2f_hi(xo.z), h2f_lo(xo.w), h2f_hi(xo.w)} + gv[bj][1] * acc[ai][bj][m][1];
                    u32x4 w; w.x = pkh2(a0[0], a0[1], lim); w.y = pkh2(a0[2], a0[3], lim); w.z = pkh2(a1[0], a1[1], lim); w.w = pkh2(a1[2], a1[3], lim);
                    *px = w; } }
    }
};
struct EpiF16 {
    static constexpr bool PERM = true, AFTER_DRAIN = false;
    bf16_t* C; int ldc;
    __device__ __forceinline__ void operator()(const f32x4 (&acc)[2][2][4][2], const Unit& u, int wr, int wc, int fr, int fq) const {
        const int row0 = u.pm * BM + wr * 64 + fr, col0 = u.pn * BM + wc * 32 + 8 * fq; const float lim = h16_lim();
#pragma unroll
        for (int ai = 0; ai < 2; ++ai)
#pragma unroll
            for (int m = 0; m < 4; ++m)
#pragma unroll
                for (int bj = 0; bj < 2; ++bj) { const f32x4 v0 = acc[ai][bj][m][0], v1 = acc[ai][bj][m][1];
                    u32x4 w; w.x = pkh2(v0[0], v0[1], lim); w.y = pkh2(v0[2], v0[3], lim); w.z = pkh2(v1[0], v1[1], lim); w.w = pkh2(v1[2], v1[3], lim);
                    *(u32x4*)(C + (size_t)(row0 + ai * HALF + m * 16) * ldc + col0 + bj * HALF) = w; }
    }
};
struct ResOrder {
    StaticOrder so; int G, c, K; bool nosplit;
    __device__ __forceinline__ void init(int K_, int G_, int c_, bool nosplit_ = false) { so.init(64 * BM, 2048, G_, c_); G = G_; c = c_; K = K_; nosplit = nosplit_; }
    __device__ __forceinline__ bool next(int i, Unit& u) const {
        int ii = i;
#ifndef RES_NOSTAGGER
        if (G == 256 && ((c >> 3) & 1) && !nosplit) ii = i == 0 ? 2 : i - 1;
#endif
        const long L = (long)ii * G + c;
        if (i > 2 && G == 256) return false;
        if (L >= 768 || (nosplit && L >= 512)) return false;
        const bool full = L < 512;
        Unit v; v.pm = 0; v.pn = 0; so.next(full ? ii : 0, v);
        const int it = full ? 0 : (int)(L - 512), cu = it >> 3, s = it & 7, np = K / 128, p0 = (np * s) / 8, p1 = (np * (s + 1)) / 8;
#ifdef RES_4X8
        { const int off = (v.pm & 7) + 8 * v.pn; v.pm = (v.pm & ~7) + (off & 3) + 4 * (off >> 5); v.pn = (off >> 2) & 7; }
#endif
        const int pm = full ? (v.pm >> 4) * 17 + 1 + (v.pm & 15) : 17 * (cu >> 3), pn = full ? v.pn : (cu & 7);
        u.pm = pm; u.pn = pn; u.kt0 = full ? 0 : 2 * p0; u.nt = full ? 0 : 2 * (p1 - p0); u.sp = full ? -1 : s;
        return true;
    }
    __device__ __forceinline__ void a_ready(const Unit&) const {}
    __device__ __forceinline__ void done(const Unit&) const {}
};
struct UpOrder {
    StaticOrder so68, so64; bool latent_only;
    __device__ __forceinline__ void init(int N, int G_, int c_, bool latent_only_) { so68.init(68 * BM, N, G_, c_); so64.init(64 * BM, N, G_, c_); latent_only = latent_only_; }
    __device__ __forceinline__ bool next(int i, Unit& u) const {
        Unit a, b; a.pm = 0; a.pn = 0; b.pm = 0; b.pn = 0;
        const bool ok68 = so68.next(i, a), ok64 = so64.next(i, b);
        const int pm = latent_only ? (b.pm >> 4) * 17 + 1 + (b.pm & 15) : a.pm, pn = latent_only ? b.pn : a.pn;
        u.pm = pm; u.pn = pn; u.kt0 = 0; u.nt = 0; u.sp = -1;
        return latent_only ? ok64 : ok68;
    }
    __device__ __forceinline__ void a_ready(const Unit&) const {}
    __device__ __forceinline__ void done(const Unit&) const {}
};
struct EpiKV {
    static constexpr bool PERM = true, AFTER_DRAIN = false;
    bf16_t* KN; bf16_t* V;
    __device__ __forceinline__ void operator()(const f32x4 (&acc)[2][2][4][2], const Unit& u, int wr, int wc, int fr, int fq) const {
        const int row0 = u.pm * BM + wr * 64 + fr, col0 = u.pn * HALF + wc * 32 + 8 * fq;
#pragma unroll
        for (int ai = 0; ai < 2; ++ai)
#pragma unroll
            for (int m = 0; m < 4; ++m)
#pragma unroll
                for (int bj = 0; bj < 2; ++bj) { const f32x4 v0 = acc[ai][bj][m][0], v1 = acc[ai][bj][m][1];
                    u32x4 w; w.x = cvt_pk_bf16(v0[0], v0[1]); w.y = cvt_pk_bf16(v0[2], v0[3]); w.z = cvt_pk_bf16(v1[0], v1[1]); w.w = cvt_pk_bf16(v1[2], v1[3]);
                    *(u32x4*)((bj ? V : KN) + (size_t)(row0 + ai * HALF + m * 16) * D + col0) = w; }
    }
};
template <int MODE> struct EpiRope {
    static constexpr bool PERM = false, AFTER_DRAIN = false;
    bf16_t* C; int ldc; const float* rope;
    __device__ __forceinline__ void operator()(const f32x4 (&acc)[2][2][4][2], const Unit& u, int wr, int wc, int fr, int fq) const {
        typedef unsigned u32x2 __attribute__((ext_vector_type(2)));
        const int row0 = u.pm * BM + wr * 64 + fr, col0 = u.pn * BM + wc * 32 + 4 * fq;
        const int q = u.pm % 17; const bool isctx = q == 0; const int t0 = (q - 1) * 256 + wr * 64 + fr;
#pragma unroll
        for (int bj = 0; bj < 2; ++bj) {
            const int g32 = 8 * u.pn + 4 * bj + wc; int ty;
            if (MODE == 0) { const int gi = g32 % 6; ty = gi == 4 ? 1 : (gi == 5 ? 2 : 0); } else { ty = g32 < 72 ? 1 + (g32 & 1) : 0; }
            if (isctx) ty = 0;
#pragma unroll
            for (int ai = 0; ai < 2; ++ai)
#pragma unroll
                for (int m = 0; m < 4; ++m) { f32x4 x1 = acc[ai][bj][m][0], x2 = acc[ai][bj][m][1];
                    if (ty) { const int t = t0 + ai * HALF + m * 16, pos = ty == 1 ? (t >> 6) : (t & 63); const f32x4* rp = (const f32x4*)(rope + (size_t)(pos * 16 + 4 * fq) * 2); const f32x4 r0 = rp[0], r1 = rp[1];
                        const f32x4 cs = {r0[0], r0[2], r1[0], r1[2]}, sn = {r0[1], r0[3], r1[1], r1[3]}; const f32x4 o1 = x1 * cs - x2 * sn, o2 = x2 * cs + x1 * sn; x1 = o1; x2 = o2; }
                    bf16_t* rowp = C + (size_t)(row0 + ai * HALF + m * 16) * ldc + col0 + bj * HALF;
                    u32x2 w0, w1; w0.x = cvt_pk_bf16(x1[0], x1[1]); w0.y = cvt_pk_bf16(x1[2], x1[3]); w1.x = cvt_pk_bf16(x2[0], x2[1]); w1.y = cvt_pk_bf16(x2[2], x2[3]);
                    *(u32x2*)rowp = w0; *(u32x2*)(rowp + 16) = w1; }
        }
    }
};

template <class E_> struct EpiNever {
    static constexpr bool PERM = E_::PERM, AFTER_DRAIN = false;
    E_ e; bool on;
    __device__ __forceinline__ void operator()(const f32x4 (&acc)[2][2][4][2], const Unit& u, int wr, int wc, int fr, int fq) const { if (on) e(acc, u, wr, wc, fr, fq); }
};
template <class Epi, class Sched, bool ALIGN_EPI = false, bool SP2 = false, int AUXA = 0>
__device__ __forceinline__ void gemm_phase(PG8_LAS unsigned char* lds, const Gemm g, const Sched& S, const Epi& E) {
    int tid_ = threadIdx.x; asm volatile("" : "+v"(tid_));
    const int tid = tid_, wid = __builtin_amdgcn_readfirstlane(tid >> 6), lane = tid & 63, wr = wid >> 2, wc = wid & 3, fr = lane & 15, fq = lane >> 4;
    const int K = g.K, nt = K / BK;
    unsigned voffA[2], voffB[2];
#pragma unroll
    for (int i = 0; i < 2; ++i) { int R, C; stage_rc(tid * 16 + i * 8192, R, C); const int Rb = Epi::PERM ? ((R & ~31) + perm32(R & 31)) : R;
        voffA[i] = (unsigned)(R * K + C) * 2u; voffB[i] = (unsigned)(Rb * K + C) * 2u; }
    const size_t kstep = (size_t)(BK * 2);
    const size_t hstep = (size_t)HALF * K * 2;
    const size_t tstep = 2 * hstep;
    const unsigned ldsw = (unsigned)wid * 1024u;
    const int aoff = lds_byte(wr * 64 + fr, fq * 8), boff = lds_byte(wc * 32 + fr, fq * 8);
#define PG8_SA(b, h) (((b) * 2 + (h)) * HTB)
#define PG8_SB(b, h) ((4 + (b) * 2 + (h)) * HTB)
#define PG8_STAGE(bufoff, gbase, voff, aux) do { _Pragma("unroll") for (int _i = 0; _i < 2; ++_i) \
        __builtin_amdgcn_global_load_lds((const unsigned*)((const char*)(gbase) + (voff)[_i]), (PG8_LAS unsigned*)(lds + (bufoff) + ldsw + _i * 8192), 16, 0, aux); } while (0)
#define PG8_LDA(dst, b, h) do { _Pragma("unroll") for (int m = 0; m < 4; ++m) _Pragma("unroll") for (int k = 0; k < 2; ++k) dst[m][k] = *(const PG8_LAS bf16x8*)(lds + PG8_SA(b, h) + aoff + m * 2048 + k * 1024); } while (0)
#define PG8_LDB(dst, b, h) do { _Pragma("unroll") for (int n = 0; n < 2; ++n) _Pragma("unroll") for (int k = 0; k < 2; ++k) dst[n][k] = *(const PG8_LAS bf16x8*)(lds + PG8_SB(b, h) + boff + n * 2048 + k * 1024); } while (0)
#define PG8_MMA(ai, bj, At, Bt) do { __builtin_amdgcn_s_setprio(1); _Pragma("unroll") for (int m = 0; m < 4; ++m) _Pragma("unroll") for (int n = 0; n < 2; ++n) _Pragma("unroll") for (int k = 0; k < 2; ++k) \
        acc[ai][bj][m][n] = __builtin_amdgcn_mfma_f32_16x16x32_bf16(Bt[n][k], At[m][k], acc[ai][bj][m][n], 0, 0, 0); __builtin_amdgcn_s_setprio(0); } while (0)
#define PG8_WAIT_V(n) asm volatile("s_waitcnt vmcnt(" #n ")" ::: "memory")
#define PG8_WAIT_L(n) asm volatile("s_waitcnt lgkmcnt(" #n ")" ::: "memory")
#define PG8_BAR __builtin_amdgcn_s_barrier()
#define PG8_SCHED __builtin_amdgcn_sched_barrier(0)
    Unit cur, nxt; int ui = 0;
    if (!S.next(0, cur)) return;
    f32x4 acc[2][2][4][2];
#pragma unroll
    for (int a = 0; a < 2; ++a)
#pragma unroll
        for (int b = 0; b < 2; ++b)
#pragma unroll
            for (int m = 0; m < 4; ++m)
#pragma unroll
                for (int n = 0; n < 2; ++n) acc[a][b][m][n] = (f32x4){0.f, 0.f, 0.f, 0.f};
    bf16x8 At[4][2], B0[2][2], B1[2][2];
    const char* cA = (const char*)g.A + (size_t)cur.pm * tstep + (size_t)cur.kt0 * kstep; const char* cB = (const char*)g.Bt + (size_t)cur.pn * tstep + (size_t)cur.kt0 * kstep;
    S.a_ready(cur);
    if constexpr (SP2) {
        PG8_STAGE(PG8_SB(0, 0), cB, voffB, 0); PG8_STAGE(PG8_SB(0, 1), cB + hstep, voffB, 0); PG8_STAGE(PG8_SA(0, 0), cA, voffA, AUXA); PG8_STAGE(PG8_SA(0, 1), cA + hstep, voffA, AUXA);
        if (wr == 1) PG8_BAR;
        PG8_WAIT_V(2); PG8_BAR;
        PG8_STAGE(PG8_SB(1, 0), cB + kstep, voffB, 0); PG8_STAGE(PG8_SA(1, 0), cA + kstep, voffA, AUXA); PG8_STAGE(PG8_SB(1, 1), cB + hstep + kstep, voffB, 0);
        PG8_WAIT_V(6); PG8_BAR;
    } else {
        PG8_STAGE(PG8_SB(0, 0), cB, voffB, 0); PG8_STAGE(PG8_SA(0, 0), cA, voffA, AUXA); PG8_STAGE(PG8_SB(0, 1), cB + hstep, voffB, 0); PG8_STAGE(PG8_SA(0, 1), cA + hstep, voffA, AUXA);
        if (wr == 1) PG8_BAR;
        PG8_WAIT_V(4); PG8_BAR;
        PG8_STAGE(PG8_SB(1, 0), cB + kstep, voffB, 0); PG8_STAGE(PG8_SA(1, 0), cA + kstep, voffA, AUXA); PG8_STAGE(PG8_SB(1, 1), cB + hstep + kstep, voffB, 0);
        PG8_WAIT_V(6); PG8_BAR;
    }
    for (;;) {
        const bool has_next = S.next(ui + 1, nxt);
        const char* nA = has_next ? (const char*)g.A + (size_t)nxt.pm * tstep + (size_t)nxt.kt0 * kstep : cA; const char* nB = has_next ? (const char*)g.Bt + (size_t)nxt.pn * tstep + (size_t)nxt.kt0 * kstep : cB;
        const int cnt = cur.nt ? cur.nt : nt;
        for (int t = 0; t < cnt; t += 2) {
            const bool last = (t == cnt - 2);
            const char* a1 = cA + (size_t)(t + 1) * kstep;
            const char* a2 = last ? nA : cA + (size_t)(t + 2) * kstep; const char* b2 = last ? nB : cB + (size_t)(t + 2) * kstep;
            const char* a3 = a2 + kstep; const char* b3 = b2 + kstep;
            if (last && has_next) S.a_ready(nxt);
            if constexpr (SP2) {
            PG8_LDB(B0, 0, 0); PG8_LDB(B1, 0, 1); PG8_SCHED; PG8_LDA(At, 0, 0); PG8_STAGE(PG8_SA(1, 1), a1 + hstep, voffA, AUXA);
            PG8_WAIT_V(8); PG8_WAIT_L(0); PG8_BAR; PG8_MMA(0, 0, At, B0); PG8_MMA(0, 1, At, B1); PG8_BAR; PG8_SCHED;
            PG8_LDA(At, 0, 1); PG8_STAGE(PG8_SB(0, 0), b2, voffB, 0); PG8_STAGE(PG8_SB(0, 1), b2 + hstep, voffB, 0); PG8_STAGE(PG8_SA(0, 0), a2, voffA, AUXA);
            PG8_WAIT_V(8); PG8_WAIT_L(0); PG8_BAR; PG8_MMA(1, 0, At, B0); PG8_MMA(1, 1, At, B1); PG8_BAR; PG8_SCHED;
            PG8_LDB(B0, 1, 0); PG8_LDB(B1, 1, 1); PG8_SCHED; PG8_LDA(At, 1, 0); PG8_STAGE(PG8_SA(0, 1), a2 + hstep, voffA, AUXA);
            PG8_WAIT_V(8); PG8_WAIT_L(0); PG8_BAR; PG8_MMA(0, 0, At, B0); PG8_MMA(0, 1, At, B1); PG8_BAR; PG8_SCHED;
            PG8_LDA(At, 1, 1); PG8_STAGE(PG8_SB(1, 0), b3, voffB, 0); PG8_STAGE(PG8_SB(1, 1), b3 + hstep, voffB, 0); PG8_STAGE(PG8_SA(1, 0), a3, voffA, AUXA);
            PG8_WAIT_V(8); PG8_WAIT_L(0); PG8_BAR; PG8_MMA(1, 0, At, B0); PG8_MMA(1, 1, At, B1); PG8_BAR; PG8_SCHED;
            } else {
            PG8_LDB(B0, 0, 0); PG8_SCHED; PG8_LDA(At, 0, 0); PG8_STAGE(PG8_SA(1, 1), a1 + hstep, voffA, AUXA);
            PG8_WAIT_L(8); PG8_BAR; PG8_WAIT_L(0); PG8_MMA(0, 0, At, B0); PG8_BAR; PG8_SCHED;
            PG8_LDB(B1, 0, 1); PG8_STAGE(PG8_SB(0, 0), b2, voffB, 0);
            PG8_BAR; PG8_WAIT_L(0); PG8_MMA(0, 1, At, B1); PG8_BAR;
            PG8_LDA(At, 0, 1); PG8_STAGE(PG8_SA(0, 0), a2, voffA, AUXA);
            PG8_BAR; PG8_WAIT_L(0); PG8_MMA(1, 0, At, B0); PG8_BAR; PG8_SCHED;
            PG8_STAGE(PG8_SB(0, 1), b2 + hstep, voffB, 0);
            PG8_WAIT_V(6); PG8_BAR; PG8_MMA(1, 1, At, B1); PG8_BAR;
            PG8_LDB(B0, 1, 0); PG8_SCHED; PG8_LDA(At, 1, 0); PG8_STAGE(PG8_SA(0, 1), a2 + hstep, voffA, AUXA);
            PG8_WAIT_L(8); PG8_BAR; PG8_WAIT_L(0); PG8_MMA(0, 0, At, B0); PG8_BAR; PG8_SCHED;
            PG8_LDB(B1, 1, 1); PG8_STAGE(PG8_SB(1, 0), b3, voffB, 0);
            PG8_BAR; PG8_WAIT_L(0); PG8_MMA(0, 1, At, B1); PG8_BAR;
            PG8_LDA(At, 1, 1); PG8_STAGE(PG8_SA(1, 0), a3, voffA, AUXA);
            PG8_BAR; PG8_WAIT_L(0); PG8_MMA(1, 0, At, B0); PG8_BAR; PG8_SCHED;
            PG8_STAGE(PG8_SB(1, 1), b3 + hstep, voffB, 0);
            PG8_WAIT_V(6); PG8_BAR; PG8_MMA(1, 1, At, B1); PG8_BAR;
            }
        }
        if constexpr (ALIGN_EPI) { if (wr == 0) PG8_BAR; }
        if constexpr (!Epi::AFTER_DRAIN) { E(acc, cur, wr, wc, fr, fq); S.done(cur); }
        if (!has_next) break;
#pragma unroll
        for (int a = 0; a < 2; ++a)
#pragma unroll
            for (int b = 0; b < 2; ++b)
#pragma unroll
                for (int m = 0; m < 4; ++m)
#pragma unroll
                    for (int n = 0; n < 2; ++n) acc[a][b][m][n] = (f32x4){0.f, 0.f, 0.f, 0.f};
        cur = nxt; cA = nA; cB = nB; ++ui;
        if constexpr (ALIGN_EPI) { if (wr == 1) PG8_BAR; }
    }
    PG8_WAIT_V(0);
    if constexpr (!ALIGN_EPI) { if (wr == 0) PG8_BAR; }
    PG8_BAR;
    if constexpr (Epi::AFTER_DRAIN) { E.fused(acc, cur, wr, wc, fr, fq, lds, wid, lane); S.done(cur); }
#undef PG8_SA
#undef PG8_SB
#undef PG8_STAGE
#undef PG8_LDA
#undef PG8_LDB
#undef PG8_MMA
#undef PG8_WAIT_V
#undef PG8_WAIT_L
#undef PG8_BAR
#undef PG8_SCHED
}
}

namespace {

#define LAS __attribute__((address_space(3)))
__device__ __forceinline__ void conv_item(const float* __restrict__ W, int K, int N, u16* __restrict__ WT, int rowbase, float* scr, int kb, int nb, int lane) {
    const int k0 = 64 * kb, n0 = 32 * nb;
#pragma unroll
    for (int i = 0; i < 8; ++i) { const int kk = 8 * i + (lane >> 3), cc = (lane & 7) * 4; const float4 w4 = *(const float4*)(W + (size_t)(k0 + kk) * N + n0 + cc);
        float* sp = scr + kk * 33 + cc; sp[0] = w4.x; sp[1] = w4.y; sp[2] = w4.z; sp[3] = w4.w; }
    asm volatile("s_waitcnt lgkmcnt(0)" ::: "memory");
    const int c = lane & 7;
#pragma unroll
    for (int j = 0; j < 4; ++j) { const int n = (lane >> 3) + 8 * j; const float* s = scr + (8 * c) * 33 + n;
        uint4 o; o.x = pk2(s[0 * 33], s[1 * 33]); o.y = pk2(s[2 * 33], s[3 * 33]); o.z = pk2(s[4 * 33], s[5 * 33]); o.w = pk2(s[6 * 33], s[7 * 33]);
        *(uint4*)(WT + (size_t)(rowbase + n) * K + k0 + 8 * c) = o; }
    asm volatile("s_waitcnt lgkmcnt(0)" ::: "memory");
}
__device__ __forceinline__ void conv_ld(const float* __restrict__ W, int N, int it, int nnb, int lane, float4 (&w)[8]) {
    const int kb = it / nnb, nb = it % nnb; const float* src = W + (size_t)(64 * kb + (lane >> 3)) * N + 32 * nb + (lane & 7) * 4;
#pragma unroll
    for (int i = 0; i < 8; ++i) {
#ifdef CONV_NT
        typedef float cv_f4 __attribute__((ext_vector_type(4)));
        const cv_f4 v = __builtin_nontemporal_load((const cv_f4*)(src + (size_t)(8 * i) * N)); w[i] = make_float4(v.x, v.y, v.z, v.w);
#else
        w[i] = *(const float4*)(src + (size_t)(8 * i) * N);
#endif
    }
}
__device__ __forceinline__ void conv_st(const float4 (&w)[8], int K, u16* __restrict__ WT, int rowbase, float* scr, int k0, int lane) {
#pragma unroll
    for (int i = 0; i < 8; ++i) { const int kk = 8 * i + (lane >> 3), cc = (lane & 7) * 4; float* sp = scr + kk * 33 + cc; sp[0] = w[i].x; sp[1] = w[i].y; sp[2] = w[i].z; sp[3] = w[i].w; }
    asm volatile("s_waitcnt lgkmcnt(0)" ::: "memory");
    const int c = lane & 7;
#pragma unroll
    for (int j = 0; j < 4; ++j) { const int n = (lane >> 3) + 8 * j; const float* s = scr + (8 * c) * 33 + n;
        uint4 o; o.x = pk2(s[0 * 33], s[1 * 33]); o.y = pk2(s[2 * 33], s[3 * 33]); o.z = pk2(s[4 * 33], s[5 * 33]); o.w = pk2(s[6 * 33], s[7 * 33]);
#ifdef CONV_NT
        { typedef unsigned cv_u4 __attribute__((ext_vector_type(4))); cv_u4 ov; ov.x = o.x; ov.y = o.y; ov.z = o.z; ov.w = o.w; __builtin_nontemporal_store(ov, (cv_u4*)(WT + (size_t)(rowbase + n) * K + k0 + 8 * c)); } }
#else
        *(uint4*)(WT + (size_t)(rowbase + n) * K + k0 + 8 * c) = o; }
#endif
    asm volatile("s_waitcnt lgkmcnt(0)" ::: "memory");
}
__device__ __forceinline__ void conv_matrix(const float* W, int K, int N, u16* WT, int roff, int GU, float* scr, int gw, int ngw, int lane) {
    const int nnb = N / 32, nitems = (K / 64) * nnb;
    if (gw < nitems) {
        float4 w[8]; conv_ld(W, N, gw, nnb, lane, w);
        for (int it = gw; it < nitems; it += ngw) { const int kb = it / nnb, nb = it % nnb, n0 = 32 * nb;
            float4 wn[8];
            if (it + ngw < nitems) conv_ld(W, N, it + ngw, nnb, lane, wn);
            else {
#pragma unroll
                for (int i = 0; i < 8; ++i) wn[i] = w[i]; }
            const int rowbase = GU == 0 ? roff + n0 : 256 * (n0 / 128) + (GU == 2 ? 128 : 0) + (n0 % 128);
            conv_st(w, K, WT, rowbase, scr, 64 * kb, lane);
#pragma unroll
            for (int i = 0; i < 8; ++i) w[i] = wn[i]; }
    }
}
struct ConvDesc { const float* W; u16* WT; int K, N, roff, GU; };
#ifdef TAIL_MIXERS
#define PRO_B1 29
#else
#define PRO_B1 38
#endif
constexpr size_t CTL_CONVTAB = 40960;
__device__ __forceinline__ void conv_all(KP p, ConvDesc* tab, float* scr, int gw, int ngw, int lane, int a0, int a1, int b0, int b1) {
    unsigned char* ws = p->ws;
    int t = threadIdx.x; asm volatile("" : "+v"(t));
    if (t < 38) {
        ConvDesc d;
        if (t < 24) { const int lf = t / 3, w = t % 3;
            if (w == 0) d = ConvDesc{p->in[I_WG] + (size_t)lf * D * DFF, (u16*)(ws + WS_WGU + lf * SZ_WGU), D, DFF, 0, 1};
            else if (w == 1) d = ConvDesc{p->in[I_WU] + (size_t)lf * D * DFF, (u16*)(ws + WS_WGU + lf * SZ_WGU), D, DFF, 0, 2};
            else d = ConvDesc{p->in[I_WD] + (size_t)lf * DFF * D, (u16*)(ws + WS_WD + lf * SZ_WD), DFF, D, 0, 0};
        } else if (t < 34) { const int j = (t - 24) / 5, w = (t - 24) % 5; u16* wdq = (u16*)(ws + WS_WDQKV) + (size_t)j * QKVA_LD * D;
            if (w == 0) d = ConvDesc{p->in[I_DQ] + (size_t)j * D * 512, wdq, D, 512, 0, 0};
            else if (w == 1) d = ConvDesc{p->in[I_DKV] + (size_t)j * D * 576, wdq, D, 576, 512, 0};
            else if (w == 2) d = ConvDesc{p->in[I_UQ] + (size_t)j * 512 * 3072, (u16*)(ws + WS_WUQ) + (size_t)j * 3072 * 512, 512, 3072, 0, 0};
            else if (w == 3) d = ConvDesc{p->in[I_UKV] + (size_t)j * 512 * 4096, (u16*)(ws + WS_WUKV) + (size_t)j * 4096 * 512, 512, 4096, 0, 0};
            else d = ConvDesc{p->in[I_MWO] + (size_t)j * D * D, (u16*)(ws + WS_WMO) + (size_t)j * D * D, D, D, 0, 0};
        } else if (t == 34) d = ConvDesc{p->in[I_HWIN], (u16*)(ws + WS_WHIN), D, 3 * D, 0, 0};
        else if (t == 35) d = ConvDesc{p->in[I_HWOUT], (u16*)(ws + WS_WHOUT), D, D, 0, 0};
        else if (t == 36) d = ConvDesc{p->in[I_WQKV], (u16*)(ws + WS_WWQKV), D, 2560, 0, 0};
        else d = ConvDesc{p->in[I_WWO], (u16*)(ws + WS_WWO), D, D, 0, 0};
        tab[t] = d; if (gw == 0) ((ConvDesc*)(ws + WS_CTL + CTL_CONVTAB))[t] = d;
    }
    __syncthreads();
#pragma unroll 1
    for (int m = a0; m < b1; m = (m + 1 == a1 ? b0 : m + 1)) { const ConvDesc d = tab[m]; conv_matrix(d.W, d.K, d.N, d.WT, d.roff, d.GU, scr, gw, ngw, lane); }
    for (int j = 0; j < 2; ++j) { u16* wdq = (u16*)(ws + WS_WDQKV) + (size_t)j * QKVA_LD * D;
        for (int i = gw * 64 + lane; i < (QKVA_LD - 1088) * D / 8; i += ngw * 64) ((uint4*)(wdq + (size_t)1088 * D))[i] = make_uint4(0u, 0u, 0u, 0u); }
    __syncthreads();
}
__device__ __forceinline__ unsigned long long rfl64(unsigned long long v) { return ((unsigned long long)(unsigned)__builtin_amdgcn_readfirstlane((int)(v >> 32)) << 32) | (unsigned)__builtin_amdgcn_readfirstlane((int)v); }
__device__ __forceinline__ void conv_tail(const ConvDesc* gtab, float* scr, int gw, int ngw, int lane, int a0, int a1, int b0, int b1) {
#pragma unroll 1
    for (int m = a0; m < b1; m = (m + 1 == a1 ? b0 : m + 1)) { const ConvDesc d = gtab[m]; conv_matrix((const float*)rfl64((unsigned long long)d.W), __builtin_amdgcn_readfirstlane(d.K), __builtin_amdgcn_readfirstlane(d.N), (u16*)rfl64((unsigned long long)d.WT), __builtin_amdgcn_readfirstlane(d.roff), __builtin_amdgcn_readfirstlane(d.GU), scr, gw, ngw, lane); }
    __syncthreads();
}

#define XB_TMO      128
#define XB_XCNT(j)  (256  + 64 * (j))
#define XB_XSUB(j)  (1280 + 64 * (j))
#define XB_XGEN(j)  (2304 + 64 * (j))
#define XB_TOP      3328
#define XB_TOPGEN   3392
#define XCD_BAR_WORDS 3456
#define XB_SPIN_CAP (1u << 22)

__device__ __forceinline__ unsigned xb_ld(unsigned* p)              { return __hip_atomic_load(p, __ATOMIC_RELAXED, __HIP_MEMORY_SCOPE_AGENT); }
__device__ __forceinline__ unsigned xb_add(unsigned* p, unsigned v) { return __hip_atomic_fetch_add(p, v, __ATOMIC_RELAXED, __HIP_MEMORY_SCOPE_AGENT); }
__device__ __forceinline__ unsigned xb_xcc_id() { return (unsigned)__builtin_amdgcn_s_getreg((3 << 11) | 20) & 0xFu; }
#define XB_SPIN(cond, bar) do { unsigned _sp = 0; while (cond) { __builtin_amdgcn_s_sleep(1); \
    if ((++_sp & 255u) == 0u) { if (xb_ld(&(bar)[XB_TMO])) break; if (_sp > XB_SPIN_CAP) { atomicAdd(&(bar)[XB_TMO], 1u); break; } } } } while (0)

struct XcdBarrier {
    unsigned* bar; unsigned x;
    volatile LAS unsigned* st;
};

__device__ __forceinline__ XcdBarrier xcd_barrier_post(unsigned* bar, volatile LAS unsigned* st) {
    XcdBarrier b; b.bar = bar; b.x = xb_xcc_id(); b.st = st;
    if (threadIdx.x == 0) (void)xb_add(&bar[XB_XCNT(b.x)], 1u);
    return b;
}
__device__ __forceinline__ void xcd_barrier_complete(unsigned* bar, unsigned x, unsigned& nloc, unsigned& nx) {
    const unsigned G = gridDim.x * gridDim.y * gridDim.z;
    unsigned sum, cnt, mine, sp = 0u;
    for (;;) {
        sum = 0u; cnt = 0u; mine = 0u;
#pragma unroll
        for (unsigned j = 0; j < 16; ++j) { const unsigned c = xb_ld(&bar[XB_XCNT(j)]); sum += c; cnt += (c > 0u) ? 1u : 0u; mine = (j == x) ? c : mine; }
        if (sum == G) break;
        __builtin_amdgcn_s_sleep(1);
        if ((++sp & 255u) == 0u) { if (xb_ld(&bar[XB_TMO])) break; if (sp > XB_SPIN_CAP) { atomicAdd(&bar[XB_TMO], 1u); break; } }
    }
    nloc = mine > 0u ? mine : 1u; nx = cnt > 0u ? cnt : 1u;
}

__device__ __forceinline__ void xcd_barrier(const XcdBarrier& b) {
    asm volatile("s_waitcnt vmcnt(0)" ::: "memory");
    __syncthreads();
    if (threadIdx.x == 0) {
        unsigned* bar = b.bar;
        unsigned xq = xb_xcc_id(); asm volatile("" : "+s"(xq));
        __builtin_amdgcn_s_waitcnt(0);
        unsigned nloc = b.st[0], nx = b.st[1];
        if (nloc == 0u) { xcd_barrier_complete(bar, xq, nloc, nx); b.st[0] = nloc; b.st[1] = nx; }
        const unsigned old = xb_add(&bar[XB_XSUB(xq)], 1u);
        const unsigned gen = old / nloc;
        if (old + 1u == (gen + 1u) * nloc) {
            __builtin_amdgcn_fence(__ATOMIC_RELEASE, "agent");
            asm volatile("s_waitcnt vmcnt(0)" ::: "memory");
            const unsigned og = xb_add(&bar[XB_TOP], 1u);
            const unsigned tg = og / nx;
            if (og + 1u == (tg + 1u) * nx) xb_add(&bar[XB_TOPGEN], 1u);
            else XB_SPIN(xb_ld(&bar[XB_TOPGEN]) == tg, bar);
            __builtin_amdgcn_fence(__ATOMIC_ACQUIRE, "agent");
            xb_add(&bar[XB_XGEN(xq)], 1u);
            asm volatile("s_waitcnt vmcnt(0)" ::: "memory");
        } else {
            XB_SPIN(xb_ld(&bar[XB_XGEN(xq)]) == gen, bar);
            __builtin_amdgcn_fence(__ATOMIC_ACQUIRE, "agent");
            asm volatile("s_waitcnt vmcnt(0)" ::: "memory");
        }
    }
    __syncthreads();
}


#define PH __device__ __forceinline__
#define LDSWAIT() asm volatile("s_waitcnt lgkmcnt(0)" ::: "memory")
__device__ __forceinline__ int otid() { int t = threadIdx.x; asm volatile("" : "+v"(t)); return t; }
PH void ph_modp(KP p, float* sc, int wg, int nwg) {
    const int TID = otid();
    for (int i = TID; i < 5 * D; i += 512) { const int m = i / D, k = i % D; const float v = m < 4 ? p->in[I_C][m * D + k] : p->in[I_CCTX][k]; sc[i] = silu_f(v); }
    __syncthreads();
    const int wave = TID >> 6, lane = TID & 63;
    float* MODP = (float*)(p->ws + WS_MODP);
    const int nitems = DEPTH * 72 * 16;
    for (int item = wg * 8 + wave; item < nitems; item += nwg * 8) {
        const int kc = item % 16, cg = (item / 16) % 72, layer = item / (16 * 72);
        const int col = cg * 256 + lane * 4;
        const float* w = p->in[I_MODW] + (size_t)layer * D * NMODV + (size_t)(kc * 128) * NMODV + col;
        float acc[5][4];
#pragma unroll
        for (int m = 0; m < 5; ++m) { acc[m][0] = acc[m][1] = acc[m][2] = acc[m][3] = 0.f; }
#pragma unroll 8
        for (int k = 0; k < 128; ++k) {
            const float4 wv = *(const float4*)(w + (size_t)k * NMODV);
#pragma unroll
            for (int m = 0; m < 5; ++m) { const float s = sc[m * D + kc * 128 + k]; acc[m][0] += s * wv.x; acc[m][1] += s * wv.y; acc[m][2] += s * wv.z; acc[m][3] += s * wv.w; }
        }
#pragma unroll
        for (int m = 0; m < 5; ++m) *(float4*)(MODP + ((size_t)(kc * DEPTH + layer) * 5 + m) * NMODV + col) = make_float4(acc[m][0], acc[m][1], acc[m][2], acc[m][3]);
    }
    __syncthreads();
}
PH void ph_modr(KP p, int wg, int nwg) {
    const int TID = otid();
    const float* MODP = (const float*)(p->ws + WS_MODP); float* MOD = (float*)(p->ws + WS_MOD);
    const int n = DEPTH * 5 * NMODV;
    for (int i = wg * 512 + TID; i < n; i += nwg * 512) {
        const int col = i % NMODV, layer = i / (5 * NMODV);
        float s = p->in[I_MODB][layer * NMODV + col];
        for (int kc = 0; kc < 16; ++kc) s += MODP[(size_t)kc * n + i];
        MOD[i] = s;
    }
}
PH void ph_tables(KP p, int wg, int nwg) {
    const int TID = otid();
    float* rope = (float*)(p->ws + WS_ROPE); float* tw = (float*)(p->ws + WS_TW);
    for (int i = wg * 512 + TID; i < 8192; i += nwg * 512) {
        if (i < 64 * 16) { const int pos = i / 16, k = i % 16; const float inv = (float)exp2(-(double)k / 16.0 * 13.287712379549449); const float ang = (float)pos * inv;
            rope[2 * i] = (float)cos((double)ang); rope[2 * i + 1] = (float)sin((double)ang); }
        const double a = -2.0 * 3.14159265358979323846 * (double)i / 8192.0; tw[2 * i] = (float)cos(a); tw[2 * i + 1] = (float)sin(a);
    }
}
template <int NR> PH void mod_rows(KP p, const int (&r)[NR], int nvalid, int layer, int slot, const float* pgate, float pcoef, bool first, bool fold, int lane) {
    u16* X = (u16*)(p->ws + WS_X); u16* HB = (u16*)(p->ws + WS_HB); const float* MOD = (const float*)(p->ws + WS_MOD); const u16* SLAB = (const u16*)(p->ws + WS_SLAB);
    const float* g = p->in[I_NORMG] + ((size_t)layer * 3 + slot) * D;
    float4 v[NR][4][2]; float rs[NR];
    const int b0 = r[0] / SB, j0 = r[0] - b0 * SB;
#pragma unroll
    for (int k = 0; k < NR; ++k) { if (k >= nvalid) { rs[k] = 0.f; continue; }
        uint4* xr = (uint4*)(X + (size_t)r[k] * D);
        const int b = r[k] / SB, j = r[k] - b * SB;
        if (first) {
            const float4* xs = j < CTX ? (const float4*)(p->in[I_CTX] + ((size_t)b * CTX + j) * D) : (const float4*)(p->in[I_X] + ((size_t)b * S + (j - CTX)) * D);
#pragma unroll
            for (int i = 0; i < 4; ++i) { const int c8 = lane + 64 * i; v[k][i][0] = xs[2 * c8]; v[k][i][1] = xs[2 * c8 + 1]; }
        } else {
#pragma unroll
            for (int i = 0; i < 4; ++i) { const uint4 q = xr[lane + 64 * i];
                v[k][i][0] = make_float4(pg8::h2f_lo(q.x), pg8::h2f_hi(q.x), pg8::h2f_lo(q.y), pg8::h2f_hi(q.y)); v[k][i][1] = make_float4(pg8::h2f_lo(q.z), pg8::h2f_hi(q.z), pg8::h2f_lo(q.w), pg8::h2f_hi(q.w)); }
        }
        if (NR == 1 && fold) {
#pragma unroll
            for (int i = 0; i < 4; ++i) { const int c8 = lane + 64 * i; float4 a0 = make_float4(0.f, 0.f, 0.f, 0.f), a1 = a0;
#pragma unroll
                for (int s = 0; s < 8; ++s) { const uint4 q = ((const uint4*)(SLAB + ((size_t)(s * 4 + b) * 256 + j) * D))[c8];
                    a0.x += __uint_as_float(q.x << 16); a0.y += __uint_as_float(q.x & 0xffff0000u); a0.z += __uint_as_float(q.y << 16); a0.w += __uint_as_float(q.y & 0xffff0000u);
                    a1.x += __uint_as_float(q.z << 16); a1.y += __uint_as_float(q.z & 0xffff0000u); a1.z += __uint_as_float(q.w << 16); a1.w += __uint_as_float(q.w & 0xffff0000u); }
                const float4 g0 = ((const float4*)pgate)[2 * c8], g1 = ((const float4*)pgate)[2 * c8 + 1];
                v[k][i][0].x += pcoef * g0.x * a0.x; v[k][i][0].y += pcoef * g0.y * a0.y; v[k][i][0].z += pcoef * g0.z * a0.z; v[k][i][0].w += pcoef * g0.w * a0.w;
                v[k][i][1].x += pcoef * g1.x * a1.x; v[k][i][1].y += pcoef * g1.y * a1.y; v[k][i][1].z += pcoef * g1.z * a1.z; v[k][i][1].w += pcoef * g1.w * a1.w; }
        }
        if (first || (NR == 1 && fold)) { const float lim = pg8::h16_lim();
#pragma unroll
            for (int i = 0; i < 4; ++i) xr[lane + 64 * i] = make_uint4(pg8::pkh2(v[k][i][0].x, v[k][i][0].y, lim), pg8::pkh2(v[k][i][0].z, v[k][i][0].w, lim), pg8::pkh2(v[k][i][1].x, v[k][i][1].y, lim), pg8::pkh2(v[k][i][1].z, v[k][i][1].w, lim));
        }
        float ss = 0.f;
#pragma unroll
        for (int i = 0; i < 4; ++i)
#pragma unroll
            for (int h = 0; h < 2; ++h) ss += v[k][i][h].x * v[k][i][h].x + v[k][i][h].y * v[k][i][h].y + v[k][i][h].z * v[k][i][h].z + v[k][i][h].w * v[k][i][h].w;
        rs[k] = rsqrtf(wave_sum(ss) * (1.f / D) + NORM_EPS);
    }
    const float* mb = MOD + ((size_t)(layer * 5 + (j0 < CTX ? 4 : b0)) * 9 + 3 * slot) * D;
#pragma unroll
    for (int i = 0; i < 4; ++i) { const int c8 = lane + 64 * i;
        float4 gs[2], sh[2];
#pragma unroll
        for (int h = 0; h < 2; ++h) { const float4 gg = ((const float4*)g)[2 * c8 + h], sl = ((const float4*)(mb + D))[2 * c8 + h]; sh[h] = ((const float4*)mb)[2 * c8 + h];
            gs[h] = make_float4(gg.x * (1.f + sl.x), gg.y * (1.f + sl.y), gg.z * (1.f + sl.z), gg.w * (1.f + sl.w)); }
#pragma unroll
        for (int k = 0; k < NR; ++k) { if (k >= nvalid) continue; unsigned ow[4];
#pragma unroll
            for (int h = 0; h < 2; ++h) { const float4 x = v[k][i][h];
                const float a = x.x * rs[k] * gs[h].x + sh[h].x, bq = x.y * rs[k] * gs[h].y + sh[h].y, c = x.z * rs[k] * gs[h].z + sh[h].z, d = x.w * rs[k] * gs[h].w + sh[h].w;
                ow[2 * h] = pk2(a, bq); ow[2 * h + 1] = pk2(c, d); }
            ((uint4*)(HB + (size_t)r[k] * D))[c8] = make_uint4(ow[0], ow[1], ow[2], ow[3]); } }
}
PH void ph_modulate(KP p, int layer, int slot, const float* pgate, float pcoef, int wg, int nwg, bool first = false, bool skip_ctx = false) {
    const int TID = otid();
    const int wave = TID >> 6, lane = TID & 63, w = wg * 8 + wave, nw = nwg * 8;
    const int cw = pgate != nullptr ? 6 : 1;
    const int base = (NB * S + cw * NB * CTX + nw - 1) / nw;
    const int nctx_before = w < NB * CTX ? w : NB * CTX;
    int l0 = w * base - cw * nctx_before, l1 = l0 + base - (w < NB * CTX ? cw : 0);
    if (nw < NB * CTX) { l0 = (int)((long)w * (NB * S) / nw); l1 = (int)((long)(w + 1) * (NB * S) / nw); }
    if (l0 > NB * S) l0 = NB * S; if (l1 > NB * S) l1 = NB * S; if (w == nw - 1) l1 = NB * S;
    const int nc = (w < NB * CTX && !skip_ctx) ? (NB * CTX - 1 - w) / nw + 1 : 0;
    for (int it = 0; it < nc; ++it) { const int c = w + it * nw; const int r1[1] = {(c >> 8) * SB + (c & 255)}; mod_rows<1>(p, r1, 1, layer, slot, pgate, pcoef, first, pgate != nullptr, lane); }
    for (int l = l0; l < l1; ) {
        int n = l1 - l; if (n > 4) n = 4; const int left = 4096 - (l & 4095); if (n > left) n = left;
        const int rb = (l >> 12) * SB + CTX + (l & 4095); const int r4[4] = {rb, rb + 1, rb + 2, rb + 3};
        mod_rows<4>(p, r4, n, layer, slot, nullptr, 0.f, first, false, lane);
        l += n;
    }
}
PH void ph_final(KP p, int wg, int nwg) {
    const int TID = otid();
    const u16* X = (const u16*)(p->ws + WS_X); const float* g = p->in[I_FINALG];
    const int wave = TID >> 6, lane = TID & 63;
    for (int q = wg * 8 + wave; q < NB * S; q += nwg * 8) {
        const int b = q / S, t = q - b * S, r = b * SB + CTX + t;
        const uint4* xr = (const uint4*)(X + (size_t)r * D);
        float4 v[4][2]; float ss = 0.f;
#pragma unroll
        for (int i = 0; i < 4; ++i) { const uint4 w = xr[lane + 64 * i];
            v[i][0] = make_float4(pg8::h2f_lo(w.x), pg8::h2f_hi(w.x), pg8::h2f_lo(w.y), pg8::h2f_hi(w.y)); v[i][1] = make_float4(pg8::h2f_lo(w.z), pg8::h2f_hi(w.z), pg8::h2f_lo(w.w), pg8::h2f_hi(w.w));
#pragma unroll
            for (int h = 0; h < 2; ++h) ss += v[i][h].x * v[i][h].x + v[i][h].y * v[i][h].y + v[i][h].z * v[i][h].z + v[i][h].w * v[i][h].w; }
        const float rs = rsqrtf(wave_sum(ss) * (1.f / D) + NORM_EPS);
        float4* o = (float4*)(p->out + (size_t)q * D);
#pragma unroll
        for (int i = 0; i < 4; ++i)
#pragma unroll
            for (int h = 0; h < 2; ++h) { const int c4 = 2 * (lane + 64 * i) + h; const float4 gg = ((const float4*)g)[c4]; const float4 x = v[i][h]; o[c4] = make_float4(x.x * rs * gg.x, x.y * rs * gg.y, x.z * rs * gg.z, x.w * rs * gg.w); }
    }
}
PH void ph_mla_norm(KP p, int jm, int wg, int nwg) {
    const int TID = otid();
    const _Float16* A = (const _Float16*)(p->ws + WS_QKVA); u16* QL = (u16*)(p->ws + WS_QL); u16* CKV = (u16*)(p->ws + WS_CKV); u16* KR = (u16*)(p->ws + WS_KR);
    const float* gq = p->in[I_GQ] + jm * 512; const float* gkv = p->in[I_GKV] + jm * 512; const float* rope = (const float*)(p->ws + WS_ROPE);
    const int wave = TID >> 6, lane = TID & 63;
    for (int r = wg * 8 + wave; r < R; r += nwg * 8) {
        const _Float16* a = A + (size_t)r * QKVA_LD;
        const uint4 qw = ((const uint4*)a)[lane], kw = ((const uint4*)(a + 512))[lane];
        const float4 q0 = make_float4(pg8::h2f_lo(qw.x), pg8::h2f_hi(qw.x), pg8::h2f_lo(qw.y), pg8::h2f_hi(qw.y)), q1 = make_float4(pg8::h2f_lo(qw.z), pg8::h2f_hi(qw.z), pg8::h2f_lo(qw.w), pg8::h2f_hi(qw.w));
        const float4 k0 = make_float4(pg8::h2f_lo(kw.x), pg8::h2f_hi(kw.x), pg8::h2f_lo(kw.y), pg8::h2f_hi(kw.y)), k1 = make_float4(pg8::h2f_lo(kw.z), pg8::h2f_hi(kw.z), pg8::h2f_lo(kw.w), pg8::h2f_hi(kw.w));
        const float sq = wave_sum(q0.x * q0.x + q0.y * q0.y + q0.z * q0.z + q0.w * q0.w + q1.x * q1.x + q1.y * q1.y + q1.z * q1.z + q1.w * q1.w);
        const float sk = wave_sum(k0.x * k0.x + k0.y * k0.y + k0.z * k0.z + k0.w * k0.w + k1.x * k1.x + k1.y * k1.y + k1.z * k1.z + k1.w * k1.w);
        const float rq = rsqrtf(sq * (1.f / 512) + NORM_EPS), rk = rsqrtf(sk * (1.f / 512) + NORM_EPS);
        const float4 g0 = ((const float4*)gq)[lane * 2], g1 = ((const float4*)gq)[lane * 2 + 1], h0 = ((const float4*)gkv)[lane * 2], h1 = ((const float4*)gkv)[lane * 2 + 1];
        uint4 oq, ok;
        oq.x = pk2(q0.x * rq * g0.x, q0.y * rq * g0.y); oq.y = pk2(q0.z * rq * g0.z, q0.w * rq * g0.w); oq.z = pk2(q1.x * rq * g1.x, q1.y * rq * g1.y); oq.w = pk2(q1.z * rq * g1.z, q1.w * rq * g1.w);
        ok.x = pk2(k0.x * rk * h0.x, k0.y * rk * h0.y); ok.y = pk2(k0.z * rk * h0.z, k0.w * rk * h0.w); ok.z = pk2(k1.x * rk * h1.x, k1.y * rk * h1.y); ok.w = pk2(k1.z * rk * h1.z, k1.w * rk * h1.w);
        ((uint4*)(QL + (size_t)r * 512))[lane] = oq; ((uint4*)(CKV + (size_t)r * 512))[lane] = ok;
        if (lane < 32) {
            const int b = r / SB, j = r - b * SB; const int half = lane >> 4, i = lane & 15;
            const float x1 = (float)a[1024 + 32 * half + i], x2 = (float)a[1024 + 32 * half + 16 + i];
            float o1 = x1, o2 = x2;
            if (j >= CTX) { const int t = j - CTX, pos = half ? (t & 63) : (t >> 6); const float cs = rope[(pos * 16 + i) * 2], sn = rope[(pos * 16 + i) * 2 + 1]; o1 = x1 * cs - x2 * sn; o2 = x2 * cs + x1 * sn; }
            KR[(size_t)r * 64 + 32 * half + i] = f2bf(o1); KR[(size_t)r * 64 + 32 * half + 16 + i] = f2bf(o2);
        }
    }
}
PH void ph_transpose(const u16* __restrict__ ZT, u16* __restrict__ Z, u16* tile, int wg, int nwg) {
    const int TID = otid();
    const int ld = TID >> 3, lr = (TID & 7) * 8;
    const int sr = TID & 63, sd = (TID >> 6) * 8;
    for (int u = wg; u < (R / 64) * (D / 64); u += nwg) {
        const int r0 = (u % (R / 64)) * 64, d0 = (u / (R / 64)) * 64;
        const uint4 v = *(const uint4*)(ZT + (size_t)(d0 + ld) * R + r0 + lr);
        *(uint4*)(tile + ld * 72 + lr) = v;
        __syncthreads();
        unsigned w[4];
#pragma unroll
        for (int k = 0; k < 4; ++k) w[k] = (unsigned)tile[(sd + 2 * k) * 72 + sr] | ((unsigned)tile[(sd + 2 * k + 1) * 72 + sr] << 16);
        *(uint4*)(Z + (size_t)(r0 + sr) * D + d0 + sd) = make_uint4(w[0], w[1], w[2], w[3]);
        __syncthreads();
    }
}
template <int NP> PH void filt_unit(KP p, float* lds, int L, int l0, float* FT, int tid) {
    float* zf = lds; float* ha = lds + 8 * 33; float* hb = ha + 512; float* h3t = hb + 512; float* tp = h3t + 512;
    const float* w1 = p->in[I_FW1]; const float* b1 = p->in[I_FB1]; const float* w2 = p->in[I_FW2]; const float* b2 = p->in[I_FB2]; const float* w3 = p->in[I_FW3]; const float* b3 = p->in[I_FB3]; const float* fr = p->in[I_FFREQ];
    const float* w4 = p->in[I_FW4]; const float* decay = p->in[I_DECAY];
    { int tf = tid; asm volatile("" : "+v"(tf));
      for (int idx = tf; idx < NP * 33; idx += 512) { const int pp = idx / 33, c = idx % 33, l = l0 + pp; const float t = (float)l / (float)(L - 1);
        float v;
        if (c == 0) { v = t; tp[pp] = t; }
        else { const int k = (c - 1) & 15; const float f = 1e-4f + (float)k * ((15.0f - 1e-4f) / 15.0f); const float w = 6.283185307179586f * (float)l / (float)L; const double a = (double)(f * w);
            v = c <= 16 ? (float)cos(a) : (float)(-sin(a)); }
        zf[pp * 33 + c] = v; } }
    __syncthreads();
    { int tj = tid; asm volatile("" : "+v"(tj)); const int pp = tj >> 6, j = tj & 63; if (pp < NP) { float s = b1[j]; for (int c = 0; c < 33; ++c) s += zf[pp * 33 + c] * w1[c * 64 + j]; ha[pp * 64 + j] = sinf(fr[j] * s); } }
    __syncthreads();
    { int tj = tid; asm volatile("" : "+v"(tj)); const int pp = tj >> 6, j = tj & 63; if (pp < NP) { float s = b2[j]; for (int c = 0; c < 64; ++c) s += ha[pp * 64 + c] * w2[c * 64 + j]; hb[pp * 64 + j] = sinf(fr[j] * s); } }
    __syncthreads();
    { int tj = tid; asm volatile("" : "+v"(tj)); const int pp = tj >> 6, j = tj & 63; if (pp < NP) { float s = b3[j]; for (int c = 0; c < 64; ++c) s += hb[pp * 64 + c] * w3[c * 64 + j]; h3t[j * 8 + pp] = sinf(fr[j] * s); } }
    __syncthreads();
#pragma unroll 1
    for (int m = 0; m < 4; ++m) {
        int tq = tid; asm volatile("" : "+v"(tq));
        const int n4 = (tq + 512 * m) * 4; float acc[NP][4];
#pragma unroll
        for (int q = 0; q < NP; ++q) { acc[q][0] = 0.f; acc[q][1] = 0.f; acc[q][2] = 0.f; acc[q][3] = 0.f; }
        const float* wp = w4 + n4;
#pragma unroll 1
        for (int k0 = 0; k0 < 64; k0 += 8) {
            float4 wv[8];
#pragma unroll
            for (int kk = 0; kk < 8; ++kk) wv[kk] = *(const float4*)(wp + (size_t)kk * 8192);
            wp += 8 * 8192;
#pragma unroll
            for (int kk = 0; kk < 8; ++kk) { float hh[8];
                if (NP == 8) { const float4 h0 = *(const float4*)(h3t + (k0 + kk) * 8), h1 = *(const float4*)(h3t + (k0 + kk) * 8 + 4); hh[0] = h0.x; hh[1] = h0.y; hh[2] = h0.z; hh[3] = h0.w; hh[4] = h1.x; hh[5] = h1.y; hh[6] = h1.z; hh[7] = h1.w; }
                else hh[0] = h3t[(k0 + kk) * 8];
#pragma unroll
                for (int q = 0; q < NP; ++q) { acc[q][0] += hh[q] * wv[kk].x; acc[q][1] += hh[q] * wv[kk].y; acc[q][2] += hh[q] * wv[kk].z; acc[q][3] += hh[q] * wv[kk].w; } }
        }
        const float4 dc4 = *(const float4*)(decay + n4); const float dc[4] = {fabsf(dc4.x), fabsf(dc4.y), fabsf(dc4.z), fabsf(dc4.w)};
        float* o = FT + (size_t)n4 * L + l0;
#pragma unroll
        for (int c = 0; c < 4; ++c) { float e[NP];
#pragma unroll
            for (int q = 0; q < NP; ++q) e[q] = acc[q][c] * __builtin_amdgcn_exp2f(-1.4426950408889634f * tp[q] * dc[c]);
            if (NP == 8) { *(float4*)o = make_float4(e[0], e[1], e[2], e[3]); *(float4*)(o + 4) = make_float4(e[4], e[5], e[6], e[7]); } else o[0] = e[0];
            o += L; }
    }
    __syncthreads();
}
PH void ph_filters(KP p, float* lds, int wg, int nwg) {
    const int TID = otid();
    for (int unit = wg; unit < 512; unit += nwg) filt_unit<8>(p, lds, 4096, unit * 8, (float*)(p->ws + WS_FT4096), TID);
    for (int q = wg; q < 256; q += nwg) filt_unit<1>(p, lds, 256, q, (float*)(p->ws + WS_FT256), TID);
}
PH void ph_nattn_mla(const u16* __restrict__ Q, const u16* __restrict__ KN, const u16* __restrict__ KR, const u16* __restrict__ V, u16* __restrict__ O, float* lds, int wg, int nwg) {
    const int TID = otid();
    const int wave = TID >> 6, lane = TID & 63;
    float* pp = lds + wave * (SB + 192); float* qq = pp + SB;
    for (int item = wg * 8 + wave; item < R * 16; item += nwg * 8) {
        const int r = item >> 4, h = item & 15;
        const int b = r / SB, j = r - b * SB, nk = j < CTX ? CTX : SB, kb = b * SB;
        for (int c = lane; c < 192; c += 64) qq[c] = bf2f(Q[(size_t)r * 3072 + h * 192 + c]);
        LDSWAIT();
        const float scale = 0.07216878364870322f;
        float mx = -3.0e38f;
        for (int key = lane; key < nk; key += 64) {
            const uint4* kn = (const uint4*)(KN + (size_t)(kb + key) * D + h * 128); const uint4* kr = (const uint4*)(KR + (size_t)(kb + key) * 64);
            float s = 0.f;
#pragma unroll 4
            for (int c8 = 0; c8 < 24; ++c8) { const uint4 w = c8 < 16 ? kn[c8] : kr[c8 - 16]; const float* q8 = qq + c8 * 8;
                s += q8[0] * __uint_as_float(w.x << 16) + q8[1] * __uint_as_float(w.x & 0xffff0000u) + q8[2] * __uint_as_float(w.y << 16) + q8[3] * __uint_as_float(w.y & 0xffff0000u)
                   + q8[4] * __uint_as_float(w.z << 16) + q8[5] * __uint_as_float(w.z & 0xffff0000u) + q8[6] * __uint_as_float(w.w << 16) + q8[7] * __uint_as_float(w.w & 0xffff0000u); }
            s *= scale; pp[key] = s; mx = fmaxf(mx, s);
        }
        mx = wave_max(mx);
        float sum = 0.f;
        for (int key = lane; key < nk; key += 64) { const float e = expf(pp[key] - mx); pp[key] = e; sum += e; }
        sum = wave_sum(sum);
        LDSWAIT();
        float o0 = 0.f, o1 = 0.f;
        const u16* vb = V + (size_t)kb * D + h * 128 + lane;
        for (int key = 0; key < nk; ++key) { const float pv = pp[key]; o0 += pv * bf2f(vb[(size_t)key * D]); o1 += pv * bf2f(vb[(size_t)key * D + 64]); }
        const float inv = 1.f / sum;
        O[(size_t)r * D + h * 128 + lane] = f2bf(o0 * inv); O[(size_t)r * D + h * 128 + 64 + lane] = f2bf(o1 * inv);
        LDSWAIT();
    }
}
PH void ph_nattn_win(const u16* __restrict__ QKV, const float* __restrict__ sink, u16* __restrict__ O, float* lds, int wg, int nwg) {
    const int TID = otid();
    const int wave = TID >> 6, lane = TID & 63;
    float* pp = lds + wave * 640; float* qq = pp + 576;
    for (int item = wg * 8 + wave; item < R * 32; item += nwg * 8) {
        const int r = item >> 5, qh = item & 31, kvh = qh >> 3;
        const int b = r / SB, j = r - b * SB, kb = b * SB;
        qq[lane] = bf2f(QKV[(size_t)r * 2560 + qh * 64 + lane]);
        LDSWAIT();
        int lo = 0, nwin = 0; if (j >= CTX) { const int t = j - CTX; lo = t - 128 < 0 ? 0 : t - 128; const int hi = t + 128 > S - 1 ? S - 1 : t + 128; nwin = hi - lo + 1; }
        const int nk = CTX + nwin;
        float mx = sink[qh];
        for (int key = lane; key < nk; key += 64) {
            const int krow = kb + (key < CTX ? key : CTX + lo + (key - CTX));
            const uint4* kk = (const uint4*)(QKV + (size_t)krow * 2560 + 2048 + kvh * 64);
            float s = 0.f;
#pragma unroll
            for (int c8 = 0; c8 < 8; ++c8) { const uint4 w = kk[c8]; const float* q8 = qq + c8 * 8;
                s += q8[0] * __uint_as_float(w.x << 16) + q8[1] * __uint_as_float(w.x & 0xffff0000u) + q8[2] * __uint_as_float(w.y << 16) + q8[3] * __uint_as_float(w.y & 0xffff0000u)
                   + q8[4] * __uint_as_float(w.z << 16) + q8[5] * __uint_as_float(w.z & 0xffff0000u) + q8[6] * __uint_as_float(w.w << 16) + q8[7] * __uint_as_float(w.w & 0xffff0000u); }
            s *= 0.125f; pp[key] = s; mx = fmaxf(mx, s);
        }
        mx = wave_max(mx);
        float sum = 0.f;
        for (int key = lane; key < nk; key += 64) { const float e = expf(pp[key] - mx); pp[key] = e; sum += e; }
        sum = wave_sum(sum) + expf(sink[qh] - mx);
        LDSWAIT();
        float o = 0.f;
        for (int key = 0; key < nk; ++key) { const int krow = kb + (key < CTX ? key : CTX + lo + (key - CTX)); o += pp[key] * bf2f(QKV[(size_t)krow * 2560 + 2304 + kvh * 64 + lane]); }
        O[(size_t)r * D + qh * 64 + lane] = f2bf(o / sum);
        LDSWAIT();
    }
}

namespace att {
typedef short bf16x8 __attribute__((ext_vector_type(8)));
typedef short s16x4 __attribute__((ext_vector_type(4)));
typedef float f32x16 __attribute__((ext_vector_type(16)));
typedef unsigned u32x4 __attribute__((ext_vector_type(4)));
#define ALDS __attribute__((address_space(3)))
#define ASBAR() __builtin_amdgcn_sched_barrier(0)
__device__ __forceinline__ int crow(int r, int hi) { return (r & 3) + 8 * (r >> 2) + 4 * hi; }
__device__ __forceinline__ unsigned cvtpk(float lo, float hi) { unsigned r; asm("v_cvt_pk_bf16_f32 %0, %1, %2" : "=v"(r) : "v"(lo), "v"(hi)); return r; }
template <int STRIDE> __device__ __forceinline__ int kswz(int row, int colB) { return row * STRIDE + (colB ^ (((row >> 1) & 7) << 4)); }
template <int DV> __device__ __forceinline__ int v_st(int k, int c) { const int kk = (k & ~0xC) | ((k & 4) << 1) | ((k & 8) >> 1); return ((kk >> 3) * (DV / 32) + (c >> 5)) * 512 + ((kk & 7) * 32 + (c & 31)) * 2; }
__device__ __forceinline__ int v_rd_base(int lane) { return ((lane & 3) << 3) | (((lane >> 2) & 3) << 6) | (((lane >> 4) & 1) << 5) | (((lane >> 5) & 1) << 8); }
template <int DV> constexpr int v_rd_off(int d0, int ks, int half) { return d0 * 512 + ks * (2 * (DV / 32) * 512) + half * ((DV / 32) * 512); }
template <int OFF> __device__ __forceinline__ s16x4 tr_read(int vb) { s16x4 r; asm volatile("ds_read_b64_tr_b16 %0, %1 offset:%2" : "=&v"(r) : "v"(vb), "i"(OFF) : "memory"); return r; }
__device__ __forceinline__ void partialSM(f32x16& p0, f32x16& p1, float& m_reg, float& mn, float& alpha, const float C, const float THRR) {
    float pmax = p0[0];
#pragma unroll
    for (int r = 1; r < 16; ++r) pmax = fmaxf(pmax, p0[r]);
#pragma unroll
    for (int r = 0; r < 16; ++r) pmax = fmaxf(pmax, p1[r]);
    { auto rr = __builtin_amdgcn_permlane32_swap(__float_as_uint(pmax), __float_as_uint(pmax), false, false); pmax = fmaxf(__uint_as_float(rr[0]), __uint_as_float(rr[1])); }
    if (__builtin_expect(__all(pmax - m_reg <= THRR), 1)) { mn = m_reg; alpha = 1.f; }
    else { mn = fmaxf(m_reg, pmax); alpha = __builtin_amdgcn_exp2f((m_reg - mn) * C); m_reg = mn; }
    const float mnC = -mn * C;
#pragma unroll
    for (int r = 0; r < 16; ++r) p0[r] = fmaf(p0[r], C, mnC);
#pragma unroll
    for (int r = 0; r < 16; ++r) p1[r] = fmaf(p1[r], C, mnC);
#pragma unroll
    for (int r = 0; r < 16; ++r) p0[r] = __builtin_amdgcn_exp2f(p0[r]);
}
__device__ __forceinline__ void finishSM(f32x16& p0, f32x16& p1, float alpha, float& l_reg, bf16x8& pa0, bf16x8& pa1, bf16x8& pa2, bf16x8& pa3) {
#pragma unroll
    for (int r = 0; r < 16; ++r) p1[r] = __builtin_amdgcn_exp2f(p1[r]);
    float ps = 0;
#pragma unroll
    for (int r = 0; r < 16; ++r) ps += p0[r];
#pragma unroll
    for (int r = 0; r < 16; ++r) ps += p1[r];
    { auto rr = __builtin_amdgcn_permlane32_swap(__float_as_uint(ps), __float_as_uint(ps), false, false); ps = __uint_as_float(rr[0]) + __uint_as_float(rr[1]); }
    l_reg = l_reg * alpha + ps;
#define ATT_PK4(P, BASE, OUT) do { unsigned a0 = cvtpk(P[BASE + 0], P[BASE + 1]), a1 = cvtpk(P[BASE + 2], P[BASE + 3]);   \
    unsigned b0 = cvtpk(P[BASE + 4], P[BASE + 5]), b1 = cvtpk(P[BASE + 6], P[BASE + 7]);                              \
    auto r0 = __builtin_amdgcn_permlane32_swap(a0, b0, false, false); auto r1 = __builtin_amdgcn_permlane32_swap(a1, b1, false, false); \
    u32x4 w = {r0[0], r1[0], r0[1], r1[1]}; OUT = *reinterpret_cast<bf16x8*>(&w); } while (0)
    ATT_PK4(p0, 0, pa0); ATT_PK4(p0, 8, pa1); ATT_PK4(p1, 0, pa2); ATT_PK4(p1, 8, pa3);
#undef ATT_PK4
}
template <int DQK, int KST> __device__ __forceinline__ void qkt(f32x16& p0, f32x16& p1, const ALDS char* Ks, const bf16x8* qr, int r32, int hi) {
    p0 = f32x16{}; p1 = f32x16{};
#pragma unroll
    for (int d0 = 0; d0 < DQK / 16; ++d0) { const int cb = (d0 * 16 + hi * 8) * 2;
        const bf16x8 b0 = *reinterpret_cast<const ALDS bf16x8*>(Ks + kswz<KST>(r32, cb));
        const bf16x8 b1 = *reinterpret_cast<const ALDS bf16x8*>(Ks + kswz<KST>(32 + r32, cb));
        p0 = __builtin_amdgcn_mfma_f32_32x32x16_bf16(b0, qr[d0], p0, 0, 0, 0);
        p1 = __builtin_amdgcn_mfma_f32_32x32x16_bf16(b1, qr[d0], p1, 0, 0, 0); }
}
template <int D0, int DV> __device__ __forceinline__ void pv_one(f32x16& od, int vb, bf16x8 pa0, bf16x8 pa1, bf16x8 pa2, bf16x8 pa3) {
    const s16x4 l0 = tr_read<v_rd_off<DV>(D0, 0, 0)>(vb), h0 = tr_read<v_rd_off<DV>(D0, 0, 1)>(vb), l1 = tr_read<v_rd_off<DV>(D0, 1, 0)>(vb), h1 = tr_read<v_rd_off<DV>(D0, 1, 1)>(vb);
    const s16x4 l2 = tr_read<v_rd_off<DV>(D0, 2, 0)>(vb), h2 = tr_read<v_rd_off<DV>(D0, 2, 1)>(vb), l3 = tr_read<v_rd_off<DV>(D0, 3, 0)>(vb), h3 = tr_read<v_rd_off<DV>(D0, 3, 1)>(vb);
    asm volatile("s_waitcnt lgkmcnt(0)" ::: "memory"); ASBAR();
#define ATT_PK(L, H) (bf16x8){L[0], L[1], L[2], L[3], H[0], H[1], H[2], H[3]}
    od = __builtin_amdgcn_mfma_f32_32x32x16_bf16(pa0, ATT_PK(l0, h0), od, 0, 0, 0);
    od = __builtin_amdgcn_mfma_f32_32x32x16_bf16(pa1, ATT_PK(l1, h1), od, 0, 0, 0);
    od = __builtin_amdgcn_mfma_f32_32x32x16_bf16(pa2, ATT_PK(l2, h2), od, 0, 0, 0);
    od = __builtin_amdgcn_mfma_f32_32x32x16_bf16(pa3, ATT_PK(l3, h3), od, 0, 0, 0);
#undef ATT_PK
}

constexpr int MLA_LDS_BYTES = 2 * 16384 + 2 * 24576 + 2048;
__device__ __forceinline__ void mla_unit(const u16* __restrict__ Qb, const u16* __restrict__ KNh, const u16* __restrict__ KRb, const u16* __restrict__ Vh, u16* __restrict__ Ob, int nkeys, ALDS char* lds, int tid) {
    constexpr int SHV = 16384, SHK = 24576;
    constexpr float SCALE = 0.07216878364870322f, C = SCALE * 1.4426950408889634f, THRR = 8.f / SCALE;
    const int wid = tid >> 6, lane = tid & 63, r32 = lane & 31, hi = lane >> 5;
    ALDS char* V_lds = lds; ALDS char* K_lds = lds + 2 * SHV;
    ALDS float* wsc = (ALDS float*)(lds + 2 * SHV + 2 * SHK) + wid * 64; ALDS float* li_l = wsc; ALDS float* al_l = wsc + 32;
    float m_reg = -1e30f, l_reg = 0.f; f32x16 o[4] = {}; bf16x8 qr[12];
    const u16* Qw = Qb + (unsigned)((wid * 32 + r32) * 3072 + hi * 8);
#pragma unroll
    for (int d0 = 0; d0 < 12; ++d0) qr[d0] = *reinterpret_cast<const bf16x8*>(Qw + d0 * 16);
    const int sr = tid >> 4, sc = (tid & 15) * 8, krr = tid >> 3, krc = (tid & 7) * 8;
    const int vst0 = v_st<128>(sr, sc), vst1 = v_st<128>(32 + sr, sc);
    const int kst0 = kswz<384>(sr, sc * 2), kst1 = kswz<384>(32 + sr, sc * 2), kst2 = kswz<384>(krr, (128 + krc) * 2);
    const int vb0 = (int)(unsigned)(uintptr_t)V_lds + v_rd_base(lane);
    bf16x8 vs0, vs1, ks0, ks1, kr0;
const unsigned goff = (unsigned)(sr * 2048 + sc), kroff = (unsigned)(krr * 64 + krc);
#define MLA_SLOAD(k0) do { const u16* vp = Vh + (size_t)(k0) * 2048; const u16* kp = KNh + (size_t)(k0) * 2048; \
    vs0 = *reinterpret_cast<const bf16x8*>(vp + goff); vs1 = *reinterpret_cast<const bf16x8*>(vp + 32 * 2048 + goff); \
    ks0 = *reinterpret_cast<const bf16x8*>(kp + goff); ks1 = *reinterpret_cast<const bf16x8*>(kp + 32 * 2048 + goff); \
    kr0 = *reinterpret_cast<const bf16x8*>(KRb + (size_t)(k0) * 64 + kroff); } while (0)
#define MLA_SWRITE(b) do { *reinterpret_cast<ALDS bf16x8*>(V_lds + (b) * SHV + vst0) = vs0; *reinterpret_cast<ALDS bf16x8*>(V_lds + (b) * SHV + vst1) = vs1; \
    *reinterpret_cast<ALDS bf16x8*>(K_lds + (b) * SHK + kst0) = ks0; *reinterpret_cast<ALDS bf16x8*>(K_lds + (b) * SHK + kst1) = ks1; *reinterpret_cast<ALDS bf16x8*>(K_lds + (b) * SHK + kst2) = kr0; } while (0)
    const int NT = nkeys / 64;
    MLA_SLOAD(0); MLA_SWRITE(0); __syncthreads();
    for (int j = 0; j < NT; ++j) {
        const int b = j & 1;
        if (j + 1 < NT) MLA_SLOAD((j + 1) * 64);
        f32x16 p0, p1; float mn, alpha; bf16x8 pa0, pa1, pa2, pa3;
        qkt<192, 384>(p0, p1, K_lds + b * SHK, qr, r32, hi);
        partialSM(p0, p1, m_reg, mn, alpha, C, THRR);
        if (__any(alpha < 1.f)) { if (hi == 0) al_l[r32] = alpha; asm volatile("s_waitcnt lgkmcnt(0)" ::: "memory");
#pragma unroll
            for (int d = 0; d < 4; ++d)
#pragma unroll
                for (int r = 0; r < 16; ++r) o[d][r] *= al_l[crow(r, hi)]; }
        finishSM(p0, p1, alpha, l_reg, pa0, pa1, pa2, pa3); ASBAR();
        const int vb = vb0 + b * SHV;
        pv_one<0, 128>(o[0], vb, pa0, pa1, pa2, pa3); pv_one<1, 128>(o[1], vb, pa0, pa1, pa2, pa3); pv_one<2, 128>(o[2], vb, pa0, pa1, pa2, pa3); pv_one<3, 128>(o[3], vb, pa0, pa1, pa2, pa3);
        if (j + 1 < NT) MLA_SWRITE(b ^ 1);
        __syncthreads();
    }
#undef MLA_SLOAD
#undef MLA_SWRITE
    if (hi == 0) li_l[r32] = l_reg;
    asm volatile("s_waitcnt lgkmcnt(0)" ::: "memory");
    ALDS char* ost = lds + wid * 8704;
#pragma unroll
    for (int r = 0; r < 16; ++r) { const int orow = crow(r, hi); const float rl = __builtin_amdgcn_rcpf(li_l[orow]);
#pragma unroll
        for (int d0 = 0; d0 < 4; ++d0) *reinterpret_cast<ALDS u16*>(ost + orow * 272 + (d0 * 32 + r32) * 2) = f2bf(o[d0][r] * rl); }
    asm volatile("s_waitcnt lgkmcnt(0)" ::: "memory");
#pragma unroll
    for (int i = 0; i < 8; ++i) { const int row = i * 4 + (lane >> 4), ch = lane & 15; const u32x4 v = *reinterpret_cast<const ALDS u32x4*>(ost + row * 272 + ch * 16);
        *reinterpret_cast<u32x4*>(Ob + (unsigned)((wid * 32 + row) * 2048 + ch * 8)) = v; }
    __syncthreads();
}

constexpr int MLA2_LDS_BYTES = 2 * 16384 + 2 * 24576 + 2048 + 8 * 4096;
__device__ __forceinline__ void qkt_mla(f32x16& p0, f32x16& p1, const ALDS char* Ks, const bf16x8* qr, const ALDS char* qrl, int r32, int hi) {
    p0 = f32x16{}; p1 = f32x16{};
    const int kb[4] = {kswz<384>(r32, (0 * 16 + hi * 8) * 2), kswz<384>(r32, (1 * 16 + hi * 8) * 2), kswz<384>(r32, (2 * 16 + hi * 8) * 2), kswz<384>(r32, (3 * 16 + hi * 8) * 2)};
    bf16x8 b0[3], b1[3], qf[3];
#define QKT_LD(d0) do { b0[(d0) % 3] = *reinterpret_cast<const ALDS bf16x8*>(Ks + kb[(d0) & 3] + ((d0) >> 2) * 128); b1[(d0) % 3] = *reinterpret_cast<const ALDS bf16x8*>(Ks + kb[(d0) & 3] + ((d0) >> 2) * 128 + 32 * 384); \
        if ((d0) >= 8) qf[(d0) % 3] = *reinterpret_cast<const ALDS bf16x8*>(qrl + ((d0) - 8) * 1024); } while (0)
    QKT_LD(0); QKT_LD(1);
#define QKT_STEP(d0) do { if ((d0) + 2 < 12) QKT_LD((d0) + 2); \
        { const bf16x8 q = (d0) < 8 ? qr[(d0) < 8 ? (d0) : 0] : qf[(d0) % 3]; \
          p0 = __builtin_amdgcn_mfma_f32_32x32x16_bf16(b0[(d0) % 3], q, p0, 0, 0, 0); p1 = __builtin_amdgcn_mfma_f32_32x32x16_bf16(b1[(d0) % 3], q, p1, 0, 0, 0); } \
        __builtin_amdgcn_sched_group_barrier(0x100, (d0) + 2 < 12 ? ((d0) + 2 >= 8 ? 3 : 2) : 0, 0);     \
        __builtin_amdgcn_sched_group_barrier(0x008, 2, 0); } while (0)
    QKT_STEP(0); QKT_STEP(1); QKT_STEP(2); QKT_STEP(3); QKT_STEP(4); QKT_STEP(5); QKT_STEP(6); QKT_STEP(7); QKT_STEP(8); QKT_STEP(9); QKT_STEP(10); QKT_STEP(11);
#undef QKT_STEP
#undef QKT_LD
}
template <int OFF> __device__ __forceinline__ bf16x8 lds_rd128(int a) { bf16x8 r; asm volatile("ds_read_b128 %0, %1 offset:%2" : "=&v"(r) : "v"(a), "i"(OFF) : "memory"); return r; }
#ifdef QROPE_REG
#define QKT_QF(d0) do { } while (0)
#define QKT_Q(d0) qr[(d0)]
#define QKT_NQ 0
#else
#define QKT_QF(d0) do { if ((d0) >= 8) qf[(d0) & 1] = lds_rd128<((d0) >= 8 ? (d0) - 8 : 0) * 1024>(qa); } while (0)
#define QKT_Q(d0) ((d0) < 8 ? qr[(d0) < 8 ? (d0) : 0] : qf[(d0) & 1])
#define QKT_NQ 1
#endif
template <int KOFF> __device__ __forceinline__ void qkt_mla_p(f32x16& p0, f32x16& p1, const int (&ka)[4], int qa, const bf16x8* qr) {
    p0 = f32x16{}; p1 = f32x16{};
    bf16x8 b0[2], b1[2], qf[2];
#define QL(d0) do { b0[(d0) & 1] = lds_rd128<KOFF + ((d0) >> 2) * 128>(ka[(d0) & 3]); b1[(d0) & 1] = lds_rd128<KOFF + ((d0) >> 2) * 128 + 32 * 384>(ka[(d0) & 3]); \
        QKT_QF(d0); } while (0)
#define QN(d0) ((d0) >= 12 ? 0 : (d0) >= 8 ? 2 + QKT_NQ : 2)
#define QS(d0) do { if ((d0) + 1 < 12) QL((d0) + 1); \
        asm volatile("s_waitcnt lgkmcnt(%0)" :: "i"(QN((d0) + 1)) : "memory"); ASBAR(); \
        { const bf16x8 q = QKT_Q(d0); \
          p0 = __builtin_amdgcn_mfma_f32_32x32x16_bf16(b0[(d0) & 1], q, p0, 0, 0, 0); p1 = __builtin_amdgcn_mfma_f32_32x32x16_bf16(b1[(d0) & 1], q, p1, 0, 0, 0); } ASBAR(); } while (0)
    QL(0);
    QS(0); QS(1); QS(2); QS(3); QS(4); QS(5); QS(6); QS(7); QS(8); QS(9); QS(10); QS(11);
#undef QS
#undef QN
#undef QL
}
template <int ABL = 0, int ORDER = 0> __device__ __forceinline__ void mla_unit2(const u16* __restrict__ Qb, const u16* __restrict__ KNh, const u16* __restrict__ KRb, const u16* __restrict__ Vh, u16* __restrict__ Ob, int nkeys, ALDS char* lds, int tid) {
    constexpr int SHV = 16384, SHK = 24576;
    constexpr float SCALE = 0.07216878364870322f, C = SCALE * 1.4426950408889634f, THRR = 8.f / SCALE;
    const int wid = __builtin_amdgcn_readfirstlane(tid >> 6), lane = tid & 63, r32 = lane & 31, hi = lane >> 5;
    ALDS char* V_lds = lds; ALDS char* K_lds = lds + 2 * SHV;
    ALDS float* wsc = (ALDS float*)(lds + 2 * SHV + 2 * SHK) + wid * 64; ALDS float* li_l = wsc; ALDS float* al_l = wsc + 32;
    ALDS char* qrl = lds + 2 * SHV + 2 * SHK + 2048 + wid * 4096 + lane * 16;
    float m_reg = -1e30f, l_reg = 0.f; f32x16 o[4] = {};
#ifdef QROPE_REG
    bf16x8 qr[12];
    const u16* Qw = Qb + (unsigned)((wid * 32 + r32) * 3072 + hi * 8);
#pragma unroll
    for (int d0 = 0; d0 < 12; ++d0) qr[d0] = *reinterpret_cast<const bf16x8*>(Qw + d0 * 16);
#else
    bf16x8 qr[8];
    const u16* Qw = Qb + (unsigned)((wid * 32 + r32) * 3072 + hi * 8);
#pragma unroll
    for (int d0 = 0; d0 < 8; ++d0) qr[d0] = *reinterpret_cast<const bf16x8*>(Qw + d0 * 16);
#pragma unroll
    for (int d0 = 8; d0 < 12; ++d0) *reinterpret_cast<ALDS bf16x8*>(qrl + (d0 - 8) * 1024) = *reinterpret_cast<const bf16x8*>(Qw + d0 * 16);
#endif
    const int vb0 = (int)(unsigned)(uintptr_t)V_lds + v_rd_base(lane);
    int ka[4]; { const int kbase = (int)(unsigned)(uintptr_t)K_lds;
#pragma unroll
      for (int r = 0; r < 4; ++r) ka[r] = kbase + kswz<384>(r32, (r * 16 + hi * 8) * 2); }
    const int qa = (int)(unsigned)(uintptr_t)qrl;
    bf16x8 vs0, vs1, ks0, ks1, kr0;
    const unsigned goff = (unsigned)((tid >> 4) * 2048 + (tid & 15) * 8), kroff = (unsigned)((tid >> 3) * 64 + (tid & 7) * 8);
    const int vst0 = v_st<128>(tid >> 4, (tid & 15) * 8), kst0 = kswz<384>(tid >> 4, (tid & 15) * 16), kst2 = kswz<384>(tid >> 3, (128 + (tid & 7) * 8) * 2);
    constexpr int vst1o = 8192, kst1o = 32 * 384;
#define MLA_SLOAD(k0) do { \
    const u16* vp = Vh + (size_t)(k0) * 2048; const u16* kp = KNh + (size_t)(k0) * 2048; \
    if (!(ABL & 1)) { vs0 = *reinterpret_cast<const bf16x8*>(vp + goff); vs1 = *reinterpret_cast<const bf16x8*>(vp + 32 * 2048 + goff); \
    ks0 = *reinterpret_cast<const bf16x8*>(kp + goff); ks1 = *reinterpret_cast<const bf16x8*>(kp + 32 * 2048 + goff); \
    kr0 = *reinterpret_cast<const bf16x8*>(KRb + (size_t)(k0) * 64 + kroff); } } while (0)
#define MLA_SWRITE(b) do { \
    if (!(ABL & 1)) { *reinterpret_cast<ALDS bf16x8*>(V_lds + (b) * SHV + vst0) = vs0; *reinterpret_cast<ALDS bf16x8*>(V_lds + (b) * SHV + vst0 + vst1o) = vs1; \
    *reinterpret_cast<ALDS bf16x8*>(K_lds + (b) * SHK + kst0) = ks0; *reinterpret_cast<ALDS bf16x8*>(K_lds + (b) * SHK + kst0 + kst1o) = ks1; *reinterpret_cast<ALDS bf16x8*>(K_lds + (b) * SHK + kst2) = kr0; } } while (0)
#define MLA_RESC(a) do { if (__any((a) < 1.f)) { if (hi == 0) al_l[r32] = (a); asm volatile("s_waitcnt lgkmcnt(0)" ::: "memory"); \
    _Pragma("unroll") for (int d = 0; d < 4; ++d) _Pragma("unroll") for (int r = 0; r < 16; ++r) o[d][r] *= al_l[crow(r, hi)]; } } while (0)
#define MLA_PV(vb) do { pv_one<0, 128>(o[0], (vb), pa0, pa1, pa2, pa3); pv_one<1, 128>(o[1], (vb), pa0, pa1, pa2, pa3); pv_one<2, 128>(o[2], (vb), pa0, pa1, pa2, pa3); pv_one<3, 128>(o[3], (vb), pa0, pa1, pa2, pa3); } while (0)
#define ABL_PSM(P0, P1, MN, AL) do { if (ABL & 2) { MN = m_reg; AL = 1.f; } else partialSM(P0, P1, m_reg, MN, AL, C, THRR); } while (0)
#define ABL_FSM(P0, P1, AL) do { if (ABL & 2) { u32x4 w_ = {__float_as_uint(P0[0]), __float_as_uint(P0[1]), __float_as_uint(P1[0]), __float_as_uint(P1[1])}; pa0 = *reinterpret_cast<bf16x8*>(&w_); pa1 = pa0; pa2 = pa0; pa3 = pa0; l_reg += 1.f; } else finishSM(P0, P1, AL, l_reg, pa0, pa1, pa2, pa3); } while (0)
    f32x16 pA0, pA1, pB0, pB1; float mnA, mnB, alA, alB; bf16x8 pa0, pa1, pa2, pa3; const int NT = nkeys / 64;
    MLA_SLOAD(0); asm volatile("s_waitcnt vmcnt(0)" ::: "memory"); MLA_SWRITE(0); __syncthreads();
    qkt_mla_p<0>(pA0, pA1, ka, qa, qr); ABL_PSM(pA0, pA1, mnA, alA);
    MLA_SLOAD(64); asm volatile("s_waitcnt vmcnt(0)" ::: "memory"); MLA_SWRITE(1); __syncthreads();
    constexpr bool lead = ORDER == 0;
#define MLA_STEP(Q0, Q1, KB, P0, P1, ALP, VB, MNQ, ALQ) do { \
        if (lead) { ASBAR(); qkt_mla_p<KB>(Q0, Q1, ka, qa, qr); ABL_FSM(P0, P1, ALP); ASBAR(); MLA_PV(VB); ABL_PSM(Q0, Q1, MNQ, ALQ); } \
        else { ASBAR(); ABL_FSM(P0, P1, ALP); ASBAR(); qkt_mla_p<KB>(Q0, Q1, ka, qa, qr); ASBAR(); ABL_PSM(Q0, Q1, MNQ, ALQ); ASBAR(); MLA_PV(VB); } } while (0)
    for (int j = 1; j + 1 < NT; j += 2) {
        MLA_SLOAD((j + 1) * 64);
        MLA_STEP(pB0, pB1, SHK, pA0, pA1, alA, vb0, mnB, alB);
        __syncthreads(); asm volatile("s_waitcnt vmcnt(0)" ::: "memory"); MLA_SWRITE(0);
        MLA_RESC(alB); __syncthreads();
        MLA_SLOAD((j + 2) * 64);
        MLA_STEP(pA0, pA1, 0, pB0, pB1, alB, vb0 + SHV, mnA, alA);
        __syncthreads(); asm volatile("s_waitcnt vmcnt(0)" ::: "memory"); MLA_SWRITE(1);
        MLA_RESC(alA); __syncthreads();
    }
#undef MLA_STEP
    ASBAR(); qkt_mla_p<SHK>(pB0, pB1, ka, qa, qr);
    ABL_FSM(pA0, pA1, alA); ASBAR();
    MLA_PV(vb0); ABL_PSM(pB0, pB1, mnB, alB);
    __syncthreads(); MLA_RESC(alB);
    ABL_FSM(pB0, pB1, alB); ASBAR();
    MLA_PV(vb0 + SHV);
#undef MLA_SLOAD
#undef MLA_SWRITE
#undef MLA_RESC
#undef MLA_PV
#undef ABL_PSM
#undef ABL_FSM
    __syncthreads();
    if (hi == 0) li_l[r32] = l_reg;
    { const int lane = (int)__builtin_amdgcn_mbcnt_hi(~0u, __builtin_amdgcn_mbcnt_lo(~0u, 0u)), r32 = lane & 31, hi = lane >> 5;
    asm volatile("s_waitcnt lgkmcnt(0)" ::: "memory");
    ALDS char* ost = lds + wid * 8704;
#pragma unroll
    for (int r = 0; r < 16; ++r) { const int orow = crow(r, hi); const float rl = __builtin_amdgcn_rcpf(li_l[orow]);
#pragma unroll
        for (int d0 = 0; d0 < 4; ++d0) *reinterpret_cast<ALDS u16*>(ost + orow * 272 + (d0 * 32 + r32) * 2) = f2bf(o[d0][r] * rl); }
    asm volatile("s_waitcnt lgkmcnt(0)" ::: "memory");
#pragma unroll
    for (int i = 0; i < 8; ++i) { const int row = i * 4 + (lane >> 4), ch = lane & 15; const u32x4 v = *reinterpret_cast<const ALDS u32x4*>(ost + row * 272 + ch * 16);
        *reinterpret_cast<u32x4*>(Ob + (unsigned)((wid * 32 + row) * 2048 + ch * 8)) = v; } }
    __syncthreads();
}

constexpr int WIN_LDS_BYTES = 4 * 8192 + 2048 + 8 * 4608;
__device__ __forceinline__ void win_unit(const u16* __restrict__ QKV, u16* __restrict__ O, const float* __restrict__ sink, int kb, int qrow0, int p0, int kvh, ALDS char* lds, int tid) {
    constexpr int SHK = 8192, SHV = 8192;
    constexpr float SCALE = 0.125f, C = SCALE * 1.4426950408889634f, THRR = 8.f / SCALE;
    const int wid = tid >> 6, lane = tid & 63, r32 = lane & 31, hi = lane >> 5, qh = kvh * 8 + wid;
    ALDS char* K_lds = lds; ALDS char* V_lds = lds + 2 * SHK;
    ALDS float* wsc = (ALDS float*)(lds + 2 * SHK + 2 * SHV) + wid * 64; ALDS float* li_l = wsc; ALDS float* al_l = wsc + 32;
    float m_reg = sink[qh] * (1.0f / SCALE), l_reg = 1.f; f32x16 o[2] = {}; bf16x8 qr[4];
    const u16* Qw = QKV + (size_t)(qrow0 + r32) * 2560 + qh * 64 + hi * 8;
#pragma unroll
    for (int d0 = 0; d0 < 4; ++d0) qr[d0] = *reinterpret_cast<const bf16x8*>(Qw + d0 * 16);
    const int srow = tid >> 3, scol = (tid & 7) * 8;
    const int vst = v_st<64>(srow, scol), kst = kswz<128>(srow, scol * 2);
    const int vb0 = (int)(unsigned)(uintptr_t)V_lds + v_rd_base(lane);
    const unsigned goff = (unsigned)(srow * 2560 + scol);
    int wlo = 0, NT = 4;
    if (p0 >= 0) { const int lo = p0 - 128 < 0 ? 0 : p0 - 128, hiP = p0 + 159 > S - 1 ? S - 1 : p0 + 159; wlo = lo >> 6; NT = 4 + (hiP >> 6) - wlo + 1; }
    bf16x8 ks, vs;
#define WIN_TROW(j) ((j) < 4 ? kb + 64 * (j) : kb + CTX + 64 * (wlo + (j) - 4))
#define WIN_SLOAD(j) do { const u16* rp = QKV + (size_t)WIN_TROW(j) * 2560; ks = *reinterpret_cast<const bf16x8*>(rp + 2048 + kvh * 64 + goff); vs = *reinterpret_cast<const bf16x8*>(rp + 2304 + kvh * 64 + goff); } while (0)
#define WIN_SWRITE(b) do { *reinterpret_cast<ALDS bf16x8*>(K_lds + (b) * SHK + kst) = ks; *reinterpret_cast<ALDS bf16x8*>(V_lds + (b) * SHV + vst) = vs; } while (0)
    WIN_SLOAD(0); WIN_SWRITE(0); __syncthreads();
    for (int j = 0; j < NT; ++j) {
        const int b = j & 1;
        if (j + 1 < NT) WIN_SLOAD(j + 1);
        f32x16 p0v, p1v; float mn, alpha; bf16x8 pa0, pa1, pa2, pa3;
        qkt<64, 128>(p0v, p1v, K_lds + b * SHK, qr, r32, hi);
        if (j >= 4) { const int dq0 = (p0 + r32) - 64 * (wlo + j - 4);
#pragma unroll
            for (int r = 0; r < 16; ++r) { const int dq = dq0 - crow(r, hi); if (dq > 128 || dq < -128) p0v[r] = -1e30f; if (dq - 32 > 128 || dq - 32 < -128) p1v[r] = -1e30f; } }
        partialSM(p0v, p1v, m_reg, mn, alpha, C, THRR);
        if (__any(alpha < 1.f)) { if (hi == 0) al_l[r32] = alpha; asm volatile("s_waitcnt lgkmcnt(0)" ::: "memory");
#pragma unroll
            for (int d = 0; d < 2; ++d)
#pragma unroll
                for (int r = 0; r < 16; ++r) o[d][r] *= al_l[crow(r, hi)]; }
        finishSM(p0v, p1v, alpha, l_reg, pa0, pa1, pa2, pa3); ASBAR();
        const int vb = vb0 + b * SHV;
        pv_one<0, 64>(o[0], vb, pa0, pa1, pa2, pa3); pv_one<1, 64>(o[1], vb, pa0, pa1, pa2, pa3);
        if (j + 1 < NT) WIN_SWRITE(b ^ 1);
        __syncthreads();
    }
#undef WIN_TROW
#undef WIN_SLOAD
#undef WIN_SWRITE
    if (hi == 0) li_l[r32] = l_reg;
    asm volatile("s_waitcnt lgkmcnt(0)" ::: "memory");
    ALDS char* ost = lds + 2 * SHK + 2 * SHV + 2048 + wid * 4608;
#pragma unroll
    for (int r = 0; r < 16; ++r) { const int orow = crow(r, hi); const float rl = __builtin_amdgcn_rcpf(li_l[orow]);
#pragma unroll
        for (int d0 = 0; d0 < 2; ++d0) *reinterpret_cast<ALDS u16*>(ost + orow * 144 + (d0 * 32 + r32) * 2) = f2bf(o[d0][r] * rl); }
    asm volatile("s_waitcnt lgkmcnt(0)" ::: "memory");
#pragma unroll
    for (int i = 0; i < 4; ++i) { const int row = i * 8 + (lane >> 3), ch = lane & 7; const u32x4 v = *reinterpret_cast<const ALDS u32x4*>(ost + row * 144 + ch * 16);
        *reinterpret_cast<u32x4*>(O + (size_t)(qrow0 + row) * 2048 + qh * 64 + ch * 8) = v; }
    __syncthreads();
}
}
#ifndef MLA_UNIT
#define MLA_UNIT mla_unit2<0, 0>
#endif
template <int ABL = 0> PH void ph_attn_mla(const u16* __restrict__ Q, const u16* __restrict__ KN, const u16* __restrict__ KR, const u16* __restrict__ V, u16* __restrict__ O, unsigned char* lds, int wg, int nwg, bool need_ctx) {
    const int TID = otid();
    const int vcu = (nwg % 8 == 0) ? (wg % 8) * (nwg / 8) + wg / 8 : wg;
    for (int u = vcu; u < (need_ctx ? NB * 16 * 17 : NB * 16 * 16); u += nwg) {
        int bh, qb; if (u < NB * 16 * 16) { bh = u >> 4; qb = 1 + (u & 15); } else { bh = u - NB * 16 * 16; qb = 0; }
        const int b = bh >> 4, h = bh & 15; const size_t kb = (size_t)b * SB, q0 = kb + (size_t)qb * 256;
        int tu = TID; asm volatile("" : "+v"(tu));
#ifndef MLA_NOSWAP
        if (__builtin_amdgcn_readfirstlane(tu >> 6) < 4) att::mla_unit2<ABL, 0>(Q + q0 * 3072 + h * 192, KN + kb * D + h * 128, KR + kb * 64, V + kb * D + h * 128, O + q0 * D + h * 128, qb == 0 ? CTX : SB, (ALDS char*)lds, tu);
        else att::mla_unit2<ABL, 1>(Q + q0 * 3072 + h * 192, KN + kb * D + h * 128, KR + kb * 64, V + kb * D + h * 128, O + q0 * D + h * 128, qb == 0 ? CTX : SB, (ALDS char*)lds, tu);
#else
        att::mla_unit2<ABL, 0>(Q + q0 * 3072 + h * 192, KN + kb * D + h * 128, KR + kb * 64, V + kb * D + h * 128, O + q0 * D + h * 128, qb == 0 ? CTX : SB, (ALDS char*)lds, tu);
#endif
    }
}

PH void ph_attn_win(const u16* __restrict__ QKV, const float* __restrict__ sink, u16* __restrict__ O, unsigned char* lds, int wg, int nwg) {
    const int TID = otid();
    const int vcu = (nwg % 8 == 0) ? (wg % 8) * (nwg / 8) + wg / 8 : wg;
    for (int u = vcu; u < NB * 4 * 136; u += nwg) {
        const int pb = u % 136, bk = u / 136, b = bk >> 2, kvh = bk & 3, kb = b * SB;
        const int p0 = pb < 128 ? pb * 32 : -1, qrow0 = pb < 128 ? kb + CTX + pb * 32 : kb + (pb - 128) * 32;
        int tu = TID; asm volatile("" : "+v"(tu));
        att::win_unit(QKV, O, sink, kb, qrow0, p0, kvh, (ALDS char*)lds, tu);
    }
}

#ifndef FFT_HD
#define FFT_HD __device__ __forceinline__
#define FFT_OPQ(t) asm volatile("" : "+v"(t))
#else
#define FFT_OPQ(t)
#endif
typedef float cf __attribute__((ext_vector_type(2)));
FFT_HD cf cswap(cf a) { return __builtin_shufflevector(a, a, 1, 0); }
FFT_HD cf cmul(cf a, cf b) { return a * b.xx + cswap(a) * (cf){-b.y, b.y}; }
FFT_HD cf cmulc(cf a, cf b) { return a * b.xx + cswap(a) * (cf){b.y, -b.y}; }
FFT_HD cf cadd(cf a, cf b) { return a + b; }
FFT_HD cf csub(cf a, cf b) { return a - b; }
FFT_HD int fidx(int a) { return a + (a >> 5) + (a >> 9); }
constexpr int FFT_N = 8192, FFT_BUF = FFT_N + FFT_N / 32 + FFT_N / 512;
FFT_HD int fpos(int k) { return ((k & 15) << 9) | (((k >> 4) & 15) << 5) | (((k >> 8) & 15) << 1) | ((k >> 12) & 1); }
template <bool INV, bool ZHI = false> FFT_HD void dft16(cf (&v)[16]) {
    constexpr float C1 = 0.9238795325112867f, S1 = 0.3826834323650898f, C2 = 0.7071067811865476f;
    const float wr[8] = {1.f, C1, C2, S1, 0.f, -S1, -C2, -C1};
    const float wi[8] = {0.f, S1, C2, C1, 1.f, C1, C2, S1};
#pragma unroll
    for (int s = 0; s < 4; ++s) {
        const int half = 8 >> s;
#pragma unroll
        for (int i = 0; i < 16; ++i) {
            if ((i & half) == 0) {
                const int j = i + half, tw = (i & (half - 1)) << s;
                const cf a = v[i], b = v[j];
                const bool z = ZHI && s == 0;
                if (!z) v[i] = cadd(a, b);
                const cf d = z ? a : csub(a, b);
                if (tw == 0) v[j] = d;
                else if (tw == 4) v[j] = INV ? (cf){-d.y, d.x} : (cf){d.y, -d.x};
                else { const float c = wr[tw], sn = INV ? -wi[tw] : wi[tw]; v[j] = d * (cf){c, c} + cswap(d) * (cf){sn, -sn}; }
            }
        }
    }
#pragma unroll
    for (int i = 0; i < 16; ++i) { const int r = ((i & 1) << 3) | ((i & 2) << 1) | ((i & 4) >> 1) | ((i & 8) >> 3); if (r > i) { const cf t = v[i]; v[i] = v[r]; v[r] = t; } }
}
template <int M, bool INV, class BufT, class TwT> FFT_HD void fft_pass16(BufT buf, TwT tw, int tid) {
    FFT_OPQ(tid);
    const int blk = tid / M, n2 = tid % M, base = blk * 16 * M + n2;
    constexpr int ST = M + (M >> 5) + (M >> 9); const int a0 = fidx(base);
    cf v[16];
#pragma unroll
    for (int j = 0; j < 16; ++j) v[j] = buf.get(a0 + j * ST);
    cf w[16];
    if (M > 1) { const cf w1 = tw.get(n2 * (FFT_N / (16 * M))); w[1] = w1; w[2] = cmul(w1, w1); w[3] = cmul(w[2], w1); w[4] = cmul(w[2], w[2]); w[5] = cmul(w[4], w1); w[6] = cmul(w[3], w[3]); w[7] = cmul(w[6], w1);
        w[8] = cmul(w[4], w[4]); w[9] = cmul(w[8], w1); w[10] = cmul(w[5], w[5]); w[11] = cmul(w[10], w1); w[12] = cmul(w[6], w[6]); w[13] = cmul(w[12], w1); w[14] = cmul(w[7], w[7]); w[15] = cmul(w[14], w1); }
    if (INV) { if (M > 1) {
#pragma unroll
        for (int k = 1; k < 16; ++k) v[k] = cmulc(v[k], w[k]); } }
    dft16<INV>(v);
    if (!INV) { if (M > 1) {
#pragma unroll
        for (int k = 1; k < 16; ++k) v[k] = cmul(v[k], w[k]); } }
#pragma unroll
    for (int j = 0; j < 16; ++j) buf.set(a0 + j * ST, v[j]);
}
template <class BufT> FFT_HD void fft_pass2(BufT buf, int tid) {
    FFT_OPQ(tid);
    const int a0 = fidx(2 * tid);
#pragma unroll
    for (int i = 0; i < 8; ++i) { const int e = a0 + 1058 * i; const cf a = buf.get(e), b = buf.get(e + 1); buf.set(e, cadd(a, b)); buf.set(e + 1, csub(a, b)); }
}
#ifndef FFT_HOST_TEST
#define FFT_SYNC() __syncthreads()
template <class BufT, class TwT> FFT_HD void fft_fwd(BufT buf, TwT tw, int tid) {
    fft_pass16<512, false>(buf, tw, tid); FFT_SYNC(); fft_pass16<32, false>(buf, tw, tid); FFT_SYNC(); fft_pass16<2, false>(buf, tw, tid); FFT_SYNC(); fft_pass2(buf, tid); FFT_SYNC();
}
template <class BufT, class TwT> FFT_HD void fft_inv(BufT buf, TwT tw, int tid) {
    fft_pass2(buf, tid); FFT_SYNC(); fft_pass16<2, true>(buf, tw, tid); FFT_SYNC(); fft_pass16<32, true>(buf, tw, tid); FFT_SYNC(); fft_pass16<512, true>(buf, tw, tid); FFT_SYNC();
}
#endif
FFT_HD void spec_pair(cf a, cf b, cf fd, cf fe, cf& ya, cf& yb) {
    const cf zd = cf{a.x + b.x, a.y - b.y};
    const cf ze = cf{a.y + b.y, b.x - a.x};
    const cf P = cmul(zd, fd), Q = cmul(ze, fe);
    ya = cf{P.x - Q.y, P.y + Q.x};
    yb = cf{P.x + Q.y, Q.x - P.y};
}

#ifndef FFT_HOST_TEST
typedef float f32x2v __attribute__((ext_vector_type(2)));
struct LdsCf { LAS f32x2v* p; __device__ __forceinline__ cf get(int i) const { return p[i]; } __device__ __forceinline__ void set(int i, cf v) const { p[i] = v; } };
constexpr int FS_LD = 4104;
PH void ph_filter_fft(KP p, unsigned char* ldsraw, int wg, int nwg) {
    const int TID = otid();
    const LdsCf buf{(LAS f32x2v*)ldsraw}, tw{(LAS f32x2v*)ldsraw + FFT_BUF};
    const cf* twg = (const cf*)(p->ws + WS_TW);
    for (int i = TID; i < FFT_N; i += 512) tw.set(i, twg[i]);
    __syncthreads();
    const float* FT = (const float*)(p->ws + WS_FT4096); cf* FS = (cf*)(p->ws + WS_FS);
    for (int u = wg; u < 2048; u += nwg) {
        const int n = u & 1, d = (u >> 1) * 2;
        const float* ff0 = FT + (size_t)(n * 4096 + d) * 4096; const float* ff1 = ff0 + 4096; const float* fb0 = FT + (size_t)(n * 4096 + 2048 + d) * 4096; const float* fb1 = fb0 + 4096;
#pragma unroll
        for (int i = 0; i < 16; ++i) { const int k = TID + 512 * i; cf v;
            if (k < 4096) v = cf{ff0[k], ff1[k]}; else if (k == 4096) v = cf{0.f, 0.f}; else v = cf{fb0[8192 - k], fb1[8192 - k]};
            buf.set(fidx(k), v); }
        __syncthreads();
        fft_fwd(buf, tw, TID);
        const float s = 1.0f / (4.0f * FFT_N);
        cf* fd = FS + (size_t)(n * 2048 + d) * FS_LD; cf* fe = fd + FS_LD;
        int tq = TID; FFT_OPQ(tq);
#pragma unroll
        for (int i = 0; i < 9; ++i) { const int w = tq + 512 * i; if (w <= 4096) { const cf a = buf.get(fidx(fpos(w))), b = buf.get(fidx(fpos((FFT_N - w) & (FFT_N - 1))));
            fd[w] = cf{(a.x + b.x) * s, (a.y - b.y) * s}; fe[w] = cf{(a.y + b.y) * s, (b.x - a.x) * s}; } }
        __syncthreads();
    }
}
#endif

#ifndef FFT_HOST_TEST
constexpr int FS2_LD = 264;
FFT_HD int fpos512(int k) { return ((k & 15) << 5) | (((k >> 4) & 15) << 1) | ((k >> 8) & 1); }
template <class BufT, class TwT> FFT_HD void fft512_fwd(BufT buf, TwT tw, int tid) { fft_pass16<32, false>(buf, tw, tid); FFT_SYNC(); fft_pass16<2, false>(buf, tw, tid); FFT_SYNC(); fft_pass2(buf, tid); FFT_SYNC(); }
template <class BufT, class TwT> FFT_HD void fft512_inv(BufT buf, TwT tw, int tid) { fft_pass2(buf, tid); FFT_SYNC(); fft_pass16<2, true>(buf, tw, tid); FFT_SYNC(); fft_pass16<32, true>(buf, tw, tid); FFT_SYNC(); }
PH void ph_filter_fft256(KP p, unsigned char* ldsraw, int wg, int nwg) {
    const int TID = otid();
    const LdsCf buf{(LAS f32x2v*)ldsraw}, tw{(LAS f32x2v*)ldsraw + FFT_BUF};
    const cf* twg = (const cf*)(p->ws + WS_TW);
    for (int i = TID; i < FFT_N; i += 512) tw.set(i, twg[i]);
    __syncthreads();
    const float* FT = (const float*)(p->ws + WS_FT256); cf* FS = (cf*)(p->ws + WS_FS256);
    for (int u = wg; u < 128; u += nwg) {
        int tq = TID; FFT_OPQ(tq);
#pragma unroll 1
        for (int i = 0; i < 16; ++i) { const int combo = u * 16 + i, n = combo & 1, d = (combo >> 1) * 2, k = tq; cf v;
            const float* ff0 = FT + (size_t)(n * 4096 + d) * 256; const float* fb0 = FT + (size_t)(n * 4096 + 2048 + d) * 256;
            if (k < 256) v = cf{ff0[k], ff0[256 + k]}; else if (k == 256) v = cf{0.f, 0.f}; else v = cf{fb0[512 - k], fb0[256 + 512 - k]};
            buf.set(fidx(i * 512 + k), v); }
        __syncthreads();
        fft512_fwd(buf, tw, TID);
        const float s = 1.0f / (4.0f * 512.0f);
        int tw2 = TID; FFT_OPQ(tw2);
        if (tw2 <= 256) {
#pragma unroll 1
            for (int i = 0; i < 16; ++i) { const int combo = u * 16 + i, n = combo & 1, d = (combo >> 1) * 2, w = tw2;
                const cf a = buf.get(fidx(i * 512 + fpos512(w))), b = buf.get(fidx(i * 512 + fpos512((512 - w) & 511)));
                cf* fd = FS + (size_t)(n * 2048 + d) * FS2_LD; cf* fe = fd + FS2_LD;
                fd[w] = cf{(a.x + b.x) * s, (a.y - b.y) * s}; fe[w] = cf{(a.y + b.y) * s, (b.x - a.x) * s}; } }
        __syncthreads();
    }
}
PH void ph_hyena_fft256(KP p, unsigned char* ldsraw, int wg, int nwg) {
    const int TID = otid();
    const LdsCf buf{(LAS f32x2v*)ldsraw}, tw{(LAS f32x2v*)ldsraw + FFT_BUF};
    const cf* twg = (const cf*)(p->ws + WS_TW);
    for (int i = TID; i < FFT_N; i += 512) tw.set(i, twg[i]);
    __syncthreads();
    const _Float16* UT = (const _Float16*)(p->ws + WS_UT); u16* ZT = (u16*)(p->ws + WS_ZT); const cf* FS = (const cf*)(p->ws + WS_FS256);
    const float* cw = p->in[I_HCW]; const float* cb = p->in[I_HCB]; const float* skip = p->in[I_SKIP];
    for (int u = wg; u < 256; u += nwg) {
        int tz = TID; FFT_OPQ(tz);
        auto sconv = [&](int ch, int rb, int t) { const _Float16* uu = UT + (size_t)ch * R + rb; const float um = t > 0 ? (float)uu[t - 1] : 0.f, u0 = (float)uu[t], up = t < CTX - 1 ? (float)uu[t + 1] : 0.f;
            return um * cw[ch] + u0 * cw[3 * D + ch] + up * cw[6 * D + ch] + cb[ch]; };
        float z[16][2];
#pragma unroll
        for (int i = 0; i < 16; ++i) { const int seq = u * 16 + i, d = (seq >> 2) * 2, rb = (seq & 3) * SB; if (tz < 256) { z[i][0] = sconv(d, rb, tz); z[i][1] = sconv(d + 1, rb, tz); } else { z[i][0] = 0.f; z[i][1] = 0.f; } }
#pragma unroll 1
        for (int n = 0; n < 2; ++n) {
            int ts = TID; FFT_OPQ(ts);
#pragma unroll
            for (int i = 0; i < 16; ++i) buf.set(fidx(i * 512 + ts), cf{z[i][0], z[i][1]});
            __syncthreads();
            fft512_fwd(buf, tw, TID);
            int tq = TID; FFT_OPQ(tq);
            if (tq <= 256) {
#pragma unroll 1
                for (int i = 0; i < 16; ++i) { const int seq = u * 16 + i, d = (seq >> 2) * 2, w = tq; const cf* fd = FS + (size_t)(n * 2048 + d) * FS2_LD; const cf* fe = fd + FS2_LD;
                    const int pw = fidx(i * 512 + fpos512(w)), pn = fidx(i * 512 + fpos512((512 - w) & 511));
                    const cf a = buf.get(pw), bb = buf.get(pn); cf ya, yb; spec_pair(a, bb, fd[w], fe[w], ya, yb); buf.set(pw, ya); if (pn != pw) buf.set(pn, yb); } }
            __syncthreads();
            fft512_inv(buf, tw, TID);
            int tg = TID; FFT_OPQ(tg);
            if (tg < 256) {
#pragma unroll
                for (int i = 0; i < 16; ++i) { const int seq = u * 16 + i, d = (seq >> 2) * 2, rb = (seq & 3) * SB; const cf y = buf.get(fidx(i * 512 + tg));
                    z[i][0] = sconv((n + 1) * D + d, rb, tg) * (y.x + z[i][0] * skip[n * D + d]); z[i][1] = sconv((n + 1) * D + d + 1, rb, tg) * (y.y + z[i][1] * skip[n * D + d + 1]); } }
            __syncthreads();
        }
        int to = TID; FFT_OPQ(to);
        if (to < 256) {
#pragma unroll
            for (int i = 0; i < 16; ++i) { const int seq = u * 16 + i, d = (seq >> 2) * 2, rb = (seq & 3) * SB; ZT[(size_t)d * R + rb + to] = f2bf(z[i][0]); ZT[(size_t)(d + 1) * R + rb + to] = f2bf(z[i][1]); } }
    }
}
#endif

#ifndef FFT_HOST_TEST
template <int M, bool INV, bool HALF_ = false> FFT_HD void fft_pass16x2(const LdsCf bufA, const LdsCf bufB, const LdsCf tw, int tid) {
    FFT_OPQ(tid);
    const int blk = tid / M, n2 = tid % M, base = blk * 16 * M + n2;
    constexpr int ST = M + (M >> 5) + (M >> 9); const int a0 = fidx(base);
    cf va[16], vb[16];
#pragma unroll
    for (int j = 0; j < 16; ++j) { if (HALF_ && !INV && j >= 8) { va[j] = cf{0.f, 0.f}; vb[j] = cf{0.f, 0.f}; } else { va[j] = bufA.get(a0 + j * ST); vb[j] = bufB.get(a0 + j * ST); } }
    cf w[16];
    if (M > 1) { const cf w1 = tw.get(n2 * (FFT_N / (16 * M))); w[1] = w1; w[2] = cmul(w1, w1); w[3] = cmul(w[2], w1); w[4] = cmul(w[2], w[2]); w[5] = cmul(w[4], w1); w[6] = cmul(w[3], w[3]); w[7] = cmul(w[6], w1);
        w[8] = cmul(w[4], w[4]); w[9] = cmul(w[8], w1); w[10] = cmul(w[5], w[5]); w[11] = cmul(w[10], w1); w[12] = cmul(w[6], w[6]); w[13] = cmul(w[12], w1); w[14] = cmul(w[7], w[7]); w[15] = cmul(w[14], w1); }
    if (INV) { if (M > 1) {
#pragma unroll
        for (int k = 1; k < 16; ++k) { va[k] = cmulc(va[k], w[k]); vb[k] = cmulc(vb[k], w[k]); } } }
    dft16<INV, HALF_ && !INV>(va); dft16<INV, HALF_ && !INV>(vb);
    if (!INV) { if (M > 1) {
#pragma unroll
        for (int k = 1; k < 16; ++k) { va[k] = cmul(va[k], w[k]); vb[k] = cmul(vb[k], w[k]); } } }
#pragma unroll
    for (int j = 0; j < 16; ++j) { if (HALF_ && INV && j >= 8) continue; bufA.set(a0 + j * ST, va[j]); bufB.set(a0 + j * ST, vb[j]); }
}
FFT_HD void fft_pass2x2(const LdsCf bufA, const LdsCf bufB, int tid) {
    FFT_OPQ(tid);
    const int a0 = fidx(2 * tid);
#pragma unroll
    for (int i = 0; i < 8; ++i) { const int e = a0 + 1058 * i; const cf a = bufA.get(e), b = bufA.get(e + 1), c = bufB.get(e), d = bufB.get(e + 1);
        bufA.set(e, cadd(a, b)); bufA.set(e + 1, csub(a, b)); bufB.set(e, cadd(c, d)); bufB.set(e + 1, csub(c, d)); }
}
FFT_HD void fft_fwd_x2(const LdsCf a, const LdsCf b, const LdsCf tw, int tid) {
    fft_pass16x2<512, false>(a, b, tw, tid); FFT_SYNC(); fft_pass16x2<32, false>(a, b, tw, tid); FFT_SYNC(); fft_pass16x2<2, false>(a, b, tw, tid); FFT_SYNC(); fft_pass2x2(a, b, tid); FFT_SYNC();
}
FFT_HD void fft_fwd_x2_zp(const LdsCf a, const LdsCf b, const LdsCf tw, int tid) {
    fft_pass16x2<512, false, true>(a, b, tw, tid); FFT_SYNC(); fft_pass16x2<32, false>(a, b, tw, tid); FFT_SYNC(); fft_pass16x2<2, false>(a, b, tw, tid); FFT_SYNC(); fft_pass2x2(a, b, tid); FFT_SYNC();
}
FFT_HD void fft_inv_x2_zp(const LdsCf a, const LdsCf b, const LdsCf tw, int tid) {
    fft_pass2x2(a, b, tid); FFT_SYNC(); fft_pass16x2<2, true>(a, b, tw, tid); FFT_SYNC(); fft_pass16x2<32, true>(a, b, tw, tid); FFT_SYNC(); fft_pass16x2<512, true, true>(a, b, tw, tid); FFT_SYNC();
}
FFT_HD void fft_inv_x2(const LdsCf a, const LdsCf b, const LdsCf tw, int tid) {
    fft_pass2x2(a, b, tid); FFT_SYNC(); fft_pass16x2<2, true>(a, b, tw, tid); FFT_SYNC(); fft_pass16x2<32, true>(a, b, tw, tid); FFT_SYNC(); fft_pass16x2<512, true>(a, b, tw, tid); FFT_SYNC();
}
PH void ph_hyena_fft2(KP p, unsigned char* ldsraw, int wg, int nwg, bool skipfft = false) {
    const int TID = otid();
    const LdsCf bufA{(LAS f32x2v*)ldsraw}, bufB{(LAS f32x2v*)ldsraw + FFT_BUF}, tw{(LAS f32x2v*)ldsraw + 2 * FFT_BUF};
    const cf* twg = (const cf*)(p->ws + WS_TW);
    tw.set(TID, twg[TID]);
    __syncthreads();
    const _Float16* UT = (const _Float16*)(p->ws + WS_UT); u16* ZT = (u16*)(p->ws + WS_ZT); const cf* FS = (const cf*)(p->ws + WS_FS);
    const float* cw = p->in[I_HCW]; const float* cb = p->in[I_HCB]; const float* skip = p->in[I_SKIP];
    const int per = (2048 + nwg - 1) / nwg; const int u1 = (wg + 1) * per < 2048 ? (wg + 1) * per : 2048;
    for (int u = wg * per; u < u1; ++u) {
        const int d = (u >> 1) * 2, b0 = (u & 1) * 2;
        auto sconv4 = [&](int ch, int rb, int t0, float (&o)[4]) { const _Float16* uu = UT + (size_t)ch * R + rb + t0; const uint2 cq = *(const uint2*)uu;
            const float4 c4 = make_float4(pg8::h2f_lo(cq.x), pg8::h2f_hi(cq.x), pg8::h2f_lo(cq.y), pg8::h2f_hi(cq.y));
            const float um = t0 > 0 ? (float)uu[-1] : 0.f, up = t0 + 4 < S ? (float)uu[4] : 0.f, w0 = cw[ch], w1 = cw[3 * D + ch], w2 = cw[6 * D + ch], bb = cb[ch];
            o[0] = um * w0 + c4.x * w1 + c4.y * w2 + bb; o[1] = c4.x * w0 + c4.y * w1 + c4.z * w2 + bb; o[2] = c4.y * w0 + c4.z * w1 + c4.w * w2 + bb; o[3] = c4.z * w0 + c4.w * w1 + up * w2 + bb; };
        const int rbA = b0 * SB + CTX, rbB = rbA + SB;
        float za[2][4][2], zb[2][4][2];
        { int tz = TID; FFT_OPQ(tz);
#pragma unroll
          for (int i = 0; i < 2; ++i) { const int t0 = 4 * tz + 2048 * i; float q0[4], q1[4], q2[4], q3[4]; sconv4(d, rbA, t0, q0); sconv4(d + 1, rbA, t0, q1); sconv4(d, rbB, t0, q2); sconv4(d + 1, rbB, t0, q3);
#pragma unroll
              for (int k = 0; k < 4; ++k) { za[i][k][0] = q0[k]; za[i][k][1] = q1[k]; zb[i][k][0] = q2[k]; zb[i][k][1] = q3[k]; } } }
#pragma unroll 1
        for (int n = 0; n < 2; ++n) {
            int ts = TID; FFT_OPQ(ts);
#pragma unroll
            for (int i = 0; i < 2; ++i)
#pragma unroll
                for (int k = 0; k < 4; ++k) { const int e = fidx(4 * ts) + 2116 * i + k; bufA.set(e, cf{za[i][k][0], za[i][k][1]}); bufB.set(e, cf{zb[i][k][0], zb[i][k][1]}); }
            __syncthreads();
            if (!skipfft) fft_fwd_x2_zp(bufA, bufB, tw, TID);
            const cf* fd = FS + (size_t)(n * 2048 + d) * FS_LD; const cf* fe = fd + FS_LD;
            int tq = TID; FFT_OPQ(tq);
            const int pw0 = fidx(fpos(tq)), pn1 = fidx(fpos((FFT_N - tq - 512) & (FFT_N - 1)));
#pragma unroll
            for (int i = 0; i < 8; ++i) { const int w = tq + 512 * i; const bool self = i == 0 && tq == 0; const int pw = pw0 + 4 * i, pn = self ? pw : pn1 - 4 * (i - 1); const cf fdw = fd[w], few = fe[w];
                { const cf a = bufA.get(pw), bb = bufA.get(pn); cf ya, yb; spec_pair(a, bb, fdw, few, ya, yb); bufA.set(pw, ya); if (!self) bufA.set(pn, yb); }
                { const cf a = bufB.get(pw), bb = bufB.get(pn); cf ya, yb; spec_pair(a, bb, fdw, few, ya, yb); bufB.set(pw, ya); if (!self) bufB.set(pn, yb); } }
            if (TID == 0) { const int pw = fidx(fpos(4096)); const cf fdw = fd[4096], few = fe[4096]; cf ya, yb;
                { const cf a = bufA.get(pw); spec_pair(a, a, fdw, few, ya, yb); bufA.set(pw, ya); } { const cf a = bufB.get(pw); spec_pair(a, a, fdw, few, ya, yb); bufB.set(pw, ya); } }
            __syncthreads();
            if (!skipfft) fft_inv_x2_zp(bufA, bufB, tw, TID);
            const float sk0 = skip[n * D + d], sk1 = skip[n * D + d + 1];
            int ty = TID; FFT_OPQ(ty);
#pragma unroll
            for (int i = 0; i < 2; ++i) { const int t0 = 4 * ty + 2048 * i; float g0[4], g1[4], g2[4], g3[4]; sconv4((n + 1) * D + d, rbA, t0, g0); sconv4((n + 1) * D + d + 1, rbA, t0, g1); sconv4((n + 1) * D + d, rbB, t0, g2); sconv4((n + 1) * D + d + 1, rbB, t0, g3);
#pragma unroll
                for (int k = 0; k < 4; ++k) { const int e = fidx(4 * ty) + 2116 * i + k; const cf ya = bufA.get(e), yb = bufB.get(e);
                    za[i][k][0] = g0[k] * (ya.x + za[i][k][0] * sk0); za[i][k][1] = g1[k] * (ya.y + za[i][k][1] * sk1);
                    zb[i][k][0] = g2[k] * (yb.x + zb[i][k][0] * sk0); zb[i][k][1] = g3[k] * (yb.y + zb[i][k][1] * sk1); } }
            __syncthreads();
        }
        int to = TID; FFT_OPQ(to);
#pragma unroll
        for (int i = 0; i < 2; ++i) { const int t0 = 4 * to + 2048 * i;
#pragma unroll
            for (int c = 0; c < 2; ++c) {
                *(uint2*)(ZT + (size_t)(d + c) * R + rbA + t0) = make_uint2(pk2(za[i][0][c], za[i][1][c]), pk2(za[i][2][c], za[i][3][c]));
                *(uint2*)(ZT + (size_t)(d + c) * R + rbB + t0) = make_uint2(pk2(zb[i][0][c], zb[i][1][c]), pk2(zb[i][2][c], zb[i][3][c])); } }
    }
}
#endif

#ifndef UP_ALIGN
#define UP_ALIGN true
#endif
#ifndef UP_SP2
#define UP_SP2 true
#endif
#ifndef DN_ALIGN
#define DN_ALIGN true
#endif
#ifndef DN_SP2
#define DN_SP2 true
#endif
#ifndef DN_AUXA
#define DN_AUXA 0
#endif
constexpr int LDS_BYTES = 155648;
constexpr int LDS_MISC = LDS_BYTES - 256;
constexpr int CW_BAR = 4096;
constexpr size_t CTL_ZERO_BYTES = 65536;

__global__ void __launch_bounds__(512, 2) mega_fwd(Ptrs p_unused) {
#define p kargs()
    extern __shared__ __attribute__((aligned(16))) unsigned char lds[];
    const int tid = threadIdx.x; int wg = blockIdx.x, nwg = gridDim.x;
    volatile LAS unsigned* MISC = (volatile LAS unsigned*)((LAS unsigned char*)lds + LDS_MISC);
    if (tid < 64) MISC[tid] = 0u;
    __syncthreads();
    XcdBarrier bar = xcd_barrier_post((unsigned*)(p->ws + WS_CTL) + CW_BAR, MISC + 8);
#define GRID_BAR() do { xcd_barrier(bar); asm volatile("" : "+s"(ws), "+s"(wg), "+s"(nwg)); } while (0)
    PG8_LAS unsigned char* ring = (PG8_LAS unsigned char*)lds;
    unsigned char* ws = p->ws;
#define X ((u16*)(ws + WS_X))
#define HB ((u16*)(ws + WS_HB))
#define ACT ((u16*)(ws + WS_ACT))
#define MOD ((const float*)(ws + WS_MOD))
#define rope ((const float*)(ws + WS_ROPE))

#ifndef NO_PRO
    ph_modp(p, (float*)lds, wg, nwg);
#ifdef PROBE_MODP
    ph_modp(p, (float*)lds, wg, nwg);
#endif
    ph_tables(p, wg, nwg);
    ph_filters(p, (float*)lds, wg, nwg);
#ifdef PROBE_FILT
    ph_filters(p, (float*)lds, wg, nwg);
#endif
    { int t2 = threadIdx.x; asm volatile("" : "+v"(t2)); conv_all(p, (ConvDesc*)(lds + 8 * 64 * 33 * 4), (float*)lds + (t2 >> 6) * (64 * 33), wg * 8 + (t2 >> 6), nwg * 8, t2 & 63, 0, 3, 24, PRO_B1); }
#ifdef PROBE_CONV
    { int t2 = threadIdx.x; asm volatile("" : "+v"(t2)); conv_all(p, (ConvDesc*)(lds + 8 * 64 * 33 * 4), (float*)lds + (t2 >> 6) * (64 * 33), wg * 8 + (t2 >> 6), nwg * 8, t2 & 63, 0, 3, 24, PRO_B1); }
#endif
#endif
#ifdef PROBE_PRO
    GRID_BAR();
    ph_modp(p, (float*)lds, wg, nwg);
    ph_tables(p, wg, nwg);
    ph_filters(p, (float*)lds, wg, nwg);
    { int t2 = threadIdx.x; asm volatile("" : "+v"(t2)); conv_all(p, (ConvDesc*)(lds + 8 * 64 * 33 * 4), (float*)lds + (t2 >> 6) * (64 * 33), wg * 8 + (t2 >> 6), nwg * 8, t2 & 63, 0, 3, 24, PRO_B1); }
#endif
    GRID_BAR();
    ph_modr(p, wg, nwg);
    ph_filter_fft(p, lds, wg, nwg);
#ifdef PROBE_P1
    GRID_BAR();
    ph_modr(p, wg, nwg);
    ph_filter_fft(p, lds, wg, nwg);
    ph_filter_fft256(p, lds, nwg - 1 - wg, nwg);
#endif
#ifdef PROBE_FFFT
    ph_filter_fft(p, lds, wg, nwg);
#endif
    ph_filter_fft256(p, lds, nwg - 1 - wg, nwg);
    GRID_BAR();

    for (int layer = 0; layer < DEPTH; ++layer) {
        const int kind = layer % 3, jm = layer / 3;
#define modl (MOD + (size_t)layer * 5 * 9 * D)
#pragma unroll 1
        for (int f = 0; f < 2; ++f) {
            const int slot = f == 0 ? 0 : 2, lf = layer * 2 + f; const bool lastffn = layer == DEPTH - 1 && f == 1;
            { const float* pg = nullptr; if (f == 1) pg = lastffn ? nullptr : modl + (size_t)(4 * 9 + 3 * 1 + 2) * D; else if (layer > 0) pg = modl - (size_t)5 * 9 * D + (size_t)(4 * 9 + 3 * 2 + 2) * D;
              ph_modulate(p, layer, slot, pg, f == 1 ? 1.0f : 0.5f, wg, nwg, layer == 0 && f == 0, lastffn);
#ifdef PROBE_THIN
              GRID_BAR(); ph_modulate(p, layer, slot, nullptr, 0.f, wg, nwg);
#endif
            }
            GRID_BAR();
            { pg8::Gemm g{HB, (const u16*)(ws + WS_WGU + lf * SZ_WGU), R, 2 * DFF, D}; pg8::UpOrder So; So.init(g.N, nwg, wg, lastffn);
              pg8::gemm_phase<pg8::EpiSwiGLU, pg8::UpOrder, UP_ALIGN, UP_SP2>(ring, g, So, pg8::EpiSwiGLU{ACT}); }
#ifdef PROBE_UP_NOEPI
            GRID_BAR();
            { pg8::Gemm g{HB, (const u16*)(ws + WS_WGU + lf * SZ_WGU), R, 2 * DFF, D}; pg8::UpOrder So; So.init(g.N, nwg, wg, lastffn);
              pg8::gemm_phase<pg8::EpiNever<pg8::EpiSwiGLU>, pg8::UpOrder, UP_ALIGN, UP_SP2>(ring, g, So, pg8::EpiNever<pg8::EpiSwiGLU>{pg8::EpiSwiGLU{ACT}, nwg == 12345}); }
#endif
#ifdef PROBE_UP
            GRID_BAR();
            { pg8::Gemm g{HB, (const u16*)(ws + WS_WGU + lf * SZ_WGU), R, 2 * DFF, D}; pg8::UpOrder So; So.init(g.N, nwg, wg, lastffn);
              pg8::gemm_phase<pg8::EpiSwiGLU, pg8::UpOrder, UP_ALIGN, UP_SP2>(ring, g, So, pg8::EpiSwiGLU{ACT}); }
#endif
#ifndef NO_TAILCONV
            if (!lastffn) {
                const int rem = (68 * 43) % nwg;
                if (wg >= rem) {
                    const int a0 = 3 * (lf + 1); int b0 = a0 + 3, b1 = a0 + 3;
#ifdef TAIL_MIXERS
                    if (f == 1) { const int k2 = (layer + 1) % 3; b0 = k2 == 1 ? 34 : k2 == 2 ? 36 : 24 + 5 * ((layer + 1) / 3); b1 = k2 == 0 ? b0 + 5 : b0 + 2; }
#endif
                    __syncthreads();
                    int t2 = threadIdx.x; asm volatile("" : "+v"(t2));
                    conv_tail((const ConvDesc*)(ws + WS_CTL + CTL_CONVTAB), (float*)lds + (t2 >> 6) * (64 * 33), (wg - rem) * 8 + (t2 >> 6), (nwg - rem) * 8, t2 & 63, a0, a0 + 3, b0, b1);
#ifdef PROBE_TAIL
                    conv_tail((const ConvDesc*)(ws + WS_CTL + CTL_CONVTAB), (float*)lds + (t2 >> 6) * (64 * 33), (wg - rem) * 8 + (t2 >> 6), (nwg - rem) * 8, t2 & 63, a0, a0 + 3, b0, b1);
#endif
                }
            }
#endif
            GRID_BAR();
            { pg8::Gemm g{ACT, (const u16*)(ws + WS_WD + lf * SZ_WD), R, D, DFF}; pg8::ResOrder So; So.init(DFF, nwg, wg, lastffn);
              pg8::gemm_phase<pg8::EpiResGate, pg8::ResOrder, DN_ALIGN, DN_SP2, DN_AUXA>(ring, g, So, pg8::EpiResGate{X, modl, slot, 0.5f, (u16*)(ws + WS_SLAB)}); }
            GRID_BAR();
#ifdef PROBE_DOWN
            { pg8::Gemm g{ACT, (const u16*)(ws + WS_WD + lf * SZ_WD), R, D, DFF}; pg8::ResOrder So; So.init(DFF, nwg, wg, lastffn);
              pg8::gemm_phase<pg8::EpiResGate, pg8::ResOrder, true, true>(ring, g, So, pg8::EpiResGate{X, modl, slot, 0.0f, (u16*)(ws + WS_SLAB)}); }
            GRID_BAR();
#endif
#ifdef PROBE_DOWN_NOEPI
            { pg8::Gemm g{ACT, (const u16*)(ws + WS_WD + lf * SZ_WD), R, D, DFF}; pg8::ResOrder So; So.init(DFF, nwg, wg, lastffn);
              pg8::gemm_phase<pg8::EpiNever<pg8::EpiResGate>, pg8::ResOrder, true, true>(ring, g, So, pg8::EpiNever<pg8::EpiResGate>{pg8::EpiResGate{X, modl, slot, 0.0f, (u16*)(ws + WS_SLAB)}, nwg == 12345}); }
            GRID_BAR();
#endif
            if (f == 0) {
                ph_modulate(p, layer, 1, modl + (size_t)(4 * 9 + 3 * 0 + 2) * D, 0.5f, wg, nwg);
#ifdef PROBE_THIN
                GRID_BAR(); ph_modulate(p, layer, 1, nullptr, 0.f, wg, nwg);
#endif
                GRID_BAR();
                const u16* Ao; const u16* Wo;
                if (kind == 0) {
                    u16* QKVA = (u16*)(ws + WS_QKVA);     u16* QL = (u16*)(ws + WS_QL); u16* CKV = (u16*)(ws + WS_CKV); u16* KR = (u16*)(ws + WS_KR); u16* Q = (u16*)(ws + WS_Q); u16* KN = (u16*)(ws + WS_KN); u16* V = (u16*)(ws + WS_V); u16* O = (u16*)(ws + WS_O);
                    { pg8::Gemm g{HB, (const u16*)(ws + WS_WDQKV) + (size_t)jm * QKVA_LD * D, R, QKVA_LD, D}; pg8::StaticOrder So; So.init(g.M, g.N, nwg, wg);
                      pg8::gemm_phase<pg8::EpiF16, pg8::StaticOrder, true, true>(ring, g, So, pg8::EpiF16{QKVA, QKVA_LD}); }
                    GRID_BAR();
                    ph_mla_norm(p, jm, wg, nwg);
                    GRID_BAR();
                    { pg8::Gemm g{QL, (const u16*)(ws + WS_WUQ) + (size_t)jm * 3072 * 512, R, 3072, 512}; pg8::UpOrder So; So.init(g.N, nwg, wg, layer == DEPTH - 1);
                      pg8::gemm_phase<pg8::EpiRope<0>, pg8::UpOrder, true, true>(ring, g, So, pg8::EpiRope<0>{Q, 3072, rope}); }
                    { pg8::Gemm g{CKV, (const u16*)(ws + WS_WUKV) + (size_t)jm * 4096 * 512, R, 4096, 512}; pg8::StaticOrder So; So.init(g.M, g.N, nwg, nwg - 1 - wg);
                      pg8::gemm_phase<pg8::EpiKV, pg8::StaticOrder, true, true>(ring, g, So, pg8::EpiKV{KN, V}); }
                    GRID_BAR();
#ifdef PROBE_MLAPRE
                    { pg8::Gemm g{HB, (const u16*)(ws + WS_WDQKV) + (size_t)jm * QKVA_LD * D, R, QKVA_LD, D}; pg8::StaticOrder So; So.init(g.M, g.N, nwg, wg);
                      pg8::gemm_phase<pg8::EpiF16, pg8::StaticOrder, true, true>(ring, g, So, pg8::EpiF16{QKVA, QKVA_LD}); }
                    GRID_BAR();
                    ph_mla_norm(p, jm, wg, nwg);
                    GRID_BAR();
                    { pg8::Gemm g{QL, (const u16*)(ws + WS_WUQ) + (size_t)jm * 3072 * 512, R, 3072, 512}; pg8::UpOrder So; So.init(g.N, nwg, wg, layer == DEPTH - 1);
                      pg8::gemm_phase<pg8::EpiRope<0>, pg8::UpOrder, true, true>(ring, g, So, pg8::EpiRope<0>{Q, 3072, rope}); }
                    { pg8::Gemm g{CKV, (const u16*)(ws + WS_WUKV) + (size_t)jm * 4096 * 512, R, 4096, 512}; pg8::StaticOrder So; So.init(g.M, g.N, nwg, nwg - 1 - wg);
                      pg8::gemm_phase<pg8::EpiKV, pg8::StaticOrder, true, true>(ring, g, So, pg8::EpiKV{KN, V}); }
                    GRID_BAR();
#endif
#ifndef NO_NAIVE
#ifdef PROBE_ATTN
#pragma unroll 1
                    for (int rep = 0; rep < 2; ++rep)
#endif
#ifdef PROBE_ATTN_ABL
                    ph_attn_mla<PROBE_ATTN_ABL>(Q, KN, KR, V, O, lds, wg, nwg, layer < DEPTH - 1);
#endif
                    ph_attn_mla(Q, KN, KR, V, O, lds, wg, nwg, layer < DEPTH - 1);
#endif
                    Ao = O; Wo = (const u16*)(ws + WS_WMO) + (size_t)jm * D * D;
                } else if (kind == 1) {
                    u16* UT = (u16*)(ws + WS_UT); u16* ZT = (u16*)(ws + WS_ZT);
                    { pg8::Gemm g{(const u16*)(ws + WS_WHIN), HB, 3 * D, R, D}; pg8::StaticOrder So; So.init(g.M, g.N, nwg, wg);
                      pg8::gemm_phase<pg8::EpiF16, pg8::StaticOrder, true, true>(ring, g, So, pg8::EpiF16{UT, R}); }
#ifdef PROBE_HIN
                    GRID_BAR();
                    { pg8::Gemm g{(const u16*)(ws + WS_WHIN), HB, 3 * D, R, D}; pg8::StaticOrder So; So.init(g.M, g.N, nwg, wg);
                      pg8::gemm_phase<pg8::EpiF16, pg8::StaticOrder, true, true>(ring, g, So, pg8::EpiF16{UT, R}); }
#endif
                    GRID_BAR();
#ifndef NO_NAIVE
#ifdef PROBE_HYF
#pragma unroll 1
                    for (int rep = 0; rep < 2; ++rep)
#endif
#ifdef PROBE_HYF_NOFFT
#pragma unroll 1
                    for (int rep = 0; rep < 2; ++rep)
                    ph_hyena_fft2(p, lds, wg, nwg, rep == 0);
#else
                    ph_hyena_fft2(p, lds, wg, nwg);
#endif
                    ph_hyena_fft256(p, lds, wg, nwg);
#ifdef PROBE_HYC
                    ph_hyena_fft256(p, lds, wg, nwg);
#endif
#endif
                    GRID_BAR();
                    ph_transpose(ZT, HB, (u16*)lds, wg, nwg);
                    Ao = HB; Wo = (const u16*)(ws + WS_WHOUT);
                } else {
                    u16* QKV = (u16*)(ws + WS_QKV); u16* O = (u16*)(ws + WS_WO);
                    { pg8::Gemm g{HB, (const u16*)(ws + WS_WWQKV), R, 2560, D}; pg8::StaticOrder So; So.init(g.M, g.N, nwg, wg);
                      pg8::gemm_phase<pg8::EpiRope<1>, pg8::StaticOrder, true, true>(ring, g, So, pg8::EpiRope<1>{QKV, 2560, rope}); }
                    GRID_BAR();
#ifndef NO_NAIVE
#ifdef PROBE_WIN
#pragma unroll 1
                    for (int rep = 0; rep < 2; ++rep)
#endif
                    ph_attn_win(QKV, p->in[I_SINK], O, lds, wg, nwg);
#endif
                    Ao = O; Wo = (const u16*)(ws + WS_WWO);
                }
                GRID_BAR();
                { pg8::Gemm g{Ao, Wo, R, D, D}; pg8::ResOrder So; So.init(D, nwg, wg, layer == DEPTH - 1);
                  pg8::gemm_phase<pg8::EpiResGate, pg8::ResOrder, true, true>(ring, g, So, pg8::EpiResGate{X, modl, 1, 1.0f, (u16*)(ws + WS_SLAB)}); }
                GRID_BAR();
#ifdef PROBE_WO
                { pg8::Gemm g{Ao, Wo, R, D, D}; pg8::ResOrder So; So.init(D, nwg, wg, layer == DEPTH - 1);
                  pg8::gemm_phase<pg8::EpiResGate, pg8::ResOrder, true, true>(ring, g, So, pg8::EpiResGate{X, modl, 1, 0.0f, (u16*)(ws + WS_SLAB)}); }
                GRID_BAR();
#endif
            }
        }
    }
    ph_final(p, wg, nwg);
#undef p
#undef X
#undef HB
#undef ACT
#undef MOD
#undef rope
#undef modl
}
}

extern "C" void kernel_launch(void* const* d_in, const int* in_sizes, int n_in, void* d_out, int out_size, void* d_ws, size_t ws_size, hipStream_t stream) {
    static int grid = 0;
    if (grid == 0) {
        if (n_in != 35 || ws_size < WS_TOTAL || out_size != NB * S * D) { fprintf(stderr, "kernel_launch: unexpected shapes (n_in %d, ws %zu need %zu, out %d)\n", n_in, ws_size, (size_t)WS_TOTAL, out_size); grid = -1; return; }
        int dev = 0, cus = 0, per_cu = 0;
        if (hipGetDevice(&dev) != hipSuccess || hipDeviceGetAttribute(&cus, hipDeviceAttributeMultiprocessorCount, dev) != hipSuccess || cus <= 0) { fprintf(stderr, "kernel_launch: device query failed\n"); grid = -1; return; }
        if (hipFuncSetAttribute((const void*)mega_fwd, hipFuncAttributeMaxDynamicSharedMemorySize, LDS_BYTES) != hipSuccess) { fprintf(stderr, "kernel_launch: hipFuncSetAttribute failed\n"); grid = -1; return; }
        if (hipOccupancyMaxActiveBlocksPerMultiprocessor(&per_cu, (const void*)mega_fwd, 512, LDS_BYTES) != hipSuccess || per_cu < 1) fprintf(stderr, "kernel_launch: note: occupancy query reports %d workgroups per CU\n", per_cu);
        (void)hipGetLastError();
        grid = cus;
    }
    if (grid < 0) return;
    if (hipMemsetAsync((char*)d_ws + WS_CTL, 0, CTL_ZERO_BYTES, stream) != hipSuccess) { fprintf(stderr, "kernel_launch: memset failed\n"); return; }
    Ptrs p{}; for (int i = 0; i < 35; ++i) p.in[i] = (const float*)d_in[i]; p.out = (float*)d_out; p.ws = (unsigned char*)d_ws;
    hipLaunchKernelGGL(mega_fwd, dim3(grid), dim3(512), LDS_BYTES, stream, p);
    const hipError_t le = hipPeekAtLastError();
    if (le != hipSuccess) fprintf(stderr, "kernel_launch: launch failed: %s\n", hipGetErrorName(le));
}
```

```cpp
#define TAIL_MIXERS 1
#define RES_4X8 1
#define RES_NOSTAGGER 1
#define MLA_NOSWAP 1
#define QROPE_REG 1
#define CONV_NT 1
#include <hip/hip_runtime.h>
#include <cstdio>
#include <cstdint>
#include <cmath>

namespace {
typedef unsigned short u16;
constexpr int D = 2048, NB = 4, S = 4096, CTX = 256, SB = S + CTX, R = NB * SB, DFF = 5504, NMODV = 9 * D, DEPTH = 4;
constexpr int QKVA_LD = 1280;
constexpr float NORM_EPS = 1e-6f;

constexpr size_t al(size_t x) { return (x + 255) / 256 * 256; }
constexpr size_t WS_CTL = 0;
constexpr size_t WS_X = 1u << 20;
constexpr size_t WS_HB = WS_X + al((size_t)R * D * 4);
constexpr size_t WS_ACT = WS_HB + al((size_t)R * D * 2);
constexpr size_t WS_MODP = WS_ACT + al((size_t)R * DFF * 2);
constexpr size_t WS_MOD = WS_MODP + al((size_t)16 * DEPTH * 5 * NMODV * 4);
constexpr size_t WS_ROPE = WS_MOD + al((size_t)DEPTH * 5 * NMODV * 4);
constexpr size_t WS_TW = WS_ROPE + al(64 * 16 * 2 * 4);
constexpr size_t WS_FS = WS_TW + al(8192 * 8);
constexpr size_t WS_FT256 = WS_FS + al((size_t)2 * 2048 * 4104 * 8);
constexpr size_t WS_MIX = WS_FT256 + al((size_t)8192 * 256 * 4);
constexpr size_t WS_FT4096 = WS_MIX;
constexpr size_t WS_QKVA = WS_MIX;
constexpr size_t WS_QL = WS_QKVA + al((size_t)R * QKVA_LD * 4);
constexpr size_t WS_CKV = WS_QL + al((size_t)R * 512 * 2);
constexpr size_t WS_KR = WS_CKV + al((size_t)R * 512 * 2);
constexpr size_t WS_Q = WS_KR + al((size_t)R * 64 * 2);
constexpr size_t WS_KN = WS_Q + al((size_t)R * 3072 * 2);
constexpr size_t WS_V = WS_KN + al((size_t)R * D * 2);
constexpr size_t WS_O = WS_V + al((size_t)R * D * 2);
constexpr size_t WS_MLA_END = WS_O + al((size_t)R * D * 2);
constexpr size_t WS_UT = WS_MIX;
constexpr size_t WS_ZT = WS_UT + al((size_t)3 * D * R * 4);
constexpr size_t WS_HY_END = WS_ZT + al((size_t)D * R * 2);
constexpr size_t WS_QKV = WS_MIX;
constexpr size_t WS_WO = WS_QKV + al((size_t)R * 2560 * 2);
constexpr size_t WS_WIN_END = WS_WO + al((size_t)R * D * 2);
constexpr size_t WS_END = (WS_MLA_END > WS_HY_END ? (WS_MLA_END > WS_WIN_END ? WS_MLA_END : WS_WIN_END) : (WS_HY_END > WS_WIN_END ? WS_HY_END : WS_WIN_END));
constexpr size_t SZ_WGU = (size_t)2 * DFF * D * 2, SZ_WD = (size_t)D * DFF * 2;
constexpr size_t WS_WGU = al(WS_END);
constexpr size_t WS_WD = WS_WGU + 8 * SZ_WGU;
constexpr size_t WS_WDQKV = WS_WD + 8 * SZ_WD;
constexpr size_t WS_WUQ = WS_WDQKV + 2 * (size_t)QKVA_LD * D * 2;
constexpr size_t WS_WUKV = WS_WUQ + 2 * (size_t)3072 * 512 * 2;
constexpr size_t WS_WMO = WS_WUKV + 2 * (size_t)4096 * 512 * 2;
constexpr size_t WS_WHIN = WS_WMO + 2 * (size_t)D * D * 2;
constexpr size_t WS_WHOUT = WS_WHIN + (size_t)3 * D * D * 2;
constexpr size_t WS_WWQKV = WS_WHOUT + (size_t)D * D * 2;
constexpr size_t WS_WWO = WS_WWQKV + (size_t)2560 * D * 2;
constexpr size_t WS_SLAB = WS_WWO + (size_t)D * D * 2;
constexpr size_t WS_FS256 = WS_SLAB + (size_t)8 * 4 * 256 * D * 4;
constexpr size_t WS_TOTAL = WS_FS256 + (size_t)2 * 2048 * 264 * 8;
static_assert(WS_TOTAL < 2000000000ull, "workspace map exceeds the guaranteed size");

__device__ __forceinline__ float bf2f(u16 b) { return __uint_as_float(((unsigned)b) << 16); }
__device__ __forceinline__ unsigned pk2(float lo, float hi) { unsigned r; asm("v_cvt_pk_bf16_f32 %0, %1, %2" : "=v"(r) : "v"(lo), "v"(hi)); return r; }
__device__ __forceinline__ u16 f2bf(float f) { return (u16)(pk2(f, f) & 0xffffu); }
template <int X> __device__ __forceinline__ float swz_xor(float v) { return __int_as_float(__builtin_amdgcn_ds_swizzle(__float_as_int(v), 0x1f | (X << 10))); }
__device__ __forceinline__ float wave_sum(float v) {
    v += swz_xor<1>(v); v += swz_xor<2>(v); v += swz_xor<4>(v); v += swz_xor<8>(v); v += swz_xor<16>(v);
    auto rr = __builtin_amdgcn_permlane32_swap(__float_as_uint(v), __float_as_uint(v), false, false); return __uint_as_float(rr[0]) + __uint_as_float(rr[1]);
}
__device__ __forceinline__ float wave_max(float v) {
    v = fmaxf(v, swz_xor<1>(v)); v = fmaxf(v, swz_xor<2>(v)); v = fmaxf(v, swz_xor<4>(v)); v = fmaxf(v, swz_xor<8>(v)); v = fmaxf(v, swz_xor<16>(v));
    auto rr = __builtin_amdgcn_permlane32_swap(__float_as_uint(v), __float_as_uint(v), false, false); return fmaxf(__uint_as_float(rr[0]), __uint_as_float(rr[1]));
}
__device__ __forceinline__ int modidx_of_row(int r) { const int b = r / SB, j = r - b * SB; return j < CTX ? 4 : b; }
__device__ __forceinline__ float silu_f(float x) { return x / (1.f + expf(-x)); }

struct Ptrs {
    const float* in[35];
    float* out;
    unsigned char* ws;
};
typedef const __attribute__((address_space(4))) Ptrs* KP;
__device__ __forceinline__ KP kargs() { KP q = (KP)__builtin_amdgcn_kernarg_segment_ptr(); asm volatile("" : "+s"(q)); return q; }
enum { I_X = 0, I_C, I_CTX, I_CCTX, I_MODW, I_MODB, I_NORMG, I_FINALG, I_WG, I_WU, I_WD, I_DQ, I_GQ, I_UQ, I_DKV, I_GKV, I_UKV, I_MWO,
       I_HWIN, I_HCW, I_HCB, I_FW1, I_FB1, I_FW2, I_FB2, I_FW3, I_FB3, I_FFREQ, I_FW4, I_DECAY, I_SKIP, I_HWOUT, I_WQKV, I_SINK, I_WWO };


}

namespace pg8 {
#define PG8_LAS __attribute__((address_space(3)))
typedef unsigned short bf16_t;
typedef short bf16x8 __attribute__((ext_vector_type(8)));
typedef float f32x4 __attribute__((ext_vector_type(4)));
typedef unsigned u32x4 __attribute__((ext_vector_type(4)));
constexpr int BM = 256, BK = 64, HALF = 128, HTB = HALF * BK * 2  , STAGE_BYTES = 8 * HTB, NXCD = 8, WGM = 8;

__host__ __device__ __forceinline__ int lds_byte(int r, int c) { const int st = (r >> 4) * 2 + (c >> 5), rr = r & 15, cc = c & 31, ob = rr * 64 + cc * 2; return st * 1024 + (ob ^ (((ob >> 9) & 1) << 5)); }
__host__ __device__ __forceinline__ void stage_rc(int b, int& R, int& C) { const int st = b / 1024, sb = b % 1024, swz = sb ^ (((sb >> 9) & 1) << 5); R = (st >> 1) * 16 + swz / 64; C = (st & 1) * 32 + (swz % 64) / 2; }
__host__ __device__ __forceinline__ int perm32(int rho) { const int n = rho >> 4, i = rho & 15; return 8 * (i >> 2) + 4 * n + (i & 3); }

struct Unit { int pm, pn; int kt0 = 0, nt = 0, sp = -1; };
struct Gemm { const bf16_t* A; const bf16_t* Bt; int M, N, K; };

struct StaticOrder {
    int nM, nN, nwg, G, c;
    __host__ __device__ __forceinline__ void init(int M, int N, int G_, int c_) { nM = M / BM; nN = N / BM; nwg = nM * nN; G = G_; c = c_; }
    __host__ __device__ __forceinline__ bool next(int i, Unit& u) const {
        const long L = (long)i * G + c; if (L >= nwg) return false;
        int wgid = (int)L; { const int q = nwg / NXCD, r = nwg % NXCD, xcd = wgid % NXCD, off = wgid / NXCD; wgid = (xcd < r ? xcd * (q + 1) : r * (q + 1) + (xcd - r) * q) + off; }
        const int nig = WGM * nN, gid = wgid / nig, fm = gid * WGM, gsz = (nM - fm) < WGM ? (nM - fm) : WGM;
        u.pm = fm + ((wgid % nig) % gsz); u.pn = (wgid % nig) / gsz; return true;
    }
    __device__ __forceinline__ void a_ready(const Unit&) const {}
    __device__ __forceinline__ void done(const Unit&) const {}
};


__device__ __forceinline__ unsigned cvt_pk_bf16(float lo, float hi) { unsigned r; asm("v_cvt_pk_bf16_f32 %0, %1, %2" : "=v"(r) : "v"(lo), "v"(hi)); return r; }
typedef float f32x2 __attribute__((ext_vector_type(2)));

struct EpiF32 {
    static constexpr bool PERM = false, AFTER_DRAIN = false;
    float* C; int ldc;
    __device__ __forceinline__ void operator()(const f32x4 (&acc)[2][2][4][2], const Unit& u, int wr, int wc, int fr, int fq) const {
        const int row0 = u.pm * BM + wr * 64 + fr, col0 = u.pn * BM + wc * 32 + 4 * fq;
#pragma unroll
        for (int ai = 0; ai < 2; ++ai)
#pragma unroll
            for (int m = 0; m < 4; ++m) { float* rowp = C + (size_t)(row0 + ai * HALF + m * 16) * ldc + col0;
#pragma unroll
                for (int bj = 0; bj < 2; ++bj)
#pragma unroll
                    for (int n = 0; n < 2; ++n) *(f32x4*)(rowp + bj * HALF + n * 16) = acc[ai][bj][m][n]; }
    }
};
struct EpiBf16 {
    static constexpr bool PERM = true, AFTER_DRAIN = false;
    bf16_t* C; int ldc;
    __device__ __forceinline__ void operator()(const f32x4 (&acc)[2][2][4][2], const Unit& u, int wr, int wc, int fr, int fq) const {
        const int row0 = u.pm * BM + wr * 64 + fr, col0 = u.pn * BM + wc * 32 + 8 * fq;
#pragma unroll
        for (int ai = 0; ai < 2; ++ai)
#pragma unroll
            for (int m = 0; m < 4; ++m)
#pragma unroll
                for (int bj = 0; bj < 2; ++bj) { const f32x4 v0 = acc[ai][bj][m][0], v1 = acc[ai][bj][m][1];
                    u32x4 w; w.x = cvt_pk_bf16(v0[0], v0[1]); w.y = cvt_pk_bf16(v0[2], v0[3]); w.z = cvt_pk_bf16(v1[0], v1[1]); w.w = cvt_pk_bf16(v1[2], v1[3]);
                    *(u32x4*)(C + (size_t)(row0 + ai * HALF + m * 16) * ldc + col0 + bj * HALF) = w; }
    }
};
__device__ __forceinline__ unsigned swiglu_pk(float g0, float g1, float u0, float u1) {
    const f32x2 g = {g0, g1}, u = {u0, u1};
    const f32x2 t = g * -1.4426950408889634f;
    f32x2 e; e.x = __builtin_amdgcn_exp2f(t.x); e.y = __builtin_amdgcn_exp2f(t.y);
    const f32x2 d = e + 1.0f;
    f32x2 r; r.x = __builtin_amdgcn_rcpf(d.x); r.y = __builtin_amdgcn_rcpf(d.y);
    const f32x2 o = (g * u) * r;
    unsigned w; asm("v_cvt_pk_bf16_f32 %0, %1, %2" : "=v"(w) : "v"(o.x), "v"(o.y)); return w;
}
struct EpiSwiGLU {
    static constexpr bool PERM = true, AFTER_DRAIN = false;
    bf16_t* act;
    __device__ __forceinline__ void operator()(const f32x4 (&acc)[2][2][4][2], const Unit& u, int wr, int wc, int fr, int fq) const {
        const int row0 = u.pm * BM + wr * 64 + fr, col0 = u.pn * HALF + wc * 32 + 8 * fq;
#pragma unroll
        for (int ai = 0; ai < 2; ++ai)
#pragma unroll
            for (int m = 0; m < 4; ++m) { const f32x4 g0 = acc[ai][0][m][0], g1 = acc[ai][0][m][1], u0 = acc[ai][1][m][0], u1 = acc[ai][1][m][1];
                u32x4 w; w.x = swiglu_pk(g0[0], g0[1], u0[0], u0[1]); w.y = swiglu_pk(g0[2], g0[3], u0[2], u0[3]); w.z = swiglu_pk(g1[0], g1[1], u1[0], u1[1]); w.w = swiglu_pk(g1[2], g1[3], u1[2], u1[3]);
                *(u32x4*)(act + (size_t)(row0 + ai * HALF + m * 16) * DFF + col0) = w; }
    }
};
typedef _Float16 f16x2 __attribute__((ext_vector_type(2)));
__device__ __forceinline__ float h16_lim() { float l; asm volatile("s_mov_b32 %0, 0x477fe000" : "=s"(l)); return l; }
__device__ __forceinline__ unsigned pkh2(float lo, float hi, float lim) { f16x2 h; h[0] = (_Float16)__builtin_amdgcn_fmed3f(lo, -lim, lim); h[1] = (_Float16)__builtin_amdgcn_fmed3f(hi, -lim, lim); return __builtin_bit_cast(unsigned, h); }
__device__ __forceinline__ float h2f_lo(unsigned w) { const f16x2 h = __builtin_bit_cast(f16x2, w); return (float)h[0]; }
__device__ __forceinline__ float h2f_hi(unsigned w) { const f16x2 h = __builtin_bit_cast(f16x2, w); return (float)h[1]; }
struct EpiResGate {
    static constexpr bool PERM = true, AFTER_DRAIN = false;
    bf16_t* X; const float* modl; int slot; float coef; bf16_t* slab;
    __device__ __forceinline__ void operator()(const f32x4 (&acc)[2][2][4][2], const Unit& u, int wr, int wc, int fr, int fq) const {
        const int col0 = u.pn * BM + wc * 32 + 8 * fq;
        const int q = u.pm % 17, midx = q == 0 ? 4 : u.pm / 17;
        if (u.sp >= 0) {
            bf16_t* sp = slab + ((size_t)(u.sp * 4 + u.pm / 17) * 256 + wr * 64 + fr) * D + col0;
#pragma unroll
            for (int ai = 0; ai < 2; ++ai)
#pragma unroll
                for (int m = 0; m < 4; ++m) { bf16_t* rowp = sp + (size_t)(ai * HALF + m * 16) * D;
#pragma unroll
                    for (int bj = 0; bj < 2; ++bj) { const f32x4 v0 = acc[ai][bj][m][0], v1 = acc[ai][bj][m][1];
                        u32x4 w; w.x = cvt_pk_bf16(v0[0], v0[1]); w.y = cvt_pk_bf16(v0[2], v0[3]); w.z = cvt_pk_bf16(v1[0], v1[1]); w.w = cvt_pk_bf16(v1[2], v1[3]);
                        *(u32x4*)(rowp + bj * HALF) = w; } }
            return;
        }
        const int row0 = u.pm * BM + wr * 64 + fr; const float lim = h16_lim();
        const float* gp = modl + ((size_t)midx * 9 + 3 * slot + 2) * D + col0;
        f32x4 gv[2][2];
#pragma unroll
        for (int bj = 0; bj < 2; ++bj)
#pragma unroll
            for (int n = 0; n < 2; ++n) gv[bj][n] = *(const f32x4*)(gp + bj * HALF + 4 * n) * coef;
#pragma unroll
        for (int ai = 0; ai < 2; ++ai)
#pragma unroll
            for (int m = 0; m < 4; ++m) { bf16_t* rowp = X + (size_t)(row0 + ai * HALF + m * 16) * D + col0;
#pragma unroll
                for (int bj = 0; bj < 2; ++bj) { u32x4* px = (u32x4*)(rowp + bj * HALF); const u32x4 xo = *px;
                    const f32x4 a0 = (f32x4){h2f_lo(xo.x), h2f_hi(xo.x), h2f_lo(xo.y), h2f_hi(xo.y)} + gv[bj][0] * acc[ai][bj][m][0];
                    const f32x4 a1 = (f32x4){h2f_lo(xo.z), h2f_hi(xo.z), h2f_lo(xo.w), h2f_hi(xo.w)} + gv[bj][1] * acc[ai][bj][m][1];
                    u32x4 w; w.x = pkh2(a0[0], a0[1], lim); w.y = pkh2(a0[2], a0[3], lim); w.z = pkh2(a1[0], a1[1], lim); w.w = pkh2(a1[2], a1[3], lim);
                    *px = w; } }
    }
};
struct EpiF16 {
    static constexpr bool PERM = true, AFTER_DRAIN = false;
    bf16_t* C; int ldc;
    __device__ __forceinline__ void operator()(const f32x4 (&acc)[2][2][4][2], const Unit& u, int wr, int wc, int fr, int fq) const {
        const int row0 = u.pm * BM + wr * 64 + fr, col0 = u.pn * BM + wc * 32 + 8 * fq; const float lim = h16_lim();
#pragma unroll
        for (int ai = 0; ai < 2; ++ai)
#pragma unroll
            for (int m = 0; m < 4; ++m)
#pragma unroll
                for (int bj = 0; bj < 2; ++bj) { const f32x4 v0 = acc[ai][bj][m][0], v1 = acc[ai][bj][m][1];
                    u32x4 w; w.x = pkh2(v0[0], v0[1], lim); w.y = pkh2(v0[2], v0[3], lim); w.z = pkh2(v1[0], v1[1], lim); w.w = pkh2(v1[2], v1[3], lim);
                    *(u32x4*)(C + (size_t)(row0 + ai * HALF + m * 16) * ldc + col0 + bj * HALF) = w; }
    }
};
struct ResOrder {
    StaticOrder so; int G, c, K; bool nosplit;
    __device__ __forceinline__ void init(int K_, int G_, int c_, bool nosplit_ = false) { so.init(64 * BM, 2048, G_, c_); G = G_; c = c_; K = K_; nosplit = nosplit_; }
    __device__ __forceinline__ bool next(int i, Unit& u) const {
        int ii = i;
#ifndef RES_NOSTAGGER
        if (G == 256 && ((c >> 3) & 1) && !nosplit) ii = i == 0 ? 2 : i - 1;
#endif
        const long L = (long)ii * G + c;
        if (i > 2 && G == 256) return false;
        if (L >= 768 || (nosplit && L >= 512)) return false;
        const bool full = L < 512;
        Unit v; v.pm = 0; v.pn = 0; so.next(full ? ii : 0, v);
        const int it = full ? 0 : (int)(L - 512), cu = it >> 3, s = it & 7, np = K / 128, p0 = (np * s) / 8, p1 = (np * (s + 1)) / 8;
#ifdef RES_4X8
        { const int off = (v.pm & 7) + 8 * v.pn; v.pm = (v.pm & ~7) + (off & 3) + 4 * (off >> 5); v.pn = (off >> 2) & 7; }
#endif
        const int pm = full ? (v.pm >> 4) * 17 + 1 + (v.pm & 15) : 17 * (cu >> 3), pn = full ? v.pn : (cu & 7);
        u.pm = pm; u.pn = pn; u.kt0 = full ? 0 : 2 * p0; u.nt = full ? 0 : 2 * (p1 - p0); u.sp = full ? -1 : s;
        return true;
    }
    __device__ __forceinline__ void a_ready(const Unit&) const {}
    __device__ __forceinline__ void done(const Unit&) const {}
};
struct UpOrder {
    StaticOrder so68, so64; bool latent_only;
    __device__ __forceinline__ void init(int N, int G_, int c_, bool latent_only_) { so68.init(68 * BM, N, G_, c_); so64.init(64 * BM, N, G_, c_); latent_only = latent_only_; }
    __device__ __forceinline__ bool next(int i, Unit& u) const {
        Unit a, b; a.pm = 0; a.pn = 0; b.pm = 0; b.pn = 0;
        const bool ok68 = so68.next(i, a), ok64 = so64.next(i, b);
        const int pm = latent_only ? (b.pm >> 4) * 17 + 1 + (b.pm & 15) : a.pm, pn = latent_only ? b.pn : a.pn;
        u.pm = pm; u.pn = pn; u.kt0 = 0; u.nt = 0; u.sp = -1;
        return latent_only ? ok64 : ok68;
    }
    __device__ __forceinline__ void a_ready(const Unit&) const {}
    __device__ __forceinline__ void done(const Unit&) const {}
};
struct EpiKV {
    static constexpr bool PERM = true, AFTER_DRAIN = false;
    bf16_t* KN; bf16_t* V;
    __device__ __forceinline__ void operator()(const f32x4 (&acc)[2][2][4][2], const Unit& u, int wr, int wc, int fr, int fq) const {
        const int row0 = u.pm * BM + wr * 64 + fr, col0 = u.pn * HALF + wc * 32 + 8 * fq;
#pragma unroll
        for (int ai = 0; ai < 2; ++ai)
#pragma unroll
            for (int m = 0; m < 4; ++m)
#pragma unroll
                for (int bj = 0; bj < 2; ++bj) { const f32x4 v0 = acc[ai][bj][m][0], v1 = acc[ai][bj][m][1];
                    u32x4 w; w.x = cvt_pk_bf16(v0[0], v0[1]); w.y = cvt_pk_bf16(v0[2], v0[3]); w.z = cvt_pk_bf16(v1[0], v1[1]); w.w = cvt_pk_bf16(v1[2], v1[3]);
                    *(u32x4*)((bj ? V : KN) + (size_t)(row0 + ai * HALF + m * 16) * D + col0) = w; }
    }
};
template <int MODE> struct EpiRope {
    static constexpr bool PERM = false, AFTER_DRAIN = false;
    bf16_t* C; int ldc; const float* rope;
    __device__ __forceinline__ void operator()(const f32x4 (&acc)[2][2][4][2], const Unit& u, int wr, int wc, int fr, int fq) const {
        typedef unsigned u32x2 __attribute__((ext_vector_type(2)));
        const int row0 = u.pm * BM + wr * 64 + fr, col0 = u.pn * BM + wc * 32 + 4 * fq;
        const int q = u.pm % 17; const bool isctx = q == 0; const int t0 = (q - 1) * 256 + wr * 64 + fr;
#pragma unroll
        for (int bj = 0; bj < 2; ++bj) {
            const int g32 = 8 * u.pn + 4 * bj + wc; int ty;
            if (MODE == 0) { const int gi = g32 % 6; ty = gi == 4 ? 1 : (gi == 5 ? 2 : 0); } else { ty = g32 < 72 ? 1 + (g32 & 1) : 0; }
            if (isctx) ty = 0;
#pragma unroll
            for (int ai = 0; ai < 2; ++ai)
#pragma unroll
                for (int m = 0; m < 4; ++m) { f32x4 x1 = acc[ai][bj][m][0], x2 = acc[ai][bj][m][1];
                    if (ty) { const int t = t0 + ai * HALF + m * 16, pos = ty == 1 ? (t >> 6) : (t & 63); const f32x4* rp = (const f32x4*)(rope + (size_t)(pos * 16 + 4 * fq) * 2); const f32x4 r0 = rp[0], r1 = rp[1];
                        const f32x4 cs = {r0[0], r0[2], r1[0], r1[2]}, sn = {r0[1], r0[3], r1[1], r1[3]}; const f32x4 o1 = x1 * cs - x2 * sn, o2 = x2 * cs + x1 * sn; x1 = o1; x2 = o2; }
                    bf16_t* rowp = C + (size_t)(row0 + ai * HALF + m * 16) * ldc + col0 + bj * HALF;
                    u32x2 w0, w1; w0.x = cvt_pk_bf16(x1[0], x1[1]); w0.y = cvt_pk_bf16(x1[2], x1[3]); w1.x = cvt_pk_bf16(x2[0], x2[1]); w1.y = cvt_pk_bf16(x2[2], x2[3]);
                    *(u32x2*)rowp = w0; *(u32x2*)(rowp + 16) = w1; }
        }
    }
};

template <class E_> struct EpiNever {
    static constexpr bool PERM = E_::PERM, AFTER_DRAIN = false;
    E_ e; bool on;
    __device__ __forceinline__ void operator()(const f32x4 (&acc)[2][2][4][2], const Unit& u, int wr, int wc, int fr, int fq) const { if (on) e(acc, u, wr, wc, fr, fq); }
};
template <class Epi, class Sched, bool ALIGN_EPI = false, bool SP2 = false, int AUXA = 0>
__device__ __forceinline__ void gemm_phase(PG8_LAS unsigned char* lds, const Gemm g, const Sched& S, const Epi& E) {
    int tid_ = threadIdx.x; asm volatile("" : "+v"(tid_));
    const int tid = tid_, wid = __builtin_amdgcn_readfirstlane(tid >> 6), lane = tid & 63, wr = wid >> 2, wc = wid & 3, fr = lane & 15, fq = lane >> 4;
    const int K = g.K, nt = K / BK;
    unsigned voffA[2], voffB[2];
#pragma unroll
    for (int i = 0; i < 2; ++i) { int R, C; stage_rc(tid * 16 + i * 8192, R, C); const int Rb = Epi::PERM ? ((R & ~31) + perm32(R & 31)) : R;
        voffA[i] = (unsigned)(R * K + C) * 2u; voffB[i] = (unsigned)(Rb * K + C) * 2u; }
    const size_t kstep = (size_t)(BK * 2);
    const size_t hstep = (size_t)HALF * K * 2;
    const size_t tstep = 2 * hstep;
    const unsigned ldsw = (unsigned)wid * 1024u;
    const int aoff = lds_byte(wr * 64 + fr, fq * 8), boff = lds_byte(wc * 32 + fr, fq * 8);
#define PG8_SA(b, h) (((b) * 2 + (h)) * HTB)
#define PG8_SB(b, h) ((4 + (b) * 2 + (h)) * HTB)
#define PG8_STAGE(bufoff, gbase, voff, aux) do { _Pragma("unroll") for (int _i = 0; _i < 2; ++_i) \
        __builtin_amdgcn_global_load_lds((const unsigned*)((const char*)(gbase) + (voff)[_i]), (PG8_LAS unsigned*)(lds + (bufoff) + ldsw + _i * 8192), 16, 0, aux); } while (0)
#define PG8_LDA(dst, b, h) do { _Pragma("unroll") for (int m = 0; m < 4; ++m) _Pragma("unroll") for (int k = 0; k < 2; ++k) dst[m][k] = *(const PG8_LAS bf16x8*)(lds + PG8_SA(b, h) + aoff + m * 2048 + k * 1024); } while (0)
#define PG8_LDB(dst, b, h) do { _Pragma("unroll") for (int n = 0; n < 2; ++n) _Pragma("unroll") for (int k = 0; k < 2; ++k) dst[n][k] = *(const PG8_LAS bf16x8*)(lds + PG8_SB(b, h) + boff + n * 2048 + k * 1024); } while (0)
#define PG8_MMA(ai, bj, At, Bt) do { __builtin_amdgcn_s_setprio(1); _Pragma("unroll") for (int m = 0; m < 4; ++m) _Pragma("unroll") for (int n = 0; n < 2; ++n) _Pragma("unroll") for (int k = 0; k < 2; ++k) \
        acc[ai][bj][m][n] = __builtin_amdgcn_mfma_f32_16x16x32_bf16(Bt[n][k], At[m][k], acc[ai][bj][m][n], 0, 0, 0); __builtin_amdgcn_s_setprio(0); } while (0)
#define PG8_WAIT_V(n) asm volatile("s_waitcnt vmcnt(" #n ")" ::: "memory")
#define PG8_WAIT_L(n) asm volatile("s_waitcnt lgkmcnt(" #n ")" ::: "memory")
#define PG8_BAR __builtin_amdgcn_s_barrier()
#define PG8_SCHED __builtin_amdgcn_sched_barrier(0)
    Unit cur, nxt; int ui = 0;
    if (!S.next(0, cur)) return;
    f32x4 acc[2][2][4][2];
#pragma unroll
    for (int a = 0; a < 2; ++a)
#pragma unroll
        for (int b = 0; b < 2; ++b)
#pragma unroll
            for (int m = 0; m < 4; ++m)
#pragma unroll
                for (int n = 0; n < 2; ++n) acc[a][b][m][n] = (f32x4){0.f, 0.f, 0.f, 0.f};
    bf16x8 At[4][2], B0[2][2], B1[2][2];
    const char* cA = (const char*)g.A + (size_t)cur.pm * tstep + (size_t)cur.kt0 * kstep; const char* cB = (const char*)g.Bt + (size_t)cur.pn * tstep + (size_t)cur.kt0 * kstep;
    S.a_ready(cur);
    if constexpr (SP2) {
        PG8_STAGE(PG8_SB(0, 0), cB, voffB, 0); PG8_STAGE(PG8_SB(0, 1), cB + hstep, voffB, 0); PG8_STAGE(PG8_SA(0, 0), cA, voffA, AUXA); PG8_STAGE(PG8_SA(0, 1), cA + hstep, voffA, AUXA);
        if (wr == 1) PG8_BAR;
        PG8_WAIT_V(2); PG8_BAR;
        PG8_STAGE(PG8_SB(1, 0), cB + kstep, voffB, 0); PG8_STAGE(PG8_SA(1, 0), cA + kstep, voffA, AUXA); PG8_STAGE(PG8_SB(1, 1), cB + hstep + kstep, voffB, 0);
        PG8_WAIT_V(6); PG8_BAR;
    } else {
        PG8_STAGE(PG8_SB(0, 0), cB, voffB, 0); PG8_STAGE(PG8_SA(0, 0), cA, voffA, AUXA); PG8_STAGE(PG8_SB(0, 1), cB + hstep, voffB, 0); PG8_STAGE(PG8_SA(0, 1), cA + hstep, voffA, AUXA);
        if (wr == 1) PG8_BAR;
        PG8_WAIT_V(4); PG8_BAR;
        PG8_STAGE(PG8_SB(1, 0), cB + kstep, voffB, 0); PG8_STAGE(PG8_SA(1, 0), cA + kstep, voffA, AUXA); PG8_STAGE(PG8_SB(1, 1), cB + hstep + kstep, voffB, 0);
        PG8_WAIT_V(6); PG8_BAR;
    }
    for (;;) {
        const bool has_next = S.next(ui + 1, nxt);
        const char* nA = has_next ? (const char*)g.A + (size_t)nxt.pm * tstep + (size_t)nxt.kt0 * kstep : cA; const char* nB = has_next ? (const char*)g.Bt + (size_t)nxt.pn * tstep + (size_t)nxt.kt0 * kstep : cB;
        const int cnt = cur.nt ? cur.nt : nt;
        for (int t = 0; t < cnt; t += 2) {
            const bool last = (t == cnt - 2);
            const char* a1 = cA + (size_t)(t + 1) * kstep;
            const char* a2 = last ? nA : cA + (size_t)(t + 2) * kstep; const char* b2 = last ? nB : cB + (size_t)(t + 2) * kstep;
            const char* a3 = a2 + kstep; const char* b3 = b2 + kstep;
            if (last && has_next) S.a_ready(nxt);
            if constexpr (SP2) {
            PG8_LDB(B0, 0, 0); PG8_LDB(B1, 0, 1); PG8_SCHED; PG8_LDA(At, 0, 0); PG8_STAGE(PG8_SA(1, 1), a1 + hstep, voffA, AUXA);
            PG8_WAIT_V(8); PG8_WAIT_L(0); PG8_BAR; PG8_MMA(0, 0, At, B0); PG8_MMA(0, 1, At, B1); PG8_BAR; PG8_SCHED;
            PG8_LDA(At, 0, 1); PG8_STAGE(PG8_SB(0, 0), b2, voffB, 0); PG8_STAGE(PG8_SB(0, 1), b2 + hstep, voffB, 0); PG8_STAGE(PG8_SA(0, 0), a2, voffA, AUXA);
            PG8_WAIT_V(8); PG8_WAIT_L(0); PG8_BAR; PG8_MMA(1, 0, At, B0); PG8_MMA(1, 1, At, B1); PG8_BAR; PG8_SCHED;
            PG8_LDB(B0, 1, 0); PG8_LDB(B1, 1, 1); PG8_SCHED; PG8_LDA(At, 1, 0); PG8_STAGE(PG8_SA(0, 1), a2 + hstep, voffA, AUXA);
            PG8_WAIT_V(8); PG8_WAIT_L(0); PG8_BAR; PG8_MMA(0, 0, At, B0); PG8_MMA(0, 1, At, B1); PG8_BAR; PG8_SCHED;
            PG8_LDA(At, 1, 1); PG8_STAGE(PG8_SB(1, 0), b3, voffB, 0); PG8_STAGE(PG8_SB(1, 1), b3 + hstep, voffB, 0); PG8_STAGE(PG8_SA(1, 0), a3, voffA, AUXA);
            PG8_WAIT_V(8); PG8_WAIT_L(0); PG8_BAR; PG8_MMA(1, 0, At, B0); PG8_MMA(1, 1, At, B1); PG8_BAR; PG8_SCHED;
            } else {
            PG8_LDB(B0, 0, 0); PG8_SCHED; PG8_LDA(At, 0, 0); PG8_STAGE(PG8_SA(1, 1), a1 + hstep, voffA, AUXA);
            PG8_WAIT_L(8); PG8_BAR; PG8_WAIT_L(0); PG8_MMA(0, 0, At, B0); PG8_BAR; PG8_SCHED;
            PG8_LDB(B1, 0, 1); PG8_STAGE(PG8_SB(0, 0), b2, voffB, 0);
            PG8_BAR; PG8_WAIT_L(0); PG8_MMA(0, 1, At, B1); PG8_BAR;
            PG8_LDA(At, 0, 1); PG8_STAGE(PG8_SA(0, 0), a2, voffA, AUXA);
            PG8_BAR; PG8_WAIT_L(0); PG8_MMA(1, 0, At, B0); PG8_BAR; PG8_SCHED;
            PG8_STAGE(PG8_SB(0, 1), b2 + hstep, voffB, 0);
            PG8_WAIT_V(6); PG8_BAR; PG8_MMA(1, 1, At, B1); PG8_BAR;
            PG8_LDB(B0, 1, 0); PG8_SCHED; PG8_LDA(At, 1, 0); PG8_STAGE(PG8_SA(0, 1), a2 + hstep, voffA, AUXA);
            PG8_WAIT_L(8); PG8_BAR; PG8_WAIT_L(0); PG8_MMA(0, 0, At, B0); PG8_BAR; PG8_SCHED;
            PG8_LDB(B1, 1, 1); PG8_STAGE(PG8_SB(1, 0), b3, voffB, 0);
            PG8_BAR; PG8_WAIT_L(0); PG8_MMA(0, 1, At, B1); PG8_BAR;
            PG8_LDA(At, 1, 1); PG8_STAGE(PG8_SA(1, 0), a3, voffA, AUXA);
            PG8_BAR; PG8_WAIT_L(0); PG8_MMA(1, 0, At, B0); PG8_BAR; PG8_SCHED;
            PG8_STAGE(PG8_SB(1, 1), b3 + hstep, voffB, 0);
            PG8_WAIT_V(6); PG8_BAR; PG8_MMA(1, 1, At, B1); PG8_BAR;
            }
        }
        if constexpr (ALIGN_EPI) { if (wr == 0) PG8_BAR; }
        if constexpr (!Epi::AFTER_DRAIN) { E(acc, cur, wr, wc, fr, fq); S.done(cur); }
        if (!has_next) break;
#pragma unroll
        for (int a = 0; a < 2; ++a)
#pragma unroll
            for (int b = 0; b < 2; ++b)
#pragma unroll
                for (int m = 0; m < 4; ++m)
#pragma unroll
                    for (int n = 0; n < 2; ++n) acc[a][b][m][n] = (f32x4){0.f, 0.f, 0.f, 0.f};
        cur = nxt; cA = nA; cB = nB; ++ui;
        if constexpr (ALIGN_EPI) { if (wr == 1) PG8_BAR; }
    }
    PG8_WAIT_V(0);
    if constexpr (!ALIGN_EPI) { if (wr == 0) PG8_BAR; }
    PG8_BAR;
    if constexpr (Epi::AFTER_DRAIN) { E.fused(acc, cur, wr, wc, fr, fq, lds, wid, lane); S.done(cur); }
#undef PG8_SA
#undef PG8_SB
#undef PG8_STAGE
#undef PG8_LDA
#undef PG8_LDB
#undef PG8_MMA
#undef PG8_WAIT_V
#undef PG8_WAIT_L
#undef PG8_BAR
#undef PG8_SCHED
}
}

namespace {

#define LAS __attribute__((address_space(3)))
__device__ __forceinline__ void conv_item(const float* __restrict__ W, int K, int N, u16* __restrict__ WT, int rowbase, float* scr, int kb, int nb, int lane) {
    const int k0 = 64 * kb, n0 = 32 * nb;
#pragma unroll
    for (int i = 0; i < 8; ++i) { const int kk = 8 * i + (lane >> 3), cc = (lane & 7) * 4; const float4 w4 = *(const float4*)(W + (size_t)(k0 + kk) * N + n0 + cc);
        float* sp = scr + kk * 33 + cc; sp[0] = w4.x; sp[1] = w4.y; sp[2] = w4.z; sp[3] = w4.w; }
    asm volatile("s_waitcnt lgkmcnt(0)" ::: "memory");
    const int c = lane & 7;
#pragma unroll
    for (int j = 0; j < 4; ++j) { const int n = (lane >> 3) + 8 * j; const float* s = scr + (8 * c) * 33 + n;
        uint4 o; o.x = pk2(s[0 * 33], s[1 * 33]); o.y = pk2(s[2 * 33], s[3 * 33]); o.z = pk2(s[4 * 33], s[5 * 33]); o.w = pk2(s[6 * 33], s[7 * 33]);
        *(uint4*)(WT + (size_t)(rowbase + n) * K + k0 + 8 * c) = o; }
    asm volatile("s_waitcnt lgkmcnt(0)" ::: "memory");
}
__device__ __forceinline__ void conv_ld(const float* __restrict__ W, int N, int it, int nnb, int lane, float4 (&w)[8]) {
    const int kb = it / nnb, nb = it % nnb; const float* src = W + (size_t)(64 * kb + (lane >> 3)) * N + 32 * nb + (lane & 7) * 4;
#pragma unroll
    for (int i = 0; i < 8; ++i) {
#ifdef CONV_NT
        typedef float cv_f4 __attribute__((ext_vector_type(4)));
        const cv_f4 v = __builtin_nontemporal_load((const cv_f4*)(src + (size_t)(8 * i) * N)); w[i] = make_float4(v.x, v.y, v.z, v.w);
#else
        w[i] = *(const float4*)(src + (size_t)(8 * i) * N);
#endif
    }
}
__device__ __forceinline__ void conv_st(const float4 (&w)[8], int K, u16* __restrict__ WT, int rowbase, float* scr, int k0, int lane) {
#pragma unroll
    for (int i = 0; i < 8; ++i) { const int kk = 8 * i + (lane >> 3), cc = (lane & 7) * 4; float* sp = scr + kk * 33 + cc; sp[0] = w[i].x; sp[1] = w[i].y; sp[2] = w[i].z; sp[3] = w[i].w; }
    asm volatile("s_waitcnt lgkmcnt(0)" ::: "memory");
    const int c = lane & 7;
#pragma unroll
    for (int j = 0; j < 4; ++j) { const int n = (lane >> 3) + 8 * j; const float* s = scr + (8 * c) * 33 + n;
        uint4 o; o.x = pk2(s[0 * 33], s[1 * 33]); o.y = pk2(s[2 * 33], s[3 * 33]); o.z = pk2(s[4 * 33], s[5 * 33]); o.w = pk2(s[6 * 33], s[7 * 33]);
#ifdef CONV_NT
        { typedef unsigned cv_u4 __attribute__((ext_vector_type(4))); cv_u4 ov; ov.x = o.x; ov.y = o.y; ov.z = o.z; ov.w = o.w; __builtin_nontemporal_store(ov, (cv_u4*)(WT + (size_t)(rowbase + n) * K + k0 + 8 * c)); } }
#else
        *(uint4*)(WT + (size_t)(rowbase + n) * K + k0 + 8 * c) = o; }
#endif
    asm volatile("s_waitcnt lgkmcnt(0)" ::: "memory");
}
__device__ __forceinline__ void conv_matrix(const float* W, int K, int N, u16* WT, int roff, int GU, float* scr, int gw, int ngw, int lane) {
    const int nnb = N / 32, nitems = (K / 64) * nnb;
    if (gw < nitems) {
        float4 w[8]; conv_ld(W, N, gw, nnb, lane, w);
        for (int it = gw; it < nitems; it += ngw) { const int kb = it / nnb, nb = it % nnb, n0 = 32 * nb;
            float4 wn[8];
            if (it + ngw < nitems) conv_ld(W, N, it + ngw, nnb, lane, wn);
            else {
#pragma unroll
                for (int i = 0; i < 8; ++i) wn[i] = w[i]; }
            const int rowbase = GU == 0 ? roff + n0 : 256 * (n0 / 128) + (GU == 2 ? 128 : 0) + (n0 % 128);
            conv_st(w, K, WT, rowbase, scr, 64 * kb, lane);
#pragma unroll
            for (int i = 0; i < 8; ++i) w[i] = wn[i]; }
    }
}
struct ConvDesc { const float* W; u16* WT; int K, N, roff, GU; };
#ifdef TAIL_MIXERS
#define PRO_B1 29
#else
#define PRO_B1 38
#endif
constexpr size_t CTL_CONVTAB = 40960;
__device__ __forceinline__ void conv_all(KP p, ConvDesc* tab, float* scr, int gw, int ngw, int lane, int a0, int a1, int b0, int b1) {
    unsigned char* ws = p->ws;
    int t = threadIdx.x; asm volatile("" : "+v"(t));
    if (t < 38) {
        ConvDesc d;
        if (t < 24) { const int lf = t / 3, w = t % 3;
            if (w == 0) d = ConvDesc{p->in[I_WG] + (size_t)lf * D * DFF, (u16*)(ws + WS_WGU + lf * SZ_WGU), D, DFF, 0, 1};
            else if (w == 1) d = ConvDesc{p->in[I_WU] + (size_t)lf * D * DFF, (u16*)(ws + WS_WGU + lf * SZ_WGU), D, DFF, 0, 2};
            else d = ConvDesc{p->in[I_WD] + (size_t)lf * DFF * D, (u16*)(ws + WS_WD + lf * SZ_WD), DFF, D, 0, 0};
        } else if (t < 34) { const int j = (t - 24) / 5, w = (t - 24) % 5; u16* wdq = (u16*)(ws + WS_WDQKV) + (size_t)j * QKVA_LD * D;
            if (w == 0) d = ConvDesc{p->in[I_DQ] + (size_t)j * D * 512, wdq, D, 512, 0, 0};
            else if (w == 1) d = ConvDesc{p->in[I_DKV] + (size_t)j * D * 576, wdq, D, 576, 512, 0};
            else if (w == 2) d = ConvDesc{p->in[I_UQ] + (size_t)j * 512 * 3072, (u16*)(ws + WS_WUQ) + (size_t)j * 3072 * 512, 512, 3072, 0, 0};
            else if (w == 3) d = ConvDesc{p->in[I_UKV] + (size_t)j * 512 * 4096, (u16*)(ws + WS_WUKV) + (size_t)j * 4096 * 512, 512, 4096, 0, 0};
            else d = ConvDesc{p->in[I_MWO] + (size_t)j * D * D, (u16*)(ws + WS_WMO) + (size_t)j * D * D, D, D, 0, 0};
        } else if (t == 34) d = ConvDesc{p->in[I_HWIN], (u16*)(ws + WS_WHIN), D, 3 * D, 0, 0};
        else if (t == 35) d = ConvDesc{p->in[I_HWOUT], (u16*)(ws + WS_WHOUT), D, D, 0, 0};
        else if (t == 36) d = ConvDesc{p->in[I_WQKV], (u16*)(ws + WS_WWQKV), D, 2560, 0, 0};
        else d = ConvDesc{p->in[I_WWO], (u16*)(ws + WS_WWO), D, D, 0, 0};
        tab[t] = d; if (gw == 0) ((ConvDesc*)(ws + WS_CTL + CTL_CONVTAB))[t] = d;
    }
    __syncthreads();
#pragma unroll 1
    for (int m = a0; m < b1; m = (m + 1 == a1 ? b0 : m + 1)) { const ConvDesc d = tab[m]; conv_matrix(d.W, d.K, d.N, d.WT, d.roff, d.GU, scr, gw, ngw, lane); }
    for (int j = 0; j < 2; ++j) { u16* wdq = (u16*)(ws + WS_WDQKV) + (size_t)j * QKVA_LD * D;
        for (int i = gw * 64 + lane; i < (QKVA_LD - 1088) * D / 8; i += ngw * 64) ((uint4*)(wdq + (size_t)1088 * D))[i] = make_uint4(0u, 0u, 0u, 0u); }
    __syncthreads();
}
__device__ __forceinline__ unsigned long long rfl64(unsigned long long v) { return ((unsigned long long)(unsigned)__builtin_amdgcn_readfirstlane((int)(v >> 32)) << 32) | (unsigned)__builtin_amdgcn_readfirstlane((int)v); }
__device__ __forceinline__ void conv_tail(const ConvDesc* gtab, float* scr, int gw, int ngw, int lane, int a0, int a1, int b0, int b1) {
#pragma unroll 1
    for (int m = a0; m < b1; m = (m + 1 == a1 ? b0 : m + 1)) { const ConvDesc d = gtab[m]; conv_matrix((const float*)rfl64((unsigned long long)d.W), __builtin_amdgcn_readfirstlane(d.K), __builtin_amdgcn_readfirstlane(d.N), (u16*)rfl64((unsigned long long)d.WT), __builtin_amdgcn_readfirstlane(d.roff), __builtin_amdgcn_readfirstlane(d.GU), scr, gw, ngw, lane); }
    __syncthreads();
}

#define XB_TMO      128
#define XB_XCNT(j)  (256  + 64 * (j))
#define XB_XSUB(j)  (1280 + 64 * (j))
#define XB_XGEN(j)  (2304 + 64 * (j))
#define XB_TOP      3328
#define XB_TOPGEN   3392
#define XCD_BAR_WORDS 3456
#define XB_SPIN_CAP (1u << 22)

__device__ __forceinline__ unsigned xb_ld(unsigned* p)              { return __hip_atomic_load(p, __ATOMIC_RELAXED, __HIP_MEMORY_SCOPE_AGENT); }
__device__ __forceinline__ unsigned xb_add(unsigned* p, unsigned v) { return __hip_atomic_fetch_add(p, v, __ATOMIC_RELAXED, __HIP_MEMORY_SCOPE_AGENT); }
__device__ __forceinline__ unsigned xb_xcc_id() { return (unsigned)__builtin_amdgcn_s_getreg((3 << 11) | 20) & 0xFu; }
#define XB_SPIN(cond, bar) do { unsigned _sp = 0; while (cond) { __builtin_amdgcn_s_sleep(1); \
    if ((++_sp & 255u) == 0u) { if (xb_ld(&(bar)[XB_TMO])) break; if (_sp > XB_SPIN_CAP) { atomicAdd(&(bar)[XB_TMO], 1u); break; } } } } while (0)

struct XcdBarrier {
    unsigned* bar; unsigned x;
    volatile LAS unsigned* st;
};

__device__ __forceinline__ XcdBarrier xcd_barrier_post(unsigned* bar, volatile LAS unsigned* st) {
    XcdBarrier b; b.bar = bar; b.x = xb_xcc_id(); b.st = st;
    if (threadIdx.x == 0) (void)xb_add(&bar[XB_XCNT(b.x)], 1u);
    return b;
}
__device__ __forceinline__ void xcd_barrier_complete(unsigned* bar, unsigned x, unsigned& nloc, unsigned& nx) {
    const unsigned G = gridDim.x * gridDim.y * gridDim.z;
    unsigned sum, cnt, mine, sp = 0u;
    for (;;) {
        sum = 0u; cnt = 0u; mine = 0u;
#pragma unroll
        for (unsigned j = 0; j < 16; ++j) { const unsigned c = xb_ld(&bar[XB_XCNT(j)]); sum += c; cnt += (c > 0u) ? 1u : 0u; mine = (j == x) ? c : mine; }
        if (sum == G) break;
        __builtin_amdgcn_s_sleep(1);
        if ((++sp & 255u) == 0u) { if (xb_ld(&bar[XB_TMO])) break; if (sp > XB_SPIN_CAP) { atomicAdd(&bar[XB_TMO], 1u); break; } }
    }
    nloc = mine > 0u ? mine : 1u; nx = cnt > 0u ? cnt : 1u;
}

__device__ __forceinline__ void xcd_barrier(const XcdBarrier& b) {
    asm volatile("s_waitcnt vmcnt(0)" ::: "memory");
    __syncthreads();
    if (threadIdx.x == 0) {
        unsigned* bar = b.bar;
        unsigned xq = xb_xcc_id(); asm volatile("" : "+s"(xq));
        __builtin_amdgcn_s_waitcnt(0);
        unsigned nloc = b.st[0], nx = b.st[1];
        if (nloc == 0u) { xcd_barrier_complete(bar, xq, nloc, nx); b.st[0] = nloc; b.st[1] = nx; }
        const unsigned old = xb_add(&bar[XB_XSUB(xq)], 1u);
        const unsigned gen = old / nloc;
        if (old + 1u == (gen + 1u) * nloc) {
            __builtin_amdgcn_fence(__ATOMIC_RELEASE, "agent");
            asm volatile("s_waitcnt vmcnt(0)" ::: "memory");
            const unsigned og = xb_add(&bar[XB_TOP], 1u);
            const unsigned tg = og / nx;
            if (og + 1u == (tg + 1u) * nx) xb_add(&bar[XB_TOPGEN], 1u);
            else XB_SPIN(xb_ld(&bar[XB_TOPGEN]) == tg, bar);
            __builtin_amdgcn_fence(__ATOMIC_ACQUIRE, "agent");
            xb_add(&bar[XB_XGEN(xq)], 1u);
            asm volatile("s_waitcnt vmcnt(0)" ::: "memory");
        } else {
            XB_SPIN(xb_ld(&bar[XB_XGEN(xq)]) == gen, bar);
            __builtin_amdgcn_fence(__ATOMIC_ACQUIRE, "agent");
            asm volatile("s_waitcnt vmcnt(0)" ::: "memory");
        }
    }
    __syncthreads();
}


#define PH __device__ __forceinline__
#define LDSWAIT() asm volatile("s_waitcnt lgkmcnt(0)" ::: "memory")
__device__ __forceinline__ int otid() { int t = threadIdx.x; asm volatile("" : "+v"(t)); return t; }
PH void ph_modp(KP p, float* sc, int wg, int nwg) {
    const int TID = otid();
    for (int i = TID; i < 5 * D; i += 512) { const int m = i / D, k = i % D; const float v = m < 4 ? p->in[I_C][m * D + k] : p->in[I_CCTX][k]; sc[i] = silu_f(v); }
    __syncthreads();
    const int wave = TID >> 6, lane = TID & 63;
    float* MODP = (float*)(p->ws + WS_MODP);
    const int nitems = DEPTH * 72 * 16;
    for (int item = wg * 8 + wave; item < nitems; item += nwg * 8) {
        const int kc = item % 16, cg = (item / 16) % 72, layer = item / (16 * 72);
        const int col = cg * 256 + lane * 4;
        const float* w = p->in[I_MODW] + (size_t)layer * D * NMODV + (size_t)(kc * 128) * NMODV + col;
        float acc[5][4];
#pragma unroll
        for (int m = 0; m < 5; ++m) { acc[m][0] = acc[m][1] = acc[m][2] = acc[m][3] = 0.f; }
#pragma unroll 8
        for (int k = 0; k < 128; ++k) {
            const float4 wv = *(const float4*)(w + (size_t)k * NMODV);
#pragma unroll
            for (int m = 0; m < 5; ++m) { const float s = sc[m * D + kc * 128 + k]; acc[m][0] += s * wv.x; acc[m][1] += s * wv.y; acc[m][2] += s * wv.z; acc[m][3] += s * wv.w; }
        }
#pragma unroll
        for (int m = 0; m < 5; ++m) *(float4*)(MODP + ((size_t)(kc * DEPTH + layer) * 5 + m) * NMODV + col) = make_float4(acc[m][0], acc[m][1], acc[m][2], acc[m][3]);
    }
    __syncthreads();
}
PH void ph_modr(KP p, int wg, int nwg) {
    const int TID = otid();
    const float* MODP = (const float*)(p->ws + WS_MODP); float* MOD = (float*)(p->ws + WS_MOD);
    const int n = DEPTH * 5 * NMODV;
    for (int i = wg * 512 + TID; i < n; i += nwg * 512) {
        const int col = i % NMODV, layer = i / (5 * NMODV);
        float s = p->in[I_MODB][layer * NMODV + col];
        for (int kc = 0; kc < 16; ++kc) s += MODP[(size_t)kc * n + i];
        MOD[i] = s;
    }
}
PH void ph_tables(KP p, int wg, int nwg) {
    const int TID = otid();
    float* rope = (float*)(p->ws + WS_ROPE); float* tw = (float*)(p->ws + WS_TW);
    for (int i = wg * 512 + TID; i < 8192; i += nwg * 512) {
        if (i < 64 * 16) { const int pos = i / 16, k = i % 16; const float inv = (float)exp2(-(double)k / 16.0 * 13.287712379549449); const float ang = (float)pos * inv;
            rope[2 * i] = (float)cos((double)ang); rope[2 * i + 1] = (float)sin((double)ang); }
        const double a = -2.0 * 3.14159265358979323846 * (double)i / 8192.0; tw[2 * i] = (float)cos(a); tw[2 * i + 1] = (float)sin(a);
    }
}
template <int NR> PH void mod_rows(KP p, const int (&r)[NR], int nvalid, int layer, int slot, const float* pgate, float pcoef, bool first, bool fold, int lane) {
    u16* X = (u16*)(p->ws + WS_X); u16* HB = (u16*)(p->ws + WS_HB); const float* MOD = (const float*)(p->ws + WS_MOD); const u16* SLAB = (const u16*)(p->ws + WS_SLAB);
    const float* g = p->in[I_NORMG] + ((size_t)layer * 3 + slot) * D;
    float4 v[NR][4][2]; float rs[NR];
    const int b0 = r[0] / SB, j0 = r[0] - b0 * SB;
#pragma unroll
    for (int k = 0; k < NR; ++k) { if (k >= nvalid) { rs[k] = 0.f; continue; }
        uint4* xr = (uint4*)(X + (size_t)r[k] * D);
        const int b = r[k] / SB, j = r[k] - b * SB;
        if (first) {
            const float4* xs = j < CTX ? (const float4*)(p->in[I_CTX] + ((size_t)b * CTX + j) * D) : (const float4*)(p->in[I_X] + ((size_t)b * S + (j - CTX)) * D);
#pragma unroll
            for (int i = 0; i < 4; ++i) { const int c8 = lane + 64 * i; v[k][i][0] = xs[2 * c8]; v[k][i][1] = xs[2 * c8 + 1]; }
        } else {
#pragma unroll
            for (int i = 0; i < 4; ++i) { const uint4 q = xr[lane + 64 * i];
                v[k][i][0] = make_float4(pg8::h2f_lo(q.x), pg8::h2f_hi(q.x), pg8::h2f_lo(q.y), pg8::h2f_hi(q.y)); v[k][i][1] = make_float4(pg8::h2f_lo(q.z), pg8::h2f_hi(q.z), pg8::h2f_lo(q.w), pg8::h2f_hi(q.w)); }
        }
        if (NR == 1 && fold) {
#pragma unroll
            for (int i = 0; i < 4; ++i) { const int c8 = lane + 64 * i; float4 a0 = make_float4(0.f, 0.f, 0.f, 0.f), a1 = a0;
#pragma unroll
                for (int s = 0; s < 8; ++s) { const uint4 q = ((const uint4*)(SLAB + ((size_t)(s * 4 + b) * 256 + j) * D))[c8];
                    a0.x += __uint_as_float(q.x << 16); a0.y += __uint_as_float(q.x & 0xffff0000u); a0.z += __uint_as_float(q.y << 16); a0.w += __uint_as_float(q.y & 0xffff0000u);
                    a1.x += __uint_as_float(q.z << 16); a1.y += __uint_as_float(q.z & 0xffff0000u); a1.z += __uint_as_float(q.w << 16); a1.w += __uint_as_float(q.w & 0xffff0000u); }
                const float4 g0 = ((const float4*)pgate)[2 * c8], g1 = ((const float4*)pgate)[2 * c8 + 1];
                v[k][i][0].x += pcoef * g0.x * a0.x; v[k][i][0].y += pcoef * g0.y * a0.y; v[k][i][0].z += pcoef * g0.z * a0.z; v[k][i][0].w += pcoef * g0.w * a0.w;
                v[k][i][1].x += pcoef * g1.x * a1.x; v[k][i][1].y += pcoef * g1.y * a1.y; v[k][i][1].z += pcoef * g1.z * a1.z; v[k][i][1].w += pcoef * g1.w * a1.w; }
        }
        if (first || (NR == 1 && fold)) { const float lim = pg8::h16_lim();
#pragma unroll
            for (int i = 0; i < 4; ++i) xr[lane + 64 * i] = make_uint4(pg8::pkh2(v[k][i][0].x, v[k][i][0].y, lim), pg8::pkh2(v[k][i][0].z, v[k][i][0].w, lim), pg8::pkh2(v[k][i][1].x, v[k][i][1].y, lim), pg8::pkh2(v[k][i][1].z, v[k][i][1].w, lim));
        }
        float ss = 0.f;
#pragma unroll
        for (int i = 0; i < 4; ++i)
#pragma unroll
            for (int h = 0; h < 2; ++h) ss += v[k][i][h].x * v[k][i][h].x + v[k][i][h].y * v[k][i][h].y + v[k][i][h].z * v[k][i][h].z + v[k][i][h].w * v[k][i][h].w;
        rs[k] = rsqrtf(wave_sum(ss) * (1.f / D) + NORM_EPS);
    }
    const float* mb = MOD + ((size_t)(layer * 5 + (j0 < CTX ? 4 : b0)) * 9 + 3 * slot) * D;
#pragma unroll
    for (int i = 0; i < 4; ++i) { const int c8 = lane + 64 * i;
        float4 gs[2], sh[2];
#pragma unroll
        for (int h = 0; h < 2; ++h) { const float4 gg = ((const float4*)g)[2 * c8 + h], sl = ((const float4*)(mb + D))[2 * c8 + h]; sh[h] = ((const float4*)mb)[2 * c8 + h];
            gs[h] = make_float4(gg.x * (1.f + sl.x), gg.y * (1.f + sl.y), gg.z * (1.f + sl.z), gg.w * (1.f + sl.w)); }
#pragma unroll
        for (int k = 0; k < NR; ++k) { if (k >= nvalid) continue; unsigned ow[4];
#pragma unroll
            for (int h = 0; h < 2; ++h) { const float4 x = v[k][i][h];
                const float a = x.x * rs[k] * gs[h].x + sh[h].x, bq = x.y * rs[k] * gs[h].y + sh[h].y, c = x.z * rs[k] * gs[h].z + sh[h].z, d = x.w * rs[k] * gs[h].w + sh[h].w;
                ow[2 * h] = pk2(a, bq); ow[2 * h + 1] = pk2(c, d); }
            ((uint4*)(HB + (size_t)r[k] * D))[c8] = make_uint4(ow[0], ow[1], ow[2], ow[3]); } }
}
PH void ph_modulate(KP p, int layer, int slot, const float* pgate, float pcoef, int wg, int nwg, bool first = false, bool skip_ctx = false) {
    const int TID = otid();
    const int wave = TID >> 6, lane = TID & 63, w = wg * 8 + wave, nw = nwg * 8;
    const int cw = pgate != nullptr ? 6 : 1;
    const int base = (NB * S + cw * NB * CTX + nw - 1) / nw;
    const int nctx_before = w < NB * CTX ? w : NB * CTX;
    int l0 = w * base - cw * nctx_before, l1 = l0 + base - (w < NB * CTX ? cw : 0);
    if (nw < NB * CTX) { l0 = (int)((long)w * (NB * S) / nw); l1 = (int)((long)(w + 1) * (NB * S) / nw); }
    if (l0 > NB * S) l0 = NB * S; if (l1 > NB * S) l1 = NB * S; if (w == nw - 1) l1 = NB * S;
    const int nc = (w < NB * CTX && !skip_ctx) ? (NB * CTX - 1 - w) / nw + 1 : 0;
    for (int it = 0; it < nc; ++it) { const int c = w + it * nw; const int r1[1] = {(c >> 8) * SB + (c & 255)}; mod_rows<1>(p, r1, 1, layer, slot, pgate, pcoef, first, pgate != nullptr, lane); }
    for (int l = l0; l < l1; ) {
        int n = l1 - l; if (n > 4) n = 4; const int left = 4096 - (l & 4095); if (n > left) n = left;
        const int rb = (l >> 12) * SB + CTX + (l & 4095); const int r4[4] = {rb, rb + 1, rb + 2, rb + 3};
        mod_rows<4>(p, r4, n, layer, slot, nullptr, 0.f, first, false, lane);
        l += n;
    }
}
PH void ph_final(KP p, int wg, int nwg) {
    const int TID = otid();
    const u16* X = (const u16*)(p->ws + WS_X); const float* g = p->in[I_FINALG];
    const int wave = TID >> 6, lane = TID & 63;
    for (int q = wg * 8 + wave; q < NB * S; q += nwg * 8) {
        const int b = q / S, t = q - b * S, r = b * SB + CTX + t;
        const uint4* xr = (const uint4*)(X + (size_t)r * D);
        float4 v[4][2]; float ss = 0.f;
#pragma unroll
        for (int i = 0; i < 4; ++i) { const uint4 w = xr[lane + 64 * i];
            v[i][0] = make_float4(pg8::h2f_lo(w.x), pg8::h2f_hi(w.x), pg8::h2f_lo(w.y), pg8::h2f_hi(w.y)); v[i][1] = make_float4(pg8::h2f_lo(w.z), pg8::h2f_hi(w.z), pg8::h2f_lo(w.w), pg8::h2f_hi(w.w));
#pragma unroll
            for (int h = 0; h < 2; ++h) ss += v[i][h].x * v[i][h].x + v[i][h].y * v[i][h].y + v[i][h].z * v[i][h].z + v[i][h].w * v[i][h].w; }
        const float rs = rsqrtf(wave_sum(ss) * (1.f / D) + NORM_EPS);
        float4* o = (float4*)(p->out + (size_t)q * D);
#pragma unroll
        for (int i = 0; i < 4; ++i)
#pragma unroll
            for (int h = 0; h < 2; ++h) { const int c4 = 2 * (lane + 64 * i) + h; const float4 gg = ((const float4*)g)[c4]; const float4 x = v[i][h]; o[c4] = make_float4(x.x * rs * gg.x, x.y * rs * gg.y, x.z * rs * gg.z, x.w * rs * gg.w); }
    }
}
PH void ph_mla_norm(KP p, int jm, int wg, int nwg) {
    const int TID = otid();
    const _Float16* A = (const _Float16*)(p->ws + WS_QKVA); u16* QL = (u16*)(p->ws + WS_QL); u16* CKV = (u16*)(p->ws + WS_CKV); u16* KR = (u16*)(p->ws + WS_KR);
    const float* gq = p->in[I_GQ] + jm * 512; const float* gkv = p->in[I_GKV] + jm * 512; const float* rope = (const float*)(p->ws + WS_ROPE);
    const int wave = TID >> 6, lane = TID & 63;
    for (int r = wg * 8 + wave; r < R; r += nwg * 8) {
        const _Float16* a = A + (size_t)r * QKVA_LD;
        const uint4 qw = ((const uint4*)a)[lane], kw = ((const uint4*)(a + 512))[lane];
        const float4 q0 = make_float4(pg8::h2f_lo(qw.x), pg8::h2f_hi(qw.x), pg8::h2f_lo(qw.y), pg8::h2f_hi(qw.y)), q1 = make_float4(pg8::h2f_lo(qw.z), pg8::h2f_hi(qw.z), pg8::h2f_lo(qw.w), pg8::h2f_hi(qw.w));
        const float4 k0 = make_float4(pg8::h2f_lo(kw.x), pg8::h2f_hi(kw.x), pg8::h2f_lo(kw.y), pg8::h2f_hi(kw.y)), k1 = make_float4(pg8::h2f_lo(kw.z), pg8::h2f_hi(kw.z), pg8::h2f_lo(kw.w), pg8::h2f_hi(kw.w));
        const float sq = wave_sum(q0.x * q0.x + q0.y * q0.y + q0.z * q0.z + q0.w * q0.w + q1.x * q1.x + q1.y * q1.y + q1.z * q1.z + q1.w * q1.w);
        const float sk = wave_sum(k0.x * k0.x + k0.y * k0.y + k0.z * k0.z + k0.w * k0.w + k1.x * k1.x + k1.y * k1.y + k1.z * k1.z + k1.w * k1.w);
        const float rq = rsqrtf(sq * (1.f / 512) + NORM_EPS), rk = rsqrtf(sk * (1.f / 512) + NORM_EPS);
        const float4 g0 = ((const float4*)gq)[lane * 2], g1 = ((const float4*)gq)[lane * 2 + 1], h0 = ((const float4*)gkv)[lane * 2], h1 = ((const float4*)gkv)[lane * 2 + 1];
        uint4 oq, ok;
        oq.x = pk2(q0.x * rq * g0.x, q0.y * rq * g0.y); oq.y = pk2(q0.z * rq * g0.z, q0.w * rq * g0.w); oq.z = pk2(q1.x * rq * g1.x, q1.y * rq * g1.y); oq.w = pk2(q1.z * rq * g1.z, q1.w * rq * g1.w);
        ok.x = pk2(k0.x * rk * h0.x, k0.y * rk * h0.y); ok.y = pk2(k0.z * rk * h0.z, k0.w * rk * h0.w); ok.z = pk2(k1.x * rk * h1.x, k1.y * rk * h1.y); ok.w = pk2(k1.z * rk * h1.z, k1.w * rk * h1.w);
        ((uint4*)(QL + (size_t)r * 512))[lane] = oq; ((uint4*)(CKV + (size_t)r * 512))[lane] = ok;
        if (lane < 32) {
            const int b = r / SB, j = r - b * SB; const int half = lane >> 4, i = lane & 15;
            const float x1 = (float)a[1024 + 32 * half + i], x2 = (float)a[1024 + 32 * half + 16 + i];
            float o1 = x1, o2 = x2;
            if (j >= CTX) { const int t = j - CTX, pos = half ? (t & 63) : (t >> 6); const float cs = rope[(pos * 16 + i) * 2], sn = rope[(pos * 16 + i) * 2 + 1]; o1 = x1 * cs - x2 * sn; o2 = x2 * cs + x1 * sn; }
            KR[(size_t)r * 64 + 32 * half + i] = f2bf(o1); KR[(size_t)r * 64 + 32 * half + 16 + i] = f2bf(o2);
        }
    }
}
PH void ph_transpose(const u16* __restrict__ ZT, u16* __restrict__ Z, u16* tile, int wg, int nwg) {
    const int TID = otid();
    const int ld = TID >> 3, lr = (TID & 7) * 8;
    const int sr = TID & 63, sd = (TID >> 6) * 8;
    for (int u = wg; u < (R / 64) * (D / 64); u += nwg) {
        const int r0 = (u % (R / 64)) * 64, d0 = (u / (R / 64)) * 64;
        const uint4 v = *(const uint4*)(ZT + (size_t)(d0 + ld) * R + r0 + lr);
        *(uint4*)(tile + ld * 72 + lr) = v;
        __syncthreads();
        unsigned w[4];
#pragma unroll
        for (int k = 0; k < 4; ++k) w[k] = (unsigned)tile[(sd + 2 * k) * 72 + sr] | ((unsigned)tile[(sd + 2 * k + 1) * 72 + sr] << 16);
        *(uint4*)(Z + (size_t)(r0 + sr) * D + d0 + sd) = make_uint4(w[0], w[1], w[2], w[3]);
        __syncthreads();
    }
}
template <int NP> PH void filt_unit(KP p, float* lds, int L, int l0, float* FT, int tid) {
    float* zf = lds; float* ha = lds + 8 * 33; float* hb = ha + 512; float* h3t = hb + 512; float* tp = h3t + 512;
    const float* w1 = p->in[I_FW1]; const float* b1 = p->in[I_FB1]; const float* w2 = p->in[I_FW2]; const float* b2 = p->in[I_FB2]; const float* w3 = p->in[I_FW3]; const float* b3 = p->in[I_FB3]; const float* fr = p->in[I_FFREQ];
    const float* w4 = p->in[I_FW4]; const float* decay = p->in[I_DECAY];
    { int tf = tid; asm volatile("" : "+v"(tf));
      for (int idx = tf; idx < NP * 33; idx += 512) { const int pp = idx / 33, c = idx % 33, l = l0 + pp; const float t = (float)l / (float)(L - 1);
        float v;
        if (c == 0) { v = t; tp[pp] = t; }
        else { const int k = (c - 1) & 15; const float f = 1e-4f + (float)k * ((15.0f - 1e-4f) / 15.0f); const float w = 6.283185307179586f * (float)l / (float)L; const double a = (double)(f * w);
            v = c <= 16 ? (float)cos(a) : (float)(-sin(a)); }
        zf[pp * 33 + c] = v; } }
    __syncthreads();
    { int tj = tid; asm volatile("" : "+v"(tj)); const int pp = tj >> 6, j = tj & 63; if (pp < NP) { float s = b1[j]; for (int c = 0; c < 33; ++c) s += zf[pp * 33 + c] * w1[c * 64 + j]; ha[pp * 64 + j] = sinf(fr[j] * s); } }
    __syncthreads();
    { int tj = tid; asm volatile("" : "+v"(tj)); const int pp = tj >> 6, j = tj & 63; if (pp < NP) { float s = b2[j]; for (int c = 0; c < 64; ++c) s += ha[pp * 64 + c] * w2[c * 64 + j]; hb[pp * 64 + j] = sinf(fr[j] * s); } }
    __syncthreads();
    { int tj = tid; asm volatile("" : "+v"(tj)); const int pp = tj >> 6, j = tj & 63; if (pp < NP) { float s = b3[j]; for (int c = 0; c < 64; ++c) s += hb[pp * 64 + c] * w3[c * 64 + j]; h3t[j * 8 + pp] = sinf(fr[j] * s); } }
    __syncthreads();
#pragma unroll 1
    for (int m = 0; m < 4; ++m) {
        int tq = tid; asm volatile("" : "+v"(tq));
        const int n4 = (tq + 512 * m) * 4; float acc[NP][4];
#pragma unroll
        for (int q = 0; q < NP; ++q) { acc[q][0] = 0.f; acc[q][1] = 0.f; acc[q][2] = 0.f; acc[q][3] = 0.f; }
        const float* wp = w4 + n4;
#pragma unroll 1
        for (int k0 = 0; k0 < 64; k0 += 8) {
            float4 wv[8];
#pragma unroll
            for (int kk = 0; kk < 8; ++kk) wv[kk] = *(const float4*)(wp + (size_t)kk * 8192);
            wp += 8 * 8192;
#pragma unroll
            for (int kk = 0; kk < 8; ++kk) { float hh[8];
                if (NP == 8) { const float4 h0 = *(const float4*)(h3t + (k0 + kk) * 8), h1 = *(const float4*)(h3t + (k0 + kk) * 8 + 4); hh[0] = h0.x; hh[1] = h0.y; hh[2] = h0.z; hh[3] = h0.w; hh[4] = h1.x; hh[5] = h1.y; hh[6] = h1.z; hh[7] = h1.w; }
                else hh[0] = h3t[(k0 + kk) * 8];
#pragma unroll
                for (int q = 0; q < NP; ++q) { acc[q][0] += hh[q] * wv[kk].x; acc[q][1] += hh[q] * wv[kk].y; acc[q][2] += hh[q] * wv[kk].z; acc[q][3] += hh[q] * wv[kk].w; } }
        }
        const float4 dc4 = *(const float4*)(decay + n4); const float dc[4] = {fabsf(dc4.x), fabsf(dc4.y), fabsf(dc4.z), fabsf(dc4.w)};
        float* o = FT + (size_t)n4 * L + l0;
#pragma unroll
        for (int c = 0; c < 4; ++c) { float e[NP];
#pragma unroll
            for (int q = 0; q < NP; ++q) e[q] = acc[q][c] * __builtin_amdgcn_exp2f(-1.4426950408889634f * tp[q] * dc[c]);
            if (NP == 8) { *(float4*)o = make_float4(e[0], e[1], e[2], e[3]); *(float4*)(o + 4) = make_float4(e[4], e[5], e[6], e[7]); } else o[0] = e[0];
            o += L; }
    }
    __syncthreads();
}
PH void ph_filters(KP p, float* lds, int wg, int nwg) {
    const int TID = otid();
    for (int unit = wg; unit < 512; unit += nwg) filt_unit<8>(p, lds, 4096, unit * 8, (float*)(p->ws + WS_FT4096), TID);
    for (int q = wg; q < 256; q += nwg) filt_unit<1>(p, lds, 256, q, (float*)(p->ws + WS_FT256), TID);
}
PH void ph_nattn_mla(const u16* __restrict__ Q, const u16* __restrict__ KN, const u16* __restrict__ KR, const u16* __restrict__ V, u16* __restrict__ O, float* lds, int wg, int nwg) {
    const int TID = otid();
    const int wave = TID >> 6, lane = TID & 63;
    float* pp = lds + wave * (SB + 192); float* qq = pp + SB;
    for (int item = wg * 8 + wave; item < R * 16; item += nwg * 8) {
        const int r = item >> 4, h = item & 15;
        const int b = r / SB, j = r - b * SB, nk = j < CTX ? CTX : SB, kb = b * SB;
        for (int c = lane; c < 192; c += 64) qq[c] = bf2f(Q[(size_t)r * 3072 + h * 192 + c]);
        LDSWAIT();
        const float scale = 0.07216878364870322f;
        float mx = -3.0e38f;
        for (int key = lane; key < nk; key += 64) {
            const uint4* kn = (const uint4*)(KN + (size_t)(kb + key) * D + h * 128); const uint4* kr = (const uint4*)(KR + (size_t)(kb + key) * 64);
            float s = 0.f;
#pragma unroll 4
            for (int c8 = 0; c8 < 24; ++c8) { const uint4 w = c8 < 16 ? kn[c8] : kr[c8 - 16]; const float* q8 = qq + c8 * 8;
                s += q8[0] * __uint_as_float(w.x << 16) + q8[1] * __uint_as_float(w.x & 0xffff0000u) + q8[2] * __uint_as_float(w.y << 16) + q8[3] * __uint_as_float(w.y & 0xffff0000u)
                   + q8[4] * __uint_as_float(w.z << 16) + q8[5] * __uint_as_float(w.z & 0xffff0000u) + q8[6] * __uint_as_float(w.w << 16) + q8[7] * __uint_as_float(w.w & 0xffff0000u); }
            s *= scale; pp[key] = s; mx = fmaxf(mx, s);
        }
        mx = wave_max(mx);
        float sum = 0.f;
        for (int key = lane; key < nk; key += 64) { const float e = expf(pp[key] - mx); pp[key] = e; sum += e; }
        sum = wave_sum(sum);
        LDSWAIT();
        float o0 = 0.f, o1 = 0.f;
        const u16* vb = V + (size_t)kb * D + h * 128 + lane;
        for (int key = 0; key < nk; ++key) { const float pv = pp[key]; o0 += pv * bf2f(vb[(size_t)key * D]); o1 += pv * bf2f(vb[(size_t)key * D + 64]); }
        const float inv = 1.f / sum;
        O[(size_t)r * D + h * 128 + lane] = f2bf(o0 * inv); O[(size_t)r * D + h * 128 + 64 + lane] = f2bf(o1 * inv);
        LDSWAIT();
    }
}
PH void ph_nattn_win(const u16* __restrict__ QKV, const float* __restrict__ sink, u16* __restrict__ O, float* lds, int wg, int nwg) {
    const int TID = otid();
    const int wave = TID >> 6, lane = TID & 63;
    float* pp = lds + wave * 640; float* qq = pp + 576;
    for (int item = wg * 8 + wave; item < R * 32; item += nwg * 8) {
        const int r = item >> 5, qh = item & 31, kvh = qh >> 3;
        const int b = r / SB, j = r - b * SB, kb = b * SB;
        qq[lane] = bf2f(QKV[(size_t)r * 2560 + qh * 64 + lane]);
        LDSWAIT();
        int lo = 0, nwin = 0; if (j >= CTX) { const int t = j - CTX; lo = t - 128 < 0 ? 0 : t - 128; const int hi = t + 128 > S - 1 ? S - 1 : t + 128; nwin = hi - lo + 1; }
        const int nk = CTX + nwin;
        float mx = sink[qh];
        for (int key = lane; key < nk; key += 64) {
            const int krow = kb + (key < CTX ? key : CTX + lo + (key - CTX));
            const uint4* kk = (const uint4*)(QKV + (size_t)krow * 2560 + 2048 + kvh * 64);
            float s = 0.f;
#pragma unroll
            for (int c8 = 0; c8 < 8; ++c8) { const uint4 w = kk[c8]; const float* q8 = qq + c8 * 8;
                s += q8[0] * __uint_as_float(w.x << 16) + q8[1] * __uint_as_float(w.x & 0xffff0000u) + q8[2] * __uint_as_float(w.y << 16) + q8[3] * __uint_as_float(w.y & 0xffff0000u)
                   + q8[4] * __uint_as_float(w.z << 16) + q8[5] * __uint_as_float(w.z & 0xffff0000u) + q8[6] * __uint_as_float(w.w << 16) + q8[7] * __uint_as_float(w.w & 0xffff0000u); }
            s *= 0.125f; pp[key] = s; mx = fmaxf(mx, s);
        }
        mx = wave_max(mx);
        float sum = 0.f;
        for (int key = lane; key < nk; key += 64) { const float e = expf(pp[key] - mx); pp[key] = e; sum += e; }
        sum = wave_sum(sum) + expf(sink[qh] - mx);
        LDSWAIT();
        float o = 0.f;
        for (int key = 0; key < nk; ++key) { const int krow = kb + (key < CTX ? key : CTX + lo + (key - CTX)); o += pp[key] * bf2f(QKV[(size_t)krow * 2560 + 2304 + kvh * 64 + lane]); }
        O[(size_t)r * D + qh * 64 + lane] = f2bf(o / sum);
        LDSWAIT();
    }
}

namespace att {
typedef short bf16x8 __attribute__((ext_vector_type(8)));
typedef short s16x4 __attribute__((ext_vector_type(4)));
typedef float f32x16 __attribute__((ext_vector_type(16)));
typedef unsigned u32x4 __attribute__((ext_vector_type(4)));
#define ALDS __attribute__((address_space(3)))
#define ASBAR() __builtin_amdgcn_sched_barrier(0)
__device__ __forceinline__ int crow(int r, int hi) { return (r & 3) + 8 * (r >> 2) + 4 * hi; }
__device__ __forceinline__ unsigned cvtpk(float lo, float hi) { unsigned r; asm("v_cvt_pk_bf16_f32 %0, %1, %2" : "=v"(r) : "v"(lo), "v"(hi)); return r; }
template <int STRIDE> __device__ __forceinline__ int kswz(int row, int colB) { return row * STRIDE + (colB ^ (((row >> 1) & 7) << 4)); }
template <int DV> __device__ __forceinline__ int v_st(int k, int c) { const int kk = (k & ~0xC) | ((k & 4) << 1) | ((k & 8) >> 1); return ((kk >> 3) * (DV / 32) + (c >> 5)) * 512 + ((kk & 7) * 32 + (c & 31)) * 2; }
__device__ __forceinline__ int v_rd_base(int lane) { return ((lane & 3) << 3) | (((lane >> 2) & 3) << 6) | (((lane >> 4) & 1) << 5) | (((lane >> 5) & 1) << 8); }
template <int DV> constexpr int v_rd_off(int d0, int ks, int half) { return d0 * 512 + ks * (2 * (DV / 32) * 512) + half * ((DV / 32) * 512); }
template <int OFF> __device__ __forceinline__ s16x4 tr_read(int vb) { s16x4 r; asm volatile("ds_read_b64_tr_b16 %0, %1 offset:%2" : "=&v"(r) : "v"(vb), "i"(OFF) : "memory"); return r; }
__device__ __forceinline__ void partialSM(f32x16& p0, f32x16& p1, float& m_reg, float& mn, float& alpha, const float C, const float THRR) {
    float pmax = p0[0];
#pragma unroll
    for (int r = 1; r < 16; ++r) pmax = fmaxf(pmax, p0[r]);
#pragma unroll
    for (int r = 0; r < 16; ++r) pmax = fmaxf(pmax, p1[r]);
    { auto rr = __builtin_amdgcn_permlane32_swap(__float_as_uint(pmax), __float_as_uint(pmax), false, false); pmax = fmaxf(__uint_as_float(rr[0]), __uint_as_float(rr[1])); }
    if (__builtin_expect(__all(pmax - m_reg <= THRR), 1)) { mn = m_reg; alpha = 1.f; }
    else { mn = fmaxf(m_reg, pmax); alpha = __builtin_amdgcn_exp2f((m_reg - mn) * C); m_reg = mn; }
    const float mnC = -mn * C;
#pragma unroll
    for (int r = 0; r < 16; ++r) p0[r] = fmaf(p0[r], C, mnC);
#pragma unroll
    for (int r = 0; r < 16; ++r) p1[r] = fmaf(p1[r], C, mnC);
#pragma unroll
    for (int r = 0; r < 16; ++r) p0[r] = __builtin_amdgcn_exp2f(p0[r]);
}
__device__ __forceinline__ void finishSM(f32x16& p0, f32x16& p1, float alpha, float& l_reg, bf16x8& pa0, bf16x8& pa1, bf16x8& pa2, bf16x8& pa3) {
#pragma unroll
    for (int r = 0; r < 16; ++r) p1[r] = __builtin_amdgcn_exp2f(p1[r]);
    float ps = 0;
#pragma unroll
    for (int r = 0; r < 16; ++r) ps += p0[r];
#pragma unroll
    for (int r = 0; r < 16; ++r) ps += p1[r];
    { auto rr = __builtin_amdgcn_permlane32_swap(__float_as_uint(ps), __float_as_uint(ps), false, false); ps = __uint_as_float(rr[0]) + __uint_as_float(rr[1]); }
    l_reg = l_reg * alpha + ps;
#define ATT_PK4(P, BASE, OUT) do { unsigned a0 = cvtpk(P[BASE + 0], P[BASE + 1]), a1 = cvtpk(P[BASE + 2], P[BASE + 3]);   \
    unsigned b0 = cvtpk(P[BASE + 4], P[BASE + 5]), b1 = cvtpk(P[BASE + 6], P[BASE + 7]);                              \
    auto r0 = __builtin_amdgcn_permlane32_swap(a0, b0, false, false); auto r1 = __builtin_amdgcn_permlane32_swap(a1, b1, false, false); \
    u32x4 w = {r0[0], r1[0], r0[1], r1[1]}; OUT = *reinterpret_cast<bf16x8*>(&w); } while (0)
    ATT_PK4(p0, 0, pa0); ATT_PK4(p0, 8, pa1); ATT_PK4(p1, 0, pa2); ATT_PK4(p1, 8, pa3);
#undef ATT_PK4
}
template <int DQK, int KST> __device__ __forceinline__ void qkt(f32x16& p0, f32x16& p1, const ALDS char* Ks, const bf16x8* qr, int r32, int hi) {
    p0 = f32x16{}; p1 = f32x16{};
#pragma unroll
    for (int d0 = 0; d0 < DQK / 16; ++d0) { const int cb = (d0 * 16 + hi * 8) * 2;
        const bf16x8 b0 = *reinterpret_cast<const ALDS bf16x8*>(Ks + kswz<KST>(r32, cb));
        const bf16x8 b1 = *reinterpret_cast<const ALDS bf16x8*>(Ks + kswz<KST>(32 + r32, cb));
        p0 = __builtin_amdgcn_mfma_f32_32x32x16_bf16(b0, qr[d0], p0, 0, 0, 0);
        p1 = __builtin_amdgcn_mfma_f32_32x32x16_bf16(b1, qr[d0], p1, 0, 0, 0); }
}
template <int D0, int DV> __device__ __forceinline__ void pv_one(f32x16& od, int vb, bf16x8 pa0, bf16x8 pa1, bf16x8 pa2, bf16x8 pa3) {
    const s16x4 l0 = tr_read<v_rd_off<DV>(D0, 0, 0)>(vb), h0 = tr_read<v_rd_off<DV>(D0, 0, 1)>(vb), l1 = tr_read<v_rd_off<DV>(D0, 1, 0)>(vb), h1 = tr_read<v_rd_off<DV>(D0, 1, 1)>(vb);
    const s16x4 l2 = tr_read<v_rd_off<DV>(D0, 2, 0)>(vb), h2 = tr_read<v_rd_off<DV>(D0, 2, 1)>(vb), l3 = tr_read<v_rd_off<DV>(D0, 3, 0)>(vb), h3 = tr_read<v_rd_off<DV>(D0, 3, 1)>(vb);
    asm volatile("s_waitcnt lgkmcnt(0)" ::: "memory"); ASBAR();
#define ATT_PK(L, H) (bf16x8){L[0], L[1], L[2], L[3], H[0], H[1], H[2], H[3]}
    od = __builtin_amdgcn_mfma_f32_32x32x16_bf16(pa0, ATT_PK(l0, h0), od, 0, 0, 0);
    od = __builtin_amdgcn_mfma_f32_32x32x16_bf16(pa1, ATT_PK(l1, h1), od, 0, 0, 0);
    od = __builtin_amdgcn_mfma_f32_32x32x16_bf16(pa2, ATT_PK(l2, h2), od, 0, 0, 0);
    od = __builtin_amdgcn_mfma_f32_32x32x16_bf16(pa3, ATT_PK(l3, h3), od, 0, 0, 0);
#undef ATT_PK
}

constexpr int MLA_LDS_BYTES = 2 * 16384 + 2 * 24576 + 2048;
__device__ __forceinline__ void mla_unit(const u16* __restrict__ Qb, const u16* __restrict__ KNh, const u16* __restrict__ KRb, const u16* __restrict__ Vh, u16* __restrict__ Ob, int nkeys, ALDS char* lds, int tid) {
    constexpr int SHV = 16384, SHK = 24576;
    constexpr float SCALE = 0.07216878364870322f, C = SCALE * 1.4426950408889634f, THRR = 8.f / SCALE;
    const int wid = tid >> 6, lane = tid & 63, r32 = lane & 31, hi = lane >> 5;
    ALDS char* V_lds = lds; ALDS char* K_lds = lds + 2 * SHV;
    ALDS float* wsc = (ALDS float*)(lds + 2 * SHV + 2 * SHK) + wid * 64; ALDS float* li_l = wsc; ALDS float* al_l = wsc + 32;
    float m_reg = -1e30f, l_reg = 0.f; f32x16 o[4] = {}; bf16x8 qr[12];
    const u16* Qw = Qb + (unsigned)((wid * 32 + r32) * 3072 + hi * 8);
#pragma unroll
    for (int d0 = 0; d0 < 12; ++d0) qr[d0] = *reinterpret_cast<const bf16x8*>(Qw + d0 * 16);
    const int sr = tid >> 4, sc = (tid & 15) * 8, krr = tid >> 3, krc = (tid & 7) * 8;
    const int vst0 = v_st<128>(sr, sc), vst1 = v_st<128>(32 + sr, sc);
    const int kst0 = kswz<384>(sr, sc * 2), kst1 = kswz<384>(32 + sr, sc * 2), kst2 = kswz<384>(krr, (128 + krc) * 2);
    const int vb0 = (int)(unsigned)(uintptr_t)V_lds + v_rd_base(lane);
    bf16x8 vs0, vs1, ks0, ks1, kr0;
const unsigned goff = (unsigned)(sr * 2048 + sc), kroff = (unsigned)(krr * 64 + krc);
#define MLA_SLOAD(k0) do { const u16* vp = Vh + (size_t)(k0) * 2048; const u16* kp = KNh + (size_t)(k0) * 2048; \
    vs0 = *reinterpret_cast<const bf16x8*>(vp + goff); vs1 = *reinterpret_cast<const bf16x8*>(vp + 32 * 2048 + goff); \
    ks0 = *reinterpret_cast<const bf16x8*>(kp + goff); ks1 = *reinterpret_cast<const bf16x8*>(kp + 32 * 2048 + goff); \
    kr0 = *reinterpret_cast<const bf16x8*>(KRb + (size_t)(k0) * 64 + kroff); } while (0)
#define MLA_SWRITE(b) do { *reinterpret_cast<ALDS bf16x8*>(V_lds + (b) * SHV + vst0) = vs0; *reinterpret_cast<ALDS bf16x8*>(V_lds + (b) * SHV + vst1) = vs1; \
    *reinterpret_cast<ALDS bf16x8*>(K_lds + (b) * SHK + kst0) = ks0; *reinterpret_cast<ALDS bf16x8*>(K_lds + (b) * SHK + kst1) = ks1; *reinterpret_cast<ALDS bf16x8*>(K_lds + (b) * SHK + kst2) = kr0; } while (0)
    const int NT = nkeys / 64;
    MLA_SLOAD(0); MLA_SWRITE(0); __syncthreads();
    for (int j = 0; j < NT; ++j) {
        const int b = j & 1;
        if (j + 1 < NT) MLA_SLOAD((j + 1) * 64);
        f32x16 p0, p1; float mn, alpha; bf16x8 pa0, pa1, pa2, pa3;
        qkt<192, 384>(p0, p1, K_lds + b * SHK, qr, r32, hi);
        partialSM(p0, p1, m_reg, mn, alpha, C, THRR);
        if (__any(alpha < 1.f)) { if (hi == 0) al_l[r32] = alpha; asm volatile("s_waitcnt lgkmcnt(0)" ::: "memory");
#pragma unroll
            for (int d = 0; d < 4; ++d)
#pragma unroll
                for (int r = 0; r < 16; ++r) o[d][r] *= al_l[crow(r, hi)]; }
        finishSM(p0, p1, alpha, l_reg, pa0, pa1, pa2, pa3); ASBAR();
        const int vb = vb0 + b * SHV;
        pv_one<0, 128>(o[0], vb, pa0, pa1, pa2, pa3); pv_one<1, 128>(o[1], vb, pa0, pa1, pa2, pa3); pv_one<2, 128>(o[2], vb, pa0, pa1, pa2, pa3); pv_one<3, 128>(o[3], vb, pa0, pa1, pa2, pa3);
        if (j + 1 < NT) MLA_SWRITE(b ^ 1);
        __syncthreads();
    }
#undef MLA_SLOAD
#undef MLA_SWRITE
    if (hi == 0) li_l[r32] = l_reg;
    asm volatile("s_waitcnt lgkmcnt(0)" ::: "memory");
    ALDS char* ost = lds + wid * 8704;
#pragma unroll
    for (int r = 0; r < 16; ++r) { const int orow = crow(r, hi); const float rl = __builtin_amdgcn_rcpf(li_l[orow]);
#pragma unroll
        for (int d0 = 0; d0 < 4; ++d0) *reinterpret_cast<ALDS u16*>(ost + orow * 272 + (d0 * 32 + r32) * 2) = f2bf(o[d0][r] * rl); }
    asm volatile("s_waitcnt lgkmcnt(0)" ::: "memory");
#pragma unroll
    for (int i = 0; i < 8; ++i) { const int row = i * 4 + (lane >> 4), ch = lane & 15; const u32x4 v = *reinterpret_cast<const ALDS u32x4*>(ost + row * 272 + ch * 16);
        *reinterpret_cast<u32x4*>(Ob + (unsigned)((wid * 32 + row) * 2048 + ch * 8)) = v; }
    __syncthreads();
}

constexpr int MLA2_LDS_BYTES = 2 * 16384 + 2 * 24576 + 2048 + 8 * 4096;
__device__ __forceinline__ void qkt_mla(f32x16& p0, f32x16& p1, const ALDS char* Ks, const bf16x8* qr, const ALDS char* qrl, int r32, int hi) {
    p0 = f32x16{}; p1 = f32x16{};
    const int kb[4] = {kswz<384>(r32, (0 * 16 + hi * 8) * 2), kswz<384>(r32, (1 * 16 + hi * 8) * 2), kswz<384>(r32, (2 * 16 + hi * 8) * 2), kswz<384>(r32, (3 * 16 + hi * 8) * 2)};
    bf16x8 b0[3], b1[3], qf[3];
#define QKT_LD(d0) do { b0[(d0) % 3] = *reinterpret_cast<const ALDS bf16x8*>(Ks + kb[(d0) & 3] + ((d0) >> 2) * 128); b1[(d0) % 3] = *reinterpret_cast<const ALDS bf16x8*>(Ks + kb[(d0) & 3] + ((d0) >> 2) * 128 + 32 * 384); \
        if ((d0) >= 8) qf[(d0) % 3] = *reinterpret_cast<const ALDS bf16x8*>(qrl + ((d0) - 8) * 1024); } while (0)
    QKT_LD(0); QKT_LD(1);
#define QKT_STEP(d0) do { if ((d0) + 2 < 12) QKT_LD((d0) + 2); \
        { const bf16x8 q = (d0) < 8 ? qr[(d0) < 8 ? (d0) : 0] : qf[(d0) % 3]; \
          p0 = __builtin_amdgcn_mfma_f32_32x32x16_bf16(b0[(d0) % 3], q, p0, 0, 0, 0); p1 = __builtin_amdgcn_mfma_f32_32x32x16_bf16(b1[(d0) % 3], q, p1, 0, 0, 0); } \
        __builtin_amdgcn_sched_group_barrier(0x100, (d0) + 2 < 12 ? ((d0) + 2 >= 8 ? 3 : 2) : 0, 0);     \
        __builtin_amdgcn_sched_group_barrier(0x008, 2, 0); } while (0)
    QKT_STEP(0); QKT_STEP(1); QKT_STEP(2); QKT_STEP(3); QKT_STEP(4); QKT_STEP(5); QKT_STEP(6); QKT_STEP(7); QKT_STEP(8); QKT_STEP(9); QKT_STEP(10); QKT_STEP(11);
#undef QKT_STEP
#undef QKT_LD
}
template <int OFF> __device__ __forceinline__ bf16x8 lds_rd128(int a) { bf16x8 r; asm volatile("ds_read_b128 %0, %1 offset:%2" : "=&v"(r) : "v"(a), "i"(OFF) : "memory"); return r; }
#ifdef QROPE_REG
#define QKT_QF(d0) do { } while (0)
#define QKT_Q(d0) qr[(d0)]
#define QKT_NQ 0
#else
#define QKT_QF(d0) do { if ((d0) >= 8) qf[(d0) & 1] = lds_rd128<((d0) >= 8 ? (d0) - 8 : 0) * 1024>(qa); } while (0)
#define QKT_Q(d0) ((d0) < 8 ? qr[(d0) < 8 ? (d0) : 0] : qf[(d0) & 1])
#define QKT_NQ 1
#endif
template <int KOFF> __device__ __forceinline__ void qkt_mla_p(f32x16& p0, f32x16& p1, const int (&ka)[4], int qa, const bf16x8* qr) {
    p0 = f32x16{}; p1 = f32x16{};
    bf16x8 b0[2], b1[2], qf[2];
#define QL(d0) do { b0[(d0) & 1] = lds_rd128<KOFF + ((d0) >> 2) * 128>(ka[(d0) & 3]); b1[(d0) & 1] = lds_rd128<KOFF + ((d0) >> 2) * 128 + 32 * 384>(ka[(d0) & 3]); \
        QKT_QF(d0); } while (0)
#define QN(d0) ((d0) >= 12 ? 0 : (d0) >= 8 ? 2 + QKT_NQ : 2)
#define QS(d0) do { if ((d0) + 1 < 12) QL((d0) + 1); \
        asm volatile("s_waitcnt lgkmcnt(%0)" :: "i"(QN((d0) + 1)) : "memory"); ASBAR(); \
        { const bf16x8 q = QKT_Q(d0); \
          p0 = __builtin_amdgcn_mfma_f32_32x32x16_bf16(b0[(d0) & 1], q, p0, 0, 0, 0); p1 = __builtin_amdgcn_mfma_f32_32x32x16_bf16(b1[(d0) & 1], q, p1, 0, 0, 0); } ASBAR(); } while (0)
    QL(0);
    QS(0); QS(1); QS(2); QS(3); QS(4); QS(5); QS(6); QS(7); QS(8); QS(9); QS(10); QS(11);
#undef QS
#undef QN
#undef QL
}
template <int ABL = 0, int ORDER = 0> __device__ __forceinline__ void mla_unit2(const u16* __restrict__ Qb, const u16* __restrict__ KNh, const u16* __restrict__ KRb, const u16* __restrict__ Vh, u16* __restrict__ Ob, int nkeys, ALDS char* lds, int tid) {
    constexpr int SHV = 16384, SHK = 24576;
    constexpr float SCALE = 0.07216878364870322f, C = SCALE * 1.4426950408889634f, THRR = 8.f / SCALE;
    const int wid = __builtin_amdgcn_readfirstlane(tid >> 6), lane = tid & 63, r32 = lane & 31, hi = lane >> 5;
    ALDS char* V_lds = lds; ALDS char* K_lds = lds + 2 * SHV;
    ALDS float* wsc = (ALDS float*)(lds + 2 * SHV + 2 * SHK) + wid * 64; ALDS float* li_l = wsc; ALDS float* al_l = wsc + 32;
    ALDS char* qrl = lds + 2 * SHV + 2 * SHK + 2048 + wid * 4096 + lane * 16;
    float m_reg = -1e30f, l_reg = 0.f; f32x16 o[4] = {};
#ifdef QROPE_REG
    bf16x8 qr[12];
    const u16* Qw = Qb + (unsigned)((wid * 32 + r32) * 3072 + hi * 8);
#pragma unroll
    for (int d0 = 0; d0 < 12; ++d0) qr[d0] = *reinterpret_cast<const bf16x8*>(Qw + d0 * 16);
#else
    bf16x8 qr[8];
    const u16* Qw = Qb + (unsigned)((wid * 32 + r32) * 3072 + hi * 8);
#pragma unroll
    for (int d0 = 0; d0 < 8; ++d0) qr[d0] = *reinterpret_cast<const bf16x8*>(Qw + d0 * 16);
#pragma unroll
    for (int d0 = 8; d0 < 12; ++d0) *reinterpret_cast<ALDS bf16x8*>(qrl + (d0 - 8) * 1024) = *reinterpret_cast<const bf16x8*>(Qw + d0 * 16);
#endif
    const int vb0 = (int)(unsigned)(uintptr_t)V_lds + v_rd_base(lane);
    int ka[4]; { const int kbase = (int)(unsigned)(uintptr_t)K_lds;
#pragma unroll
      for (int r = 0; r < 4; ++r) ka[r] = kbase + kswz<384>(r32, (r * 16 + hi * 8) * 2); }
    const int qa = (int)(unsigned)(uintptr_t)qrl;
    bf16x8 vs0, vs1, ks0, ks1, kr0;
    const unsigned goff = (unsigned)((tid >> 4) * 2048 + (tid & 15) * 8), kroff = (unsigned)((tid >> 3) * 64 + (tid & 7) * 8);
    const int vst0 = v_st<128>(tid >> 4, (tid & 15) * 8), kst0 = kswz<384>(tid >> 4, (tid & 15) * 16), kst2 = kswz<384>(tid >> 3, (128 + (tid & 7) * 8) * 2);
    constexpr int vst1o = 8192, kst1o = 32 * 384;
#define MLA_SLOAD(k0) do { \
    const u16* vp = Vh + (size_t)(k0) * 2048; const u16* kp = KNh + (size_t)(k0) * 2048; \
    if (!(ABL & 1)) { vs0 = *reinterpret_cast<const bf16x8*>(vp + goff); vs1 = *reinterpret_cast<const bf16x8*>(vp + 32 * 2048 + goff); \
    ks0 = *reinterpret_cast<const bf16x8*>(kp + goff); ks1 = *reinterpret_cast<const bf16x8*>(kp + 32 * 2048 + goff); \
    kr0 = *reinterpret_cast<const bf16x8*>(KRb + (size_t)(k0) * 64 + kroff); } } while (0)
#define MLA_SWRITE(b) do { \
    if (!(ABL & 1)) { *reinterpret_cast<ALDS bf16x8*>(V_lds + (b) * SHV + vst0) = vs0; *reinterpret_cast<ALDS bf16x8*>(V_lds + (b) * SHV + vst0 + vst1o) = vs1; \
    *reinterpret_cast<ALDS bf16x8*>(K_lds + (b) * SHK + kst0) = ks0; *reinterpret_cast<ALDS bf16x8*>(K_lds + (b) * SHK + kst0 + kst1o) = ks1; *reinterpret_cast<ALDS bf16x8*>(K_lds + (b) * SHK + kst2) = kr0; } } while (0)
#define MLA_RESC(a) do { if (__any((a) < 1.f)) { if (hi == 0) al_l[r32] = (a); asm volatile("s_waitcnt lgkmcnt(0)" ::: "memory"); \
    _Pragma("unroll") for (int d = 0; d < 4; ++d) _Pragma("unroll") for (int r = 0; r < 16; ++r) o[d][r] *= al_l[crow(r, hi)]; } } while (0)
#define MLA_PV(vb) do { pv_one<0, 128>(o[0], (vb), pa0, pa1, pa2, pa3); pv_one<1, 128>(o[1], (vb), pa0, pa1, pa2, pa3); pv_one<2, 128>(o[2], (vb), pa0, pa1, pa2, pa3); pv_one<3, 128>(o[3], (vb), pa0, pa1, pa2, pa3); } while (0)
#define ABL_PSM(P0, P1, MN, AL) do { if (ABL & 2) { MN = m_reg; AL = 1.f; } else partialSM(P0, P1, m_reg, MN, AL, C, THRR); } while (0)
#define ABL_FSM(P0, P1, AL) do { if (ABL & 2) { u32x4 w_ = {__float_as_uint(P0[0]), __float_as_uint(P0[1]), __float_as_uint(P1[0]), __float_as_uint(P1[1])}; pa0 = *reinterpret_cast<bf16x8*>(&w_); pa1 = pa0; pa2 = pa0; pa3 = pa0; l_reg += 1.f; } else finishSM(P0, P1, AL, l_reg, pa0, pa1, pa2, pa3); } while (0)
    f32x16 pA0, pA1, pB0, pB1; float mnA, mnB, alA, alB; bf16x8 pa0, pa1, pa2, pa3; const int NT = nkeys / 64;
    MLA_SLOAD(0); asm volatile("s_waitcnt vmcnt(0)" ::: "memory"); MLA_SWRITE(0); __syncthreads();
    qkt_mla_p<0>(pA0, pA1, ka, qa, qr); ABL_PSM(pA0, pA1, mnA, alA);
    MLA_SLOAD(64); asm volatile("s_waitcnt vmcnt(0)" ::: "memory"); MLA_SWRITE(1); __syncthreads();
    constexpr bool lead = ORDER == 0;
#define MLA_STEP(Q0, Q1, KB, P0, P1, ALP, VB, MNQ, ALQ) do { \
        if (lead) { ASBAR(); qkt_mla_p<KB>(Q0, Q1, ka, qa, qr); ABL_FSM(P0, P1, ALP); ASBAR(); MLA_PV(VB); ABL_PSM(Q0, Q1, MNQ, ALQ); } \
        else { ASBAR(); ABL_FSM(P0, P1, ALP); ASBAR(); qkt_mla_p<KB>(Q0, Q1, ka, qa, qr); ASBAR(); ABL_PSM(Q0, Q1, MNQ, ALQ); ASBAR(); MLA_PV(VB); } } while (0)
    for (int j = 1; j + 1 < NT; j += 2) {
        MLA_SLOAD((j + 1) * 64);
        MLA_STEP(pB0, pB1, SHK, pA0, pA1, alA, vb0, mnB, alB);
        __syncthreads(); asm volatile("s_waitcnt vmcnt(0)" ::: "memory"); MLA_SWRITE(0);
        MLA_RESC(alB); __syncthreads();
        MLA_SLOAD((j + 2) * 64);
        MLA_STEP(pA0, pA1, 0, pB0, pB1, alB, vb0 + SHV, mnA, alA);
        __syncthreads(); asm volatile("s_waitcnt vmcnt(0)" ::: "memory"); MLA_SWRITE(1);
        MLA_RESC(alA); __syncthreads();
    }
#undef MLA_STEP
    ASBAR(); qkt_mla_p<SHK>(pB0, pB1, ka, qa, qr);
    ABL_FSM(pA0, pA1, alA); ASBAR();
    MLA_PV(vb0); ABL_PSM(pB0, pB1, mnB, alB);
    __syncthreads(); MLA_RESC(alB);
    ABL_FSM(pB0, pB1, alB); ASBAR();
    MLA_PV(vb0 + SHV);
#undef MLA_SLOAD
#undef MLA_SWRITE
#undef MLA_RESC
#undef MLA_PV
#undef ABL_PSM
#undef ABL_FSM
    __syncthreads();
    if (hi == 0) li_l[r32] = l_reg;
    { const int lane = (int)__builtin_amdgcn_mbcnt_hi(~0u, __builtin_amdgcn_mbcnt_lo(~0u, 0u)), r32 = lane & 31, hi = lane >> 5;
    asm volatile("s_waitcnt lgkmcnt(0)" ::: "memory");
    ALDS char* ost = lds + wid * 8704;
#pragma unroll
    for (int r = 0; r < 16; ++r) { const int orow = crow(r, hi); const float rl = __builtin_amdgcn_rcpf(li_l[orow]);
#pragma unroll
        for (int d0 = 0; d0 < 4; ++d0) *reinterpret_cast<ALDS u16*>(ost + orow * 272 + (d0 * 32 + r32) * 2) = f2bf(o[d0][r] * rl); }
    asm volatile("s_waitcnt lgkmcnt(0)" ::: "memory");
#pragma unroll
    for (int i = 0; i < 8; ++i) { const int row = i * 4 + (lane >> 4), ch = lane & 15; const u32x4 v = *reinterpret_cast<const ALDS u32x4*>(ost + row * 272 + ch * 16);
        *reinterpret_cast<u32x4*>(Ob + (unsigned)((wid * 32 + row) * 2048 + ch * 8)) = v; } }
    __syncthreads();
}

constexpr int WIN_LDS_BYTES = 4 * 8192 + 2048 + 8 * 4608;
__device__ __forceinline__ void win_unit(const u16* __restrict__ QKV, u16* __restrict__ O, const float* __restrict__ sink, int kb, int qrow0, int p0, int kvh, ALDS char* lds, int tid) {
    constexpr int SHK = 8192, SHV = 8192;
    constexpr float SCALE = 0.125f, C = SCALE * 1.4426950408889634f, THRR = 8.f / SCALE;
    const int wid = tid >> 6, lane = tid & 63, r32 = lane & 31, hi = lane >> 5, qh = kvh * 8 + wid;
    ALDS char* K_lds = lds; ALDS char* V_lds = lds + 2 * SHK;
    ALDS float* wsc = (ALDS float*)(lds + 2 * SHK + 2 * SHV) + wid * 64; ALDS float* li_l = wsc; ALDS float* al_l = wsc + 32;
    float m_reg = sink[qh] * (1.0f / SCALE), l_reg = 1.f; f32x16 o[2] = {}; bf16x8 qr[4];
    const u16* Qw = QKV + (size_t)(qrow0 + r32) * 2560 + qh * 64 + hi * 8;
#pragma unroll
    for (int d0 = 0; d0 < 4; ++d0) qr[d0] = *reinterpret_cast<const bf16x8*>(Qw + d0 * 16);
    const int srow = tid >> 3, scol = (tid & 7) * 8;
    const int vst = v_st<64>(srow, scol), kst = kswz<128>(srow, scol * 2);
    const int vb0 = (int)(unsigned)(uintptr_t)V_lds + v_rd_base(lane);
    const unsigned goff = (unsigned)(srow * 2560 + scol);
    int wlo = 0, NT = 4;
    if (p0 >= 0) { const int lo = p0 - 128 < 0 ? 0 : p0 - 128, hiP = p0 + 159 > S - 1 ? S - 1 : p0 + 159; wlo = lo >> 6; NT = 4 + (hiP >> 6) - wlo + 1; }
    bf16x8 ks, vs;
#define WIN_TROW(j) ((j) < 4 ? kb + 64 * (j) : kb + CTX + 64 * (wlo + (j) - 4))
#define WIN_SLOAD(j) do { const u16* rp = QKV + (size_t)WIN_TROW(j) * 2560; ks = *reinterpret_cast<const bf16x8*>(rp + 2048 + kvh * 64 + goff); vs = *reinterpret_cast<const bf16x8*>(rp + 2304 + kvh * 64 + goff); } while (0)
#define WIN_SWRITE(b) do { *reinterpret_cast<ALDS bf16x8*>(K_lds + (b) * SHK + kst) = ks; *reinterpret_cast<ALDS bf16x8*>(V_lds + (b) * SHV + vst) = vs; } while (0)
    WIN_SLOAD(0); WIN_SWRITE(0); __syncthreads();
    for (int j = 0; j < NT; ++j) {
        const int b = j & 1;
        if (j + 1 < NT) WIN_SLOAD(j + 1);
        f32x16 p0v, p1v; float mn, alpha; bf16x8 pa0, pa1, pa2, pa3;
        qkt<64, 128>(p0v, p1v, K_lds + b * SHK, qr, r32, hi);
        if (j >= 4) { const int dq0 = (p0 + r32) - 64 * (wlo + j - 4);
#pragma unroll
            for (int r = 0; r < 16; ++r) { const int dq = dq0 - crow(r, hi); if (dq > 128 || dq < -128) p0v[r] = -1e30f; if (dq - 32 > 128 || dq - 32 < -128) p1v[r] = -1e30f; } }
        partialSM(p0v, p1v, m_reg, mn, alpha, C, THRR);
        if (__any(alpha < 1.f)) { if (hi == 0) al_l[r32] = alpha; asm volatile("s_waitcnt lgkmcnt(0)" ::: "memory");
#pragma unroll
            for (int d = 0; d < 2; ++d)
#pragma unroll
                for (int r = 0; r < 16; ++r) o[d][r] *= al_l[crow(r, hi)]; }
        finishSM(p0v, p1v, alpha, l_reg, pa0, pa1, pa2, pa3); ASBAR();
        const int vb = vb0 + b * SHV;
        pv_one<0, 64>(o[0], vb, pa0, pa1, pa2, pa3); pv_one<1, 64>(o[1], vb, pa0, pa1, pa2, pa3);
        if (j + 1 < NT) WIN_SWRITE(b ^ 1);
        __syncthreads();
    }
#undef WIN_TROW
#undef WIN_SLOAD
#undef WIN_SWRITE
    if (hi == 0) li_l[r32] = l_reg;
    asm volatile("s_waitcnt lgkmcnt(0)" ::: "memory");
    ALDS char* ost = lds + 2 * SHK + 2 * SHV + 2048 + wid * 4608;
#pragma unroll
    for (int r = 0; r < 16; ++r) { const int orow = crow(r, hi); const float rl = __builtin_amdgcn_rcpf(li_l[orow]);
#pragma unroll
        for (int d0 = 0; d0 < 2; ++d0) *reinterpret_cast<ALDS u16*>(ost + orow * 144 + (d0 * 32 + r32) * 2) = f2bf(o[d0][r] * rl); }
    asm volatile("s_waitcnt lgkmcnt(0)" ::: "memory");
#pragma unroll
    for (int i = 0; i < 4; ++i) { const int row = i * 8 + (lane >> 3), ch = lane & 7; const u32x4 v = *reinterpret_cast<const ALDS u32x4*>(ost + row * 144 + ch * 16);
        *reinterpret_cast<u32x4*>(O + (size_t)(qrow0 + row) * 2048 + qh * 64 + ch * 8) = v; }
    __syncthreads();
}
}
#ifndef MLA_UNIT
#define MLA_UNIT mla_unit2<0, 0>
#endif
template <int ABL = 0> PH void ph_attn_mla(const u16* __restrict__ Q, const u16* __restrict__ KN, const u16* __restrict__ KR, const u16* __restrict__ V, u16* __restrict__ O, unsigned char* lds, int wg, int nwg, bool need_ctx) {
    const int TID = otid();
    const int vcu = (nwg % 8 == 0) ? (wg % 8) * (nwg / 8) + wg / 8 : wg;
    for (int u = vcu; u < (need_ctx ? NB * 16 * 17 : NB * 16 * 16); u += nwg) {
        int bh, qb; if (u < NB * 16 * 16) { bh = u >> 4; qb = 1 + (u & 15); } else { bh = u - NB * 16 * 16; qb = 0; }
        const int b = bh >> 4, h = bh & 15; const size_t kb = (size_t)b * SB, q0 = kb + (size_t)qb * 256;
        int tu = TID; asm volatile("" : "+v"(tu));
#ifndef MLA_NOSWAP
        if (__builtin_amdgcn_readfirstlane(tu >> 6) < 4) att::mla_unit2<ABL, 0>(Q + q0 * 3072 + h * 192, KN + kb * D + h * 128, KR + kb * 64, V + kb * D + h * 128, O + q0 * D + h * 128, qb == 0 ? CTX : SB, (ALDS char*)lds, tu);
        else att::mla_unit2<ABL, 1>(Q + q0 * 3072 + h * 192, KN + kb * D + h * 128, KR + kb * 64, V + kb * D + h * 128, O + q0 * D + h * 128, qb == 0 ? CTX : SB, (ALDS char*)lds, tu);
#else
        att::mla_unit2<ABL, 0>(Q + q0 * 3072 + h * 192, KN + kb * D + h * 128, KR + kb * 64, V + kb * D + h * 128, O + q0 * D + h * 128, qb == 0 ? CTX : SB, (ALDS char*)lds, tu);
#endif
    }
}

PH void ph_attn_win(const u16* __restrict__ QKV, const float* __restrict__ sink, u16* __restrict__ O, unsigned char* lds, int wg, int nwg) {
    const int TID = otid();
    const int vcu = (nwg % 8 == 0) ? (wg % 8) * (nwg / 8) + wg / 8 : wg;
    for (int u = vcu; u < NB * 4 * 136; u += nwg) {
        const int pb = u % 136, bk = u / 136, b = bk >> 2, kvh = bk & 3, kb = b * SB;
        const int p0 = pb < 128 ? pb * 32 : -1, qrow0 = pb < 128 ? kb + CTX + pb * 32 : kb + (pb - 128) * 32;
        int tu = TID; asm volatile("" : "+v"(tu));
        att::win_unit(QKV, O, sink, kb, qrow0, p0, kvh, (ALDS char*)lds, tu);
    }
}

#ifndef FFT_HD
#define FFT_HD __device__ __forceinline__
#define FFT_OPQ(t) asm volatile("" : "+v"(t))
#else
#define FFT_OPQ(t)
#endif
typedef float cf __attribute__((ext_vector_type(2)));
FFT_HD cf cswap(cf a) { return __builtin_shufflevector(a, a, 1, 0); }
FFT_HD cf cmul(cf a, cf b) { return a * b.xx + cswap(a) * (cf){-b.y, b.y}; }
FFT_HD cf cmulc(cf a, cf b) { return a * b.xx + cswap(a) * (cf){b.y, -b.y}; }
FFT_HD cf cadd(cf a, cf b) { return a + b; }
FFT_HD cf csub(cf a, cf b) { return a - b; }
FFT_HD int fidx(int a) { return a + (a >> 5) + (a >> 9); }
constexpr int FFT_N = 8192, FFT_BUF = FFT_N + FFT_N / 32 + FFT_N / 512;
FFT_HD int fpos(int k) { return ((k & 15) << 9) | (((k >> 4) & 15) << 5) | (((k >> 8) & 15) << 1) | ((k >> 12) & 1); }
template <bool INV, bool ZHI = false> FFT_HD void dft16(cf (&v)[16]) {
    constexpr float C1 = 0.9238795325112867f, S1 = 0.3826834323650898f, C2 = 0.7071067811865476f;
    const float wr[8] = {1.f, C1, C2, S1, 0.f, -S1, -C2, -C1};
    const float wi[8] = {0.f, S1, C2, C1, 1.f, C1, C2, S1};
#pragma unroll
    for (int s = 0; s < 4; ++s) {
        const int half = 8 >> s;
#pragma unroll
        for (int i = 0; i < 16; ++i) {
            if ((i & half) == 0) {
                const int j = i + half, tw = (i & (half - 1)) << s;
                const cf a = v[i], b = v[j];
                const bool z = ZHI && s == 0;
                if (!z) v[i] = cadd(a, b);
                const cf d = z ? a : csub(a, b);
                if (tw == 0) v[j] = d;
                else if (tw == 4) v[j] = INV ? (cf){-d.y, d.x} : (cf){d.y, -d.x};
                else { const float c = wr[tw], sn = INV ? -wi[tw] : wi[tw]; v[j] = d * (cf){c, c} + cswap(d) * (cf){sn, -sn}; }
            }
        }
    }
#pragma unroll
    for (int i = 0; i < 16; ++i) { const int r = ((i & 1) << 3) | ((i & 2) << 1) | ((i & 4) >> 1) | ((i & 8) >> 3); if (r > i) { const cf t = v[i]; v[i] = v[r]; v[r] = t; } }
}
template <int M, bool INV, class BufT, class TwT> FFT_HD void fft_pass16(BufT buf, TwT tw, int tid) {
    FFT_OPQ(tid);
    const int blk = tid / M, n2 = tid % M, base = blk * 16 * M + n2;
    constexpr int ST = M + (M >> 5) + (M >> 9); const int a0 = fidx(base);
    cf v[16];
#pragma unroll
    for (int j = 0; j < 16; ++j) v[j] = buf.get(a0 + j * ST);
    cf w[16];
    if (M > 1) { const cf w1 = tw.get(n2 * (FFT_N / (16 * M))); w[1] = w1; w[2] = cmul(w1, w1); w[3] = cmul(w[2], w1); w[4] = cmul(w[2], w[2]); w[5] = cmul(w[4], w1); w[6] = cmul(w[3], w[3]); w[7] = cmul(w[6], w1);
        w[8] = cmul(w[4], w[4]); w[9] = cmul(w[8], w1); w[10] = cmul(w[5], w[5]); w[11] = cmul(w[10], w1); w[12] = cmul(w[6], w[6]); w[13] = cmul(w[12], w1); w[14] = cmul(w[7], w[7]); w[15] = cmul(w[14], w1); }
    if (INV) { if (M > 1) {
#pragma unroll
        for (int k = 1; k < 16; ++k) v[k] = cmulc(v[k], w[k]); } }
    dft16<INV>(v);
    if (!INV) { if (M > 1) {
#pragma unroll
        for (int k = 1; k < 16; ++k) v[k] = cmul(v[k], w[k]); } }
#pragma unroll
    for (int j = 0; j < 16; ++j) buf.set(a0 + j * ST, v[j]);
}
template <class BufT> FFT_HD void fft_pass2(BufT buf, int tid) {
    FFT_OPQ(tid);
    const int a0 = fidx(2 * tid);
#pragma unroll
    for (int i = 0; i < 8; ++i) { const int e = a0 + 1058 * i; const cf a = buf.get(e), b = buf.get(e + 1); buf.set(e, cadd(a, b)); buf.set(e + 1, csub(a, b)); }
}
#ifndef FFT_HOST_TEST
#define FFT_SYNC() __syncthreads()
template <class BufT, class TwT> FFT_HD void fft_fwd(BufT buf, TwT tw, int tid) {
    fft_pass16<512, false>(buf, tw, tid); FFT_SYNC(); fft_pass16<32, false>(buf, tw, tid); FFT_SYNC(); fft_pass16<2, false>(buf, tw, tid); FFT_SYNC(); fft_pass2(buf, tid); FFT_SYNC();
}
template <class BufT, class TwT> FFT_HD void fft_inv(BufT buf, TwT tw, int tid) {
    fft_pass2(buf, tid); FFT_SYNC(); fft_pass16<2, true>(buf, tw, tid); FFT_SYNC(); fft_pass16<32, true>(buf, tw, tid); FFT_SYNC(); fft_pass16<512, true>(buf, tw, tid); FFT_SYNC();
}
#endif
FFT_HD void spec_pair(cf a, cf b, cf fd, cf fe, cf& ya, cf& yb) {
    const cf zd = cf{a.x + b.x, a.y - b.y};
    const cf ze = cf{a.y + b.y, b.x - a.x};
    const cf P = cmul(zd, fd), Q = cmul(ze, fe);
    ya = cf{P.x - Q.y, P.y + Q.x};
    yb = cf{P.x + Q.y, Q.x - P.y};
}

#ifndef FFT_HOST_TEST
typedef float f32x2v __attribute__((ext_vector_type(2)));
struct LdsCf { LAS f32x2v* p; __device__ __forceinline__ cf get(int i) const { return p[i]; } __device__ __forceinline__ void set(int i, cf v) const { p[i] = v; } };
constexpr int FS_LD = 4104;
PH void ph_filter_fft(KP p, unsigned char* ldsraw, int wg, int nwg) {
    const int TID = otid();
    const LdsCf buf{(LAS f32x2v*)ldsraw}, tw{(LAS f32x2v*)ldsraw + FFT_BUF};
    const cf* twg = (const cf*)(p->ws + WS_TW);
    for (int i = TID; i < FFT_N; i += 512) tw.set(i, twg[i]);
    __syncthreads();
    const float* FT = (const float*)(p->ws + WS_FT4096); cf* FS = (cf*)(p->ws + WS_FS);
    for (int u = wg; u < 2048; u += nwg) {
        const int n = u & 1, d = (u >> 1) * 2;
        const float* ff0 = FT + (size_t)(n * 4096 + d) * 4096; const float* ff1 = ff0 + 4096; const float* fb0 = FT + (size_t)(n * 4096 + 2048 + d) * 4096; const float* fb1 = fb0 + 4096;
#pragma unroll
        for (int i = 0; i < 16; ++i) { const int k = TID + 512 * i; cf v;
            if (k < 4096) v = cf{ff0[k], ff1[k]}; else if (k == 4096) v = cf{0.f, 0.f}; else v = cf{fb0[8192 - k], fb1[8192 - k]};
            buf.set(fidx(k), v); }
        __syncthreads();
        fft_fwd(buf, tw, TID);
        const float s = 1.0f / (4.0f * FFT_N);
        cf* fd = FS + (size_t)(n * 2048 + d) * FS_LD; cf* fe = fd + FS_LD;
        int tq = TID; FFT_OPQ(tq);
#pragma unroll
        for (int i = 0; i < 9; ++i) { const int w = tq + 512 * i; if (w <= 4096) { const cf a = buf.get(fidx(fpos(w))), b = buf.get(fidx(fpos((FFT_N - w) & (FFT_N - 1))));
            fd[w] = cf{(a.x + b.x) * s, (a.y - b.y) * s}; fe[w] = cf{(a.y + b.y) * s, (b.x - a.x) * s}; } }
        __syncthreads();
    }
}
#endif

#ifndef FFT_HOST_TEST
constexpr int FS2_LD = 264;
FFT_HD int fpos512(int k) { return ((k & 15) << 5) | (((k >> 4) & 15) << 1) | ((k >> 8) & 1); }
template <class BufT, class TwT> FFT_HD void fft512_fwd(BufT buf, TwT tw, int tid) { fft_pass16<32, false>(buf, tw, tid); FFT_SYNC(); fft_pass16<2, false>(buf, tw, tid); FFT_SYNC(); fft_pass2(buf, tid); FFT_SYNC(); }
template <class BufT, class TwT> FFT_HD void fft512_inv(BufT buf, TwT tw, int tid) { fft_pass2(buf, tid); FFT_SYNC(); fft_pass16<2, true>(buf, tw, tid); FFT_SYNC(); fft_pass16<32, true>(buf, tw, tid); FFT_SYNC(); }
PH void ph_filter_fft256(KP p, unsigned char* ldsraw, int wg, int nwg) {
    const int TID = otid();
    const LdsCf buf{(LAS f32x2v*)ldsraw}, tw{(LAS f32x2v*)ldsraw + FFT_BUF};
    const cf* twg = (const cf*)(p->ws + WS_TW);
    for (int i = TID; i < FFT_N; i += 512) tw.set(i, twg[i]);
    __syncthreads();
    const float* FT = (const float*)(p->ws + WS_FT256); cf* FS = (cf*)(p->ws + WS_FS256);
    for (int u = wg; u < 128; u += nwg) {
        int tq = TID; FFT_OPQ(tq);
#pragma unroll 1
        for (int i = 0; i < 16; ++i) { const int combo = u * 16 + i, n = combo & 1, d = (combo >> 1) * 2, k = tq; cf v;
            const float* ff0 = FT + (size_t)(n * 4096 + d) * 256; const float* fb0 = FT + (size_t)(n * 4096 + 2048 + d) * 256;
            if (k < 256) v = cf{ff0[k], ff0[256 + k]}; else if (k == 256) v = cf{0.f, 0.f}; else v = cf{fb0[512 - k], fb0[256 + 512 - k]};
            buf.set(fidx(i * 512 + k), v); }
        __syncthreads();
        fft512_fwd(buf, tw, TID);
        const float s = 1.0f / (4.0f * 512.0f);
        int tw2 = TID; FFT_OPQ(tw2);
        if (tw2 <= 256) {
#pragma unroll 1
            for (int i = 0; i < 16; ++i) { const int combo = u * 16 + i, n = combo & 1, d = (combo >> 1) * 2, w = tw2;
                const cf a = buf.get(fidx(i * 512 + fpos512(w))), b = buf.get(fidx(i * 512 + fpos512((512 - w) & 511)));
                cf* fd = FS + (size_t)(n * 2048 + d) * FS2_LD; cf* fe = fd + FS2_LD;
                fd[w] = cf{(a.x + b.x) * s, (a.y - b.y) * s}; fe[w] = cf{(a.y + b.y) * s, (b.x - a.x) * s}; } }
        __syncthreads();
    }
}
PH void ph_hyena_fft256(KP p, unsigned char* ldsraw, int wg, int nwg) {
    const int TID = otid();
    const LdsCf buf{(LAS f32x2v*)ldsraw}, tw{(LAS f32x2v*)ldsraw + FFT_BUF};
    const cf* twg = (const cf*)(p->ws + WS_TW);
    for (int i = TID; i < FFT_N; i += 512) tw.set(i, twg[i]);
    __syncthreads();
    const _Float16* UT = (const _Float16*)(p->ws + WS_UT); u16* ZT = (u16*)(p->ws + WS_ZT); const cf* FS = (const cf*)(p->ws + WS_FS256);
    const float* cw = p->in[I_HCW]; const float* cb = p->in[I_HCB]; const float* skip = p->in[I_SKIP];
    for (int u = wg; u < 256; u += nwg) {
        int tz = TID; FFT_OPQ(tz);
        auto sconv = [&](int ch, int rb, int t) { const _Float16* uu = UT + (size_t)ch * R + rb; const float um = t > 0 ? (float)uu[t - 1] : 0.f, u0 = (float)uu[t], up = t < CTX - 1 ? (float)uu[t + 1] : 0.f;
            return um * cw[ch] + u0 * cw[3 * D + ch] + up * cw[6 * D + ch] + cb[ch]; };
        float z[16][2];
#pragma unroll
        for (int i = 0; i < 16; ++i) { const int seq = u * 16 + i, d = (seq >> 2) * 2, rb = (seq & 3) * SB; if (tz < 256) { z[i][0] = sconv(d, rb, tz); z[i][1] = sconv(d + 1, rb, tz); } else { z[i][0] = 0.f; z[i][1] = 0.f; } }
#pragma unroll 1
        for (int n = 0; n < 2; ++n) {
            int ts = TID; FFT_OPQ(ts);
#pragma unroll
            for (int i = 0; i < 16; ++i) buf.set(fidx(i * 512 + ts), cf{z[i][0], z[i][1]});
            __syncthreads();
            fft512_fwd(buf, tw, TID);
            int tq = TID; FFT_OPQ(tq);
            if (tq <= 256) {
#pragma unroll 1
                for (int i = 0; i < 16; ++i) { const int seq = u * 16 + i, d = (seq >> 2) * 2, w = tq; const cf* fd = FS + (size_t)(n * 2048 + d) * FS2_LD; const cf* fe = fd + FS2_LD;
                    const int pw = fidx(i * 512 + fpos512(w)), pn = fidx(i * 512 + fpos512((512 - w) & 511));
                    const cf a = buf.get(pw), bb = buf.get(pn); cf ya, yb; spec_pair(a, bb, fd[w], fe[w], ya, yb); buf.set(pw, ya); if (pn != pw) buf.set(pn, yb); } }
            __syncthreads();
            fft512_inv(buf, tw, TID);
            int tg = TID; FFT_OPQ(tg);
            if (tg < 256) {
#pragma unroll
                for (int i = 0; i < 16; ++i) { const int seq = u * 16 + i, d = (seq >> 2) * 2, rb = (seq & 3) * SB; const cf y = buf.get(fidx(i * 512 + tg));
                    z[i][0] = sconv((n + 1) * D + d, rb, tg) * (y.x + z[i][0] * skip[n * D + d]); z[i][1] = sconv((n + 1) * D + d + 1, rb, tg) * (y.y + z[i][1] * skip[n * D + d + 1]); } }
            __syncthreads();
        }
        int to = TID; FFT_OPQ(to);
        if (to < 256) {
#pragma unroll
            for (int i = 0; i < 16; ++i) { const int seq = u * 16 + i, d = (seq >> 2) * 2, rb = (seq & 3) * SB; ZT[(size_t)d * R + rb + to] = f2bf(z[i][0]); ZT[(size_t)(d + 1) * R + rb + to] = f2bf(z[i][1]); } }
    }
}
#endif

#ifndef FFT_HOST_TEST
template <int M, bool INV, bool HALF_ = false> FFT_HD void fft_pass16x2(const LdsCf bufA, const LdsCf bufB, const LdsCf tw, int tid) {
    FFT_OPQ(tid);
    const int blk = tid / M, n2 = tid % M, base = blk * 16 * M + n2;
    constexpr int ST = M + (M >> 5) + (M >> 9); const int a0 = fidx(base);
    cf va[16], vb[16];
#pragma unroll
    for (int j = 0; j < 16; ++j) { if (HALF_ && !INV && j >= 8) { va[j] = cf{0.f, 0.f}; vb[j] = cf{0.f, 0.f}; } else { va[j] = bufA.get(a0 + j * ST); vb[j] = bufB.get(a0 + j * ST); } }
    cf w[16];
    if (M > 1) { const cf w1 = tw.get(n2 * (FFT_N / (16 * M))); w[1] = w1; w[2] = cmul(w1, w1); w[3] = cmul(w[2], w1); w[4] = cmul(w[2], w[2]); w[5] = cmul(w[4], w1); w[6] = cmul(w[3], w[3]); w[7] = cmul(w[6], w1);
        w[8] = cmul(w[4], w[4]); w[9] = cmul(w[8], w1); w[10] = cmul(w[5], w[5]); w[11] = cmul(w[10], w1); w[12] = cmul(w[6], w[6]); w[13] = cmul(w[12], w1); w[14] = cmul(w[7], w[7]); w[15] = cmul(w[14], w1); }
    if (INV) { if (M > 1) {
#pragma unroll
        for (int k = 1; k < 16; ++k) { va[k] = cmulc(va[k], w[k]); vb[k] = cmulc(vb[k], w[k]); } } }
    dft16<INV, HALF_ && !INV>(va); dft16<INV, HALF_ && !INV>(vb);
    if (!INV) { if (M > 1) {
#pragma unroll
        for (int k = 1; k < 16; ++k) { va[k] = cmul(va[k], w[k]); vb[k] = cmul(vb[k], w[k]); } } }
#pragma unroll
    for (int j = 0; j < 16; ++j) { if (HALF_ && INV && j >= 8) continue; bufA.set(a0 + j * ST, va[j]); bufB.set(a0 + j * ST, vb[j]); }
}
FFT_HD void fft_pass2x2(const LdsCf bufA, const LdsCf bufB, int tid) {
    FFT_OPQ(tid);
    const int a0 = fidx(2 * tid);
#pragma unroll
    for (int i = 0; i < 8; ++i) { const int e = a0 + 1058 * i; const cf a = bufA.get(e), b = bufA.get(e + 1), c = bufB.get(e), d = bufB.get(e + 1);
        bufA.set(e, cadd(a, b)); bufA.set(e + 1, csub(a, b)); bufB.set(e, cadd(c, d)); bufB.set(e + 1, csub(c, d)); }
}
FFT_HD void fft_fwd_x2(const LdsCf a, const LdsCf b, const LdsCf tw, int tid) {
    fft_pass16x2<512, false>(a, b, tw, tid); FFT_SYNC(); fft_pass16x2<32, false>(a, b, tw, tid); FFT_SYNC(); fft_pass16x2<2, false>(a, b, tw, tid); FFT_SYNC(); fft_pass2x2(a, b, tid); FFT_SYNC();
}
FFT_HD void fft_fwd_x2_zp(const LdsCf a, const LdsCf b, const LdsCf tw, int tid) {
    fft_pass16x2<512, false, true>(a, b, tw, tid); FFT_SYNC(); fft_pass16x2<32, false>(a, b, tw, tid); FFT_SYNC(); fft_pass16x2<2, false>(a, b, tw, tid); FFT_SYNC();
}
FFT_HD void fft_inv_x2_zp(const LdsCf a, const LdsCf b, const LdsCf tw, int tid) {
    fft_pass16x2<2, true>(a, b, tw, tid); FFT_SYNC(); fft_pass16x2<32, true>(a, b, tw, tid); FFT_SYNC(); fft_pass16x2<512, true, true>(a, b, tw, tid); FFT_SYNC();
}
FFT_HD void fft_inv_x2(const LdsCf a, const LdsCf b, const LdsCf tw, int tid) {
    fft_pass2x2(a, b, tid); FFT_SYNC(); fft_pass16x2<2, true>(a, b, tw, tid); FFT_SYNC(); fft_pass16x2<32, true>(a, b, tw, tid); FFT_SYNC(); fft_pass16x2<512, true>(a, b, tw, tid); FFT_SYNC();
}
PH void ph_hyena_fft2(KP p, unsigned char* ldsraw, int wg, int nwg, bool skipfft = false) {
    const int TID = otid();
    const LdsCf bufA{(LAS f32x2v*)ldsraw}, bufB{(LAS f32x2v*)ldsraw + FFT_BUF}, tw{(LAS f32x2v*)ldsraw + 2 * FFT_BUF};
    const cf* twg = (const cf*)(p->ws + WS_TW);
    tw.set(TID, twg[TID]);
    __syncthreads();
    const _Float16* UT = (const _Float16*)(p->ws + WS_UT); u16* ZT = (u16*)(p->ws + WS_ZT); const cf* FS = (const cf*)(p->ws + WS_FS);
    const float* cw = p->in[I_HCW]; const float* cb = p->in[I_HCB]; const float* skip = p->in[I_SKIP];
    const int per = (2048 + nwg - 1) / nwg; const int u1 = (wg + 1) * per < 2048 ? (wg + 1) * per : 2048;
    for (int u = wg * per; u < u1; ++u) {
        const int d = (u >> 1) * 2, b0 = (u & 1) * 2;
        auto sconv4 = [&](int ch, int rb, int t0, float (&o)[4]) { const _Float16* uu = UT + (size_t)ch * R + rb + t0; const uint2 cq = *(const uint2*)uu;
            const float4 c4 = make_float4(pg8::h2f_lo(cq.x), pg8::h2f_hi(cq.x), pg8::h2f_lo(cq.y), pg8::h2f_hi(cq.y));
            const float um = t0 > 0 ? (float)uu[-1] : 0.f, up = t0 + 4 < S ? (float)uu[4] : 0.f, w0 = cw[ch], w1 = cw[3 * D + ch], w2 = cw[6 * D + ch], bb = cb[ch];
            o[0] = um * w0 + c4.x * w1 + c4.y * w2 + bb; o[1] = c4.x * w0 + c4.y * w1 + c4.z * w2 + bb; o[2] = c4.y * w0 + c4.z * w1 + c4.w * w2 + bb; o[3] = c4.z * w0 + c4.w * w1 + up * w2 + bb; };
        const int rbA = b0 * SB + CTX, rbB = rbA + SB;
        float za[2][4][2], zb[2][4][2];
        { int tz = TID; FFT_OPQ(tz);
#pragma unroll
          for (int i = 0; i < 2; ++i) { const int t0 = 4 * tz + 2048 * i; float q0[4], q1[4], q2[4], q3[4]; sconv4(d, rbA, t0, q0); sconv4(d + 1, rbA, t0, q1); sconv4(d, rbB, t0, q2); sconv4(d + 1, rbB, t0, q3);
#pragma unroll
              for (int k = 0; k < 4; ++k) { za[i][k][0] = q0[k]; za[i][k][1] = q1[k]; zb[i][k][0] = q2[k]; zb[i][k][1] = q3[k]; } } }
#pragma unroll 1
        for (int n = 0; n < 2; ++n) {
            int ts = TID; FFT_OPQ(ts);
#pragma unroll
            for (int i = 0; i < 2; ++i)
#pragma unroll
                for (int k = 0; k < 4; ++k) { const int e = fidx(4 * ts) + 2116 * i + k; bufA.set(e, cf{za[i][k][0], za[i][k][1]}); bufB.set(e, cf{zb[i][k][0], zb[i][k][1]}); }
            __syncthreads();
            if (!skipfft) fft_fwd_x2_zp(bufA, bufB, tw, TID);
            const cf* fd = FS + (size_t)(n * 2048 + d) * FS_LD; const cf* fe = fd + FS_LD;
            int tq = TID; FFT_OPQ(tq);
            auto quad = [&](const LdsCf& bf, int p1, int p2, bool z, cf f1d, cf f1e, cf f2d, cf f2e) {
                const cf A1 = bf.get(p1), B1 = bf.get(p1 + 1), A2 = bf.get(p2), B2 = bf.get(p2 + 1);
                const cf Xw = cadd(A1, B1), Xw4 = csub(A1, B1), Xm = cadd(A2, B2), Xn = csub(A2, B2);
                cf Yw, Yn, Ym, Yw4;
                spec_pair(Xw, z ? Xw : Xn, f1d, f1e, Yw, Yn); spec_pair(z ? Xw4 : Xm, Xw4, f2d, f2e, Ym, Yw4); if (z) Yw4 = Ym;
                bf.set(p1, cadd(Yw, Yw4)); bf.set(p1 + 1, csub(Yw, Yw4));
                if (!z) { bf.set(p2, cadd(Ym, Yn)); bf.set(p2 + 1, csub(Ym, Yn)); } };
#pragma unroll
            for (int i = 0; i < 4; ++i) { const int w = tq + 512 * i; const bool z = w == 0; const int p1 = fidx(fpos(w)), p2 = z ? p1 : fidx(fpos(4096 - w));
                const cf f1d = fd[w], f1e = fe[w], f2d = fd[4096 - w], f2e = fe[4096 - w];
                quad(bufA, p1, p2, z, f1d, f1e, f2d, f2e); quad(bufB, p1, p2, z, f1d, f1e, f2d, f2e); }
            if (TID == 0) { const int pp = fidx(fpos(2048)); const cf fdw = fd[2048], few = fe[2048];
                { const cf A = bufA.get(pp), B = bufA.get(pp + 1); cf y1, y2; spec_pair(cadd(A, B), csub(A, B), fdw, few, y1, y2); bufA.set(pp, cadd(y1, y2)); bufA.set(pp + 1, csub(y1, y2)); }
                { const cf A = bufB.get(pp), B = bufB.get(pp + 1); cf y1, y2; spec_pair(cadd(A, B), csub(A, B), fdw, few, y1, y2); bufB.set(pp, cadd(y1, y2)); bufB.set(pp + 1, csub(y1, y2)); } }
            __syncthreads();
            if (!skipfft) fft_inv_x2_zp(bufA, bufB, tw, TID);
            const float sk0 = skip[n * D + d], sk1 = skip[n * D + d + 1];
            int ty = TID; FFT_OPQ(ty);
#pragma unroll
            for (int i = 0; i < 2; ++i) { const int t0 = 4 * ty + 2048 * i; float g0[4], g1[4], g2[4], g3[4]; sconv4((n + 1) * D + d, rbA, t0, g0); sconv4((n + 1) * D + d + 1, rbA, t0, g1); sconv4((n + 1) * D + d, rbB, t0, g2); sconv4((n + 1) * D + d + 1, rbB, t0, g3);
#pragma unroll
                for (int k = 0; k < 4; ++k) { const int e = fidx(4 * ty) + 2116 * i + k; const cf ya = bufA.get(e), yb = bufB.get(e);
                    za[i][k][0] = g0[k] * (ya.x + za[i][k][0] * sk0); za[i][k][1] = g1[k] * (ya.y + za[i][k][1] * sk1);
                    zb[i][k][0] = g2[k] * (yb.x + zb[i][k][0] * sk0); zb[i][k][1] = g3[k] * (yb.y + zb[i][k][1] * sk1); } }
            __syncthreads();
        }
        int to = TID; FFT_OPQ(to);
#pragma unroll
        for (int i = 0; i < 2; ++i) { const int t0 = 4 * to + 2048 * i;
#pragma unroll
            for (int c = 0; c < 2; ++c) {
                *(uint2*)(ZT + (size_t)(d + c) * R + rbA + t0) = make_uint2(pk2(za[i][0][c], za[i][1][c]), pk2(za[i][2][c], za[i][3][c]));
                *(uint2*)(ZT + (size_t)(d + c) * R + rbB + t0) = make_uint2(pk2(zb[i][0][c], zb[i][1][c]), pk2(zb[i][2][c], zb[i][3][c])); } }
    }
}
#endif

#ifndef UP_ALIGN
#define UP_ALIGN true
#endif
#ifndef UP_SP2
#define UP_SP2 true
#endif
#ifndef DN_ALIGN
#define DN_ALIGN true
#endif
#ifndef DN_SP2
#define DN_SP2 true
#endif
#ifndef DN_AUXA
#define DN_AUXA 0
#endif
constexpr int LDS_BYTES = 155648;
constexpr int LDS_MISC = LDS_BYTES - 256;
constexpr int CW_BAR = 4096;
constexpr size_t CTL_ZERO_BYTES = 65536;

__global__ void __launch_bounds__(512, 2) mega_fwd(Ptrs p_unused) {
#define p kargs()
    extern __shared__ __attribute__((aligned(16))) unsigned char lds[];
    const int tid = threadIdx.x; int wg = blockIdx.x, nwg = gridDim.x;
    volatile LAS unsigned* MISC = (volatile LAS unsigned*)((LAS unsigned char*)lds + LDS_MISC);
    if (tid < 64) MISC[tid] = 0u;
    __syncthreads();
    XcdBarrier bar = xcd_barrier_post((unsigned*)(p->ws + WS_CTL) + CW_BAR, MISC + 8);
#define GRID_BAR() do { xcd_barrier(bar); asm volatile("" : "+s"(ws), "+s"(wg), "+s"(nwg)); } while (0)
    PG8_LAS unsigned char* ring = (PG8_LAS unsigned char*)lds;
    unsigned char* ws = p->ws;
#define X ((u16*)(ws + WS_X))
#define HB ((u16*)(ws + WS_HB))
#define ACT ((u16*)(ws + WS_ACT))
#define MOD ((const float*)(ws + WS_MOD))
#define rope ((const float*)(ws + WS_ROPE))

#ifndef NO_PRO
    ph_modp(p, (float*)lds, wg, nwg);
#ifdef PROBE_MODP
    ph_modp(p, (float*)lds, wg, nwg);
#endif
    ph_tables(p, wg, nwg);
    ph_filters(p, (float*)lds, wg, nwg);
#ifdef PROBE_FILT
    ph_filters(p, (float*)lds, wg, nwg);
#endif
    { int t2 = threadIdx.x; asm volatile("" : "+v"(t2)); conv_all(p, (ConvDesc*)(lds + 8 * 64 * 33 * 4), (float*)lds + (t2 >> 6) * (64 * 33), wg * 8 + (t2 >> 6), nwg * 8, t2 & 63, 0, 3, 24, PRO_B1); }
#ifdef PROBE_CONV
    { int t2 = threadIdx.x; asm volatile("" : "+v"(t2)); conv_all(p, (ConvDesc*)(lds + 8 * 64 * 33 * 4), (float*)lds + (t2 >> 6) * (64 * 33), wg * 8 + (t2 >> 6), nwg * 8, t2 & 63, 0, 3, 24, PRO_B1); }
#endif
#endif
#ifdef PROBE_PRO
    GRID_BAR();
    ph_modp(p, (float*)lds, wg, nwg);
    ph_tables(p, wg, nwg);
    ph_filters(p, (float*)lds, wg, nwg);
    { int t2 = threadIdx.x; asm volatile("" : "+v"(t2)); conv_all(p, (ConvDesc*)(lds + 8 * 64 * 33 * 4), (float*)lds + (t2 >> 6) * (64 * 33), wg * 8 + (t2 >> 6), nwg * 8, t2 & 63, 0, 3, 24, PRO_B1); }
#endif
    GRID_BAR();
    ph_modr(p, wg, nwg);
    ph_filter_fft(p, lds, wg, nwg);
#ifdef PROBE_P1
    GRID_BAR();
    ph_modr(p, wg, nwg);
    ph_filter_fft(p, lds, wg, nwg);
    ph_filter_fft256(p, lds, nwg - 1 - wg, nwg);
#endif
#ifdef PROBE_FFFT
    ph_filter_fft(p, lds, wg, nwg);
#endif
    ph_filter_fft256(p, lds, nwg - 1 - wg, nwg);
    GRID_BAR();

    for (int layer = 0; layer < DEPTH; ++layer) {
        const int kind = layer % 3, jm = layer / 3;
#define modl (MOD + (size_t)layer * 5 * 9 * D)
#pragma unroll 1
        for (int f = 0; f < 2; ++f) {
            const int slot = f == 0 ? 0 : 2, lf = layer * 2 + f; const bool lastffn = layer == DEPTH - 1 && f == 1;
            { const float* pg = nullptr; if (f == 1) pg = lastffn ? nullptr : modl + (size_t)(4 * 9 + 3 * 1 + 2) * D; else if (layer > 0) pg = modl - (size_t)5 * 9 * D + (size_t)(4 * 9 + 3 * 2 + 2) * D;
              ph_modulate(p, layer, slot, pg, f == 1 ? 1.0f : 0.5f, wg, nwg, layer == 0 && f == 0, lastffn);
#ifdef PROBE_THIN
              GRID_BAR(); ph_modulate(p, layer, slot, nullptr, 0.f, wg, nwg);
#endif
            }
            GRID_BAR();
            { pg8::Gemm g{HB, (const u16*)(ws + WS_WGU + lf * SZ_WGU), R, 2 * DFF, D}; pg8::UpOrder So; So.init(g.N, nwg, wg, lastffn);
              pg8::gemm_phase<pg8::EpiSwiGLU, pg8::UpOrder, UP_ALIGN, UP_SP2>(ring, g, So, pg8::EpiSwiGLU{ACT}); }
#ifdef PROBE_UP_NOEPI
            GRID_BAR();
            { pg8::Gemm g{HB, (const u16*)(ws + WS_WGU + lf * SZ_WGU), R, 2 * DFF, D}; pg8::UpOrder So; So.init(g.N, nwg, wg, lastffn);
              pg8::gemm_phase<pg8::EpiNever<pg8::EpiSwiGLU>, pg8::UpOrder, UP_ALIGN, UP_SP2>(ring, g, So, pg8::EpiNever<pg8::EpiSwiGLU>{pg8::EpiSwiGLU{ACT}, nwg == 12345}); }
#endif
#ifdef PROBE_UP
            GRID_BAR();
            { pg8::Gemm g{HB, (const u16*)(ws + WS_WGU + lf * SZ_WGU), R, 2 * DFF, D}; pg8::UpOrder So; So.init(g.N, nwg, wg, lastffn);
              pg8::gemm_phase<pg8::EpiSwiGLU, pg8::UpOrder, UP_ALIGN, UP_SP2>(ring, g, So, pg8::EpiSwiGLU{ACT}); }
#endif
#ifndef NO_TAILCONV
            if (!lastffn) {
                const int rem = (68 * 43) % nwg;
                if (wg >= rem) {
                    const int a0 = 3 * (lf + 1); int b0 = a0 + 3, b1 = a0 + 3;
#ifdef TAIL_MIXERS
                    if (f == 1) { const int k2 = (layer + 1) % 3; b0 = k2 == 1 ? 34 : k2 == 2 ? 36 : 24 + 5 * ((layer + 1) / 3); b1 = k2 == 0 ? b0 + 5 : b0 + 2; }
#endif
                    __syncthreads();
                    int t2 = threadIdx.x; asm volatile("" : "+v"(t2));
                    conv_tail((const ConvDesc*)(ws + WS_CTL + CTL_CONVTAB), (float*)lds + (t2 >> 6) * (64 * 33), (wg - rem) * 8 + (t2 >> 6), (nwg - rem) * 8, t2 & 63, a0, a0 + 3, b0, b1);
#ifdef PROBE_TAIL
                    conv_tail((const ConvDesc*)(ws + WS_CTL + CTL_CONVTAB), (float*)lds + (t2 >> 6) * (64 * 33), (wg - rem) * 8 + (t2 >> 6), (nwg - rem) * 8, t2 & 63, a0, a0 + 3, b0, b1);
#endif
                }
            }
#endif
            GRID_BAR();
            { pg8::Gemm g{ACT, (const u16*)(ws + WS_WD + lf * SZ_WD), R, D, DFF}; pg8::ResOrder So; So.init(DFF, nwg, wg, lastffn);
              pg8::gemm_phase<pg8::EpiResGate, pg8::ResOrder, DN_ALIGN, DN_SP2, DN_AUXA>(ring, g, So, pg8::EpiResGate{X, modl, slot, 0.5f, (u16*)(ws + WS_SLAB)}); }
            GRID_BAR();
#ifdef PROBE_DOWN
            { pg8::Gemm g{ACT, (const u16*)(ws + WS_WD + lf * SZ_WD), R, D, DFF}; pg8::ResOrder So; So.init(DFF, nwg, wg, lastffn);
              pg8::gemm_phase<pg8::EpiResGate, pg8::ResOrder, true, true>(ring, g, So, pg8::EpiResGate{X, modl, slot, 0.0f, (u16*)(ws + WS_SLAB)}); }
            GRID_BAR();
#endif
#ifdef PROBE_DOWN_NOEPI
            { pg8::Gemm g{ACT, (const u16*)(ws + WS_WD + lf * SZ_WD), R, D, DFF}; pg8::ResOrder So; So.init(DFF, nwg, wg, lastffn);
              pg8::gemm_phase<pg8::EpiNever<pg8::EpiResGate>, pg8::ResOrder, true, true>(ring, g, So, pg8::EpiNever<pg8::EpiResGate>{pg8::EpiResGate{X, modl, slot, 0.0f, (u16*)(ws + WS_SLAB)}, nwg == 12345}); }
            GRID_BAR();
#endif
            if (f == 0) {
                ph_modulate(p, layer, 1, modl + (size_t)(4 * 9 + 3 * 0 + 2) * D, 0.5f, wg, nwg);
#ifdef PROBE_THIN
                GRID_BAR(); ph_modulate(p, layer, 1, nullptr, 0.f, wg, nwg);
#endif
                GRID_BAR();
                const u16* Ao; const u16* Wo;
                if (kind == 0) {
                    u16* QKVA = (u16*)(ws + WS_QKVA);     u16* QL = (u16*)(ws + WS_QL); u16* CKV = (u16*)(ws + WS_CKV); u16* KR = (u16*)(ws + WS_KR); u16* Q = (u16*)(ws + WS_Q); u16* KN = (u16*)(ws + WS_KN); u16* V = (u16*)(ws + WS_V); u16* O = (u16*)(ws + WS_O);
                    { pg8::Gemm g{HB, (const u16*)(ws + WS_WDQKV) + (size_t)jm * QKVA_LD * D, R, QKVA_LD, D}; pg8::StaticOrder So; So.init(g.M, g.N, nwg, wg);
                      pg8::gemm_phase<pg8::EpiF16, pg8::StaticOrder, true, true>(ring, g, So, pg8::EpiF16{QKVA, QKVA_LD}); }
                    GRID_BAR();
                    ph_mla_norm(p, jm, wg, nwg);
                    GRID_BAR();
                    { pg8::Gemm g{QL, (const u16*)(ws + WS_WUQ) + (size_t)jm * 3072 * 512, R, 3072, 512}; pg8::UpOrder So; So.init(g.N, nwg, wg, layer == DEPTH - 1);
                      pg8::gemm_phase<pg8::EpiRope<0>, pg8::UpOrder, true, true>(ring, g, So, pg8::EpiRope<0>{Q, 3072, rope}); }
                    { pg8::Gemm g{CKV, (const u16*)(ws + WS_WUKV) + (size_t)jm * 4096 * 512, R, 4096, 512}; pg8::StaticOrder So; So.init(g.M, g.N, nwg, nwg - 1 - wg);
                      pg8::gemm_phase<pg8::EpiKV, pg8::StaticOrder, true, true>(ring, g, So, pg8::EpiKV{KN, V}); }
                    GRID_BAR();
#ifdef PROBE_MLAPRE
                    { pg8::Gemm g{HB, (const u16*)(ws + WS_WDQKV) + (size_t)jm * QKVA_LD * D, R, QKVA_LD, D}; pg8::StaticOrder So; So.init(g.M, g.N, nwg, wg);
                      pg8::gemm_phase<pg8::EpiF16, pg8::StaticOrder, true, true>(ring, g, So, pg8::EpiF16{QKVA, QKVA_LD}); }
                    GRID_BAR();
                    ph_mla_norm(p, jm, wg, nwg);
                    GRID_BAR();
                    { pg8::Gemm g{QL, (const u16*)(ws + WS_WUQ) + (size_t)jm * 3072 * 512, R, 3072, 512}; pg8::UpOrder So; So.init(g.N, nwg, wg, layer == DEPTH - 1);
                      pg8::gemm_phase<pg8::EpiRope<0>, pg8::UpOrder, true, true>(ring, g, So, pg8::EpiRope<0>{Q, 3072, rope}); }
                    { pg8::Gemm g{CKV, (const u16*)(ws + WS_WUKV) + (size_t)jm * 4096 * 512, R, 4096, 512}; pg8::StaticOrder So; So.init(g.M, g.N, nwg, nwg - 1 - wg);
                      pg8::gemm_phase<pg8::EpiKV, pg8::StaticOrder, true, true>(ring, g, So, pg8::EpiKV{KN, V}); }
                    GRID_BAR();
#endif
#ifndef NO_NAIVE
#ifdef PROBE_ATTN
#pragma unroll 1
                    for (int rep = 0; rep < 2; ++rep)
#endif
#ifdef PROBE_ATTN_ABL
                    ph_attn_mla<PROBE_ATTN_ABL>(Q, KN, KR, V, O, lds, wg, nwg, layer < DEPTH - 1);
#endif
                    ph_attn_mla(Q, KN, KR, V, O, lds, wg, nwg, layer < DEPTH - 1);
#endif
                    Ao = O; Wo = (const u16*)(ws + WS_WMO) + (size_t)jm * D * D;
                } else if (kind == 1) {
                    u16* UT = (u16*)(ws + WS_UT); u16* ZT = (u16*)(ws + WS_ZT);
                    { pg8::Gemm g{(const u16*)(ws + WS_WHIN), HB, 3 * D, R, D}; pg8::StaticOrder So; So.init(g.M, g.N, nwg, wg);
                      pg8::gemm_phase<pg8::EpiF16, pg8::StaticOrder, true, true>(ring, g, So, pg8::EpiF16{UT, R}); }
#ifdef PROBE_HIN
                    GRID_BAR();
                    { pg8::Gemm g{(const u16*)(ws + WS_WHIN), HB, 3 * D, R, D}; pg8::StaticOrder So; So.init(g.M, g.N, nwg, wg);
                      pg8::gemm_phase<pg8::EpiF16, pg8::StaticOrder, true, true>(ring, g, So, pg8::EpiF16{UT, R}); }
#endif
                    GRID_BAR();
#ifndef NO_NAIVE
#ifdef PROBE_HYF
#pragma unroll 1
                    for (int rep = 0; rep < 2; ++rep)
#endif
#ifdef PROBE_HYF_NOFFT
#pragma unroll 1
                    for (int rep = 0; rep < 2; ++rep)
                    ph_hyena_fft2(p, lds, wg, nwg, rep == 0);
#else
                    ph_hyena_fft2(p, lds, wg, nwg);
#endif
                    ph_hyena_fft256(p, lds, wg, nwg);
#ifdef PROBE_HYC
                    ph_hyena_fft256(p, lds, wg, nwg);
#endif
#endif
                    GRID_BAR();
                    ph_transpose(ZT, HB, (u16*)lds, wg, nwg);
                    Ao = HB; Wo = (const u16*)(ws + WS_WHOUT);
                } else {
                    u16* QKV = (u16*)(ws + WS_QKV); u16* O = (u16*)(ws + WS_WO);
                    { pg8::Gemm g{HB, (const u16*)(ws + WS_WWQKV), R, 2560, D}; pg8::StaticOrder So; So.init(g.M, g.N, nwg, wg);
                      pg8::gemm_phase<pg8::EpiRope<1>, pg8::StaticOrder, true, true>(ring, g, So, pg8::EpiRope<1>{QKV, 2560, rope}); }
                    GRID_BAR();
#ifndef NO_NAIVE
#ifdef PROBE_WIN
#pragma unroll 1
                    for (int rep = 0; rep < 2; ++rep)
#endif
                    ph_attn_win(QKV, p->in[I_SINK], O, lds, wg, nwg);
#endif
                    Ao = O; Wo = (const u16*)(ws + WS_WWO);
                }
                GRID_BAR();
                { pg8::Gemm g{Ao, Wo, R, D, D}; pg8::ResOrder So; So.init(D, nwg, wg, layer == DEPTH - 1);
                  pg8::gemm_phase<pg8::EpiResGate, pg8::ResOrder, true, true>(ring, g, So, pg8::EpiResGate{X, modl, 1, 1.0f, (u16*)(ws + WS_SLAB)}); }
                GRID_BAR();
#ifdef PROBE_WO
                { pg8::Gemm g{Ao, Wo, R, D, D}; pg8::ResOrder So; So.init(D, nwg, wg, layer == DEPTH - 1);
                  pg8::gemm_phase<pg8::EpiResGate, pg8::ResOrder, true, true>(ring, g, So, pg8::EpiResGate{X, modl, 1, 0.0f, (u16*)(ws + WS_SLAB)}); }
                GRID_BAR();
#endif
            }
        }
    }
    ph_final(p, wg, nwg);
#undef p
#undef X
#undef HB
#undef ACT
#undef MOD
#undef rope
#undef modl
}
}

extern "C" void kernel_launch(void* const* d_in, const int* in_sizes, int n_in, void* d_out, int out_size, void* d_ws, size_t ws_size, hipStream_t stream) {
    static int grid = 0;
    if (grid == 0) {
        if (n_in != 35 || ws_size < WS_TOTAL || out_size != NB * S * D) { fprintf(stderr, "kernel_launch: unexpected shapes (n_in %d, ws %zu need %zu, out %d)\n", n_in, ws_size, (size_t)WS_TOTAL, out_size); grid = -1; return; }
        int dev = 0, cus = 0, per_cu = 0;
        if (hipGetDevice(&dev) != hipSuccess || hipDeviceGetAttribute(&cus, hipDeviceAttributeMultiprocessorCount, dev) != hipSuccess || cus <= 0) { fprintf(stderr, "kernel_launch: device query failed\n"); grid = -1; return; }
        if (hipFuncSetAttribute((const void*)mega_fwd, hipFuncAttributeMaxDynamicSharedMemorySize, LDS_BYTES) != hipSuccess) { fprintf(stderr, "kernel_launch: hipFuncSetAttribute failed\n"); grid = -1; return; }
        if (hipOccupancyMaxActiveBlocksPerMultiprocessor(&per_cu, (const void*)mega_fwd, 512, LDS_BYTES) != hipSuccess || per_cu < 1) fprintf(stderr, "kernel_launch: note: occupancy query reports %d workgroups per CU\n", per_cu);
        (void)hipGetLastError();
        grid = cus;
    }
    if (grid < 0) return;
    if (hipMemsetAsync((char*)d_ws + WS_CTL, 0, CTL_ZERO_BYTES, stream) != hipSuccess) { fprintf(stderr, "kernel_launch: memset failed\n"); return; }
    Ptrs p{}; for (int i = 0; i < 35; ++i) p.in[i] = (const float*)d_in[i]; p.out = (float*)d_out; p.ws = (unsigned char*)d_ws;
    hipLaunchKernelGGL(mega_fwd, dim3(grid), dim3(512), LDS_BYTES, stream, p);
    const hipError_t le = hipPeekAtLastError();
    if (le != hipSuccess) fprintf(stderr, "kernel_launch: launch failed: %s\n", hipGetErrorName(le));
}
```
